# Optimizing an MI355X kernel written in HIP

```python
import jax, jax.numpy as jnp
from jax import lax
import numpy as np

D_MODEL = 1024
BATCH = 16
SEQ = 2048
DEPTH = 2

CTX_LEN = 256
GRID_W = 64
EXPAND = 2
D_INNER = EXPAND * D_MODEL
HEAD_DIM = 128
A_WIDTH = D_INNER // 2
N_Q_HEADS = A_WIDTH // HEAD_DIM
N_KV_HEADS = 2
Q_PER_KV = N_Q_HEADS // N_KV_HEADS
KV_WIDTH = N_KV_HEADS * HEAD_DIM
B_WIDTH = D_INNER - A_WIDTH
CHUNK = 128
B_GROUP_DIM = 128
B_GROUPS = B_WIDTH // B_GROUP_DIM
C_GROUP_DIM = 128
C_GROUPS = D_INNER // C_GROUP_DIM
Q_BLOCK = 128
ROPE_THETA = 10000.0
EVEN_SPLITS = (A_WIDTH, A_WIDTH + KV_WIDTH, A_WIDTH + 2 * KV_WIDTH,
               A_WIDTH + 2 * KV_WIDTH + B_WIDTH, A_WIDTH + 2 * KV_WIDTH + 2 * B_WIDTH)
EVEN_IN = A_WIDTH + 2 * KV_WIDTH + 2 * B_WIDTH + D_INNER
ODD_IN = 2 * D_INNER
N_EVEN = (DEPTH + 1) // 2
N_ODD = DEPTH // 2
ALPHA = (2 * DEPTH) ** 0.25
BETA = (8 * DEPTH) ** -0.25
EPS = 1e-6
MOD_INIT = 0.5

kernel_name = "hybrid_dit_gqa_gmlp_fnet_prefix"


def layer_norm(x, g=None, b=None):
    x32 = x.astype(jnp.float32)
    mu = jnp.mean(x32, axis=-1, keepdims=True)
    var = jnp.mean(jnp.square(x32 - mu), axis=-1, keepdims=True)
    y = (x32 - mu) * lax.rsqrt(var + EPS)
    if g is not None:
        y = y * g.astype(jnp.float32) + b.astype(jnp.float32)
    return y.astype(x.dtype)


def rms_norm(x, g):
    x32 = x.astype(jnp.float32)
    y = x32 * lax.rsqrt(jnp.mean(jnp.square(x32), axis=-1, keepdims=True) + EPS)
    return (y * g.astype(jnp.float32)).astype(x.dtype)


def adaln(cond, w_mod, b_mod):
    h = jax.nn.silu(cond) @ w_mod + b_mod
    return jnp.split(h, 3, axis=-1)


def modulate(x, shift, scale):
    return layer_norm(x) * (1.0 + scale) + shift


def axial_rope_tables(n_tokens, dtype):
    rows = n_tokens // GRID_W
    r, cl = jnp.meshgrid(jnp.arange(rows), jnp.arange(GRID_W), indexing="ij")
    row = r.reshape(-1).astype(jnp.float32)
    col = cl.reshape(-1).astype(jnp.float32)
    n_pairs_axis = HEAD_DIM // 4
    inv_freq = ROPE_THETA ** (-jnp.arange(n_pairs_axis, dtype=jnp.float32) / n_pairs_axis)
    ang = jnp.concatenate([row[:, None] * inv_freq, col[:, None] * inv_freq], axis=-1)
    return jnp.cos(ang).astype(dtype), jnp.sin(ang).astype(dtype)


def apply_rope(x, cos, sin):
    half = HEAD_DIM // 2
    x1, x2 = x[..., :half], x[..., half:]
    cs, sn = cos[:, None, :], sin[:, None, :]
    return jnp.concatenate([x1 * cs - x2 * sn, x2 * cs + x1 * sn], axis=-1)


def attend_blocked(q, k, v):
    bsz, t = q.shape[0], q.shape[1]
    nblk = t // Q_BLOCK
    qb = q.reshape(bsz, nblk, Q_BLOCK, N_KV_HEADS, Q_PER_KV, HEAD_DIM).transpose(1, 0, 2, 3, 4, 5)
    scale = HEAD_DIM ** -0.5

    def one_block(qblk):
        s = jnp.einsum("bqkgd,bskd->bkgqs", qblk, k).astype(jnp.float32) * scale
        p = jax.nn.softmax(s, axis=-1).astype(v.dtype)
        return jnp.einsum("bkgqs,bskd->bqkgd", p, v)

    o = lax.map(one_block, qb)
    return o.transpose(1, 0, 2, 3, 4, 5).reshape(bsz, t, N_Q_HEADS * HEAD_DIM)


def chunk_spatial_gate(u, v, ln_g, ln_b, w_s, b_s):
    bsz, t = v.shape[0], v.shape[1]
    vn = layer_norm(v, ln_g, ln_b).reshape(bsz, t // CHUNK, CHUNK, B_GROUPS, B_GROUP_DIM)
    mixed = jnp.einsum("gpq,bnqgc->bnpgc", w_s, vn) + b_s.T[:, :, None]
    return u * mixed.reshape(bsz, t, B_WIDTH)


def fourier_mix(h):
    bsz, t, w = h.shape
    hg = h.astype(jnp.float32).reshape(bsz, t, C_GROUPS, C_GROUP_DIM)
    f = jnp.fft.fft2(hg, axes=(1, 3), norm="ortho").real
    return f.reshape(bsz, t, w).astype(h.dtype)


def even_project(h, w_in, q_g, k_g):
    bsz, t = h.shape[0], h.shape[1]
    z = h @ w_in
    q, k, v, bu, bv, g = jnp.split(z, EVEN_SPLITS, axis=-1)
    q = rms_norm(q.reshape(bsz, t, N_Q_HEADS, HEAD_DIM), q_g)
    k = rms_norm(k.reshape(bsz, t, N_KV_HEADS, HEAD_DIM), k_g)
    v = v.reshape(bsz, t, N_KV_HEADS, HEAD_DIM)
    return q, k, v, jax.nn.gelu(bu), jax.nn.gelu(bv), g


def even_layer(x, ctx, c, c_ctx, w_mod, b_mod, post_g, post_b, w_in, q_g, k_g,
               v_ln_g, v_ln_b, w_s, b_s, w_out, cos, sin, update_ctx):
    sh, sc, gt = adaln(c, w_mod, b_mod)
    sh_c, sc_c, gt_c = adaln(c_ctx, w_mod, b_mod)
    m = modulate(x, sh[:, None], sc[:, None])
    mc = modulate(ctx, sh_c, sc_c)
    q, k, v, bu, bv, g = even_project(m, w_in, q_g, k_g)
    qc, kc, vc, buc, bvc, gc = even_project(mc, w_in, q_g, k_g)
    q = apply_rope(q, cos, sin)
    k = apply_rope(k, cos, sin)
    a = attend_blocked(q, jnp.concatenate([kc, k], axis=1), jnp.concatenate([vc, v], axis=1))
    s = chunk_spatial_gate(bu, bv, v_ln_g, v_ln_b, w_s, b_s)
    y = (jnp.concatenate([a, s], axis=-1) * jax.nn.silu(g)) @ w_out
    x_new = layer_norm(ALPHA * x + gt[:, None] * y, post_g, post_b)
    if update_ctx:
        ac = attend_blocked(qc, kc, vc)
        scx = chunk_spatial_gate(buc, bvc, v_ln_g, v_ln_b, w_s, b_s)
        yc = (jnp.concatenate([ac, scx], axis=-1) * jax.nn.silu(gc)) @ w_out
        ctx = layer_norm(ALPHA * ctx + gt_c * yc, post_g, post_b)
    return x_new, ctx


def odd_stream(h_in, shift, scale, gate, w_in, w_out, post_g, post_b):
    m = modulate(h_in, shift, scale)
    hb, g = jnp.split(m @ w_in, 2, axis=-1)
    y = (fourier_mix(hb) * jax.nn.silu(g)) @ w_out
    return layer_norm(ALPHA * h_in + gate * y, post_g, post_b)


def odd_layer(x, ctx, c, c_ctx, w_mod, b_mod, post_g, post_b, w_in, w_out, update_ctx):
    sh, sc, gt = adaln(c, w_mod, b_mod)
    x_new = odd_stream(x, sh[:, None], sc[:, None], gt[:, None], w_in, w_out, post_g, post_b)
    if update_ctx:
        sh_c, sc_c, gt_c = adaln(c_ctx, w_mod, b_mod)
        ctx = odd_stream(ctx, sh_c, sc_c, gt_c, w_in, w_out, post_g, post_b)
    return x_new, ctx


def setup_inputs(seed: int = 0) -> dict:
    key = jax.random.key(seed)
    ks = jax.random.split(key, 20)
    f32 = jnp.float32
    nrm = lambda k, shape, s: jax.random.normal(k, shape, f32) * s
    return {
        "x": nrm(ks[0], (BATCH, SEQ, D_MODEL), 1.0),
        "c": nrm(ks[1], (BATCH, D_MODEL), 1.0),
        "ctx": nrm(ks[2], (BATCH, CTX_LEN, D_MODEL), 1.0),
        "c_ctx": nrm(ks[3], (D_MODEL,), 1.0),
        "w_mod": nrm(ks[4], (DEPTH, D_MODEL, 3 * D_MODEL), MOD_INIT * D_MODEL ** -0.5),
        "b_mod": nrm(ks[5], (DEPTH, 3 * D_MODEL), 0.01),
        "post_ln_g": 1.0 + nrm(ks[6], (DEPTH, D_MODEL), 0.01),
        "post_ln_b": nrm(ks[7], (DEPTH, D_MODEL), 0.01),
        "even_w_in": nrm(ks[8], (N_EVEN, D_MODEL, EVEN_IN), D_MODEL ** -0.5),
        "even_q_norm": 1.0 + nrm(ks[9], (N_EVEN, HEAD_DIM), 0.01),
        "even_k_norm": 1.0 + nrm(ks[10], (N_EVEN, HEAD_DIM), 0.01),
        "even_v_ln_g": 1.0 + nrm(ks[11], (N_EVEN, B_WIDTH), 0.01),
        "even_v_ln_b": nrm(ks[12], (N_EVEN, B_WIDTH), 0.01),
        "even_w_s": nrm(ks[13], (N_EVEN, B_GROUPS, CHUNK, CHUNK), CHUNK ** -0.5),
        "even_b_s": 1.0 + nrm(ks[14], (N_EVEN, B_GROUPS, CHUNK), 0.01),
        "even_w_out": nrm(ks[15], (N_EVEN, D_INNER, D_MODEL), BETA * D_INNER ** -0.5),
        "odd_w_in": nrm(ks[16], (N_ODD, D_MODEL, ODD_IN), D_MODEL ** -0.5),
        "odd_w_out": nrm(ks[17], (N_ODD, D_INNER, D_MODEL), BETA * D_INNER ** -0.5),
    }


def reference(x, c, ctx, c_ctx, w_mod, b_mod, post_ln_g, post_ln_b, even_w_in, even_q_norm,
              even_k_norm, even_v_ln_g, even_v_ln_b, even_w_s, even_b_s, even_w_out,
              odd_w_in, odd_w_out):
    cos, sin = axial_rope_tables(x.shape[1], x.dtype)
    for l in range(DEPTH):
        update_ctx = l < DEPTH - 1
        i = l // 2
        if l % 2 == 0:
            x, ctx = even_layer(x, ctx, c, c_ctx, w_mod[l], b_mod[l], post_ln_g[l], post_ln_b[l],
                                even_w_in[i], even_q_norm[i], even_k_norm[i], even_v_ln_g[i],
                                even_v_ln_b[i], even_w_s[i], even_b_s[i], even_w_out[i],
                                cos, sin, update_ctx)
        else:
            x, ctx = odd_layer(x, ctx, c, c_ctx, w_mod[l], b_mod[l], post_ln_g[l], post_ln_b[l],
                               odd_w_in[i], odd_w_out[i], update_ctx)
    return x
```

```cpp
#include <hip/hip_runtime.h>
#include <hip/hip_cooperative_groups.h>
#include <cstdio>
#include <cstdint>
namespace cg = cooperative_groups;

typedef unsigned short bf16_t;
using bf16x8 = __attribute__((ext_vector_type(8))) short;
using s16x4  = __attribute__((ext_vector_type(4))) short;
using f32x16 = __attribute__((ext_vector_type(16))) float;
using u32x4  = __attribute__((ext_vector_type(4))) unsigned;
using u32x2  = __attribute__((ext_vector_type(2))) unsigned;

constexpr int DM = 1024, NB = 16, SEQ = 2048, CTXL = 256, SKV = SEQ + CTXL;
constexpr int NTOK = NB * SEQ;
constexpr int NCTX = NB * CTXL;
constexpr int EVEN_IN = 5632, ODD_IN = 4096, DIN = 2048;
constexpr float ALPHA = 1.4142135623730951f;
constexpr float EPS = 1e-6f;

constexpr size_t MiB = 1ull << 20;
constexpr size_t OFF_WT_EIN = 0, OFF_WT_EOUT = 11 * MiB, OFF_WT_OIN = 15 * MiB, OFF_WT_OOUT = 23 * MiB;
constexpr size_t OFF_TAB_C = 27 * MiB, OFF_TAB_S = 30 * MiB, OFF_SMALL = 33 * MiB;
constexpr size_t OFF_CDM = OFF_SMALL, OFF_CDP = OFF_SMALL + 64 * 1024, OFF_WSB = OFF_SMALL + 128 * 1024;
constexpr size_t OFF_ROPE = OFF_SMALL + 384 * 1024, OFF_MOD = OFF_SMALL + 512 * 1024, OFF_XM = OFF_SMALL + 1024 * 1024;
constexpr size_t OFF_M0 = 36 * MiB, OFF_MC = 100 * MiB;
constexpr size_t OFF_SG = 108 * MiB;
constexpr size_t OFF_Q = 236 * MiB, OFF_BU = 300 * MiB;
constexpr size_t OFF_KALL = 364 * MiB, OFF_VALL = 382 * MiB, OFF_BV = 400 * MiB;
constexpr size_t OFF_F = 364 * MiB, OFF_RV = 428 * MiB;
constexpr size_t WS_NEED = 492 * MiB;

struct Params {
  const float *x, *c, *ctx, *c_ctx, *w_mod, *b_mod, *post_g, *post_b, *e_w_in, *e_qn, *e_kn, *e_vg, *e_vb, *e_ws, *e_bs,
      *e_w_out, *o_w_in, *o_w_out;
  float* out;
  char* ws;
  long pad_;
};

typedef float f32x2_t __attribute__((ext_vector_type(2)));
typedef __bf16 bf16x2_t __attribute__((ext_vector_type(2)));
__device__ __forceinline__ unsigned cvtpk(float lo, float hi) {
  f32x2_t v = {lo, hi}; bf16x2_t h = __builtin_convertvector(v, bf16x2_t); return __builtin_bit_cast(unsigned, h);
}
__device__ __forceinline__ int tid_fresh() { int t = (int)__builtin_amdgcn_workitem_id_x(); asm volatile("" : "+v"(t)); return t; }
__device__ __forceinline__ float bf_lo(unsigned w) { return __uint_as_float(w << 16); }
__device__ __forceinline__ float bf_hi(unsigned w) { return __uint_as_float(w & 0xffff0000u); }
__device__ __forceinline__ bf16_t f2bf(float x) { return (bf16_t)(cvtpk(x, 0.f) & 0xffffu); }
__device__ __forceinline__ float bf2f(bf16_t h) { return __uint_as_float(((unsigned)h) << 16); }
__device__ __forceinline__ int crow(int r, int hi) { return (r & 3) + 8 * (r >> 2) + 4 * hi; }
__device__ __forceinline__ float wave_sum(float v) {
#pragma unroll
  for (int o = 32; o >= 1; o >>= 1) v += __shfl_xor(v, o);
  return v;
}
__device__ __forceinline__ float silu_f(float x) { return x * __builtin_amdgcn_rcpf(1.f + __expf(-x)); }
__device__ __forceinline__ float gelu_tanh_f(float x) {
  const float u = 0.7978845608028654f * (x + 0.044715f * x * x * x);
  const float t = 1.f - 2.f * __builtin_amdgcn_rcpf(__expf(2.f * u) + 1.f);
  return 0.5f * x * (1.f + t);
}
__device__ __forceinline__ int logical_block() {
  const int g = gridDim.x, b = blockIdx.x;
  return (g & 7) ? b : (b & 7) * (g >> 3) + (b >> 3);
}

constexpr int LDS_ROWB = 144;
constexpr int LDS_A = 256 * LDS_ROWB;
constexpr int LDS_B = 128 * LDS_ROWB;
constexpr int LDS_STAGE = LDS_A + LDS_B;
constexpr int L2_A = 256 * LDS_ROWB;
constexpr int L2_STAGE = 2 * L2_A;
constexpr int LDS_RED = 2 * L2_STAGE;
constexpr int SMEM_BYTES = LDS_RED + 2048 + 2048;

struct LdPlain {
  const bf16_t* p; size_t rs;
  __device__ __forceinline__ u32x4 ld(int kt, int i) const { return *(const u32x4*)(p + (size_t)i * rs + kt * 64); }
};
__device__ __forceinline__ LdPlain mkPlain(const bf16_t* base, int ld) {
  const int tid = tid_fresh();
  LdPlain l; l.p = base + (size_t)(tid >> 3) * ld + (tid & 7) * 8; l.rs = (size_t)64 * ld; return l;
}
struct LdSplit {
  const bf16_t* p0; const bf16_t* p1; size_t rs; int kts;
  __device__ __forceinline__ u32x4 ld(int kt, int i) const {
    const bf16_t* q = (kt < kts) ? (p0 + kt * 64) : (p1 + (kt - kts) * 64);
    return *(const u32x4*)(q + (size_t)i * rs);
  }
};
__device__ __forceinline__ LdSplit mkSplit(const bf16_t* b0, const bf16_t* b1, int ld, int kts) {
  const int tid = tid_fresh(); const size_t o = (size_t)(tid >> 3) * ld + (tid & 7) * 8;
  LdSplit l; l.p0 = b0 + o; l.p1 = b1 + o; l.rs = (size_t)64 * ld; l.kts = kts; return l;
}
struct LdFold {
  const bf16_t* f; const bf16_t* r; size_t rs; float sg;
  __device__ __forceinline__ u32x4 ld(int kt, int i) const {
    const u32x4 a = *(const u32x4*)(f + (size_t)i * rs + kt * 64);
    const u32x4 b = *(const u32x4*)(r + (size_t)i * rs + kt * 64);
    u32x4 o;
    o[0] = cvtpk(bf_lo(a[0]) + sg * bf_lo(b[0]), bf_hi(a[0]) + sg * bf_hi(b[0]));
    o[1] = cvtpk(bf_lo(a[1]) + sg * bf_lo(b[1]), bf_hi(a[1]) + sg * bf_hi(b[1]));
    o[2] = cvtpk(bf_lo(a[2]) + sg * bf_lo(b[2]), bf_hi(a[2]) + sg * bf_hi(b[2]));
    o[3] = cvtpk(bf_lo(a[3]) + sg * bf_lo(b[3]), bf_hi(a[3]) + sg * bf_hi(b[3]));
    return o;
  }
};
__device__ __forceinline__ LdFold mkFold(const bf16_t* f, const bf16_t* r, int ld, float sg) {
  const int tid = tid_fresh(); const size_t o = (size_t)(tid >> 3) * ld + (tid & 7) * 8;
  LdFold l; l.f = f + o; l.r = r + o; l.rs = (size_t)64 * ld; l.sg = sg; return l;
}

template <class LA, class LB>
__device__ __forceinline__ void gemm_mainloop(const LA& la, const LB& lb, int KT, char* smem, f32x16 (&acc)[2][2]) {
  const int tid = tid_fresh(), wid = tid >> 6, lane = tid & 63, r32 = lane & 31, hi = lane >> 5, wm = wid >> 1, wn = wid & 1;
#pragma unroll
  for (int mi = 0; mi < 2; ++mi)
#pragma unroll
    for (int nj = 0; nj < 2; ++nj)
#pragma unroll
      for (int r = 0; r < 16; ++r) acc[mi][nj][r] = 0.f;
  const int st_off = (tid >> 3) * LDS_ROWB + (tid & 7) * 16;
  const int a_rd = (wm * 64 + r32) * LDS_ROWB + hi * 16;
  const int b_rd = LDS_A + (wn * 32 + r32) * LDS_ROWB + hi * 16;
  u32x4 ra0, ra1, ra2, ra3, rb0, rb1;
  ra0 = la.ld(0, 0); ra1 = la.ld(0, 1); ra2 = la.ld(0, 2); ra3 = la.ld(0, 3); rb0 = lb.ld(0, 0); rb1 = lb.ld(0, 1);
  {
    char* s = smem + st_off;
    *(u32x4*)(s) = ra0; *(u32x4*)(s + 64 * LDS_ROWB) = ra1; *(u32x4*)(s + 128 * LDS_ROWB) = ra2; *(u32x4*)(s + 192 * LDS_ROWB) = ra3;
    *(u32x4*)(s + LDS_A) = rb0; *(u32x4*)(s + LDS_A + 64 * LDS_ROWB) = rb1;
  }
  __syncthreads();
#define GEMM_COMPUTE(SB)                                                                              \
  _Pragma("unroll") for (int kk = 0; kk < 4; ++kk) {                                                  \
    const bf16x8 a0 = *(const bf16x8*)((SB) + a_rd + kk * 32);                                        \
    const bf16x8 a1 = *(const bf16x8*)((SB) + a_rd + 32 * LDS_ROWB + kk * 32);                        \
    const bf16x8 b0 = *(const bf16x8*)((SB) + b_rd + kk * 32);                                        \
    const bf16x8 b1 = *(const bf16x8*)((SB) + b_rd + 64 * LDS_ROWB + kk * 32);                        \
    acc[0][0] = __builtin_amdgcn_mfma_f32_32x32x16_bf16(b0, a0, acc[0][0], 0, 0, 0);                  \
    acc[0][1] = __builtin_amdgcn_mfma_f32_32x32x16_bf16(b1, a0, acc[0][1], 0, 0, 0);                  \
    acc[1][0] = __builtin_amdgcn_mfma_f32_32x32x16_bf16(b0, a1, acc[1][0], 0, 0, 0);                  \
    acc[1][1] = __builtin_amdgcn_mfma_f32_32x32x16_bf16(b1, a1, acc[1][1], 0, 0, 0);                  \
  }
#define GEMM_LOAD(KT_) do { ra0 = la.ld((KT_), 0); ra1 = la.ld((KT_), 1); ra2 = la.ld((KT_), 2); ra3 = la.ld((KT_), 3); rb0 = lb.ld((KT_), 0); rb1 = lb.ld((KT_), 1); } while (0)
#define GEMM_WRITE(ST) do { char* s = smem + (ST) * LDS_STAGE + st_off;                                \
    *(u32x4*)(s) = ra0; *(u32x4*)(s + 64 * LDS_ROWB) = ra1; *(u32x4*)(s + 128 * LDS_ROWB) = ra2; *(u32x4*)(s + 192 * LDS_ROWB) = ra3; \
    *(u32x4*)(s + LDS_A) = rb0; *(u32x4*)(s + LDS_A + 64 * LDS_ROWB) = rb1; } while (0)
#pragma unroll 1
  for (int kt = 0; kt < KT; kt += 2) {
    GEMM_LOAD(kt + 1);
    GEMM_COMPUTE(smem);
    GEMM_WRITE(1);
    __syncthreads();
    GEMM_LOAD(kt + 2 < KT ? kt + 2 : kt);
    GEMM_COMPUTE(smem + LDS_STAGE);
    GEMM_WRITE(0);
    __syncthreads();
  }
#undef GEMM_COMPUTE
#undef GEMM_LOAD
#undef GEMM_WRITE
}

template <class LA, class LB>
__device__ __forceinline__ void gemm2(const LA& la, const LB& lb, int KT, char* smem, f32x16 (&acc)[2][4]) {
  const int tid = tid_fresh(), wid = tid >> 6, lane = tid & 63, r32 = lane & 31, hi = lane >> 5, wm = wid >> 1, wn = wid & 1;
#pragma unroll
  for (int mi = 0; mi < 2; ++mi)
#pragma unroll
    for (int nj = 0; nj < 4; ++nj)
#pragma unroll
      for (int r = 0; r < 16; ++r) acc[mi][nj][r] = 0.f;
  const int st_off = (tid >> 3) * LDS_ROWB + (tid & 7) * 16;
  const int a_rd = (wm * 64 + r32) * LDS_ROWB + hi * 16;
  const int b_rd = L2_A + (wn * 128 + r32) * LDS_ROWB + hi * 16;
  u32x4 xa0, xa1, xa2, xa3, xb0, xb1, xb2, xb3, ya0, ya1, ya2, ya3, yb0, yb1, yb2, yb3;
#define G2_LOADX(KT_) do { xa0 = la.ld((KT_), 0); xa1 = la.ld((KT_), 1); xa2 = la.ld((KT_), 2); xa3 = la.ld((KT_), 3); xb0 = lb.ld((KT_), 0); xb1 = lb.ld((KT_), 1); xb2 = lb.ld((KT_), 2); xb3 = lb.ld((KT_), 3); } while (0)
#define G2_LOADY(KT_) do { ya0 = la.ld((KT_), 0); ya1 = la.ld((KT_), 1); ya2 = la.ld((KT_), 2); ya3 = la.ld((KT_), 3); yb0 = lb.ld((KT_), 0); yb1 = lb.ld((KT_), 1); yb2 = lb.ld((KT_), 2); yb3 = lb.ld((KT_), 3); } while (0)
#define G2_W2(ST, P, R0, R1, O0, O1) do { char* s_ = smem + (ST) * L2_STAGE + st_off; *(u32x4*)(s_ + (O0)) = P##R0; *(u32x4*)(s_ + (O1)) = P##R1; } while (0)
#define G2_WRITE(ST, P) do { G2_W2(ST, P, a0, a1, 0, 64 * LDS_ROWB); G2_W2(ST, P, a2, a3, 128 * LDS_ROWB, 192 * LDS_ROWB); \
    G2_W2(ST, P, b0, b1, L2_A, L2_A + 64 * LDS_ROWB); G2_W2(ST, P, b2, b3, L2_A + 128 * LDS_ROWB, L2_A + 192 * LDS_ROWB); } while (0)
#define G2_STEP(SB, kk) do {                                                                          \
    const bf16x8 a0 = *(const bf16x8*)((SB) + a_rd + (kk) * 32);                                      \
    const bf16x8 a1 = *(const bf16x8*)((SB) + a_rd + 32 * LDS_ROWB + (kk) * 32);                      \
    _Pragma("unroll") for (int nj = 0; nj < 4; ++nj) {                                                \
      const bf16x8 b_ = *(const bf16x8*)((SB) + b_rd + nj * 32 * LDS_ROWB + (kk) * 32);               \
      acc[0][nj] = __builtin_amdgcn_mfma_f32_32x32x16_bf16(b_, a0, acc[0][nj], 0, 0, 0);              \
      acc[1][nj] = __builtin_amdgcn_mfma_f32_32x32x16_bf16(b_, a1, acc[1][nj], 0, 0, 0);              \
    } } while (0)
#define G2_COMPUTE_W(SB, ST, P) do {                                                                  \
    G2_STEP(SB, 0); G2_W2(ST, P, a0, a1, 0, 64 * LDS_ROWB);                                           \
    G2_STEP(SB, 1); G2_W2(ST, P, a2, a3, 128 * LDS_ROWB, 192 * LDS_ROWB);                             \
    G2_STEP(SB, 2); G2_W2(ST, P, b0, b1, L2_A, L2_A + 64 * LDS_ROWB);                                 \
    G2_STEP(SB, 3); G2_W2(ST, P, b2, b3, L2_A + 128 * LDS_ROWB, L2_A + 192 * LDS_ROWB); } while (0)
  G2_LOADX(0); G2_LOADY(1);
  G2_WRITE(0, x);
  __syncthreads();
  G2_LOADX(2 < KT ? 2 : 0);
#pragma unroll 1
  for (int kt = 0; kt < KT; kt += 2) {
    G2_COMPUTE_W(smem, 1, y);
    __syncthreads();
    G2_LOADY(kt + 3 < KT ? kt + 3 : KT - 1);
    G2_COMPUTE_W(smem + L2_STAGE, 0, x);
    __syncthreads();
    G2_LOADX(kt + 4 < KT ? kt + 4 : KT - 2);
  }
#undef G2_LOADX
#undef G2_LOADY
#undef G2_WRITE
#undef G2_W2
#undef G2_STEP
#undef G2_COMPUTE_W
}
template <class F>
__device__ __forceinline__ void epi2_foreach(const f32x16 (&acc)[2][4], F&& f) {
  const int tid = tid_fresh(), wid = tid >> 6, lane = tid & 63, r32 = lane & 31, hi = lane >> 5, wm = wid >> 1, wn = wid & 1;
#pragma unroll
  for (int mi = 0; mi < 2; ++mi)
#pragma unroll
    for (int nj = 0; nj < 4; ++nj)
#pragma unroll
      for (int q = 0; q < 4; ++q)
        f(wm * 64 + mi * 32 + r32, wn * 128 + nj * 32 + q * 8 + hi * 4, acc[mi][nj][4 * q + 0], acc[mi][nj][4 * q + 1],
          acc[mi][nj][4 * q + 2], acc[mi][nj][4 * q + 3]);
}

template <class F>
__device__ __forceinline__ void epi_foreach(const f32x16 (&acc)[2][2], F&& f) {
  const int tid = tid_fresh(), wid = tid >> 6, lane = tid & 63, r32 = lane & 31, hi = lane >> 5, wm = wid >> 1, wn = wid & 1;
#pragma unroll
  for (int mi = 0; mi < 2; ++mi)
#pragma unroll
    for (int nj = 0; nj < 2; ++nj)
#pragma unroll
      for (int q = 0; q < 4; ++q)
        f(wm * 64 + mi * 32 + r32, nj * 64 + wn * 32 + q * 8 + hi * 4, acc[mi][nj][4 * q + 0], acc[mi][nj][4 * q + 1],
          acc[mi][nj][4 * q + 2], acc[mi][nj][4 * q + 3]);
}
__device__ __forceinline__ void st_bf4(bf16_t* p, float a, float b, float c, float d) {
  u32x2 w = {cvtpk(a, b), cvtpk(c, d)}; *(u32x2*)p = w;
}

__device__ __forceinline__ void tr_tile(const float* src, bf16_t* dst, int K, int N, int kt, int nt, float* tile) {
  const int tid = tid_fresh(), k0 = kt * 64, n0 = nt * 64;
#pragma unroll
  for (int j = 0; j < 8; ++j) { const int e = j * 512 + tid, r = e >> 6, c = e & 63; tile[r * 65 + c] = src[(size_t)(k0 + r) * N + n0 + c]; }
  __syncthreads();
  const int rn = tid >> 3, ck = (tid & 7) * 8;
  const float v0 = tile[(ck + 0) * 65 + rn], v1 = tile[(ck + 1) * 65 + rn], v2 = tile[(ck + 2) * 65 + rn], v3 = tile[(ck + 3) * 65 + rn];
  const float v4 = tile[(ck + 4) * 65 + rn], v5 = tile[(ck + 5) * 65 + rn], v6 = tile[(ck + 6) * 65 + rn], v7 = tile[(ck + 7) * 65 + rn];
  u32x4 w = {cvtpk(v0, v1), cvtpk(v2, v3), cvtpk(v4, v5), cvtpk(v6, v7)};
  *(u32x4*)(dst + (size_t)(n0 + rn) * K + k0 + ck) = w;
  __syncthreads();
}

__device__ __forceinline__ void phase0(const Params& p, char* smem) {
  const int tid = tid_fresh(), G = gridDim.x, bid = blockIdx.x;
  char* ws = p.ws;
  {
    float* s = (float*)smem;
    float* part = (float*)(smem + 17 * 1024 * 4);
    float* MOD = (float*)(ws + OFF_MOD);
    for (int u = bid; u < 96; u += G) {
      const int l = u / 48, j0 = (u % 48) * 64;
      for (int e = tid; e < 17 * 1024; e += 512) { const int r = e >> 10, k = e & 1023; const float cv = (r < 16) ? p.c[r * 1024 + k] : p.c_ctx[k]; s[e] = silu_f(cv); }
      __syncthreads();
      const int col = tid & 63, ks = tid >> 6;
      float a0 = 0, a1 = 0, a2 = 0, a3 = 0, a4 = 0, a5 = 0, a6 = 0, a7 = 0, a8 = 0, a9 = 0, a10 = 0, a11 = 0, a12 = 0, a13 = 0, a14 = 0, a15 = 0, a16 = 0;
      const float* w = p.w_mod + (size_t)l * 1024 * 3072 + j0 + col;
#pragma unroll 16
      for (int k = ks * 128; k < ks * 128 + 128; ++k) {
        const float wv = w[(size_t)k * 3072];
        a0 += s[0 * 1024 + k] * wv; a1 += s[1 * 1024 + k] * wv; a2 += s[2 * 1024 + k] * wv; a3 += s[3 * 1024 + k] * wv;
        a4 += s[4 * 1024 + k] * wv; a5 += s[5 * 1024 + k] * wv; a6 += s[6 * 1024 + k] * wv; a7 += s[7 * 1024 + k] * wv;
        a8 += s[8 * 1024 + k] * wv; a9 += s[9 * 1024 + k] * wv; a10 += s[10 * 1024 + k] * wv; a11 += s[11 * 1024 + k] * wv;
        a12 += s[12 * 1024 + k] * wv; a13 += s[13 * 1024 + k] * wv; a14 += s[14 * 1024 + k] * wv; a15 += s[15 * 1024 + k] * wv;
        a16 += s[16 * 1024 + k] * wv;
      }
      float* pp = part + ks * 17 * 64 + col;
      pp[0 * 64] = a0; pp[1 * 64] = a1; pp[2 * 64] = a2; pp[3 * 64] = a3; pp[4 * 64] = a4; pp[5 * 64] = a5; pp[6 * 64] = a6; pp[7 * 64] = a7;
      pp[8 * 64] = a8; pp[9 * 64] = a9; pp[10 * 64] = a10; pp[11 * 64] = a11; pp[12 * 64] = a12; pp[13 * 64] = a13; pp[14 * 64] = a14; pp[15 * 64] = a15;
      pp[16 * 64] = a16;
      __syncthreads();
      for (int e = tid; e < 17 * 64; e += 512) {
        const int r = e >> 6, cc = e & 63;
        float t = p.b_mod[l * 3072 + j0 + cc];
#pragma unroll
        for (int q = 0; q < 8; ++q) t += part[q * 17 * 64 + r * 64 + cc];
        MOD[(size_t)(l * 17 + r) * 3072 + j0 + cc] = t;
      }
      __syncthreads();
    }
  }
  {
    float* tile = (float*)smem;
    constexpr int T0 = 16 * 88, T1 = 32 * 16, T2 = 16 * 64, T3 = 32 * 16;
    for (int u = bid; u < T0 + T1 + T2 + T3; u += G) {
      if (u < T0) tr_tile(p.e_w_in, (bf16_t*)(ws + OFF_WT_EIN), 1024, EVEN_IN, u / 88, u % 88, tile);
      else if (u < T0 + T1) { const int v = u - T0; tr_tile(p.e_w_out, (bf16_t*)(ws + OFF_WT_EOUT), 2048, 1024, v / 16, v % 16, tile); }
      else if (u < T0 + T1 + T2) { const int v = u - T0 - T1; tr_tile(p.o_w_in, (bf16_t*)(ws + OFF_WT_OIN), 1024, ODD_IN, v / 64, v % 64, tile); }
      else { const int v = u - T0 - T1 - T2; tr_tile(p.o_w_out, (bf16_t*)(ws + OFF_WT_OOUT), 2048, 1024, v / 16, v % 16, tile); }
    }
  }
  {
    const long gt = (long)bid * 512 + tid, gn = (long)G * 512;
    bf16_t* TC = (bf16_t*)(ws + OFF_TAB_C); bf16_t* TS = (bf16_t*)(ws + OFF_TAB_S);
    for (long e = gt; e < 1280L * 1024; e += gn) {
      const int tp = (int)(e >> 10), t = (int)(e & 1023);
      float v = 0.f;
      if (tp <= 1024) { const int m = (tp * t) & 2047; v = cospif((float)m * (1.f / 1024.f)); }
      TC[e] = f2bf(v);
    }
    for (long e = gt; e < 1024L * 1024; e += gn) {
      const int tp = (int)(e >> 10), t = (int)(e & 1023);
      const int m = (tp * t) & 2047;
      TS[e] = f2bf(sinpif((float)m * (1.f / 1024.f)));
    }
    bf16_t* CDM = (bf16_t*)(ws + OFF_CDM); bf16_t* CDP = (bf16_t*)(ws + OFF_CDP);
    for (long e = gt; e < 128L * 256; e += gn) {
      const int cp = (int)(e >> 8), k = (int)(e & 255);
      const int m = (cp * (k & 127)) & 127;
      const float x = (float)m * (1.f / 64.f);
      float vm, vp;
      if (k < 128) { vm = cospif(x); vp = vm; } else { vp = sinpif(x); vm = -vp; }
      CDM[e] = f2bf(vm); CDP[e] = f2bf(vp);
    }
    bf16_t* WSB = (bf16_t*)(ws + OFF_WSB);
    for (long e = gt; e < 8L * 128 * 128; e += gn) WSB[e] = f2bf(p.e_ws[e]);
    float2* ROPE = (float2*)(ws + OFF_ROPE);
    for (long e = gt; e < 64L * 32; e += gn) {
      const int pos = (int)(e >> 5), i = (int)(e & 31);
      const float inv = powf(10000.f, -(float)i / 32.f);
      const float ang = (float)pos * inv;
      ROPE[e] = make_float2(cosf(ang), sinf(ang));
    }
  }
}

__device__ __forceinline__ void ln_rows_modulate(const float* src, bf16_t* dst, int nrows, int rows_per_b, const float* mod17, int fixed_row) {
  const int tid = tid_fresh(), wid = tid >> 6, lane = tid & 63;
  const int gw = blockIdx.x * 8 + wid, nw = gridDim.x * 8;
  float4 n0, n1, n2, n3;
  { const int r0 = gw < nrows ? gw : 0; const float4* ps = (const float4*)(src + (size_t)r0 * 1024); n0 = ps[lane]; n1 = ps[lane + 64]; n2 = ps[lane + 128]; n3 = ps[lane + 192]; }
  for (int row = gw; row < nrows; row += nw) {
    float4 v0 = n0, v1 = n1, v2 = n2, v3 = n3;
    { const int nr = (row + nw < nrows) ? row + nw : row;
      const float4* ps = (const float4*)(src + (size_t)nr * 1024); n0 = ps[lane]; n1 = ps[lane + 64]; n2 = ps[lane + 128]; n3 = ps[lane + 192]; }
    float s = v0.x + v0.y + v0.z + v0.w + v1.x + v1.y + v1.z + v1.w + v2.x + v2.y + v2.z + v2.w + v3.x + v3.y + v3.z + v3.w;
    const float mu = wave_sum(s) * (1.f / 1024.f);
    v0.x -= mu; v0.y -= mu; v0.z -= mu; v0.w -= mu; v1.x -= mu; v1.y -= mu; v1.z -= mu; v1.w -= mu;
    v2.x -= mu; v2.y -= mu; v2.z -= mu; v2.w -= mu; v3.x -= mu; v3.y -= mu; v3.z -= mu; v3.w -= mu;
    float q = v0.x * v0.x + v0.y * v0.y + v0.z * v0.z + v0.w * v0.w + v1.x * v1.x + v1.y * v1.y + v1.z * v1.z + v1.w * v1.w +
              v2.x * v2.x + v2.y * v2.y + v2.z * v2.z + v2.w * v2.w + v3.x * v3.x + v3.y * v3.y + v3.z * v3.z + v3.w * v3.w;
    const float rstd = rsqrtf(wave_sum(q) * (1.f / 1024.f) + EPS);
    const int mr = (fixed_row >= 0) ? fixed_row : (row / rows_per_b);
    const float* md = mod17 + (size_t)mr * 3072;
    bf16_t* pd = dst + (size_t)row * 1024;
#define MODST(V, J) { const int col = (lane + 64 * J) * 4; const float4 sh = *(const float4*)(md + col); const float4 sc = *(const float4*)(md + 1024 + col); \
      st_bf4(pd + col, V.x * rstd * (1.f + sc.x) + sh.x, V.y * rstd * (1.f + sc.y) + sh.y, V.z * rstd * (1.f + sc.z) + sh.z, V.w * rstd * (1.f + sc.w) + sh.w); }
    MODST(v0, 0) MODST(v1, 1) MODST(v2, 2) MODST(v3, 3)
#undef MODST
  }
}

__device__ __forceinline__ void phase2(const Params& p, char* smem) {
  char* ws = p.ws;
  const bf16_t* M0 = (const bf16_t*)(ws + OFF_M0); const bf16_t* MC = (const bf16_t*)(ws + OFF_MC);
  const bf16_t* WT = (const bf16_t*)(ws + OFF_WT_EIN);
  bf16_t* Q = (bf16_t*)(ws + OFF_Q); bf16_t* KA = (bf16_t*)(ws + OFF_KALL); bf16_t* VA = (bf16_t*)(ws + OFF_VALL);
  bf16_t* BU = (bf16_t*)(ws + OFF_BU); bf16_t* BV = (bf16_t*)(ws + OFF_BV); bf16_t* SG = (bf16_t*)(ws + OFF_SG);
  const float2* ROPE = (const float2*)(ws + OFF_ROPE);
  const int tid = tid_fresh(), wid = tid >> 6, lane = tid & 63, r32 = lane & 31, hi = lane >> 5, wm = wid >> 1, wn = wid & 1;
  const int lb = logical_block();
  for (int u = lb; u < 2816 + 32; u += gridDim.x) {
    const bool isctx = (u >= 2816);
    int mt, nt;
    if (!isctx) { mt = u / 22; nt = u % 22; } else { const int v = u - 2816; mt = v >> 1; nt = 4 + (v & 1); }
    const bf16_t* A = (isctx ? MC : M0) + (size_t)mt * 256 * 1024;
    f32x16 acc[2][4];
    gemm2(mkPlain(A, 1024), mkPlain(WT + (size_t)nt * 256 * 1024, 1024), 16, smem, acc);
    if (nt < 5) {
      const bool isq = nt < 4;
      const int head = isq ? (nt * 2 + wn) : wn;
      const float* gv = isq ? p.e_qn : p.e_kn;
#pragma unroll
      for (int mi = 0; mi < 2; ++mi) {
        float ss = 0.f;
#pragma unroll
        for (int nj = 0; nj < 4; ++nj)
#pragma unroll
          for (int r = 0; r < 16; ++r) ss += acc[mi][nj][r] * acc[mi][nj][r];
        ss += __shfl_xor(ss, 32);
        const float rstd = rsqrtf(ss * (1.f / 128.f) + EPS);
        const int row = wm * 64 + mi * 32 + r32;
        int t = 0; size_t obase;
        if (!isctx) {
          const int b = mt >> 3; t = (mt & 7) * 256 + row;
          if (isq) obase = ((size_t)(b * SEQ + t) * 8 + head) * 128;
          else obase = ((size_t)(b * SKV + CTXL + t) * 2 + head) * 128;
        } else {
          obase = ((size_t)(mt * SKV + row) * 2 + head) * 128;
        }
        bf16_t* dst = (isq ? Q : KA) + obase;
#pragma unroll
        for (int nj = 0; nj < 2; ++nj) {
          const int pos = (nj == 0) ? (t >> 6) : (t & 63);
#pragma unroll
          for (int q = 0; q < 4; ++q) {
            float o1[4], o2[4];
#pragma unroll
            for (int e = 0; e < 4; ++e) {
              const int r = 4 * q + e;
              const int i = 8 * q + 4 * hi + e;
              const int d = nj * 32 + i;
              const float x1 = acc[mi][nj][r] * rstd * gv[d];
              const float x2 = acc[mi][nj + 2][r] * rstd * gv[64 + d];
              if (!isctx) {
                const float2 cs = ROPE[pos * 32 + i];
                o1[e] = x1 * cs.x - x2 * cs.y; o2[e] = x2 * cs.x + x1 * cs.y;
              } else { o1[e] = x1; o2[e] = x2; }
            }
            const int d0 = nj * 32 + 8 * q + 4 * hi;
            st_bf4(dst + d0, o1[0], o1[1], o1[2], o1[3]);
            st_bf4(dst + 64 + d0, o2[0], o2[1], o2[2], o2[3]);
          }
        }
      }
    } else if (nt == 5) {
      epi2_foreach(acc, [&](int row, int col, float a, float b, float c, float d) {
        size_t tokrow;
        if (!isctx) { const int bb = mt >> 3, t = (mt & 7) * 256 + row; tokrow = (size_t)bb * SKV + CTXL + t; } else tokrow = (size_t)mt * SKV + row;
        st_bf4(VA + tokrow * 256 + col, a, b, c, d);
      });
    } else if (nt < 14) {
      bf16_t* dst = (nt < 10) ? (BU + (size_t)(nt - 6) * 256) : (BV + (size_t)(nt - 10) * 256);
      epi2_foreach(acc, [&](int row, int col, float a, float b, float c, float d) {
        st_bf4(dst + (size_t)(mt * 256 + row) * 1024 + col, gelu_tanh_f(a), gelu_tanh_f(b), gelu_tanh_f(c), gelu_tanh_f(d));
      });
    } else {
      bf16_t* dst = SG + (size_t)(nt - 14) * 256;
      epi2_foreach(acc, [&](int row, int col, float a, float b, float c, float d) {
        st_bf4(dst + (size_t)(mt * 256 + row) * 2048 + col, silu_f(a), silu_f(b), silu_f(c), silu_f(d));
      });
    }
  }
}

namespace att {
constexpr int D = 128, NW = 8, QBLK = 32, KVBLK = 64;
constexpr float SCALE = 0.088388347648318440f;
constexpr float THR = 8.f;
constexpr int LDQ = 1024, LDK = 256;
constexpr int SHM_V = KVBLK * D * 2, SHM_K = KVBLK * D * 2;
#define KSWZ(row, colB) ((row) * 256 + ((colB) ^ (((row) & 7) << 4)))
#define SBAR() __builtin_amdgcn_sched_barrier(0)
__device__ __forceinline__ void partialSM(f32x16& p0, f32x16& p1, float& m_reg, float& mn, float& alpha) {
  constexpr float C = SCALE * 1.4426950408889634f;
  float pmax = p0[0];
#pragma unroll
  for (int r = 1; r < 16; ++r) pmax = fmaxf(pmax, p0[r]);
#pragma unroll
  for (int r = 0; r < 16; ++r) pmax = fmaxf(pmax, p1[r]);
  { auto rr = __builtin_amdgcn_permlane32_swap(__float_as_uint(pmax), __float_as_uint(pmax), false, false);
    pmax = fmaxf(__uint_as_float(rr[0]), __uint_as_float(rr[1])); }
  if (__builtin_expect(__all(pmax - m_reg <= THR / SCALE), 1)) { mn = m_reg; alpha = 1.f; }
  else { mn = fmaxf(m_reg, pmax); alpha = __builtin_amdgcn_exp2f((m_reg - mn) * C); m_reg = mn; }
  const float mnC = -mn * C;
#pragma unroll
  for (int r = 0; r < 16; ++r) p0[r] = fmaf(p0[r], C, mnC);
#pragma unroll
  for (int r = 0; r < 16; ++r) p1[r] = fmaf(p1[r], C, mnC);
#pragma unroll
  for (int r = 0; r < 16; ++r) p0[r] = __builtin_amdgcn_exp2f(p0[r]);
}
__device__ __forceinline__ void finishSM(f32x16& p0, f32x16& p1, float alpha, float& l_reg, bf16x8& pa0, bf16x8& pa1, bf16x8& pa2, bf16x8& pa3) {
#pragma unroll
  for (int r = 0; r < 16; ++r) p1[r] = __builtin_amdgcn_exp2f(p1[r]);
  float ps = 0;
#pragma unroll
  for (int r = 0; r < 16; ++r) ps += p0[r];
#pragma unroll
  for (int r = 0; r < 16; ++r) ps += p1[r];
  { auto rr = __builtin_amdgcn_permlane32_swap(__float_as_uint(ps), __float_as_uint(ps), false, false);
    ps = __uint_as_float(rr[0]) + __uint_as_float(rr[1]); }
  l_reg = l_reg * alpha + ps;
#define PK4(P, BASE, OUT) do { unsigned a0 = cvtpk(P[BASE + 0], P[BASE + 1]), a1 = cvtpk(P[BASE + 2], P[BASE + 3]);   \
    unsigned b0 = cvtpk(P[BASE + 4], P[BASE + 5]), b1 = cvtpk(P[BASE + 6], P[BASE + 7]);                              \
    auto r0 = __builtin_amdgcn_permlane32_swap(a0, b0, false, false); auto r1 = __builtin_amdgcn_permlane32_swap(a1, b1, false, false); \
    u32x4 w = {r0[0], r1[0], r0[1], r1[1]}; OUT = *reinterpret_cast<bf16x8*>(&w); } while (0)
  PK4(p0, 0, pa0); PK4(p0, 8, pa1); PK4(p1, 0, pa2); PK4(p1, 8, pa3);
#undef PK4
}
__device__ __forceinline__ void qkt(f32x16& p0, f32x16& p1, const bf16_t* Ks, const bf16x8* qr, int r32, int hi) {
#pragma unroll
  for (int r = 0; r < 16; ++r) { p0[r] = 0.f; p1[r] = 0.f; }
#pragma unroll
  for (int d0 = 0; d0 < 8; ++d0) { const int cb = (d0 * 16 + hi * 8) * 2;
    bf16x8 b0 = *reinterpret_cast<const bf16x8*>((const char*)Ks + KSWZ(r32, cb));
    bf16x8 b1 = *reinterpret_cast<const bf16x8*>((const char*)Ks + KSWZ(32 + r32, cb));
    p0 = __builtin_amdgcn_mfma_f32_32x32x16_bf16(b0, qr[d0], p0, 0, 0, 0);
    p1 = __builtin_amdgcn_mfma_f32_32x32x16_bf16(b1, qr[d0], p1, 0, 0, 0); }
}
__device__ __forceinline__ int v_st(int k, int c) { const int kk = (k & ~0xC) | ((k & 4) << 1) | ((k & 8) >> 1); return ((kk >> 3) * 4 + (c >> 5)) * 512 + ((kk & 7) * 32 + (c & 31)) * 2; }
__device__ __forceinline__ int v_rd_base(int lane) { return ((lane & 3) << 3) | (((lane >> 2) & 3) << 6) | (((lane >> 4) & 1) << 5) | (((lane >> 5) & 1) << 8); }
constexpr int v_rd_off(int d0, int ks, int half) { return d0 * 512 + ks * 4096 + half * 2048; }
template <int OFF> __device__ __forceinline__ s16x4 tr_read(int vb) {
  s16x4 r; asm volatile("ds_read_b64_tr_b16 %0, %1 offset:%2" : "=&v"(r) : "v"(vb), "i"(OFF) : "memory"); return r;
}
template <int D0> __device__ __forceinline__ void pv_one(f32x16& od, int vb, bf16x8 pa0, bf16x8 pa1, bf16x8 pa2, bf16x8 pa3) {
  const s16x4 l0 = tr_read<v_rd_off(D0, 0, 0)>(vb), h0 = tr_read<v_rd_off(D0, 0, 1)>(vb), l1 = tr_read<v_rd_off(D0, 1, 0)>(vb), h1 = tr_read<v_rd_off(D0, 1, 1)>(vb);
  const s16x4 l2 = tr_read<v_rd_off(D0, 2, 0)>(vb), h2 = tr_read<v_rd_off(D0, 2, 1)>(vb), l3 = tr_read<v_rd_off(D0, 3, 0)>(vb), h3 = tr_read<v_rd_off(D0, 3, 1)>(vb);
  asm volatile("s_waitcnt lgkmcnt(0)" ::: "memory"); SBAR();
#define PK(L, H) (bf16x8){L[0], L[1], L[2], L[3], H[0], H[1], H[2], H[3]}
  od = __builtin_amdgcn_mfma_f32_32x32x16_bf16(pa0, PK(l0, h0), od, 0, 0, 0);
  od = __builtin_amdgcn_mfma_f32_32x32x16_bf16(pa1, PK(l1, h1), od, 0, 0, 0);
  od = __builtin_amdgcn_mfma_f32_32x32x16_bf16(pa2, PK(l2, h2), od, 0, 0, 0);
  od = __builtin_amdgcn_mfma_f32_32x32x16_bf16(pa3, PK(l3, h3), od, 0, 0, 0);
#undef PK
}
__device__ __forceinline__ void pv_d0(f32x16* o, int vb, bf16x8 pa0, bf16x8 pa1, bf16x8 pa2, bf16x8 pa3) {
  pv_one<0>(o[0], vb, pa0, pa1, pa2, pa3); pv_one<1>(o[1], vb, pa0, pa1, pa2, pa3); pv_one<2>(o[2], vb, pa0, pa1, pa2, pa3); pv_one<3>(o[3], vb, pa0, pa1, pa2, pa3);
}
__device__ __forceinline__ void attn_body(const bf16_t* __restrict__ Qb, const bf16_t* __restrict__ Kh, const bf16_t* __restrict__ Vh,
                                          bf16_t* GO, int seq, char* lds) {
  const int tid = tid_fresh(), wid = tid >> 6, lane = tid & 63, r32 = lane & 31, hi = lane >> 5;
  bf16_t* V_lds = (bf16_t*)lds; bf16_t* K_lds = (bf16_t*)(lds + 2 * SHM_V);
  float* wsx = (float*)(lds + 2 * SHM_V + 2 * SHM_K) + wid * 64; float* li_l = wsx; float* al_l = wsx + 32;
  float m_reg = -1e30f, l_reg = 0; f32x16 o[4]; bf16x8 qr[8];
#pragma unroll
  for (int d = 0; d < 4; ++d)
#pragma unroll
    for (int r = 0; r < 16; ++r) o[d][r] = 0.f;
  const bf16_t* Qw = Qb + (long)(wid * QBLK + r32) * LDQ + hi * 8;
#pragma unroll
  for (int d0 = 0; d0 < 8; ++d0) qr[d0] = *reinterpret_cast<const bf16x8*>(Qw + d0 * 16);
  const int sr = tid >> 4, sc = (tid & 15) * 8, vst0 = v_st(sr, sc), vst1 = v_st(32 + sr, sc);
  const int vb0 = (int)(uintptr_t)V_lds + v_rd_base(lane);
  constexpr int SDEPTH = 1;
  bf16x8 sv0[SDEPTH], sv1[SDEPTH], sk0[SDEPTH], sk1[SDEPTH];
#define SLOAD(i, k0) do { sv0[i] = *reinterpret_cast<const bf16x8*>(&Vh[(long)((k0) + sr) * LDK + sc]); sv1[i] = *reinterpret_cast<const bf16x8*>(&Vh[(long)((k0) + 32 + sr) * LDK + sc]); \
    sk0[i] = *reinterpret_cast<const bf16x8*>(&Kh[(long)((k0) + sr) * LDK + sc]); sk1[i] = *reinterpret_cast<const bf16x8*>(&Kh[(long)((k0) + 32 + sr) * LDK + sc]); } while (0)
#define SWRITE(b, i) do { *(bf16x8*)((char*)V_lds + (b) * SHM_V + vst0) = sv0[i];          \
    *(bf16x8*)((char*)V_lds + (b) * SHM_V + vst1) = sv1[i]; const int kc = sc * 2;               \
    *(bf16x8*)((char*)K_lds + (b) * SHM_K + KSWZ(sr, kc)) = sk0[i];                       \
    *(bf16x8*)((char*)K_lds + (b) * SHM_K + KSWZ(32 + sr, kc)) = sk1[i]; } while (0)
#define SWAIT() do { if (SDEPTH == 2) asm volatile("s_waitcnt vmcnt(4)" ::: "memory"); else asm volatile("s_waitcnt vmcnt(0)" ::: "memory"); } while (0)
#define RESC(a) do { if (__any((a) < 1.f)) { if (hi == 0) al_l[r32] = (a); asm volatile("s_waitcnt lgkmcnt(0)" ::: "memory"); \
    _Pragma("unroll") for (int d = 0; d < 4; ++d) _Pragma("unroll") for (int r = 0; r < 16; ++r) o[d][r] *= al_l[crow(r, hi)]; } } while (0)
  f32x16 pA0, pA1, pB0, pB1; float mnA, mnB, alA, alB; bf16x8 pa0, pa1, pa2, pa3; const int NT = seq / KVBLK;
  constexpr int SE = 0, SO = SDEPTH - 1;
  SLOAD(SE, 0); asm volatile("s_waitcnt vmcnt(0)" ::: "memory"); SWRITE(0, SE); __syncthreads();
  qkt(pA0, pA1, K_lds, qr, r32, hi); partialSM(pA0, pA1, m_reg, mnA, alA);
  SLOAD(SO, KVBLK); if (SDEPTH == 2) { if (2 < NT) SLOAD(SE, 2 * KVBLK); }
  SWAIT(); SWRITE(1, SO); __syncthreads();
  for (int j = 1; j + 1 < NT; j += 2) {
    SBAR(); qkt(pB0, pB1, (bf16_t*)((char*)K_lds + SHM_K), qr, r32, hi);
    finishSM(pA0, pA1, alA, l_reg, pa0, pa1, pa2, pa3); SBAR();
    SLOAD(SO, (j + SDEPTH) * KVBLK); SBAR();
    pv_d0(o, vb0, pa0, pa1, pa2, pa3); partialSM(pB0, pB1, m_reg, mnB, alB);
    __syncthreads(); SWAIT(); SWRITE(0, SE);
    RESC(alB); __syncthreads();
    SBAR(); qkt(pA0, pA1, K_lds, qr, r32, hi);
    finishSM(pB0, pB1, alB, l_reg, pa0, pa1, pa2, pa3); SBAR();
    if (SDEPTH == 1 || j + 3 < NT) SLOAD(SE, (j + 1 + SDEPTH) * KVBLK); SBAR();
    pv_d0(o, vb0 + (int)SHM_V, pa0, pa1, pa2, pa3); partialSM(pA0, pA1, m_reg, mnA, alA);
    __syncthreads(); SWAIT(); SWRITE(1, SO);
    RESC(alA); __syncthreads();
  }
  SBAR(); qkt(pB0, pB1, (bf16_t*)((char*)K_lds + SHM_K), qr, r32, hi);
  finishSM(pA0, pA1, alA, l_reg, pa0, pa1, pa2, pa3); SBAR();
  pv_d0(o, vb0, pa0, pa1, pa2, pa3); partialSM(pB0, pB1, m_reg, mnB, alB);
  __syncthreads(); RESC(alB);
  finishSM(pB0, pB1, alB, l_reg, pa0, pa1, pa2, pa3); SBAR();
  pv_d0(o, vb0 + (int)SHM_V, pa0, pa1, pa2, pa3);
  if (hi == 0) li_l[r32] = l_reg; asm volatile("s_waitcnt lgkmcnt(0)" ::: "memory");
  float rli[16];
#pragma unroll
  for (int r = 0; r < 16; ++r) rli[r] = __builtin_amdgcn_rcpf(li_l[crow(r, hi)]);
  bf16_t* Ow = GO + (long)(wid * QBLK) * 2048;
#pragma unroll
  for (int r = 0; r < 16; ++r) { const int orow = crow(r, hi);
#pragma unroll
    for (int d0 = 0; d0 < 4; ++d0) { bf16_t* q = Ow + (long)orow * 2048 + d0 * 32 + r32; *q = f2bf(o[d0][r] * rli[r] * bf2f(*q)); }
    SBAR(); }
  __syncthreads();
#undef SLOAD
#undef SWRITE
#undef SWAIT
#undef RESC
}
}

__device__ __forceinline__ void chunk_gate_unit(const Params& p, int b, int n, char* smem) {
  char* ws = p.ws;
  const bf16_t* BU = (const bf16_t*)(ws + OFF_BU); const bf16_t* BV = (const bf16_t*)(ws + OFF_BV);
  bf16_t* SG = (bf16_t*)(ws + OFF_SG); const bf16_t* WSB = (const bf16_t*)(ws + OFF_WSB);
  const int tid = tid_fresh(), wid = tid >> 6, lane = tid & 63, r32 = lane & 31, hi = lane >> 5;
  constexpr int RS = 272;
  char* sW = smem; char* sV = smem + 128 * RS;
  float* smu = (float*)(smem + 2 * 128 * RS); float* srs = smu + 128;
  const size_t tok0 = (size_t)b * SEQ + (size_t)n * 128;
  {
    const int q = tid >> 2, part = tid & 3;
    const u32x4* src = (const u32x4*)(BV + (tok0 + q) * 1024 + part * 256);
    float s = 0.f, s2 = 0.f;
#pragma unroll 4
    for (int i = 0; i < 32; ++i) {
      const u32x4 w = src[i];
#pragma unroll
      for (int e = 0; e < 4; ++e) { const float a = bf_lo(w[e]), c = bf_hi(w[e]); s += a + c; s2 += a * a + c * c; }
    }
    s += __shfl_xor(s, 1); s2 += __shfl_xor(s2, 1); s += __shfl_xor(s, 2); s2 += __shfl_xor(s2, 2);
    const float mu = s * (1.f / 1024.f);
    const float var = fmaxf(s2 * (1.f / 1024.f) - mu * mu, 0.f);
    if (part == 0) { smu[q] = mu; srs[q] = rsqrtf(var + EPS); }
  }
  __syncthreads();
  const int wp = wid >> 1, wc = wid & 1;
  u32x4 rw0, rw1, rw2, rw3, rv0, rv1, rv2, rv3;
#define CG_LD1(I, RW, RV, G_) do { const int id_ = tid + 512 * (I);                                                            \
    RW = *(const u32x4*)(WSB + (size_t)(G_) * 16384 + (id_ >> 4) * 128 + (id_ & 15) * 8);                                      \
    RV = *(const u32x4*)(BV + (tok0 + (id_ & 127)) * 1024 + (G_) * 128 + (id_ >> 7) * 8); } while (0)
#define CG_LOAD(G_) do { const int g_ = (G_); CG_LD1(0, rw0, rv0, g_); CG_LD1(1, rw1, rv1, g_); CG_LD1(2, rw2, rv2, g_); CG_LD1(3, rw3, rv3, g_); } while (0)
#define CG_ST1(I, RW, RV) do { const int id_ = tid + 512 * (I);                                                                \
    *(u32x4*)(sW + (id_ >> 4) * RS + (id_ & 15) * 16) = RW;                                                                     \
    const int q_ = id_ & 127, cc_ = (id_ >> 7) * 8; const float mu_ = smu[q_], rs_ = srs[q_];                                   \
    const float* lg_ = p.e_vg + g * 128 + cc_; const float* lb_ = p.e_vb + g * 128 + cc_;                                       \
    _Pragma("unroll") for (int e = 0; e < 4; ++e) {                                                                             \
      const float a_ = (bf_lo(RV[e]) - mu_) * rs_ * lg_[2 * e] + lb_[2 * e];                                                    \
      const float c_ = (bf_hi(RV[e]) - mu_) * rs_ * lg_[2 * e + 1] + lb_[2 * e + 1];                                            \
      *(bf16_t*)(sV + (cc_ + 2 * e) * RS + q_ * 2) = f2bf(a_);                                                                  \
      *(bf16_t*)(sV + (cc_ + 2 * e + 1) * RS + q_ * 2) = f2bf(c_); } } while (0)
  CG_LOAD(0);
  for (int g = 0; g < 8; ++g) {
    CG_ST1(0, rw0, rv0); CG_ST1(1, rw1, rv1); CG_ST1(2, rw2, rv2); CG_ST1(3, rw3, rv3);
    __syncthreads();
    CG_LOAD(g + 1 < 8 ? g + 1 : g);
    const int pr = wp * 32 + r32;
    const size_t tok = tok0 + pr;
    u32x2 bu[8], sgv[8];
#pragma unroll
    for (int nj = 0; nj < 2; ++nj)
#pragma unroll
      for (int q = 0; q < 4; ++q) {
        const int col = g * 128 + wc * 64 + nj * 32 + q * 8 + hi * 4;
        bu[nj * 4 + q] = *(const u32x2*)(BU + tok * 1024 + col);
        sgv[nj * 4 + q] = *(const u32x2*)(SG + tok * 2048 + 1024 + col);
      }
    const float bias = p.e_bs[g * 128 + pr];
    f32x16 acc0, acc1;
#pragma unroll
    for (int r = 0; r < 16; ++r) { acc0[r] = 0.f; acc1[r] = 0.f; }
#pragma unroll
    for (int kk = 0; kk < 8; ++kk) {
      const bf16x8 af = *(const bf16x8*)(sW + (wp * 32 + r32) * RS + kk * 32 + hi * 16);
      const bf16x8 b0 = *(const bf16x8*)(sV + (wc * 64 + r32) * RS + kk * 32 + hi * 16);
      const bf16x8 b1 = *(const bf16x8*)(sV + (wc * 64 + 32 + r32) * RS + kk * 32 + hi * 16);
      acc0 = __builtin_amdgcn_mfma_f32_32x32x16_bf16(b0, af, acc0, 0, 0, 0);
      acc1 = __builtin_amdgcn_mfma_f32_32x32x16_bf16(b1, af, acc1, 0, 0, 0);
    }
#pragma unroll
    for (int nj = 0; nj < 2; ++nj)
#pragma unroll
      for (int q = 0; q < 4; ++q) {
        const int col = g * 128 + wc * 64 + nj * 32 + q * 8 + hi * 4;
        bf16_t* gp = SG + tok * 2048 + 1024 + col;
        const u32x2 b2 = bu[nj * 4 + q], s2 = sgv[nj * 4 + q];
        const float m0 = (nj ? acc1[4 * q + 0] : acc0[4 * q + 0]) + bias, m1 = (nj ? acc1[4 * q + 1] : acc0[4 * q + 1]) + bias;
        const float m2 = (nj ? acc1[4 * q + 2] : acc0[4 * q + 2]) + bias, m3 = (nj ? acc1[4 * q + 3] : acc0[4 * q + 3]) + bias;
        st_bf4(gp, bf_lo(b2[0]) * m0 * bf_lo(s2[0]), bf_hi(b2[0]) * m1 * bf_hi(s2[0]), bf_lo(b2[1]) * m2 * bf_lo(s2[1]), bf_hi(b2[1]) * m3 * bf_hi(s2[1]));
      }
    __syncthreads();
  }
#undef CG_LD1
#undef CG_LOAD
#undef CG_ST1
}

__device__ __forceinline__ void post_ln_rows(const float* src, float* dst, const float* pg, const float* pb, bf16_t* m1, const float* mod17) {
  const int tid = tid_fresh(), wid = tid >> 6, lane = tid & 63;
  const int gw = blockIdx.x * 8 + wid, nw = gridDim.x * 8;
  float4 nx[4];
  { const float4* ps = (const float4*)(src + (size_t)gw * 1024);
#pragma unroll
    for (int j = 0; j < 4; ++j) nx[j] = ps[lane + 64 * j]; }
  for (int row = gw; row < NTOK; row += nw) {
    float4 v[4];
#pragma unroll
    for (int j = 0; j < 4; ++j) v[j] = nx[j];
    { const int nr = (row + nw < NTOK) ? row + nw : row;
      const float4* ps = (const float4*)(src + (size_t)nr * 1024);
#pragma unroll
      for (int j = 0; j < 4; ++j) nx[j] = ps[lane + 64 * j]; }
    float s = 0.f;
#pragma unroll
    for (int j = 0; j < 4; ++j) s += v[j].x + v[j].y + v[j].z + v[j].w;
    float mu = wave_sum(s) * (1.f / 1024.f);
    float q = 0.f;
#pragma unroll
    for (int j = 0; j < 4; ++j) { v[j].x -= mu; v[j].y -= mu; v[j].z -= mu; v[j].w -= mu; q += v[j].x * v[j].x + v[j].y * v[j].y + v[j].z * v[j].z + v[j].w * v[j].w; }
    float rstd = rsqrtf(wave_sum(q) * (1.f / 1024.f) + EPS);
    float4* pd = (float4*)(dst + (size_t)row * 1024);
    s = 0.f;
#pragma unroll
    for (int j = 0; j < 4; ++j) {
      const int col = (lane + 64 * j) * 4;
      const float4 g4 = *(const float4*)(pg + col), b4 = *(const float4*)(pb + col);
      v[j].x = v[j].x * rstd * g4.x + b4.x; v[j].y = v[j].y * rstd * g4.y + b4.y; v[j].z = v[j].z * rstd * g4.z + b4.z; v[j].w = v[j].w * rstd * g4.w + b4.w;
      pd[lane + 64 * j] = v[j];
      s += v[j].x + v[j].y + v[j].z + v[j].w;
    }
    if (m1) {
      mu = wave_sum(s) * (1.f / 1024.f);
      q = 0.f;
#pragma unroll
      for (int j = 0; j < 4; ++j) { v[j].x -= mu; v[j].y -= mu; v[j].z -= mu; v[j].w -= mu; q += v[j].x * v[j].x + v[j].y * v[j].y + v[j].z * v[j].z + v[j].w * v[j].w; }
      rstd = rsqrtf(wave_sum(q) * (1.f / 1024.f) + EPS);
      const float* md = mod17 + (size_t)(row >> 11) * 3072;
      bf16_t* pm = m1 + (size_t)row * 1024;
#pragma unroll
      for (int j = 0; j < 4; ++j) {
        const int col = (lane + 64 * j) * 4;
        const float4 sh = *(const float4*)(md + col), sc = *(const float4*)(md + 1024 + col);
        st_bf4(pm + col, v[j].x * rstd * (1.f + sc.x) + sh.x, v[j].y * rstd * (1.f + sc.y) + sh.y, v[j].z * rstd * (1.f + sc.z) + sh.z, v[j].w * rstd * (1.f + sc.w) + sh.w);
      }
    }
  }
}

__device__ __forceinline__ void out_proj(const bf16_t* A, const bf16_t* WT, const float* resid, const float* gate17, float* dst, char* smem) {
  const int lb = logical_block();
  for (int u = lb; u < 512; u += gridDim.x) {
    const int mt = u >> 2, nt = u & 3;
    f32x16 acc[2][4];
    gemm2(mkPlain(A + (size_t)mt * 256 * 2048, 2048), mkPlain(WT + (size_t)nt * 256 * 2048, 2048), 32, smem, acc);
    const float* gt = gate17 + (size_t)(mt >> 3) * 3072 + 2048 + nt * 256;
    epi2_foreach(acc, [&](int row, int col, float a, float b, float c, float d) {
      const size_t idx = (size_t)(mt * 256 + row) * 1024 + nt * 256 + col;
      const float4 xr = *(const float4*)(resid + idx); const float4 g4 = *(const float4*)(gt + col);
      float4 o; o.x = ALPHA * xr.x + g4.x * a; o.y = ALPHA * xr.y + g4.y * b; o.z = ALPHA * xr.z + g4.z * c; o.w = ALPHA * xr.w + g4.w * d;
      *(float4*)(dst + idx) = o;
    });
  }
}

#define XB_TMO      128
#define XB_XCNT(j)  (256  + 64 * (j))
#define XB_XSUB(j)  (1280 + 64 * (j))
#define XB_XGEN(j)  (2304 + 64 * (j))
#define XB_TOP      3328
#define XB_TOPGEN   3392
#define XCD_BAR_WORDS 3456
#define XB_SPIN_CAP (1u << 18)
#define LAS __attribute__((address_space(3)))

__device__ __forceinline__ unsigned xb_ld(unsigned* p)              { return __hip_atomic_load(p, __ATOMIC_RELAXED, __HIP_MEMORY_SCOPE_AGENT); }
__device__ __forceinline__ unsigned xb_add(unsigned* p, unsigned v) { return __hip_atomic_fetch_add(p, v, __ATOMIC_RELAXED, __HIP_MEMORY_SCOPE_AGENT); }
__device__ __forceinline__ unsigned xb_xcc_id() { return (unsigned)__builtin_amdgcn_s_getreg((3 << 11) | 20) & 0xFu; }
#define XB_SPIN(cond, bar) do { unsigned _sp = 0; while (cond) { __builtin_amdgcn_s_sleep(1); \
    if ((++_sp & 255u) == 0u) { if (xb_ld(&(bar)[XB_TMO])) break; if (_sp > XB_SPIN_CAP) { atomicAdd(&(bar)[XB_TMO], 1u); break; } } } } while (0)

struct XcdBarrier {
    unsigned* bar; unsigned x;
    volatile LAS unsigned* st;
};

__device__ __forceinline__ XcdBarrier xcd_barrier_post(unsigned* bar, volatile LAS unsigned* st) {
    XcdBarrier b; b.bar = bar; b.x = xb_xcc_id(); b.st = st;
    if (threadIdx.x == 0) (void)xb_add(&bar[XB_XCNT(b.x)], 1u);
    return b;
}
__device__ __forceinline__ void xcd_barrier_complete(unsigned* bar, unsigned x, unsigned& nloc, unsigned& nx) {
    const unsigned G = gridDim.x * gridDim.y * gridDim.z;
    unsigned sum, cnt, mine, sp = 0u;
    for (;;) {
        sum = 0u; cnt = 0u; mine = 0u;
#pragma unroll
        for (unsigned j = 0; j < 16; ++j) { const unsigned c = xb_ld(&bar[XB_XCNT(j)]); sum += c; cnt += (c > 0u) ? 1u : 0u; mine = (j == x) ? c : mine; }
        if (sum == G) break;
        __builtin_amdgcn_s_sleep(1);
        if ((++sp & 255u) == 0u) { if (xb_ld(&bar[XB_TMO])) break; if (sp > XB_SPIN_CAP) { atomicAdd(&bar[XB_TMO], 1u); break; } }
    }
    nloc = mine > 0u ? mine : 1u; nx = cnt > 0u ? cnt : 1u;
}

__device__ __forceinline__ void xcd_barrier(const XcdBarrier& b) {
    asm volatile("s_waitcnt vmcnt(0)" ::: "memory");
    __syncthreads();
    if (threadIdx.x == 0) {
        unsigned* bar = b.bar;
        __builtin_amdgcn_s_waitcnt(0);
        unsigned nloc = b.st[0], nx = b.st[1];
        if (nloc == 0u) { xcd_barrier_complete(bar, b.x, nloc, nx); b.st[0] = nloc; b.st[1] = nx; }
        const unsigned old = xb_add(&bar[XB_XSUB(b.x)], 1u);
        const unsigned gen = old / nloc;
        if (old + 1u == (gen + 1u) * nloc) {
            __builtin_amdgcn_fence(__ATOMIC_RELEASE, "agent");
            asm volatile("s_waitcnt vmcnt(0)" ::: "memory");
            const unsigned og = xb_add(&bar[XB_TOP], 1u);
            const unsigned tg = og / nx;
            if (og + 1u == (tg + 1u) * nx) xb_add(&bar[XB_TOPGEN], 1u);
            else XB_SPIN(xb_ld(&bar[XB_TOPGEN]) == tg, bar);
            __builtin_amdgcn_fence(__ATOMIC_ACQUIRE, "agent");
            xb_add(&bar[XB_XGEN(b.x)], 1u);
            asm volatile("s_waitcnt vmcnt(0)" ::: "memory");
        } else {
            XB_SPIN(xb_ld(&bar[XB_XGEN(b.x)]) == gen, bar);
            __builtin_amdgcn_fence(__ATOMIC_ACQUIRE, "agent");
            asm volatile("s_waitcnt vmcnt(0)" ::: "memory");
        }
    }
    __syncthreads();
}


constexpr size_t OFF_XBAR = OFF_SMALL + 1536 * 1024;
constexpr size_t OFF_PX = OFF_SMALL + 1152 * 1024;
#define GSYNC_CG() do { __threadfence(); grid.sync(); __threadfence(); } while (0)
#define GSYNC() xcd_barrier(xbar)
#ifndef LAUNCH_SPLITS
#define LAUNCH_SPLITS {{0,0},{1,1},{2,2},{3,3},{4,4},{5,5},{6,6},{7,7},{8,8},{9,9},{10,10}}
#endif
template <int PLO, int PHI>
__global__ void __launch_bounds__(512) mega(Params p) {
  cg::grid_group grid = cg::this_grid();
  __shared__ __attribute__((aligned(16))) char smem[SMEM_BYTES];
  char* ws = p.ws;
  float* MOD = (float*)(ws + OFF_MOD);
  const int lb = logical_block();
  volatile LAS unsigned* xst = (volatile LAS unsigned*)(smem + LDS_RED + 2048);
  if (tid_fresh() < 4) xst[tid_fresh()] = 0u;
  __syncthreads();
  XcdBarrier xbar = xcd_barrier_post((unsigned*)(ws + OFF_XBAR), xst);
  if (PLO < PHI) grid.sync();

  if (PLO <= 0 && 0 <= PHI) {
  phase0(p, smem);
  }
  if (PLO <= 0 && 0 < PHI) { GSYNC(); }
  if (PLO <= 1 && 1 <= PHI) {

  ln_rows_modulate(p.x, (bf16_t*)(ws + OFF_M0), NTOK, SEQ, MOD, -1);
  ln_rows_modulate(p.ctx, (bf16_t*)(ws + OFF_MC), NCTX, CTXL, MOD, 16);
  }
  if (PLO <= 1 && 1 < PHI) { GSYNC(); }
  if (PLO <= 2 && 2 <= PHI) {

  phase2(p, smem);
  }
  if (PLO <= 2 && 2 < PHI) { GSYNC(); }
  if (PLO <= 3 && 3 <= PHI) {

  for (int u = lb; u < 1024; u += gridDim.x) {
      const int grp = u >> 5, j = u & 31, b = grp >> 1, kvh = grp & 1, hq = kvh * 4 + (j >> 3), qb = j & 7;
      const bf16_t* Qb = (const bf16_t*)(ws + OFF_Q) + ((size_t)(b * SEQ + qb * 256) * 8 + hq) * 128;
      const bf16_t* Kh = (const bf16_t*)(ws + OFF_KALL) + ((size_t)b * SKV * 2 + kvh) * 128;
      const bf16_t* Vh = (const bf16_t*)(ws + OFF_VALL) + ((size_t)b * SKV * 2 + kvh) * 128;
      bf16_t* GO = (bf16_t*)(ws + OFF_SG) + (size_t)(b * SEQ + qb * 256) * 2048 + hq * 128;
      att::attn_body(Qb, Kh, Vh, GO, SKV, smem);
  }
  for (int v = lb; v < 256; v += gridDim.x) chunk_gate_unit(p, v >> 4, v & 15, smem);
  }
  if (PLO <= 3 && 3 < PHI) { GSYNC(); }
  if (PLO <= 4 && 4 <= PHI) {

  out_proj((const bf16_t*)(ws + OFF_SG), (const bf16_t*)(ws + OFF_WT_EOUT), p.x, MOD, (float*)(ws + OFF_Q), smem);
  }
  if (PLO <= 4 && 4 < PHI) { GSYNC(); }
  if (PLO <= 5 && 5 <= PHI) {

  post_ln_rows((const float*)(ws + OFF_Q), (float*)(ws + OFF_Q), p.post_g, p.post_b, (bf16_t*)(ws + OFF_M0), MOD + 17 * 3072);
  }
  if (PLO <= 5 && 5 < PHI) { GSYNC(); }
  if (PLO <= 6 && 6 <= PHI) {

  {
    const bf16_t* M1 = (const bf16_t*)(ws + OFF_M0); const bf16_t* WT = (const bf16_t*)(ws + OFF_WT_OIN);
    bf16_t* F = (bf16_t*)(ws + OFF_F); bf16_t* RV = (bf16_t*)(ws + OFF_RV); bf16_t* XM = (bf16_t*)(ws + OFF_XM);
    bf16_t* SG1 = (bf16_t*)(ws + OFF_SG);
    for (int u = lb; u < 2048; u += gridDim.x) {
      f32x16 acc[2][4];
      if (u < 1024) {
        const int tt = u >> 3, ct = u & 7, b = tt >> 3, t0 = (tt & 7) * 256;
        gemm2(mkPlain(WT + (size_t)ct * 256 * 1024, 1024), mkPlain(M1 + (size_t)tt * 256 * 1024, 1024), 16, smem, acc);
        epi2_foreach(acc, [&](int row, int col, float a, float bq, float c, float d) {
          const int ch = ct * 256 + row, t = t0 + col;
          const size_t base = ((size_t)b * 2048 + ch) * 1024;
          if (t < 1024) {
            st_bf4(F + base + t, a, bq, c, d);
            if (t == 0) RV[base] = 0;
          } else if (t == 1024) {
            XM[(size_t)b * 2048 + ch] = f2bf(a);
            RV[base + 1023] = f2bf(bq); RV[base + 1022] = f2bf(c); RV[base + 1021] = f2bf(d);
          } else {
            RV[base + 2048 - t] = f2bf(a); RV[base + 2047 - t] = f2bf(bq); RV[base + 2046 - t] = f2bf(c); RV[base + 2045 - t] = f2bf(d);
          }
        });
      } else {
        const int v = u - 1024, mt = v >> 3, nt = v & 7;
        gemm2(mkPlain(M1 + (size_t)mt * 256 * 1024, 1024), mkPlain(WT + (size_t)(2048 + nt * 256) * 1024, 1024), 16, smem, acc);
        epi2_foreach(acc, [&](int row, int col, float a, float bq, float c, float d) {
          st_bf4(SG1 + (size_t)(mt * 256 + row) * 2048 + nt * 256 + col, silu_f(a), silu_f(bq), silu_f(c), silu_f(d));
        });
      }
    }
  }
  }
  if (PLO <= 6 && 6 < PHI) { GSYNC(); }
  if (PLO <= 7 && 7 <= PHI) {

  {
    {
      const int tid = tid_fresh(), wid = tid >> 6, lane = tid & 63;
      const int gw = blockIdx.x * 8 + wid, nw = gridDim.x * 8;
      const bf16_t* XMr = (const bf16_t*)(ws + OFF_XM); float* PX = (float*)(ws + OFF_PX);
      u32x4 na0, na1, nb0, nb1;
      { const size_t ro = (size_t)gw * 128; const u32x4* Fr = (const u32x4*)(ws + OFF_F) + ro; const u32x4* Rr = (const u32x4*)(ws + OFF_RV) + ro;
        na0 = Fr[lane]; na1 = Fr[lane + 64]; nb0 = Rr[lane]; nb1 = Rr[lane + 64]; }
      for (int row = gw; row < 16 * 2048; row += nw) {
        const u32x4 a0 = na0, a1 = na1, b0 = nb0, b1 = nb1;
        { const int nr = (row + nw < 16 * 2048) ? row + nw : row; const size_t ro = (size_t)nr * 128;
          const u32x4* Fr = (const u32x4*)(ws + OFF_F) + ro; const u32x4* Rr = (const u32x4*)(ws + OFF_RV) + ro;
          na0 = Fr[lane]; na1 = Fr[lane + 64]; nb0 = Rr[lane]; nb1 = Rr[lane + 64]; }
        u32x4 e0, e1, o0, o1; float alt = 0.f;
#pragma unroll
        for (int k = 0; k < 4; ++k) {
          { const float al = bf_lo(a0[k]), ah = bf_hi(a0[k]), bl = bf_lo(b0[k]), bh = bf_hi(b0[k]);
            e0[k] = cvtpk(al + bl, ah + bh); o0[k] = cvtpk(al - bl, ah - bh); alt += (al + bl) - (ah + bh); }
          { const float al = bf_lo(a1[k]), ah = bf_hi(a1[k]), bl = bf_lo(b1[k]), bh = bf_hi(b1[k]);
            e1[k] = cvtpk(al + bl, ah + bh); o1[k] = cvtpk(al - bl, ah - bh); alt += (al + bl) - (ah + bh); }
        }
        u32x4* Fw = (u32x4*)(ws + OFF_F) + (size_t)row * 128; u32x4* Rw = (u32x4*)(ws + OFF_RV) + (size_t)row * 128;
        Fw[lane] = e0; Fw[lane + 64] = e1; Rw[lane] = o0; Rw[lane + 64] = o1;
        alt = wave_sum(alt);
        if (lane == 0) PX[row] = alt + bf2f(XMr[row]);
      }
    }
    if (PLO < PHI) { GSYNC(); }
    const bf16_t* F = (const bf16_t*)(ws + OFF_F); const bf16_t* RV = (const bf16_t*)(ws + OFF_RV); const bf16_t* XM = (const bf16_t*)(ws + OFF_XM);
    const bf16_t* TC = (const bf16_t*)(ws + OFF_TAB_C); const bf16_t* TS = (const bf16_t*)(ws + OFF_TAB_S);
    bf16_t* PC = (bf16_t*)p.out; bf16_t* PS = (bf16_t*)(ws + OFF_M0);
    for (int u = lb; u < 1024; u += gridDim.x) {
      f32x16 acc[2][4];
      const int v = u & 511, b = v >> 5, mt = (v & 31) >> 3, nt = v & 7;
      const size_t bo = ((size_t)b * 2048 + nt * 256) * 1024;
      if (u < 512) {
        gemm2(mkPlain(TC + (size_t)mt * 256 * 1024, 1024), mkPlain(F + bo, 1024), 16, smem, acc);
        epi2_foreach(acc, [&](int row, int col, float a, float bq, float c, float d) {
          const int tp = mt * 256 + row, ch = nt * 256 + col;
          const u32x2 xm = *(const u32x2*)(XM + (size_t)b * 2048 + ch);
          const float sg = (tp & 1) ? -1.f : 1.f;
          a += sg * bf_lo(xm[0]); bq += sg * bf_hi(xm[0]); c += sg * bf_lo(xm[1]); d += sg * bf_hi(xm[1]);
          st_bf4(PC + ((size_t)b * 1024 + tp) * 2048 + ch, a, bq, c, d);
        });
      } else {
        gemm2(mkPlain(TS + (size_t)mt * 256 * 1024, 1024), mkPlain(RV + bo, 1024), 16, smem, acc);
        epi2_foreach(acc, [&](int row, int col, float a, float bq, float c, float d) {
          st_bf4(PS + ((size_t)b * 1024 + mt * 256 + row) * 2048 + nt * 256 + col, a, bq, c, d);
        });
      }
    }
  }
  }
  if (PLO <= 7 && 7 < PHI) { GSYNC(); }
  if (PLO <= 8 && 8 <= PHI) {

  {
    const bf16_t* PC = (const bf16_t*)p.out; const bf16_t* PS = (const bf16_t*)(ws + OFF_M0);
    const bf16_t* CDP = (const bf16_t*)(ws + OFF_CDP);
    bf16_t* SG1 = (bf16_t*)(ws + OFF_SG);
    const int tid = tid_fresh(), wid = tid >> 6, lane = tid & 63, r32 = lane & 31, hi = lane >> 5, wm = wid >> 1, wn = wid & 1;
    constexpr int TBS = 528;
    constexpr int TB_BYTES = 128 * TBS;
    char* sT = smem; char* sA = smem + TB_BYTES;
#pragma unroll
    for (int i = 0; i < 8; ++i) {
      const int id = tid + 512 * i, row = id >> 5, ck = id & 31;
      *(u32x4*)(sT + row * TBS + ck * 16) = *(const u32x4*)(CDP + row * 256 + ck * 8);
    }
    const int st_off = (tid >> 3) * LDS_ROWB + (tid & 7) * 16;
    const int a_rd = (wm * 64 + r32) * LDS_ROWB + hi * 16;
    const int b_rd = (wn * 32 + r32) * TBS + hi * 16;
    const size_t rowoff = (size_t)(tid >> 3) * 2048 + (tid & 7) * 8;
    u32x4 r00, r01, r02, r03, r10, r11, r12, r13, r20, r21, r22, r23, r30, r31, r32_, r33;
    auto a_base = [&](int u_, int s_) -> const bf16_t* {
      const int b_ = u_ >> 6, j_ = (u_ >> 4) & 3, G_ = u_ & 15;
      return ((s_ < 2) ? PC : PS) + ((size_t)b_ * 1024 + j_ * 256) * 2048 + G_ * 128 + (s_ & 1) * 64 + rowoff;
    };
#define P8_LOAD(S, U, A, B, C, D) do { const bf16_t* q_ = a_base((U), (S)); A = *(const u32x4*)(q_); B = *(const u32x4*)(q_ + (size_t)64 * 2048); \
      C = *(const u32x4*)(q_ + (size_t)128 * 2048); D = *(const u32x4*)(q_ + (size_t)192 * 2048); } while (0)
#define P8_WRITE(ST, A, B, C, D) do { char* s_ = sA + (ST) * L2_A + st_off; *(u32x4*)(s_) = A; *(u32x4*)(s_ + 64 * LDS_ROWB) = B; \
      *(u32x4*)(s_ + 128 * LDS_ROWB) = C; *(u32x4*)(s_ + 192 * LDS_ROWB) = D; } while (0)
#define P8_COMPUTE(ST, S, ACC) do { const char* sb_ = sA + (ST) * L2_A;                                              \
      _Pragma("unroll") for (int kk = 0; kk < 4; ++kk) {                                                               \
        const bf16x8 fa0 = *(const bf16x8*)(sb_ + a_rd + kk * 32);                                                      \
        const bf16x8 fa1 = *(const bf16x8*)(sb_ + a_rd + 32 * LDS_ROWB + kk * 32);                                      \
        const bf16x8 fb0 = *(const bf16x8*)(sT + b_rd + ((S) * 64 + kk * 16) * 2);                                      \
        const bf16x8 fb1 = *(const bf16x8*)(sT + b_rd + 64 * TBS + ((S) * 64 + kk * 16) * 2);                           \
        ACC[0][0] = __builtin_amdgcn_mfma_f32_32x32x16_bf16(fb0, fa0, ACC[0][0], 0, 0, 0);                              \
        ACC[0][1] = __builtin_amdgcn_mfma_f32_32x32x16_bf16(fb1, fa0, ACC[0][1], 0, 0, 0);                              \
        ACC[1][0] = __builtin_amdgcn_mfma_f32_32x32x16_bf16(fb0, fa1, ACC[1][0], 0, 0, 0);                              \
        ACC[1][1] = __builtin_amdgcn_mfma_f32_32x32x16_bf16(fb1, fa1, ACC[1][1], 0, 0, 0);                              \
      } } while (0)
    P8_LOAD(0, lb, r00, r01, r02, r03); P8_LOAD(1, lb, r10, r11, r12, r13); P8_LOAD(2, lb, r20, r21, r22, r23); P8_LOAD(3, lb, r30, r31, r32_, r33);
    for (int u = lb; u < 1024; u += gridDim.x) {
      const int un = (u + (int)gridDim.x < 1024) ? u + (int)gridDim.x : u;
      f32x16 acc1[2][2], acc2[2][2];
#pragma unroll
      for (int mi = 0; mi < 2; ++mi)
#pragma unroll
        for (int nj = 0; nj < 2; ++nj)
#pragma unroll
          for (int r = 0; r < 16; ++r) { acc1[mi][nj][r] = 0.f; acc2[mi][nj][r] = 0.f; }
      P8_WRITE(0, r00, r01, r02, r03); __syncthreads(); P8_LOAD(0, un, r00, r01, r02, r03); P8_COMPUTE(0, 0, acc1);
      P8_WRITE(1, r10, r11, r12, r13); __syncthreads(); P8_LOAD(1, un, r10, r11, r12, r13); P8_COMPUTE(1, 1, acc1);
      P8_WRITE(0, r20, r21, r22, r23); __syncthreads(); P8_LOAD(2, un, r20, r21, r22, r23); P8_COMPUTE(0, 2, acc2);
      P8_WRITE(1, r30, r31, r32_, r33); __syncthreads(); P8_LOAD(3, un, r30, r31, r32_, r33); P8_COMPUTE(1, 3, acc2);
      const int b = u >> 6, j = (u >> 4) & 3, G = u & 15;
      const float sc = 1.f / 512.f;
#pragma unroll
      for (int mi = 0; mi < 2; ++mi) {
        const int tp = j * 256 + wm * 64 + mi * 32 + r32;
#pragma unroll
        for (int nj = 0; nj < 2; ++nj)
#pragma unroll
          for (int q = 0; q < 4; ++q) {
            const int col = G * 128 + nj * 64 + wn * 32 + q * 8 + hi * 4;
            const float p0 = acc1[mi][nj][4 * q + 0], p1 = acc1[mi][nj][4 * q + 1], p2 = acc1[mi][nj][4 * q + 2], p3 = acc1[mi][nj][4 * q + 3];
            const float m0 = acc2[mi][nj][4 * q + 0], m1 = acc2[mi][nj][4 * q + 1], m2 = acc2[mi][nj][4 * q + 2], m3 = acc2[mi][nj][4 * q + 3];
            { bf16_t* gp = SG1 + ((size_t)b * 2048 + tp) * 2048 + col; const u32x2 sg = *(const u32x2*)gp;
              st_bf4(gp, (p0 - m0) * sc * bf_lo(sg[0]), (p1 - m1) * sc * bf_hi(sg[0]), (p2 - m2) * sc * bf_lo(sg[1]), (p3 - m3) * sc * bf_hi(sg[1])); }
            if (tp >= 1) { bf16_t* gp = SG1 + ((size_t)b * 2048 + (2048 - tp)) * 2048 + col; const u32x2 sg = *(const u32x2*)gp;
              st_bf4(gp, (p0 + m0) * sc * bf_lo(sg[0]), (p1 + m1) * sc * bf_hi(sg[0]), (p2 + m2) * sc * bf_lo(sg[1]), (p3 + m3) * sc * bf_hi(sg[1])); }
          }
      }
    }
#undef P8_LOAD
#undef P8_WRITE
#undef P8_COMPUTE
    {
      const float* PX = (const float*)(ws + OFF_PX);
      for (int i = blockIdx.x; i < 256; i += gridDim.x) {
        if (tid < 128) {
          const int b = i >> 4, G = i & 15;
          const float* px = PX + (size_t)b * 2048 + G * 128;
          float y = 0.f;
          for (int c = 0; c < 128; ++c) y += px[c] * bf2f(*(const bf16_t*)(sT + tid * TBS + c * 2));
          bf16_t* gp = SG1 + ((size_t)b * 2048 + 1024) * 2048 + G * 128 + tid;
          *gp = f2bf(y * (1.f / 512.f) * bf2f(*gp));
        }
      }
    }
  }
  }
  if (PLO <= 8 && 8 < PHI) { GSYNC(); }
  if (PLO <= 9 && 9 <= PHI) {

  out_proj((const bf16_t*)(ws + OFF_SG), (const bf16_t*)(ws + OFF_WT_OOUT), (const float*)(ws + OFF_Q), MOD + 17 * 3072, p.out, smem);
  }
  if (PLO <= 9 && 9 < PHI) { GSYNC(); }
  if (PLO <= 10 && 10 <= PHI) {

  post_ln_rows(p.out, p.out, p.post_g + 1024, p.post_b + 1024, nullptr, nullptr);
  }
}

extern "C" void kernel_launch(void* const* d_in, const int* in_sizes, int n_in, void* d_out, int out_size, void* d_ws, size_t ws_size,
                              hipStream_t stream) {
  static int grid_blocks = 0;
  if (!grid_blocks) {
    int dev = 0, cus = 0, per_cu = 0;
    hipGetDevice(&dev);
    hipDeviceGetAttribute(&cus, hipDeviceAttributeMultiprocessorCount, dev);
    hipOccupancyMaxActiveBlocksPerMultiprocessor(&per_cu, mega<0, 10>, 512, 0);
    if (per_cu > 1) per_cu = 1;
    grid_blocks = cus * per_cu;
    if (n_in != 18 || ws_size < WS_NEED) fprintf(stderr, "kernel_launch: unexpected n_in %d or ws_size %zu (need %zu)\n", n_in, ws_size, (size_t)WS_NEED);
  }
  Params p{};
  p.x = (const float*)d_in[0]; p.c = (const float*)d_in[1]; p.ctx = (const float*)d_in[2]; p.c_ctx = (const float*)d_in[3];
  p.w_mod = (const float*)d_in[4]; p.b_mod = (const float*)d_in[5]; p.post_g = (const float*)d_in[6]; p.post_b = (const float*)d_in[7];
  p.e_w_in = (const float*)d_in[8]; p.e_qn = (const float*)d_in[9]; p.e_kn = (const float*)d_in[10]; p.e_vg = (const float*)d_in[11];
  p.e_vb = (const float*)d_in[12]; p.e_ws = (const float*)d_in[13]; p.e_bs = (const float*)d_in[14]; p.e_w_out = (const float*)d_in[15];
  p.o_w_in = (const float*)d_in[16]; p.o_w_out = (const float*)d_in[17];
  p.out = (float*)d_out; p.ws = (char*)d_ws;
#define ONE_LAUNCH 1
#ifdef ONE_LAUNCH
  hipMemsetAsync((char*)d_ws + OFF_XBAR, 0, XCD_BAR_WORDS * 4, stream);
  { void* args[] = {&p};
    hipError_t e = hipLaunchCooperativeKernel((void*)mega<0, 10>, dim3(grid_blocks), dim3(512), args, 0, stream);
    if (e != hipSuccess) fprintf(stderr, "cooperative launch failed: %s (grid %d)\n", hipGetErrorString(e), grid_blocks); }
#else
  hipLaunchKernelGGL((mega<0, 0>), dim3(grid_blocks), dim3(512), 0, stream, p);
  hipLaunchKernelGGL((mega<1, 1>), dim3(grid_blocks), dim3(512), 0, stream, p);
  hipLaunchKernelGGL((mega<2, 2>), dim3(grid_blocks), dim3(512), 0, stream, p);
  hipLaunchKernelGGL((mega<3, 3>), dim3(grid_blocks), dim3(512), 0, stream, p);
  hipLaunchKernelGGL((mega<4, 4>), dim3(grid_blocks), dim3(512), 0, stream, p);
  hipLaunchKernelGGL((mega<5, 5>), dim3(grid_blocks), dim3(512), 0, stream, p);
  hipLaunchKernelGGL((mega<6, 6>), dim3(grid_blocks), dim3(512), 0, stream, p);
  hipLaunchKernelGGL((mega<7, 7>), dim3(grid_blocks), dim3(512), 0, stream, p);
  hipLaunchKernelGGL((mega<8, 8>), dim3(grid_blocks), dim3(512), 0, stream, p);
  hipLaunchKernelGGL((mega<9, 9>), dim3(grid_blocks), dim3(512), 0, stream, p);
  hipLaunchKernelGGL((mega<10, 10>), dim3(grid_blocks), dim3(512), 0, stream, p);
#endif
}
```

```cpp
#include <hip/hip_runtime.h>
#include <hip/hip_cooperative_groups.h>
#include <cstdio>
#include <cstdint>
namespace cg = cooperative_groups;

typedef unsigned short bf16_t;
using bf16x8 = __attribute__((ext_vector_type(8))) short;
using s16x4  = __attribute__((ext_vector_type(4))) short;
using f32x16 = __attribute__((ext_vector_type(16))) float;
using u32x4  = __attribute__((ext_vector_type(4))) unsigned;
using u32x2  = __attribute__((ext_vector_type(2))) unsigned;

constexpr int DM = 1024, NB = 16, SEQ = 2048, CTXL = 256, SKV = SEQ + CTXL;
constexpr int NTOK = NB * SEQ;
constexpr int NCTX = NB * CTXL;
constexpr int EVEN_IN = 5632, ODD_IN = 4096, DIN = 2048;
constexpr float ALPHA = 1.4142135623730951f;
constexpr float EPS = 1e-6f;

constexpr size_t MiB = 1ull << 20;
constexpr size_t OFF_WT_EIN = 0, OFF_WT_EOUT = 11 * MiB, OFF_WT_OIN = 15 * MiB, OFF_WT_OOUT = 23 * MiB;
constexpr size_t OFF_TAB_C = 27 * MiB, OFF_TAB_S = 30 * MiB, OFF_SMALL = 33 * MiB;
constexpr size_t OFF_CDM = OFF_SMALL, OFF_CDP = OFF_SMALL + 64 * 1024, OFF_WSB = OFF_SMALL + 128 * 1024;
constexpr size_t OFF_ROPE = OFF_SMALL + 384 * 1024, OFF_MOD = OFF_SMALL + 512 * 1024, OFF_XM = OFF_SMALL + 1024 * 1024;
constexpr size_t OFF_M0 = 36 * MiB, OFF_MC = 100 * MiB;
constexpr size_t OFF_SG = 108 * MiB;
constexpr size_t OFF_Q = 236 * MiB, OFF_BU = 300 * MiB;
constexpr size_t OFF_KALL = 364 * MiB, OFF_VALL = 382 * MiB, OFF_BV = 400 * MiB;
constexpr size_t OFF_F = 364 * MiB, OFF_RV = 428 * MiB;
constexpr size_t WS_NEED = 492 * MiB;

struct Params {
  const float *x, *c, *ctx, *c_ctx, *w_mod, *b_mod, *post_g, *post_b, *e_w_in, *e_qn, *e_kn, *e_vg, *e_vb, *e_ws, *e_bs,
      *e_w_out, *o_w_in, *o_w_out;
  float* out;
  char* ws;
  long pad_;
};

typedef float f32x2_t __attribute__((ext_vector_type(2)));
typedef __bf16 bf16x2_t __attribute__((ext_vector_type(2)));
__device__ __forceinline__ unsigned cvtpk(float lo, float hi) {
  f32x2_t v = {lo, hi}; bf16x2_t h = __builtin_convertvector(v, bf16x2_t); return __builtin_bit_cast(unsigned, h);
}
__device__ __forceinline__ int tid_fresh() { int t = (int)__builtin_amdgcn_workitem_id_x(); asm volatile("" : "+v"(t)); return t; }
__device__ __forceinline__ float bf_lo(unsigned w) { return __uint_as_float(w << 16); }
__device__ __forceinline__ float bf_hi(unsigned w) { return __uint_as_float(w & 0xffff0000u); }
__device__ __forceinline__ bf16_t f2bf(float x) { return (bf16_t)(cvtpk(x, 0.f) & 0xffffu); }
__device__ __forceinline__ float bf2f(bf16_t h) { return __uint_as_float(((unsigned)h) << 16); }
__device__ __forceinline__ int crow(int r, int hi) { return (r & 3) + 8 * (r >> 2) + 4 * hi; }
__device__ __forceinline__ float wave_sum(float v) {
#pragma unroll
  for (int o = 32; o >= 1; o >>= 1) v += __shfl_xor(v, o);
  return v;
}
__device__ __forceinline__ float silu_f(float x) { return x * __builtin_amdgcn_rcpf(1.f + __expf(-x)); }
__device__ __forceinline__ float gelu_tanh_f(float x) {
  const float u = 0.7978845608028654f * (x + 0.044715f * x * x * x);
  const float t = 1.f - 2.f * __builtin_amdgcn_rcpf(__expf(2.f * u) + 1.f);
  return 0.5f * x * (1.f + t);
}
__device__ __forceinline__ int logical_block() {
  const int g = gridDim.x, b = blockIdx.x;
  return (g & 7) ? b : (b & 7) * (g >> 3) + (b >> 3);
}

constexpr int LDS_ROWB = 144;
constexpr int LDS_A = 256 * LDS_ROWB;
constexpr int LDS_B = 128 * LDS_ROWB;
constexpr int LDS_STAGE = LDS_A + LDS_B;
constexpr int L2_A = 256 * LDS_ROWB;
constexpr int L2_STAGE = 2 * L2_A;
constexpr int LDS_RED = 2 * L2_STAGE;
constexpr int SMEM_BYTES = LDS_RED + 2048 + 2048;

struct LdPlain {
  const bf16_t* p; size_t rs;
  __device__ __forceinline__ u32x4 ld(int kt, int i) const { return *(const u32x4*)(p + (size_t)i * rs + kt * 64); }
};
__device__ __forceinline__ LdPlain mkPlain(const bf16_t* base, int ld) {
  const int tid = tid_fresh();
  LdPlain l; l.p = base + (size_t)(tid >> 3) * ld + (tid & 7) * 8; l.rs = (size_t)64 * ld; return l;
}
struct LdSplit {
  const bf16_t* p0; const bf16_t* p1; size_t rs; int kts;
  __device__ __forceinline__ u32x4 ld(int kt, int i) const {
    const bf16_t* q = (kt < kts) ? (p0 + kt * 64) : (p1 + (kt - kts) * 64);
    return *(const u32x4*)(q + (size_t)i * rs);
  }
};
__device__ __forceinline__ LdSplit mkSplit(const bf16_t* b0, const bf16_t* b1, int ld, int kts) {
  const int tid = tid_fresh(); const size_t o = (size_t)(tid >> 3) * ld + (tid & 7) * 8;
  LdSplit l; l.p0 = b0 + o; l.p1 = b1 + o; l.rs = (size_t)64 * ld; l.kts = kts; return l;
}
struct LdFold {
  const bf16_t* f; const bf16_t* r; size_t rs; float sg;
  __device__ __forceinline__ u32x4 ld(int kt, int i) const {
    const u32x4 a = *(const u32x4*)(f + (size_t)i * rs + kt * 64);
    const u32x4 b = *(const u32x4*)(r + (size_t)i * rs + kt * 64);
    u32x4 o;
    o[0] = cvtpk(bf_lo(a[0]) + sg * bf_lo(b[0]), bf_hi(a[0]) + sg * bf_hi(b[0]));
    o[1] = cvtpk(bf_lo(a[1]) + sg * bf_lo(b[1]), bf_hi(a[1]) + sg * bf_hi(b[1]));
    o[2] = cvtpk(bf_lo(a[2]) + sg * bf_lo(b[2]), bf_hi(a[2]) + sg * bf_hi(b[2]));
    o[3] = cvtpk(bf_lo(a[3]) + sg * bf_lo(b[3]), bf_hi(a[3]) + sg * bf_hi(b[3]));
    return o;
  }
};
__device__ __forceinline__ LdFold mkFold(const bf16_t* f, const bf16_t* r, int ld, float sg) {
  const int tid = tid_fresh(); const size_t o = (size_t)(tid >> 3) * ld + (tid & 7) * 8;
  LdFold l; l.f = f + o; l.r = r + o; l.rs = (size_t)64 * ld; l.sg = sg; return l;
}

template <class LA, class LB>
__device__ __forceinline__ void gemm_mainloop(const LA& la, const LB& lb, int KT, char* smem, f32x16 (&acc)[2][2]) {
  const int tid = tid_fresh(), wid = tid >> 6, lane = tid & 63, r32 = lane & 31, hi = lane >> 5, wm = wid >> 1, wn = wid & 1;
#pragma unroll
  for (int mi = 0; mi < 2; ++mi)
#pragma unroll
    for (int nj = 0; nj < 2; ++nj)
#pragma unroll
      for (int r = 0; r < 16; ++r) acc[mi][nj][r] = 0.f;
  const int st_off = (tid >> 3) * LDS_ROWB + (tid & 7) * 16;
  const int a_rd = (wm * 64 + r32) * LDS_ROWB + hi * 16;
  const int b_rd = LDS_A + (wn * 32 + r32) * LDS_ROWB + hi * 16;
  u32x4 ra0, ra1, ra2, ra3, rb0, rb1;
  ra0 = la.ld(0, 0); ra1 = la.ld(0, 1); ra2 = la.ld(0, 2); ra3 = la.ld(0, 3); rb0 = lb.ld(0, 0); rb1 = lb.ld(0, 1);
  {
    char* s = smem + st_off;
    *(u32x4*)(s) = ra0; *(u32x4*)(s + 64 * LDS_ROWB) = ra1; *(u32x4*)(s + 128 * LDS_ROWB) = ra2; *(u32x4*)(s + 192 * LDS_ROWB) = ra3;
    *(u32x4*)(s + LDS_A) = rb0; *(u32x4*)(s + LDS_A + 64 * LDS_ROWB) = rb1;
  }
  __syncthreads();
#define GEMM_COMPUTE(SB)                                                                              \
  _Pragma("unroll") for (int kk = 0; kk < 4; ++kk) {                                                  \
    const bf16x8 a0 = *(const bf16x8*)((SB) + a_rd + kk * 32);                                        \
    const bf16x8 a1 = *(const bf16x8*)((SB) + a_rd + 32 * LDS_ROWB + kk * 32);                        \
    const bf16x8 b0 = *(const bf16x8*)((SB) + b_rd + kk * 32);                                        \
    const bf16x8 b1 = *(const bf16x8*)((SB) + b_rd + 64 * LDS_ROWB + kk * 32);                        \
    acc[0][0] = __builtin_amdgcn_mfma_f32_32x32x16_bf16(b0, a0, acc[0][0], 0, 0, 0);                  \
    acc[0][1] = __builtin_amdgcn_mfma_f32_32x32x16_bf16(b1, a0, acc[0][1], 0, 0, 0);                  \
    acc[1][0] = __builtin_amdgcn_mfma_f32_32x32x16_bf16(b0, a1, acc[1][0], 0, 0, 0);                  \
    acc[1][1] = __builtin_amdgcn_mfma_f32_32x32x16_bf16(b1, a1, acc[1][1], 0, 0, 0);                  \
  }
#define GEMM_LOAD(KT_) do { ra0 = la.ld((KT_), 0); ra1 = la.ld((KT_), 1); ra2 = la.ld((KT_), 2); ra3 = la.ld((KT_), 3); rb0 = lb.ld((KT_), 0); rb1 = lb.ld((KT_), 1); } while (0)
#define GEMM_WRITE(ST) do { char* s = smem + (ST) * LDS_STAGE + st_off;                                \
    *(u32x4*)(s) = ra0; *(u32x4*)(s + 64 * LDS_ROWB) = ra1; *(u32x4*)(s + 128 * LDS_ROWB) = ra2; *(u32x4*)(s + 192 * LDS_ROWB) = ra3; \
    *(u32x4*)(s + LDS_A) = rb0; *(u32x4*)(s + LDS_A + 64 * LDS_ROWB) = rb1; } while (0)
#pragma unroll 1
  for (int kt = 0; kt < KT; kt += 2) {
    GEMM_LOAD(kt + 1);
    GEMM_COMPUTE(smem);
    GEMM_WRITE(1);
    __syncthreads();
    GEMM_LOAD(kt + 2 < KT ? kt + 2 : kt);
    GEMM_COMPUTE(smem + LDS_STAGE);
    GEMM_WRITE(0);
    __syncthreads();
  }
#undef GEMM_COMPUTE
#undef GEMM_LOAD
#undef GEMM_WRITE
}

template <class LA, class LB>
__device__ __forceinline__ void gemm2(const LA& la, const LB& lb, int KT, char* smem, f32x16 (&acc)[2][4]) {
  const int tid = tid_fresh(), wid = tid >> 6, lane = tid & 63, r32 = lane & 31, hi = lane >> 5, wm = wid >> 1, wn = wid & 1;
#pragma unroll
  for (int mi = 0; mi < 2; ++mi)
#pragma unroll
    for (int nj = 0; nj < 4; ++nj)
#pragma unroll
      for (int r = 0; r < 16; ++r) acc[mi][nj][r] = 0.f;
  const int st_off = (tid >> 3) * LDS_ROWB + (tid & 7) * 16;
  const int a_rd = (wm * 64 + r32) * LDS_ROWB + hi * 16;
  const int b_rd = L2_A + (wn * 128 + r32) * LDS_ROWB + hi * 16;
  u32x4 xa0, xa1, xa2, xa3, xb0, xb1, xb2, xb3, ya0, ya1, ya2, ya3, yb0, yb1, yb2, yb3;
#define G2_LOADX(KT_) do { xa0 = la.ld((KT_), 0); xa1 = la.ld((KT_), 1); xa2 = la.ld((KT_), 2); xa3 = la.ld((KT_), 3); xb0 = lb.ld((KT_), 0); xb1 = lb.ld((KT_), 1); xb2 = lb.ld((KT_), 2); xb3 = lb.ld((KT_), 3); } while (0)
#define G2_LOADY(KT_) do { ya0 = la.ld((KT_), 0); ya1 = la.ld((KT_), 1); ya2 = la.ld((KT_), 2); ya3 = la.ld((KT_), 3); yb0 = lb.ld((KT_), 0); yb1 = lb.ld((KT_), 1); yb2 = lb.ld((KT_), 2); yb3 = lb.ld((KT_), 3); } while (0)
#define G2_W2(ST, P, R0, R1, O0, O1) do { char* s_ = smem + (ST) * L2_STAGE + st_off; *(u32x4*)(s_ + (O0)) = P##R0; *(u32x4*)(s_ + (O1)) = P##R1; } while (0)
#define G2_WRITE(ST, P) do { G2_W2(ST, P, a0, a1, 0, 64 * LDS_ROWB); G2_W2(ST, P, a2, a3, 128 * LDS_ROWB, 192 * LDS_ROWB); \
    G2_W2(ST, P, b0, b1, L2_A, L2_A + 64 * LDS_ROWB); G2_W2(ST, P, b2, b3, L2_A + 128 * LDS_ROWB, L2_A + 192 * LDS_ROWB); } while (0)
#define G2_STEP(SB, kk) do {                                                                          \
    const bf16x8 a0 = *(const bf16x8*)((SB) + a_rd + (kk) * 32);                                      \
    const bf16x8 a1 = *(const bf16x8*)((SB) + a_rd + 32 * LDS_ROWB + (kk) * 32);                      \
    _Pragma("unroll") for (int nj = 0; nj < 4; ++nj) {                                                \
      const bf16x8 b_ = *(const bf16x8*)((SB) + b_rd + nj * 32 * LDS_ROWB + (kk) * 32);               \
      acc[0][nj] = __builtin_amdgcn_mfma_f32_32x32x16_bf16(b_, a0, acc[0][nj], 0, 0, 0);              \
      acc[1][nj] = __builtin_amdgcn_mfma_f32_32x32x16_bf16(b_, a1, acc[1][nj], 0, 0, 0);              \
    } } while (0)
#define G2_COMPUTE_W(SB, ST, P) do {                                                                  \
    G2_STEP(SB, 0); G2_W2(ST, P, a0, a1, 0, 64 * LDS_ROWB);                                           \
    G2_STEP(SB, 1); G2_W2(ST, P, a2, a3, 128 * LDS_ROWB, 192 * LDS_ROWB);                             \
    G2_STEP(SB, 2); G2_W2(ST, P, b0, b1, L2_A, L2_A + 64 * LDS_ROWB);                                 \
    G2_STEP(SB, 3); G2_W2(ST, P, b2, b3, L2_A + 128 * LDS_ROWB, L2_A + 192 * LDS_ROWB); } while (0)
  G2_LOADX(0); G2_LOADY(1);
  G2_WRITE(0, x);
  __syncthreads();
  G2_LOADX(2 < KT ? 2 : 0);
#pragma unroll 1
  for (int kt = 0; kt < KT; kt += 2) {
    G2_COMPUTE_W(smem, 1, y);
    __syncthreads();
    G2_LOADY(kt + 3 < KT ? kt + 3 : KT - 1);
    G2_COMPUTE_W(smem + L2_STAGE, 0, x);
    __syncthreads();
    G2_LOADX(kt + 4 < KT ? kt + 4 : KT - 2);
  }
#undef G2_LOADX
#undef G2_LOADY
#undef G2_WRITE
#undef G2_W2
#undef G2_STEP
#undef G2_COMPUTE_W
}
template <class F>
__device__ __forceinline__ void epi2_foreach(const f32x16 (&acc)[2][4], F&& f) {
  const int tid = tid_fresh(), wid = tid >> 6, lane = tid & 63, r32 = lane & 31, hi = lane >> 5, wm = wid >> 1, wn = wid & 1;
#pragma unroll
  for (int mi = 0; mi < 2; ++mi)
#pragma unroll
    for (int nj = 0; nj < 4; ++nj)
#pragma unroll
      for (int q = 0; q < 4; ++q)
        f(wm * 64 + mi * 32 + r32, wn * 128 + nj * 32 + q * 8 + hi * 4, acc[mi][nj][4 * q + 0], acc[mi][nj][4 * q + 1],
          acc[mi][nj][4 * q + 2], acc[mi][nj][4 * q + 3]);
}

template <class F>
__device__ __forceinline__ void epi_foreach(const f32x16 (&acc)[2][2], F&& f) {
  const int tid = tid_fresh(), wid = tid >> 6, lane = tid & 63, r32 = lane & 31, hi = lane >> 5, wm = wid >> 1, wn = wid & 1;
#pragma unroll
  for (int mi = 0; mi < 2; ++mi)
#pragma unroll
    for (int nj = 0; nj < 2; ++nj)
#pragma unroll
      for (int q = 0; q < 4; ++q)
        f(wm * 64 + mi * 32 + r32, nj * 64 + wn * 32 + q * 8 + hi * 4, acc[mi][nj][4 * q + 0], acc[mi][nj][4 * q + 1],
          acc[mi][nj][4 * q + 2], acc[mi][nj][4 * q + 3]);
}
__device__ __forceinline__ void st_bf4(bf16_t* p, float a, float b, float c, float d) {
  u32x2 w = {cvtpk(a, b), cvtpk(c, d)}; *(u32x2*)p = w;
}

__device__ __forceinline__ void tr_tile(const float* src, bf16_t* dst, int K, int N, int kt, int nt, float* tile) {
  const int tid = tid_fresh(), k0 = kt * 64, n0 = nt * 64;
#pragma unroll
  for (int j = 0; j < 8; ++j) { const int e = j * 512 + tid, r = e >> 6, c = e & 63; tile[r * 65 + c] = src[(size_t)(k0 + r) * N + n0 + c]; }
  __syncthreads();
  const int rn = tid >> 3, ck = (tid & 7) * 8;
  const float v0 = tile[(ck + 0) * 65 + rn], v1 = tile[(ck + 1) * 65 + rn], v2 = tile[(ck + 2) * 65 + rn], v3 = tile[(ck + 3) * 65 + rn];
  const float v4 = tile[(ck + 4) * 65 + rn], v5 = tile[(ck + 5) * 65 + rn], v6 = tile[(ck + 6) * 65 + rn], v7 = tile[(ck + 7) * 65 + rn];
  u32x4 w = {cvtpk(v0, v1), cvtpk(v2, v3), cvtpk(v4, v5), cvtpk(v6, v7)};
  *(u32x4*)(dst + (size_t)(n0 + rn) * K + k0 + ck) = w;
  __syncthreads();
}

__device__ __forceinline__ void phase0(const Params& p, char* smem) {
  const int tid = tid_fresh(), G = gridDim.x, bid = blockIdx.x;
  char* ws = p.ws;
  {
    float* s = (float*)smem;
    float* part = (float*)(smem + 17 * 1024 * 4);
    float* MOD = (float*)(ws + OFF_MOD);
    for (int u = bid; u < 96; u += G) {
      const int l = u / 48, j0 = (u % 48) * 64;
      for (int e = tid; e < 17 * 1024; e += 512) { const int r = e >> 10, k = e & 1023; const float cv = (r < 16) ? p.c[r * 1024 + k] : p.c_ctx[k]; s[e] = silu_f(cv); }
      __syncthreads();
      const int col = tid & 63, ks = tid >> 6;
      float a0 = 0, a1 = 0, a2 = 0, a3 = 0, a4 = 0, a5 = 0, a6 = 0, a7 = 0, a8 = 0, a9 = 0, a10 = 0, a11 = 0, a12 = 0, a13 = 0, a14 = 0, a15 = 0, a16 = 0;
      const float* w = p.w_mod + (size_t)l * 1024 * 3072 + j0 + col;
#pragma unroll 4
      for (int k = ks * 128; k < ks * 128 + 128; ++k) {
        const float wv = w[(size_t)k * 3072];
        a0 += s[0 * 1024 + k] * wv; a1 += s[1 * 1024 + k] * wv; a2 += s[2 * 1024 + k] * wv; a3 += s[3 * 1024 + k] * wv;
        a4 += s[4 * 1024 + k] * wv; a5 += s[5 * 1024 + k] * wv; a6 += s[6 * 1024 + k] * wv; a7 += s[7 * 1024 + k] * wv;
        a8 += s[8 * 1024 + k] * wv; a9 += s[9 * 1024 + k] * wv; a10 += s[10 * 1024 + k] * wv; a11 += s[11 * 1024 + k] * wv;
        a12 += s[12 * 1024 + k] * wv; a13 += s[13 * 1024 + k] * wv; a14 += s[14 * 1024 + k] * wv; a15 += s[15 * 1024 + k] * wv;
        a16 += s[16 * 1024 + k] * wv;
      }
      float* pp = part + ks * 17 * 64 + col;
      pp[0 * 64] = a0; pp[1 * 64] = a1; pp[2 * 64] = a2; pp[3 * 64] = a3; pp[4 * 64] = a4; pp[5 * 64] = a5; pp[6 * 64] = a6; pp[7 * 64] = a7;
      pp[8 * 64] = a8; pp[9 * 64] = a9; pp[10 * 64] = a10; pp[11 * 64] = a11; pp[12 * 64] = a12; pp[13 * 64] = a13; pp[14 * 64] = a14; pp[15 * 64] = a15;
      pp[16 * 64] = a16;
      __syncthreads();
      for (int e = tid; e < 17 * 64; e += 512) {
        const int r = e >> 6, cc = e & 63;
        float t = p.b_mod[l * 3072 + j0 + cc];
#pragma unroll
        for (int q = 0; q < 8; ++q) t += part[q * 17 * 64 + r * 64 + cc];
        MOD[(size_t)(l * 17 + r) * 3072 + j0 + cc] = t;
      }
      __syncthreads();
    }
  }
  {
    float* tile = (float*)smem;
    constexpr int T0 = 16 * 88, T1 = 32 * 16, T2 = 16 * 64, T3 = 32 * 16;
    for (int u = bid; u < T0 + T1 + T2 + T3; u += G) {
      if (u < T0) tr_tile(p.e_w_in, (bf16_t*)(ws + OFF_WT_EIN), 1024, EVEN_IN, u / 88, u % 88, tile);
      else if (u < T0 + T1) { const int v = u - T0; tr_tile(p.e_w_out, (bf16_t*)(ws + OFF_WT_EOUT), 2048, 1024, v / 16, v % 16, tile); }
      else if (u < T0 + T1 + T2) { const int v = u - T0 - T1; tr_tile(p.o_w_in, (bf16_t*)(ws + OFF_WT_OIN), 1024, ODD_IN, v / 64, v % 64, tile); }
      else { const int v = u - T0 - T1 - T2; tr_tile(p.o_w_out, (bf16_t*)(ws + OFF_WT_OOUT), 2048, 1024, v / 16, v % 16, tile); }
    }
  }
  {
    const long gt = (long)bid * 512 + tid, gn = (long)G * 512;
    bf16_t* TC = (bf16_t*)(ws + OFF_TAB_C); bf16_t* TS = (bf16_t*)(ws + OFF_TAB_S);
    for (long e = gt; e < 1280L * 1024; e += gn) {
      const int tp = (int)(e >> 10), t = (int)(e & 1023);
      float v = 0.f;
      if (tp <= 1024) { const int m = (tp * t) & 2047; v = cospif((float)m * (1.f / 1024.f)); }
      TC[e] = f2bf(v);
    }
    for (long e = gt; e < 1024L * 1024; e += gn) {
      const int tp = (int)(e >> 10), t = (int)(e & 1023);
      const int m = (tp * t) & 2047;
      TS[e] = f2bf(sinpif((float)m * (1.f / 1024.f)));
    }
    bf16_t* CDM = (bf16_t*)(ws + OFF_CDM); bf16_t* CDP = (bf16_t*)(ws + OFF_CDP);
    for (long e = gt; e < 128L * 256; e += gn) {
      const int cp = (int)(e >> 8), k = (int)(e & 255);
      const int m = (cp * (k & 127)) & 127;
      const float x = (float)m * (1.f / 64.f);
      float vm, vp;
      if (k < 128) { vm = cospif(x); vp = vm; } else { vp = sinpif(x); vm = -vp; }
      CDM[e] = f2bf(vm); CDP[e] = f2bf(vp);
    }
    bf16_t* WSB = (bf16_t*)(ws + OFF_WSB);
    for (long e = gt; e < 8L * 128 * 128; e += gn) WSB[e] = f2bf(p.e_ws[e]);
    float2* ROPE = (float2*)(ws + OFF_ROPE);
    for (long e = gt; e < 64L * 32; e += gn) {
      const int pos = (int)(e >> 5), i = (int)(e & 31);
      const float inv = powf(10000.f, -(float)i / 32.f);
      const float ang = (float)pos * inv;
      ROPE[e] = make_float2(cosf(ang), sinf(ang));
    }
  }
}

__device__ __forceinline__ void ln_rows_modulate(const float* src, bf16_t* dst, int nrows, int rows_per_b, const float* mod17, int fixed_row) {
  const int tid = tid_fresh(), wid = tid >> 6, lane = tid & 63;
  const int gw = blockIdx.x * 8 + wid, nw = gridDim.x * 8;
  float4 n0, n1, n2, n3;
  { const int r0 = gw < nrows ? gw : 0; const float4* ps = (const float4*)(src + (size_t)r0 * 1024); n0 = ps[lane]; n1 = ps[lane + 64]; n2 = ps[lane + 128]; n3 = ps[lane + 192]; }
  for (int row = gw; row < nrows; row += nw) {
    float4 v0 = n0, v1 = n1, v2 = n2, v3 = n3;
    { const int nr = (row + nw < nrows) ? row + nw : row;
      const float4* ps = (const float4*)(src + (size_t)nr * 1024); n0 = ps[lane]; n1 = ps[lane + 64]; n2 = ps[lane + 128]; n3 = ps[lane + 192]; }
    float s = v0.x + v0.y + v0.z + v0.w + v1.x + v1.y + v1.z + v1.w + v2.x + v2.y + v2.z + v2.w + v3.x + v3.y + v3.z + v3.w;
    const float mu = wave_sum(s) * (1.f / 1024.f);
    v0.x -= mu; v0.y -= mu; v0.z -= mu; v0.w -= mu; v1.x -= mu; v1.y -= mu; v1.z -= mu; v1.w -= mu;
    v2.x -= mu; v2.y -= mu; v2.z -= mu; v2.w -= mu; v3.x -= mu; v3.y -= mu; v3.z -= mu; v3.w -= mu;
    float q = v0.x * v0.x + v0.y * v0.y + v0.z * v0.z + v0.w * v0.w + v1.x * v1.x + v1.y * v1.y + v1.z * v1.z + v1.w * v1.w +
              v2.x * v2.x + v2.y * v2.y + v2.z * v2.z + v2.w * v2.w + v3.x * v3.x + v3.y * v3.y + v3.z * v3.z + v3.w * v3.w;
    const float rstd = rsqrtf(wave_sum(q) * (1.f / 1024.f) + EPS);
    const int mr = (fixed_row >= 0) ? fixed_row : (row / rows_per_b);
    const float* md = mod17 + (size_t)mr * 3072;
    bf16_t* pd = dst + (size_t)row * 1024;
#define MODST(V, J) { const int col = (lane + 64 * J) * 4; const float4 sh = *(const float4*)(md + col); const float4 sc = *(const float4*)(md + 1024 + col); \
      st_bf4(pd + col, V.x * rstd * (1.f + sc.x) + sh.x, V.y * rstd * (1.f + sc.y) + sh.y, V.z * rstd * (1.f + sc.z) + sh.z, V.w * rstd * (1.f + sc.w) + sh.w); }
    MODST(v0, 0) MODST(v1, 1) MODST(v2, 2) MODST(v3, 3)
#undef MODST
  }
}

__device__ __forceinline__ void phase2(const Params& p, char* smem) {
  char* ws = p.ws;
  const bf16_t* M0 = (const bf16_t*)(ws + OFF_M0); const bf16_t* MC = (const bf16_t*)(ws + OFF_MC);
  const bf16_t* WT = (const bf16_t*)(ws + OFF_WT_EIN);
  bf16_t* Q = (bf16_t*)(ws + OFF_Q); bf16_t* KA = (bf16_t*)(ws + OFF_KALL); bf16_t* VA = (bf16_t*)(ws + OFF_VALL);
  bf16_t* BU = (bf16_t*)(ws + OFF_BU); bf16_t* BV = (bf16_t*)(ws + OFF_BV); bf16_t* SG = (bf16_t*)(ws + OFF_SG);
  const float2* ROPE = (const float2*)(ws + OFF_ROPE);
  const int tid = tid_fresh(), wid = tid >> 6, lane = tid & 63, r32 = lane & 31, hi = lane >> 5, wm = wid >> 1, wn = wid & 1;
  const int lb = logical_block();
  for (int u = lb; u < 2816 + 32; u += gridDim.x) {
    const bool isctx = (u >= 2816);
    int mt, nt;
    if (!isctx) { mt = u / 22; nt = u % 22; } else { const int v = u - 2816; mt = v >> 1; nt = 4 + (v & 1); }
    const bf16_t* A = (isctx ? MC : M0) + (size_t)mt * 256 * 1024;
    f32x16 acc[2][4];
    gemm2(mkPlain(A, 1024), mkPlain(WT + (size_t)nt * 256 * 1024, 1024), 16, smem, acc);
    if (nt < 5) {
      const bool isq = nt < 4;
      const int head = isq ? (nt * 2 + wn) : wn;
      const float* gv = isq ? p.e_qn : p.e_kn;
#pragma unroll
      for (int mi = 0; mi < 2; ++mi) {
        float ss = 0.f;
#pragma unroll
        for (int nj = 0; nj < 4; ++nj)
#pragma unroll
          for (int r = 0; r < 16; ++r) ss += acc[mi][nj][r] * acc[mi][nj][r];
        ss += __shfl_xor(ss, 32);
        const float rstd = rsqrtf(ss * (1.f / 128.f) + EPS);
        const int row = wm * 64 + mi * 32 + r32;
        int t = 0; size_t obase;
        if (!isctx) {
          const int b = mt >> 3; t = (mt & 7) * 256 + row;
          if (isq) obase = ((size_t)(b * SEQ + t) * 8 + head) * 128;
          else obase = ((size_t)(b * SKV + CTXL + t) * 2 + head) * 128;
        } else {
          obase = ((size_t)(mt * SKV + row) * 2 + head) * 128;
        }
        bf16_t* dst = (isq ? Q : KA) + obase;
#pragma unroll
        for (int nj = 0; nj < 2; ++nj) {
          const int pos = (nj == 0) ? (t >> 6) : (t & 63);
#pragma unroll
          for (int q = 0; q < 4; ++q) {
            float o1[4], o2[4];
#pragma unroll
            for (int e = 0; e < 4; ++e) {
              const int r = 4 * q + e;
              const int i = 8 * q + 4 * hi + e;
              const int d = nj * 32 + i;
              const float x1 = acc[mi][nj][r] * rstd * gv[d];
              const float x2 = acc[mi][nj + 2][r] * rstd * gv[64 + d];
              if (!isctx) {
                const float2 cs = ROPE[pos * 32 + i];
                o1[e] = x1 * cs.x - x2 * cs.y; o2[e] = x2 * cs.x + x1 * cs.y;
              } else { o1[e] = x1; o2[e] = x2; }
            }
            const int d0 = nj * 32 + 8 * q + 4 * hi;
            st_bf4(dst + d0, o1[0], o1[1], o1[2], o1[3]);
            st_bf4(dst + 64 + d0, o2[0], o2[1], o2[2], o2[3]);
          }
        }
      }
    } else if (nt == 5) {
      epi2_foreach(acc, [&](int row, int col, float a, float b, float c, float d) {
        size_t tokrow;
        if (!isctx) { const int bb = mt >> 3, t = (mt & 7) * 256 + row; tokrow = (size_t)bb * SKV + CTXL + t; } else tokrow = (size_t)mt * SKV + row;
        st_bf4(VA + tokrow * 256 + col, a, b, c, d);
      });
    } else if (nt < 14) {
      bf16_t* dst = (nt < 10) ? (BU + (size_t)(nt - 6) * 256) : (BV + (size_t)(nt - 10) * 256);
      epi2_foreach(acc, [&](int row, int col, float a, float b, float c, float d) {
        st_bf4(dst + (size_t)(mt * 256 + row) * 1024 + col, gelu_tanh_f(a), gelu_tanh_f(b), gelu_tanh_f(c), gelu_tanh_f(d));
      });
    } else {
      bf16_t* dst = SG + (size_t)(nt - 14) * 256;
      epi2_foreach(acc, [&](int row, int col, float a, float b, float c, float d) {
        st_bf4(dst + (size_t)(mt * 256 + row) * 2048 + col, silu_f(a), silu_f(b), silu_f(c), silu_f(d));
      });
    }
  }
}

namespace att {
constexpr int D = 128, NW = 8, QBLK = 32, KVBLK = 64;
constexpr float SCALE = 0.088388347648318440f;
constexpr float THR = 8.f;
constexpr int LDQ = 1024, LDK = 256;
constexpr int SHM_V = KVBLK * D * 2, SHM_K = KVBLK * D * 2;
#define KSWZ(row, colB) ((row) * 256 + ((colB) ^ (((row) & 7) << 4)))
#define SBAR() __builtin_amdgcn_sched_barrier(0)
__device__ __forceinline__ void partialSM(f32x16& p0, f32x16& p1, float& m_reg, float& mn, float& alpha) {
  constexpr float C = SCALE * 1.4426950408889634f;
  float pmax = p0[0];
#pragma unroll
  for (int r = 1; r < 16; ++r) pmax = fmaxf(pmax, p0[r]);
#pragma unroll
  for (int r = 0; r < 16; ++r) pmax = fmaxf(pmax, p1[r]);
  { auto rr = __builtin_amdgcn_permlane32_swap(__float_as_uint(pmax), __float_as_uint(pmax), false, false);
    pmax = fmaxf(__uint_as_float(rr[0]), __uint_as_float(rr[1])); }
  if (__builtin_expect(__all(pmax - m_reg <= THR / SCALE), 1)) { mn = m_reg; alpha = 1.f; }
  else { mn = fmaxf(m_reg, pmax); alpha = __builtin_amdgcn_exp2f((m_reg - mn) * C); m_reg = mn; }
  const float mnC = -mn * C;
#pragma unroll
  for (int r = 0; r < 16; ++r) p0[r] = fmaf(p0[r], C, mnC);
#pragma unroll
  for (int r = 0; r < 16; ++r) p1[r] = fmaf(p1[r], C, mnC);
#pragma unroll
  for (int r = 0; r < 16; ++r) p0[r] = __builtin_amdgcn_exp2f(p0[r]);
}
__device__ __forceinline__ void finishSM(f32x16& p0, f32x16& p1, float alpha, float& l_reg, bf16x8& pa0, bf16x8& pa1, bf16x8& pa2, bf16x8& pa3) {
#pragma unroll
  for (int r = 0; r < 16; ++r) p1[r] = __builtin_amdgcn_exp2f(p1[r]);
  float ps = 0;
#pragma unroll
  for (int r = 0; r < 16; ++r) ps += p0[r];
#pragma unroll
  for (int r = 0; r < 16; ++r) ps += p1[r];
  { auto rr = __builtin_amdgcn_permlane32_swap(__float_as_uint(ps), __float_as_uint(ps), false, false);
    ps = __uint_as_float(rr[0]) + __uint_as_float(rr[1]); }
  l_reg = l_reg * alpha + ps;
#define PK4(P, BASE, OUT) do { unsigned a0 = cvtpk(P[BASE + 0], P[BASE + 1]), a1 = cvtpk(P[BASE + 2], P[BASE + 3]);   \
    unsigned b0 = cvtpk(P[BASE + 4], P[BASE + 5]), b1 = cvtpk(P[BASE + 6], P[BASE + 7]);                              \
    auto r0 = __builtin_amdgcn_permlane32_swap(a0, b0, false, false); auto r1 = __builtin_amdgcn_permlane32_swap(a1, b1, false, false); \
    u32x4 w = {r0[0], r1[0], r0[1], r1[1]}; OUT = *reinterpret_cast<bf16x8*>(&w); } while (0)
  PK4(p0, 0, pa0); PK4(p0, 8, pa1); PK4(p1, 0, pa2); PK4(p1, 8, pa3);
#undef PK4
}
__device__ __forceinline__ void qkt(f32x16& p0, f32x16& p1, const bf16_t* Ks, const bf16x8* qr, int r32, int hi) {
#pragma unroll
  for (int r = 0; r < 16; ++r) { p0[r] = 0.f; p1[r] = 0.f; }
#pragma unroll
  for (int d0 = 0; d0 < 8; ++d0) { const int cb = (d0 * 16 + hi * 8) * 2;
    bf16x8 b0 = *reinterpret_cast<const bf16x8*>((const char*)Ks + KSWZ(r32, cb));
    bf16x8 b1 = *reinterpret_cast<const bf16x8*>((const char*)Ks + KSWZ(32 + r32, cb));
    p0 = __builtin_amdgcn_mfma_f32_32x32x16_bf16(b0, qr[d0], p0, 0, 0, 0);
    p1 = __builtin_amdgcn_mfma_f32_32x32x16_bf16(b1, qr[d0], p1, 0, 0, 0); }
}
__device__ __forceinline__ int v_st(int k, int c) { const int kk = (k & ~0xC) | ((k & 4) << 1) | ((k & 8) >> 1); return ((kk >> 3) * 4 + (c >> 5)) * 512 + ((kk & 7) * 32 + (c & 31)) * 2; }
__device__ __forceinline__ int v_rd_base(int lane) { return ((lane & 3) << 3) | (((lane >> 2) & 3) << 6) | (((lane >> 4) & 1) << 5) | (((lane >> 5) & 1) << 8); }
constexpr int v_rd_off(int d0, int ks, int half) { return d0 * 512 + ks * 4096 + half * 2048; }
template <int OFF> __device__ __forceinline__ s16x4 tr_read(int vb) {
  s16x4 r; asm volatile("ds_read_b64_tr_b16 %0, %1 offset:%2" : "=&v"(r) : "v"(vb), "i"(OFF) : "memory"); return r;
}
template <int D0> __device__ __forceinline__ void pv_one(f32x16& od, int vb, bf16x8 pa0, bf16x8 pa1, bf16x8 pa2, bf16x8 pa3) {
  const s16x4 l0 = tr_read<v_rd_off(D0, 0, 0)>(vb), h0 = tr_read<v_rd_off(D0, 0, 1)>(vb), l1 = tr_read<v_rd_off(D0, 1, 0)>(vb), h1 = tr_read<v_rd_off(D0, 1, 1)>(vb);
  const s16x4 l2 = tr_read<v_rd_off(D0, 2, 0)>(vb), h2 = tr_read<v_rd_off(D0, 2, 1)>(vb), l3 = tr_read<v_rd_off(D0, 3, 0)>(vb), h3 = tr_read<v_rd_off(D0, 3, 1)>(vb);
  asm volatile("s_waitcnt lgkmcnt(0)" ::: "memory"); SBAR();
#define PK(L, H) (bf16x8){L[0], L[1], L[2], L[3], H[0], H[1], H[2], H[3]}
  od = __builtin_amdgcn_mfma_f32_32x32x16_bf16(pa0, PK(l0, h0), od, 0, 0, 0);
  od = __builtin_amdgcn_mfma_f32_32x32x16_bf16(pa1, PK(l1, h1), od, 0, 0, 0);
  od = __builtin_amdgcn_mfma_f32_32x32x16_bf16(pa2, PK(l2, h2), od, 0, 0, 0);
  od = __builtin_amdgcn_mfma_f32_32x32x16_bf16(pa3, PK(l3, h3), od, 0, 0, 0);
#undef PK
}
__device__ __forceinline__ void pv_d0(f32x16* o, int vb, bf16x8 pa0, bf16x8 pa1, bf16x8 pa2, bf16x8 pa3) {
  pv_one<0>(o[0], vb, pa0, pa1, pa2, pa3); pv_one<1>(o[1], vb, pa0, pa1, pa2, pa3); pv_one<2>(o[2], vb, pa0, pa1, pa2, pa3); pv_one<3>(o[3], vb, pa0, pa1, pa2, pa3);
}
__device__ __forceinline__ void attn_body(const bf16_t* __restrict__ Qb, const bf16_t* __restrict__ Kh, const bf16_t* __restrict__ Vh,
                                          bf16_t* GO, int seq, char* lds) {
  const int tid = tid_fresh(), wid = tid >> 6, lane = tid & 63, r32 = lane & 31, hi = lane >> 5;
  bf16_t* V_lds = (bf16_t*)lds; bf16_t* K_lds = (bf16_t*)(lds + 2 * SHM_V);
  float* wsx = (float*)(lds + 2 * SHM_V + 2 * SHM_K) + wid * 64; float* li_l = wsx; float* al_l = wsx + 32;
  float m_reg = -1e30f, l_reg = 0; f32x16 o[4]; bf16x8 qr[8];
#pragma unroll
  for (int d = 0; d < 4; ++d)
#pragma unroll
    for (int r = 0; r < 16; ++r) o[d][r] = 0.f;
  const bf16_t* Qw = Qb + (long)(wid * QBLK + r32) * LDQ + hi * 8;
#pragma unroll
  for (int d0 = 0; d0 < 8; ++d0) qr[d0] = *reinterpret_cast<const bf16x8*>(Qw + d0 * 16);
  const int sr = tid >> 4, sc = (tid & 15) * 8, vst0 = v_st(sr, sc), vst1 = v_st(32 + sr, sc);
  const int vb0 = (int)(uintptr_t)V_lds + v_rd_base(lane);
  constexpr int SDEPTH = 1;
  bf16x8 sv0[SDEPTH], sv1[SDEPTH], sk0[SDEPTH], sk1[SDEPTH];
#define SLOAD(i, k0) do { sv0[i] = *reinterpret_cast<const bf16x8*>(&Vh[(long)((k0) + sr) * LDK + sc]); sv1[i] = *reinterpret_cast<const bf16x8*>(&Vh[(long)((k0) + 32 + sr) * LDK + sc]); \
    sk0[i] = *reinterpret_cast<const bf16x8*>(&Kh[(long)((k0) + sr) * LDK + sc]); sk1[i] = *reinterpret_cast<const bf16x8*>(&Kh[(long)((k0) + 32 + sr) * LDK + sc]); } while (0)
#define SWRITE(b, i) do { *(bf16x8*)((char*)V_lds + (b) * SHM_V + vst0) = sv0[i];          \
    *(bf16x8*)((char*)V_lds + (b) * SHM_V + vst1) = sv1[i]; const int kc = sc * 2;               \
    *(bf16x8*)((char*)K_lds + (b) * SHM_K + KSWZ(sr, kc)) = sk0[i];                       \
    *(bf16x8*)((char*)K_lds + (b) * SHM_K + KSWZ(32 + sr, kc)) = sk1[i]; } while (0)
#define SWAIT() do { if (SDEPTH == 2) asm volatile("s_waitcnt vmcnt(4)" ::: "memory"); else asm volatile("s_waitcnt vmcnt(0)" ::: "memory"); } while (0)
#define RESC(a) do { if (__any((a) < 1.f)) { if (hi == 0) al_l[r32] = (a); asm volatile("s_waitcnt lgkmcnt(0)" ::: "memory"); \
    _Pragma("unroll") for (int d = 0; d < 4; ++d) _Pragma("unroll") for (int r = 0; r < 16; ++r) o[d][r] *= al_l[crow(r, hi)]; } } while (0)
  f32x16 pA0, pA1, pB0, pB1; float mnA, mnB, alA, alB; bf16x8 pa0, pa1, pa2, pa3; const int NT = seq / KVBLK;
  constexpr int SE = 0, SO = SDEPTH - 1;
  SLOAD(SE, 0); asm volatile("s_waitcnt vmcnt(0)" ::: "memory"); SWRITE(0, SE); __syncthreads();
  qkt(pA0, pA1, K_lds, qr, r32, hi); partialSM(pA0, pA1, m_reg, mnA, alA);
  SLOAD(SO, KVBLK); if (SDEPTH == 2) { if (2 < NT) SLOAD(SE, 2 * KVBLK); }
  SWAIT(); SWRITE(1, SO); __syncthreads();
  for (int j = 1; j + 1 < NT; j += 2) {
    SBAR(); qkt(pB0, pB1, (bf16_t*)((char*)K_lds + SHM_K), qr, r32, hi);
    finishSM(pA0, pA1, alA, l_reg, pa0, pa1, pa2, pa3); SBAR();
    SLOAD(SO, (j + SDEPTH) * KVBLK); SBAR();
    pv_d0(o, vb0, pa0, pa1, pa2, pa3); partialSM(pB0, pB1, m_reg, mnB, alB);
    __syncthreads(); SWAIT(); SWRITE(0, SE);
    RESC(alB); __syncthreads();
    SBAR(); qkt(pA0, pA1, K_lds, qr, r32, hi);
    finishSM(pB0, pB1, alB, l_reg, pa0, pa1, pa2, pa3); SBAR();
    if (SDEPTH == 1 || j + 3 < NT) SLOAD(SE, (j + 1 + SDEPTH) * KVBLK); SBAR();
    pv_d0(o, vb0 + (int)SHM_V, pa0, pa1, pa2, pa3); partialSM(pA0, pA1, m_reg, mnA, alA);
    __syncthreads(); SWAIT(); SWRITE(1, SO);
    RESC(alA); __syncthreads();
  }
  SBAR(); qkt(pB0, pB1, (bf16_t*)((char*)K_lds + SHM_K), qr, r32, hi);
  finishSM(pA0, pA1, alA, l_reg, pa0, pa1, pa2, pa3); SBAR();
  pv_d0(o, vb0, pa0, pa1, pa2, pa3); partialSM(pB0, pB1, m_reg, mnB, alB);
  __syncthreads(); RESC(alB);
  finishSM(pB0, pB1, alB, l_reg, pa0, pa1, pa2, pa3); SBAR();
  pv_d0(o, vb0 + (int)SHM_V, pa0, pa1, pa2, pa3);
  if (hi == 0) li_l[r32] = l_reg; asm volatile("s_waitcnt lgkmcnt(0)" ::: "memory");
  float rli[16];
#pragma unroll
  for (int r = 0; r < 16; ++r) rli[r] = __builtin_amdgcn_rcpf(li_l[crow(r, hi)]);
  bf16_t* Ow = GO + (long)(wid * QBLK) * 2048;
#pragma unroll
  for (int r = 0; r < 16; ++r) { const int orow = crow(r, hi);
#pragma unroll
    for (int d0 = 0; d0 < 4; ++d0) { bf16_t* q = Ow + (long)orow * 2048 + d0 * 32 + r32; *q = f2bf(o[d0][r] * rli[r] * bf2f(*q)); }
    SBAR(); }
  __syncthreads();
#undef SLOAD
#undef SWRITE
#undef SWAIT
#undef RESC
}
}

__device__ __forceinline__ void chunk_gate_unit(const Params& p, int b, int n, char* smem) {
  char* ws = p.ws;
  const bf16_t* BU = (const bf16_t*)(ws + OFF_BU); const bf16_t* BV = (const bf16_t*)(ws + OFF_BV);
  bf16_t* SG = (bf16_t*)(ws + OFF_SG); const bf16_t* WSB = (const bf16_t*)(ws + OFF_WSB);
  const int tid = tid_fresh(), wid = tid >> 6, lane = tid & 63, r32 = lane & 31, hi = lane >> 5;
  constexpr int RS = 272;
  char* sW = smem; char* sV = smem + 128 * RS;
  float* smu = (float*)(smem + 2 * 128 * RS); float* srs = smu + 128;
  const size_t tok0 = (size_t)b * SEQ + (size_t)n * 128;
  {
    const int q = tid >> 2, part = tid & 3;
    const u32x4* src = (const u32x4*)(BV + (tok0 + q) * 1024 + part * 256);
    float s = 0.f, s2 = 0.f;
#pragma unroll 4
    for (int i = 0; i < 32; ++i) {
      const u32x4 w = src[i];
#pragma unroll
      for (int e = 0; e < 4; ++e) { const float a = bf_lo(w[e]), c = bf_hi(w[e]); s += a + c; s2 += a * a + c * c; }
    }
    s += __shfl_xor(s, 1); s2 += __shfl_xor(s2, 1); s += __shfl_xor(s, 2); s2 += __shfl_xor(s2, 2);
    const float mu = s * (1.f / 1024.f);
    const float var = fmaxf(s2 * (1.f / 1024.f) - mu * mu, 0.f);
    if (part == 0) { smu[q] = mu; srs[q] = rsqrtf(var + EPS); }
  }
  __syncthreads();
  const int wp = wid >> 1, wc = wid & 1;
  u32x4 rw0, rw1, rw2, rw3, rv0, rv1, rv2, rv3;
#define CG_LD1(I, RW, RV, G_) do { const int id_ = tid + 512 * (I);                                                            \
    RW = *(const u32x4*)(WSB + (size_t)(G_) * 16384 + (id_ >> 4) * 128 + (id_ & 15) * 8);                                      \
    RV = *(const u32x4*)(BV + (tok0 + (id_ & 127)) * 1024 + (G_) * 128 + (id_ >> 7) * 8); } while (0)
#define CG_LOAD(G_) do { const int g_ = (G_); CG_LD1(0, rw0, rv0, g_); CG_LD1(1, rw1, rv1, g_); CG_LD1(2, rw2, rv2, g_); CG_LD1(3, rw3, rv3, g_); } while (0)
#define CG_ST1(I, RW, RV) do { const int id_ = tid + 512 * (I);                                                                \
    *(u32x4*)(sW + (id_ >> 4) * RS + (id_ & 15) * 16) = RW;                                                                     \
    const int q_ = id_ & 127, cc_ = (id_ >> 7) * 8; const float mu_ = smu[q_], rs_ = srs[q_];                                   \
    const float* lg_ = p.e_vg + g * 128 + cc_; const float* lb_ = p.e_vb + g * 128 + cc_;                                       \
    _Pragma("unroll") for (int e = 0; e < 4; ++e) {                                                                             \
      const float a_ = (bf_lo(RV[e]) - mu_) * rs_ * lg_[2 * e] + lb_[2 * e];                                                    \
      const float c_ = (bf_hi(RV[e]) - mu_) * rs_ * lg_[2 * e + 1] + lb_[2 * e + 1];                                            \
      *(bf16_t*)(sV + (cc_ + 2 * e) * RS + q_ * 2) = f2bf(a_);                                                                  \
      *(bf16_t*)(sV + (cc_ + 2 * e + 1) * RS + q_ * 2) = f2bf(c_); } } while (0)
  CG_LOAD(0);
  for (int g = 0; g < 8; ++g) {
    CG_ST1(0, rw0, rv0); CG_ST1(1, rw1, rv1); CG_ST1(2, rw2, rv2); CG_ST1(3, rw3, rv3);
    __syncthreads();
    CG_LOAD(g + 1 < 8 ? g + 1 : g);
    const int pr = wp * 32 + r32;
    const size_t tok = tok0 + pr;
    u32x2 bu[8], sgv[8];
#pragma unroll
    for (int nj = 0; nj < 2; ++nj)
#pragma unroll
      for (int q = 0; q < 4; ++q) {
        const int col = g * 128 + wc * 64 + nj * 32 + q * 8 + hi * 4;
        bu[nj * 4 + q] = *(const u32x2*)(BU + tok * 1024 + col);
        sgv[nj * 4 + q] = *(const u32x2*)(SG + tok * 2048 + 1024 + col);
      }
    const float bias = p.e_bs[g * 128 + pr];
    f32x16 acc0, acc1;
#pragma unroll
    for (int r = 0; r < 16; ++r) { acc0[r] = 0.f; acc1[r] = 0.f; }
#pragma unroll
    for (int kk = 0; kk < 8; ++kk) {
      const bf16x8 af = *(const bf16x8*)(sW + (wp * 32 + r32) * RS + kk * 32 + hi * 16);
      const bf16x8 b0 = *(const bf16x8*)(sV + (wc * 64 + r32) * RS + kk * 32 + hi * 16);
      const bf16x8 b1 = *(const bf16x8*)(sV + (wc * 64 + 32 + r32) * RS + kk * 32 + hi * 16);
      acc0 = __builtin_amdgcn_mfma_f32_32x32x16_bf16(b0, af, acc0, 0, 0, 0);
      acc1 = __builtin_amdgcn_mfma_f32_32x32x16_bf16(b1, af, acc1, 0, 0, 0);
    }
#pragma unroll
    for (int nj = 0; nj < 2; ++nj)
#pragma unroll
      for (int q = 0; q < 4; ++q) {
        const int col = g * 128 + wc * 64 + nj * 32 + q * 8 + hi * 4;
        bf16_t* gp = SG + tok * 2048 + 1024 + col;
        const u32x2 b2 = bu[nj * 4 + q], s2 = sgv[nj * 4 + q];
        const float m0 = (nj ? acc1[4 * q + 0] : acc0[4 * q + 0]) + bias, m1 = (nj ? acc1[4 * q + 1] : acc0[4 * q + 1]) + bias;
        const float m2 = (nj ? acc1[4 * q + 2] : acc0[4 * q + 2]) + bias, m3 = (nj ? acc1[4 * q + 3] : acc0[4 * q + 3]) + bias;
        st_bf4(gp, bf_lo(b2[0]) * m0 * bf_lo(s2[0]), bf_hi(b2[0]) * m1 * bf_hi(s2[0]), bf_lo(b2[1]) * m2 * bf_lo(s2[1]), bf_hi(b2[1]) * m3 * bf_hi(s2[1]));
      }
    __syncthreads();
  }
#undef CG_LD1
#undef CG_LOAD
#undef CG_ST1
}

__device__ __forceinline__ void post_ln_rows(const float* src, float* dst, const float* pg, const float* pb, bf16_t* m1, const float* mod17) {
  const int tid = tid_fresh(), wid = tid >> 6, lane = tid & 63;
  const int gw = blockIdx.x * 8 + wid, nw = gridDim.x * 8;
  float4 nx[4];
  { const float4* ps = (const float4*)(src + (size_t)gw * 1024);
#pragma unroll
    for (int j = 0; j < 4; ++j) nx[j] = ps[lane + 64 * j]; }
  for (int row = gw; row < NTOK; row += nw) {
    float4 v[4];
#pragma unroll
    for (int j = 0; j < 4; ++j) v[j] = nx[j];
    { const int nr = (row + nw < NTOK) ? row + nw : row;
      const float4* ps = (const float4*)(src + (size_t)nr * 1024);
#pragma unroll
      for (int j = 0; j < 4; ++j) nx[j] = ps[lane + 64 * j]; }
    float s = 0.f;
#pragma unroll
    for (int j = 0; j < 4; ++j) s += v[j].x + v[j].y + v[j].z + v[j].w;
    float mu = wave_sum(s) * (1.f / 1024.f);
    float q = 0.f;
#pragma unroll
    for (int j = 0; j < 4; ++j) { v[j].x -= mu; v[j].y -= mu; v[j].z -= mu; v[j].w -= mu; q += v[j].x * v[j].x + v[j].y * v[j].y + v[j].z * v[j].z + v[j].w * v[j].w; }
    float rstd = rsqrtf(wave_sum(q) * (1.f / 1024.f) + EPS);
    float4* pd = (float4*)(dst + (size_t)row * 1024);
    s = 0.f;
#pragma unroll
    for (int j = 0; j < 4; ++j) {
      const int col = (lane + 64 * j) * 4;
      const float4 g4 = *(const float4*)(pg + col), b4 = *(const float4*)(pb + col);
      v[j].x = v[j].x * rstd * g4.x + b4.x; v[j].y = v[j].y * rstd * g4.y + b4.y; v[j].z = v[j].z * rstd * g4.z + b4.z; v[j].w = v[j].w * rstd * g4.w + b4.w;
      pd[lane + 64 * j] = v[j];
      s += v[j].x + v[j].y + v[j].z + v[j].w;
    }
    if (m1) {
      mu = wave_sum(s) * (1.f / 1024.f);
      q = 0.f;
#pragma unroll
      for (int j = 0; j < 4; ++j) { v[j].x -= mu; v[j].y -= mu; v[j].z -= mu; v[j].w -= mu; q += v[j].x * v[j].x + v[j].y * v[j].y + v[j].z * v[j].z + v[j].w * v[j].w; }
      rstd = rsqrtf(wave_sum(q) * (1.f / 1024.f) + EPS);
      const float* md = mod17 + (size_t)(row >> 11) * 3072;
      bf16_t* pm = m1 + (size_t)row * 1024;
#pragma unroll
      for (int j = 0; j < 4; ++j) {
        const int col = (lane + 64 * j) * 4;
        const float4 sh = *(const float4*)(md + col), sc = *(const float4*)(md + 1024 + col);
        st_bf4(pm + col, v[j].x * rstd * (1.f + sc.x) + sh.x, v[j].y * rstd * (1.f + sc.y) + sh.y, v[j].z * rstd * (1.f + sc.z) + sh.z, v[j].w * rstd * (1.f + sc.w) + sh.w);
      }
    }
  }
}

__device__ __forceinline__ void out_proj(const bf16_t* A, const bf16_t* WT, const float* resid, const float* gate17, float* dst, char* smem) {
  const int lb = logical_block();
  for (int u = lb; u < 512; u += gridDim.x) {
    const int mt = u >> 2, nt = u & 3;
    f32x16 acc[2][4];
    gemm2(mkPlain(A + (size_t)mt * 256 * 2048, 2048), mkPlain(WT + (size_t)nt * 256 * 2048, 2048), 32, smem, acc);
    const float* gt = gate17 + (size_t)(mt >> 3) * 3072 + 2048 + nt * 256;
    epi2_foreach(acc, [&](int row, int col, float a, float b, float c, float d) {
      const size_t idx = (size_t)(mt * 256 + row) * 1024 + nt * 256 + col;
      const float4 xr = *(const float4*)(resid + idx); const float4 g4 = *(const float4*)(gt + col);
      float4 o; o.x = ALPHA * xr.x + g4.x * a; o.y = ALPHA * xr.y + g4.y * b; o.z = ALPHA * xr.z + g4.z * c; o.w = ALPHA * xr.w + g4.w * d;
      *(float4*)(dst + idx) = o;
    });
  }
}

#define XB_TMO      128
#define XB_XCNT(j)  (256  + 64 * (j))
#define XB_XSUB(j)  (1280 + 64 * (j))
#define XB_XGEN(j)  (2304 + 64 * (j))
#define XB_TOP      3328
#define XB_TOPGEN   3392
#define XCD_BAR_WORDS 3456
#define XB_SPIN_CAP (1u << 18)
#define LAS __attribute__((address_space(3)))

__device__ __forceinline__ unsigned xb_ld(unsigned* p)              { return __hip_atomic_load(p, __ATOMIC_RELAXED, __HIP_MEMORY_SCOPE_AGENT); }
__device__ __forceinline__ unsigned xb_add(unsigned* p, unsigned v) { return __hip_atomic_fetch_add(p, v, __ATOMIC_RELAXED, __HIP_MEMORY_SCOPE_AGENT); }
__device__ __forceinline__ unsigned xb_xcc_id() { return (unsigned)__builtin_amdgcn_s_getreg((3 << 11) | 20) & 0xFu; }
#define XB_SPIN(cond, bar) do { unsigned _sp = 0; while (cond) { __builtin_amdgcn_s_sleep(1); \
    if ((++_sp & 255u) == 0u) { if (xb_ld(&(bar)[XB_TMO])) break; if (_sp > XB_SPIN_CAP) { atomicAdd(&(bar)[XB_TMO], 1u); break; } } } } while (0)

struct XcdBarrier {
    unsigned* bar; unsigned x;
    volatile LAS unsigned* st;
};

__device__ __forceinline__ XcdBarrier xcd_barrier_post(unsigned* bar, volatile LAS unsigned* st) {
    XcdBarrier b; b.bar = bar; b.x = xb_xcc_id(); b.st = st;
    if (threadIdx.x == 0) (void)xb_add(&bar[XB_XCNT(b.x)], 1u);
    return b;
}
__device__ __forceinline__ void xcd_barrier_complete(unsigned* bar, unsigned x, unsigned& nloc, unsigned& nx) {
    const unsigned G = gridDim.x * gridDim.y * gridDim.z;
    unsigned sum, cnt, mine, sp = 0u;
    for (;;) {
        sum = 0u; cnt = 0u; mine = 0u;
#pragma unroll
        for (unsigned j = 0; j < 16; ++j) { const unsigned c = xb_ld(&bar[XB_XCNT(j)]); sum += c; cnt += (c > 0u) ? 1u : 0u; mine = (j == x) ? c : mine; }
        if (sum == G) break;
        __builtin_amdgcn_s_sleep(1);
        if ((++sp & 255u) == 0u) { if (xb_ld(&bar[XB_TMO])) break; if (sp > XB_SPIN_CAP) { atomicAdd(&bar[XB_TMO], 1u); break; } }
    }
    nloc = mine > 0u ? mine : 1u; nx = cnt > 0u ? cnt : 1u;
}

__device__ __forceinline__ void xcd_barrier(const XcdBarrier& b) {
    asm volatile("s_waitcnt vmcnt(0)" ::: "memory");
    __syncthreads();
    if (threadIdx.x == 0) {
        unsigned* bar = b.bar;
        __builtin_amdgcn_s_waitcnt(0);
        unsigned nloc = b.st[0], nx = b.st[1];
        if (nloc == 0u) { xcd_barrier_complete(bar, b.x, nloc, nx); b.st[0] = nloc; b.st[1] = nx; }
        const unsigned old = xb_add(&bar[XB_XSUB(b.x)], 1u);
        const unsigned gen = old / nloc;
        if (old + 1u == (gen + 1u) * nloc) {
            __builtin_amdgcn_fence(__ATOMIC_RELEASE, "agent");
            asm volatile("s_waitcnt vmcnt(0)" ::: "memory");
            const unsigned og = xb_add(&bar[XB_TOP], 1u);
            const unsigned tg = og / nx;
            if (og + 1u == (tg + 1u) * nx) xb_add(&bar[XB_TOPGEN], 1u);
            else XB_SPIN(xb_ld(&bar[XB_TOPGEN]) == tg, bar);
            __builtin_amdgcn_fence(__ATOMIC_ACQUIRE, "agent");
            xb_add(&bar[XB_XGEN(b.x)], 1u);
            asm volatile("s_waitcnt vmcnt(0)" ::: "memory");
        } else {
            XB_SPIN(xb_ld(&bar[XB_XGEN(b.x)]) == gen, bar);
            __builtin_amdgcn_fence(__ATOMIC_ACQUIRE, "agent");
            asm volatile("s_waitcnt vmcnt(0)" ::: "memory");
        }
    }
    __syncthreads();
}


constexpr size_t OFF_XBAR = OFF_SMALL + 1536 * 1024;
constexpr size_t OFF_PX = OFF_SMALL + 1152 * 1024;
#define GSYNC_CG() do { __threadfence(); grid.sync(); __threadfence(); } while (0)
#define GSYNC() xcd_barrier(xbar)
#ifndef LAUNCH_SPLITS
#define LAUNCH_SPLITS {{0,0},{1,1},{2,2},{3,3},{4,4},{5,5},{6,6},{7,7},{8,8},{9,9},{10,10}}
#endif
template <int PLO, int PHI>
__global__ void __launch_bounds__(512) mega(Params p) {
  cg::grid_group grid = cg::this_grid();
  __shared__ __attribute__((aligned(16))) char smem[SMEM_BYTES];
  char* ws = p.ws;
  float* MOD = (float*)(ws + OFF_MOD);
  const int lb = logical_block();
  volatile LAS unsigned* xst = (volatile LAS unsigned*)(smem + LDS_RED + 2048);
  if (tid_fresh() < 4) xst[tid_fresh()] = 0u;
  __syncthreads();
  XcdBarrier xbar = xcd_barrier_post((unsigned*)(ws + OFF_XBAR), xst);
  if (PLO < PHI) grid.sync();

  if (PLO <= 0 && 0 <= PHI) {
  phase0(p, smem);
  }
  if (PLO <= 0 && 0 < PHI) { GSYNC(); }
  if (PLO <= 1 && 1 <= PHI) {

  ln_rows_modulate(p.x, (bf16_t*)(ws + OFF_M0), NTOK, SEQ, MOD, -1);
  ln_rows_modulate(p.ctx, (bf16_t*)(ws + OFF_MC), NCTX, CTXL, MOD, 16);
  }
  if (PLO <= 1 && 1 < PHI) { GSYNC(); }
  if (PLO <= 2 && 2 <= PHI) {

  phase2(p, smem);
  }
  if (PLO <= 2 && 2 < PHI) { GSYNC(); }
  if (PLO <= 3 && 3 <= PHI) {

  for (int u = lb; u < 1024; u += gridDim.x) {
      const int grp = u >> 5, j = u & 31, b = grp >> 1, kvh = grp & 1, hq = kvh * 4 + (j >> 3), qb = j & 7;
      const bf16_t* Qb = (const bf16_t*)(ws + OFF_Q) + ((size_t)(b * SEQ + qb * 256) * 8 + hq) * 128;
      const bf16_t* Kh = (const bf16_t*)(ws + OFF_KALL) + ((size_t)b * SKV * 2 + kvh) * 128;
      const bf16_t* Vh = (const bf16_t*)(ws + OFF_VALL) + ((size_t)b * SKV * 2 + kvh) * 128;
      bf16_t* GO = (bf16_t*)(ws + OFF_SG) + (size_t)(b * SEQ + qb * 256) * 2048 + hq * 128;
      att::attn_body(Qb, Kh, Vh, GO, SKV, smem);
  }
  for (int v = lb; v < 256; v += gridDim.x) chunk_gate_unit(p, v >> 4, v & 15, smem);
  }
  if (PLO <= 3 && 3 < PHI) { GSYNC(); }
  if (PLO <= 4 && 4 <= PHI) {

  out_proj((const bf16_t*)(ws + OFF_SG), (const bf16_t*)(ws + OFF_WT_EOUT), p.x, MOD, (float*)(ws + OFF_Q), smem);
  }
  if (PLO <= 4 && 4 < PHI) { GSYNC(); }
  if (PLO <= 5 && 5 <= PHI) {

  post_ln_rows((const float*)(ws + OFF_Q), (float*)(ws + OFF_Q), p.post_g, p.post_b, (bf16_t*)(ws + OFF_M0), MOD + 17 * 3072);
  }
  if (PLO <= 5 && 5 < PHI) { GSYNC(); }
  if (PLO <= 6 && 6 <= PHI) {

  {
    const bf16_t* M1 = (const bf16_t*)(ws + OFF_M0); const bf16_t* WT = (const bf16_t*)(ws + OFF_WT_OIN);
    bf16_t* F = (bf16_t*)(ws + OFF_F); bf16_t* RV = (bf16_t*)(ws + OFF_RV); bf16_t* XM = (bf16_t*)(ws + OFF_XM);
    bf16_t* SG1 = (bf16_t*)(ws + OFF_SG);
    for (int u = lb; u < 2048; u += gridDim.x) {
      f32x16 acc[2][4];
      if (u < 1024) {
        const int tt = u >> 3, ct = u & 7, b = tt >> 3, t0 = (tt & 7) * 256;
        gemm2(mkPlain(WT + (size_t)ct * 256 * 1024, 1024), mkPlain(M1 + (size_t)tt * 256 * 1024, 1024), 16, smem, acc);
        epi2_foreach(acc, [&](int row, int col, float a, float bq, float c, float d) {
          const int ch = ct * 256 + row, t = t0 + col;
          const size_t base = ((size_t)b * 2048 + ch) * 1024;
          if (t < 1024) {
            st_bf4(F + base + t, a, bq, c, d);
            if (t == 0) RV[base] = 0;
          } else if (t == 1024) {
            XM[(size_t)b * 2048 + ch] = f2bf(a);
            RV[base + 1023] = f2bf(bq); RV[base + 1022] = f2bf(c); RV[base + 1021] = f2bf(d);
          } else {
            RV[base + 2048 - t] = f2bf(a); RV[base + 2047 - t] = f2bf(bq); RV[base + 2046 - t] = f2bf(c); RV[base + 2045 - t] = f2bf(d);
          }
        });
      } else {
        const int v = u - 1024, mt = v >> 3, nt = v & 7;
        gemm2(mkPlain(M1 + (size_t)mt * 256 * 1024, 1024), mkPlain(WT + (size_t)(2048 + nt * 256) * 1024, 1024), 16, smem, acc);
        epi2_foreach(acc, [&](int row, int col, float a, float bq, float c, float d) {
          st_bf4(SG1 + (size_t)(mt * 256 + row) * 2048 + nt * 256 + col, silu_f(a), silu_f(bq), silu_f(c), silu_f(d));
        });
      }
    }
  }
  }
  if (PLO <= 6 && 6 < PHI) { GSYNC(); }
  if (PLO <= 7 && 7 <= PHI) {

  {
    {
      const int tid = tid_fresh(), wid = tid >> 6, lane = tid & 63;
      const int gw = blockIdx.x * 8 + wid, nw = gridDim.x * 8;
      const bf16_t* XMr = (const bf16_t*)(ws + OFF_XM); float* PX = (float*)(ws + OFF_PX);
      u32x4 na0, na1, nb0, nb1;
      { const size_t ro = (size_t)gw * 128; const u32x4* Fr = (const u32x4*)(ws + OFF_F) + ro; const u32x4* Rr = (const u32x4*)(ws + OFF_RV) + ro;
        na0 = Fr[lane]; na1 = Fr[lane + 64]; nb0 = Rr[lane]; nb1 = Rr[lane + 64]; }
      for (int row = gw; row < 16 * 2048; row += nw) {
        const u32x4 a0 = na0, a1 = na1, b0 = nb0, b1 = nb1;
        { const int nr = (row + nw < 16 * 2048) ? row + nw : row; const size_t ro = (size_t)nr * 128;
          const u32x4* Fr = (const u32x4*)(ws + OFF_F) + ro; const u32x4* Rr = (const u32x4*)(ws + OFF_RV) + ro;
          na0 = Fr[lane]; na1 = Fr[lane + 64]; nb0 = Rr[lane]; nb1 = Rr[lane + 64]; }
        u32x4 e0, e1, o0, o1; float alt = 0.f;
#pragma unroll
        for (int k = 0; k < 4; ++k) {
          { const float al = bf_lo(a0[k]), ah = bf_hi(a0[k]), bl = bf_lo(b0[k]), bh = bf_hi(b0[k]);
            e0[k] = cvtpk(al + bl, ah + bh); o0[k] = cvtpk(al - bl, ah - bh); alt += (al + bl) - (ah + bh); }
          { const float al = bf_lo(a1[k]), ah = bf_hi(a1[k]), bl = bf_lo(b1[k]), bh = bf_hi(b1[k]);
            e1[k] = cvtpk(al + bl, ah + bh); o1[k] = cvtpk(al - bl, ah - bh); alt += (al + bl) - (ah + bh); }
        }
        u32x4* Fw = (u32x4*)(ws + OFF_F) + (size_t)row * 128; u32x4* Rw = (u32x4*)(ws + OFF_RV) + (size_t)row * 128;
        Fw[lane] = e0; Fw[lane + 64] = e1; Rw[lane] = o0; Rw[lane + 64] = o1;
        alt = wave_sum(alt);
        if (lane == 0) PX[row] = alt + bf2f(XMr[row]);
      }
    }
    if (PLO < PHI) { GSYNC(); }
    const bf16_t* F = (const bf16_t*)(ws + OFF_F); const bf16_t* RV = (const bf16_t*)(ws + OFF_RV); const bf16_t* XM = (const bf16_t*)(ws + OFF_XM);
    const bf16_t* TC = (const bf16_t*)(ws + OFF_TAB_C); const bf16_t* TS = (const bf16_t*)(ws + OFF_TAB_S);
    bf16_t* PC = (bf16_t*)p.out; bf16_t* PS = (bf16_t*)(ws + OFF_M0);
    for (int u = lb; u < 1024; u += gridDim.x) {
      f32x16 acc[2][4];
      const int v = u & 511, b = v >> 5, mt = (v & 31) >> 3, nt = v & 7;
      const size_t bo = ((size_t)b * 2048 + nt * 256) * 1024;
      if (u < 512) {
        gemm2(mkPlain(TC + (size_t)mt * 256 * 1024, 1024), mkPlain(F + bo, 1024), 16, smem, acc);
        epi2_foreach(acc, [&](int row, int col, float a, float bq, float c, float d) {
          const int tp = mt * 256 + row, ch = nt * 256 + col;
          const u32x2 xm = *(const u32x2*)(XM + (size_t)b * 2048 + ch);
          const float sg = (tp & 1) ? -1.f : 1.f;
          a += sg * bf_lo(xm[0]); bq += sg * bf_hi(xm[0]); c += sg * bf_lo(xm[1]); d += sg * bf_hi(xm[1]);
          st_bf4(PC + ((size_t)b * 1024 + tp) * 2048 + ch, a, bq, c, d);
        });
      } else {
        gemm2(mkPlain(TS + (size_t)mt * 256 * 1024, 1024), mkPlain(RV + bo, 1024), 16, smem, acc);
        epi2_foreach(acc, [&](int row, int col, float a, float bq, float c, float d) {
          st_bf4(PS + ((size_t)b * 1024 + mt * 256 + row) * 2048 + nt * 256 + col, a, bq, c, d);
        });
      }
    }
  }
  }
  if (PLO <= 7 && 7 < PHI) { GSYNC(); }
  if (PLO <= 8 && 8 <= PHI) {

  {
    const bf16_t* PC = (const bf16_t*)p.out; const bf16_t* PS = (const bf16_t*)(ws + OFF_M0);
    const bf16_t* CDP = (const bf16_t*)(ws + OFF_CDP);
    bf16_t* SG1 = (bf16_t*)(ws + OFF_SG);
    const int tid = tid_fresh(), wid = tid >> 6, lane = tid & 63, r32 = lane & 31, hi = lane >> 5, wm = wid >> 1, wn = wid & 1;
    constexpr int TBS = 528;
    constexpr int TB_BYTES = 128 * TBS;
    char* sT = smem; char* sA = smem + TB_BYTES;
#pragma unroll
    for (int i = 0; i < 8; ++i) {
      const int id = tid + 512 * i, row = id >> 5, ck = id & 31;
      *(u32x4*)(sT + row * TBS + ck * 16) = *(const u32x4*)(CDP + row * 256 + ck * 8);
    }
    const int st_off = (tid >> 3) * LDS_ROWB + (tid & 7) * 16;
    const int a_rd = (wm * 64 + r32) * LDS_ROWB + hi * 16;
    const int b_rd = (wn * 32 + r32) * TBS + hi * 16;
    const size_t rowoff = (size_t)(tid >> 3) * 2048 + (tid & 7) * 8;
    u32x4 r00, r01, r02, r03, r10, r11, r12, r13, r20, r21, r22, r23, r30, r31, r32_, r33;
    auto a_base = [&](int u_, int s_) -> const bf16_t* {
      const int b_ = u_ >> 6, j_ = (u_ >> 4) & 3, G_ = u_ & 15;
      return ((s_ < 2) ? PC : PS) + ((size_t)b_ * 1024 + j_ * 256) * 2048 + G_ * 128 + (s_ & 1) * 64 + rowoff;
    };
#define P8_LOAD(S, U, A, B, C, D) do { const bf16_t* q_ = a_base((U), (S)); A = *(const u32x4*)(q_); B = *(const u32x4*)(q_ + (size_t)64 * 2048); \
      C = *(const u32x4*)(q_ + (size_t)128 * 2048); D = *(const u32x4*)(q_ + (size_t)192 * 2048); } while (0)
#define P8_WRITE(ST, A, B, C, D) do { char* s_ = sA + (ST) * L2_A + st_off; *(u32x4*)(s_) = A; *(u32x4*)(s_ + 64 * LDS_ROWB) = B; \
      *(u32x4*)(s_ + 128 * LDS_ROWB) = C; *(u32x4*)(s_ + 192 * LDS_ROWB) = D; } while (0)
#define P8_COMPUTE(ST, S, ACC) do { const char* sb_ = sA + (ST) * L2_A;                                              \
      _Pragma("unroll") for (int kk = 0; kk < 4; ++kk) {                                                               \
        const bf16x8 fa0 = *(const bf16x8*)(sb_ + a_rd + kk * 32);                                                      \
        const bf16x8 fa1 = *(const bf16x8*)(sb_ + a_rd + 32 * LDS_ROWB + kk * 32);                                      \
        const bf16x8 fb0 = *(const bf16x8*)(sT + b_rd + ((S) * 64 + kk * 16) * 2);                                      \
        const bf16x8 fb1 = *(const bf16x8*)(sT + b_rd + 64 * TBS + ((S) * 64 + kk * 16) * 2);                           \
        ACC[0][0] = __builtin_amdgcn_mfma_f32_32x32x16_bf16(fb0, fa0, ACC[0][0], 0, 0, 0);                              \
        ACC[0][1] = __builtin_amdgcn_mfma_f32_32x32x16_bf16(fb1, fa0, ACC[0][1], 0, 0, 0);                              \
        ACC[1][0] = __builtin_amdgcn_mfma_f32_32x32x16_bf16(fb0, fa1, ACC[1][0], 0, 0, 0);                              \
        ACC[1][1] = __builtin_amdgcn_mfma_f32_32x32x16_bf16(fb1, fa1, ACC[1][1], 0, 0, 0);                              \
      } } while (0)
    P8_LOAD(0, lb, r00, r01, r02, r03); P8_LOAD(1, lb, r10, r11, r12, r13); P8_LOAD(2, lb, r20, r21, r22, r23); P8_LOAD(3, lb, r30, r31, r32_, r33);
    for (int u = lb; u < 1024; u += gridDim.x) {
      const int un = (u + (int)gridDim.x < 1024) ? u + (int)gridDim.x : u;
      f32x16 acc1[2][2], acc2[2][2];
#pragma unroll
      for (int mi = 0; mi < 2; ++mi)
#pragma unroll
        for (int nj = 0; nj < 2; ++nj)
#pragma unroll
          for (int r = 0; r < 16; ++r) { acc1[mi][nj][r] = 0.f; acc2[mi][nj][r] = 0.f; }
      P8_WRITE(0, r00, r01, r02, r03); __syncthreads(); P8_LOAD(0, un, r00, r01, r02, r03); P8_COMPUTE(0, 0, acc1);
      P8_WRITE(1, r10, r11, r12, r13); __syncthreads(); P8_LOAD(1, un, r10, r11, r12, r13); P8_COMPUTE(1, 1, acc1);
      P8_WRITE(0, r20, r21, r22, r23); __syncthreads(); P8_LOAD(2, un, r20, r21, r22, r23); P8_COMPUTE(0, 2, acc2);
      P8_WRITE(1, r30, r31, r32_, r33); __syncthreads(); P8_LOAD(3, un, r30, r31, r32_, r33); P8_COMPUTE(1, 3, acc2);
      const int b = u >> 6, j = (u >> 4) & 3, G = u & 15;
      const float sc = 1.f / 512.f;
#pragma unroll
      for (int mi = 0; mi < 2; ++mi) {
        const int tp = j * 256 + wm * 64 + mi * 32 + r32;
#pragma unroll
        for (int nj = 0; nj < 2; ++nj)
#pragma unroll
          for (int q = 0; q < 4; ++q) {
            const int col = G * 128 + nj * 64 + wn * 32 + q * 8 + hi * 4;
            const float p0 = acc1[mi][nj][4 * q + 0], p1 = acc1[mi][nj][4 * q + 1], p2 = acc1[mi][nj][4 * q + 2], p3 = acc1[mi][nj][4 * q + 3];
            const float m0 = acc2[mi][nj][4 * q + 0], m1 = acc2[mi][nj][4 * q + 1], m2 = acc2[mi][nj][4 * q + 2], m3 = acc2[mi][nj][4 * q + 3];
            { bf16_t* gp = SG1 + ((size_t)b * 2048 + tp) * 2048 + col; const u32x2 sg = *(const u32x2*)gp;
              st_bf4(gp, (p0 - m0) * sc * bf_lo(sg[0]), (p1 - m1) * sc * bf_hi(sg[0]), (p2 - m2) * sc * bf_lo(sg[1]), (p3 - m3) * sc * bf_hi(sg[1])); }
            if (tp >= 1) { bf16_t* gp = SG1 + ((size_t)b * 2048 + (2048 - tp)) * 2048 + col; const u32x2 sg = *(const u32x2*)gp;
              st_bf4(gp, (p0 + m0) * sc * bf_lo(sg[0]), (p1 + m1) * sc * bf_hi(sg[0]), (p2 + m2) * sc * bf_lo(sg[1]), (p3 + m3) * sc * bf_hi(sg[1])); }
          }
      }
    }
#undef P8_LOAD
#undef P8_WRITE
#undef P8_COMPUTE
    {
      const float* PX = (const float*)(ws + OFF_PX);
      for (int i = blockIdx.x; i < 256; i += gridDim.x) {
        if (tid < 128) {
          const int b = i >> 4, G = i & 15;
          const float* px = PX + (size_t)b * 2048 + G * 128;
          float y = 0.f;
          for (int c = 0; c < 128; ++c) y += px[c] * bf2f(*(const bf16_t*)(sT + tid * TBS + c * 2));
          bf16_t* gp = SG1 + ((size_t)b * 2048 + 1024) * 2048 + G * 128 + tid;
          *gp = f2bf(y * (1.f / 512.f) * bf2f(*gp));
        }
      }
    }
  }
  }
  if (PLO <= 8 && 8 < PHI) { GSYNC(); }
  if (PLO <= 9 && 9 <= PHI) {

  out_proj((const bf16_t*)(ws + OFF_SG), (const bf16_t*)(ws + OFF_WT_OOUT), (const float*)(ws + OFF_Q), MOD + 17 * 3072, p.out, smem);
  }
  if (PLO <= 9 && 9 < PHI) { GSYNC(); }
  if (PLO <= 10 && 10 <= PHI) {

  post_ln_rows(p.out, p.out, p.post_g + 1024, p.post_b + 1024, nullptr, nullptr);
  }
}

extern "C" void kernel_launch(void* const* d_in, const int* in_sizes, int n_in, void* d_out, int out_size, void* d_ws, size_t ws_size,
                              hipStream_t stream) {
  static int grid_blocks = 0;
  if (!grid_blocks) {
    int dev = 0, cus = 0, per_cu = 0;
    hipGetDevice(&dev);
    hipDeviceGetAttribute(&cus, hipDeviceAttributeMultiprocessorCount, dev);
    hipOccupancyMaxActiveBlocksPerMultiprocessor(&per_cu, mega<0, 10>, 512, 0);
    if (per_cu > 1) per_cu = 1;
    grid_blocks = cus * per_cu;
    if (n_in != 18 || ws_size < WS_NEED) fprintf(stderr, "kernel_launch: unexpected n_in %d or ws_size %zu (need %zu)\n", n_in, ws_size, (size_t)WS_NEED);
  }
  Params p{};
  p.x = (const float*)d_in[0]; p.c = (const float*)d_in[1]; p.ctx = (const float*)d_in[2]; p.c_ctx = (const float*)d_in[3];
  p.w_mod = (const float*)d_in[4]; p.b_mod = (const float*)d_in[5]; p.post_g = (const float*)d_in[6]; p.post_b = (const float*)d_in[7];
  p.e_w_in = (const float*)d_in[8]; p.e_qn = (const float*)d_in[9]; p.e_kn = (const float*)d_in[10]; p.e_vg = (const float*)d_in[11];
  p.e_vb = (const float*)d_in[12]; p.e_ws = (const float*)d_in[13]; p.e_bs = (const float*)d_in[14]; p.e_w_out = (const float*)d_in[15];
  p.o_w_in = (const float*)d_in[16]; p.o_w_out = (const float*)d_in[17];
  p.out = (float*)d_out; p.ws = (char*)d_ws;
#define ONE_LAUNCH 1
#ifdef ONE_LAUNCH
  hipMemsetAsync((char*)d_ws + OFF_XBAR, 0, XCD_BAR_WORDS * 4, stream);
  { void* args[] = {&p};
    hipError_t e = hipLaunchCooperativeKernel((void*)mega<0, 10>, dim3(grid_blocks), dim3(512), args, 0, stream);
    if (e != hipSuccess) fprintf(stderr, "cooperative launch failed: %s (grid %d)\n", hipGetErrorString(e), grid_blocks); }
#else
  hipLaunchKernelGGL((mega<0, 0>), dim3(grid_blocks), dim3(512), 0, stream, p);
  hipLaunchKernelGGL((mega<1, 1>), dim3(grid_blocks), dim3(512), 0, stream, p);
  hipLaunchKernelGGL((mega<2, 2>), dim3(grid_blocks), dim3(512), 0, stream, p);
  hipLaunchKernelGGL((mega<3, 3>), dim3(grid_blocks), dim3(512), 0, stream, p);
  hipLaunchKernelGGL((mega<4, 4>), dim3(grid_blocks), dim3(512), 0, stream, p);
  hipLaunchKernelGGL((mega<5, 5>), dim3(grid_blocks), dim3(512), 0, stream, p);
  hipLaunchKernelGGL((mega<6, 6>), dim3(grid_blocks), dim3(512), 0, stream, p);
  hipLaunchKernelGGL((mega<7, 7>), dim3(grid_blocks), dim3(512), 0, stream, p);
  hipLaunchKernelGGL((mega<8, 8>), dim3(grid_blocks), dim3(512), 0, stream, p);
  hipLaunchKernelGGL((mega<9, 9>), dim3(grid_blocks), dim3(512), 0, stream, p);
  hipLaunchKernelGGL((mega<10, 10>), dim3(grid_blocks), dim3(512), 0, stream, p);
#endif
}
```

```cpp
#include <hip/hip_runtime.h>
#include <hip/hip_cooperative_groups.h>
#include <cstdio>
#include <cstdint>
namespace cg = cooperative_groups;

typedef unsigned short bf16_t;
using bf16x8 = __attribute__((ext_vector_type(8))) short;
using s16x4  = __attribute__((ext_vector_type(4))) short;
using f32x16 = __attribute__((ext_vector_type(16))) float;
using u32x4  = __attribute__((ext_vector_type(4))) unsigned;
using u32x2  = __attribute__((ext_vector_type(2))) unsigned;

constexpr int DM = 1024, NB = 16, SEQ = 2048, CTXL = 256, SKV = SEQ + CTXL;
constexpr int NTOK = NB * SEQ;
constexpr int NCTX = NB * CTXL;
constexpr int EVEN_IN = 5632, ODD_IN = 4096, DIN = 2048;
constexpr float ALPHA = 1.4142135623730951f;
constexpr float EPS = 1e-6f;

constexpr size_t MiB = 1ull << 20;
constexpr size_t OFF_WT_EIN = 0, OFF_WT_EOUT = 11 * MiB, OFF_WT_OIN = 15 * MiB, OFF_WT_OOUT = 23 * MiB;
constexpr size_t OFF_TAB_C = 27 * MiB, OFF_TAB_S = 30 * MiB, OFF_SMALL = 33 * MiB;
constexpr size_t OFF_CDM = OFF_SMALL, OFF_CDP = OFF_SMALL + 64 * 1024, OFF_WSB = OFF_SMALL + 128 * 1024;
constexpr size_t OFF_ROPE = OFF_SMALL + 384 * 1024, OFF_MOD = OFF_SMALL + 512 * 1024, OFF_XM = OFF_SMALL + 1024 * 1024;
constexpr size_t OFF_M0 = 36 * MiB, OFF_MC = 100 * MiB;
constexpr size_t OFF_SG = 108 * MiB;
constexpr size_t OFF_Q = 236 * MiB, OFF_BU = 300 * MiB;
constexpr size_t OFF_KALL = 364 * MiB, OFF_VALL = 382 * MiB, OFF_BV = 400 * MiB;
constexpr size_t OFF_F = 364 * MiB, OFF_RV = 428 * MiB;
constexpr size_t WS_NEED = 492 * MiB;

struct Params {
  const float *x, *c, *ctx, *c_ctx, *w_mod, *b_mod, *post_g, *post_b, *e_w_in, *e_qn, *e_kn, *e_vg, *e_vb, *e_ws, *e_bs,
      *e_w_out, *o_w_in, *o_w_out;
  float* out;
  char* ws;
  long pad_;
};

typedef float f32x2_t __attribute__((ext_vector_type(2)));
typedef __bf16 bf16x2_t __attribute__((ext_vector_type(2)));
__device__ __forceinline__ unsigned cvtpk(float lo, float hi) {
  f32x2_t v = {lo, hi}; bf16x2_t h = __builtin_convertvector(v, bf16x2_t); return __builtin_bit_cast(unsigned, h);
}
__device__ __forceinline__ int tid_fresh() { int t = (int)__builtin_amdgcn_workitem_id_x(); asm volatile("" : "+v"(t)); return t; }
__device__ __forceinline__ float bf_lo(unsigned w) { return __uint_as_float(w << 16); }
__device__ __forceinline__ float bf_hi(unsigned w) { return __uint_as_float(w & 0xffff0000u); }
__device__ __forceinline__ bf16_t f2bf(float x) { return (bf16_t)(cvtpk(x, 0.f) & 0xffffu); }
__device__ __forceinline__ float bf2f(bf16_t h) { return __uint_as_float(((unsigned)h) << 16); }
__device__ __forceinline__ int crow(int r, int hi) { return (r & 3) + 8 * (r >> 2) + 4 * hi; }
__device__ __forceinline__ float wave_sum(float v) {
#pragma unroll
  for (int o = 32; o >= 1; o >>= 1) v += __shfl_xor(v, o);
  return v;
}
__device__ __forceinline__ float silu_f(float x) { return x * __builtin_amdgcn_rcpf(1.f + __expf(-x)); }
__device__ __forceinline__ float gelu_tanh_f(float x) {
  const float u = 0.7978845608028654f * (x + 0.044715f * x * x * x);
  const float t = 1.f - 2.f * __builtin_amdgcn_rcpf(__expf(2.f * u) + 1.f);
  return 0.5f * x * (1.f + t);
}
__device__ __forceinline__ int logical_block() {
  const int g = gridDim.x, b = blockIdx.x;
  return (g & 7) ? b : (b & 7) * (g >> 3) + (b >> 3);
}

constexpr int LDS_ROWB = 144;
constexpr int LDS_A = 256 * LDS_ROWB;
constexpr int LDS_B = 128 * LDS_ROWB;
constexpr int LDS_STAGE = LDS_A + LDS_B;
constexpr int L2_A = 256 * LDS_ROWB;
constexpr int L2_STAGE = 2 * L2_A;
constexpr int LDS_RED = 2 * L2_STAGE;
constexpr int SMEM_BYTES = LDS_RED + 2048 + 2048;

struct LdPlain {
  const bf16_t* p; size_t rs;
  __device__ __forceinline__ u32x4 ld(int kt, int i) const { return *(const u32x4*)(p + (size_t)i * rs + kt * 64); }
};
__device__ __forceinline__ LdPlain mkPlain(const bf16_t* base, int ld) {
  const int tid = tid_fresh();
  LdPlain l; l.p = base + (size_t)(tid >> 3) * ld + (tid & 7) * 8; l.rs = (size_t)64 * ld; return l;
}
struct LdSplit {
  const bf16_t* p0; const bf16_t* p1; size_t rs; int kts;
  __device__ __forceinline__ u32x4 ld(int kt, int i) const {
    const bf16_t* q = (kt < kts) ? (p0 + kt * 64) : (p1 + (kt - kts) * 64);
    return *(const u32x4*)(q + (size_t)i * rs);
  }
};
__device__ __forceinline__ LdSplit mkSplit(const bf16_t* b0, const bf16_t* b1, int ld, int kts) {
  const int tid = tid_fresh(); const size_t o = (size_t)(tid >> 3) * ld + (tid & 7) * 8;
  LdSplit l; l.p0 = b0 + o; l.p1 = b1 + o; l.rs = (size_t)64 * ld; l.kts = kts; return l;
}
struct LdFold {
  const bf16_t* f; const bf16_t* r; size_t rs; float sg;
  __device__ __forceinline__ u32x4 ld(int kt, int i) const {
    const u32x4 a = *(const u32x4*)(f + (size_t)i * rs + kt * 64);
    const u32x4 b = *(const u32x4*)(r + (size_t)i * rs + kt * 64);
    u32x4 o;
    o[0] = cvtpk(bf_lo(a[0]) + sg * bf_lo(b[0]), bf_hi(a[0]) + sg * bf_hi(b[0]));
    o[1] = cvtpk(bf_lo(a[1]) + sg * bf_lo(b[1]), bf_hi(a[1]) + sg * bf_hi(b[1]));
    o[2] = cvtpk(bf_lo(a[2]) + sg * bf_lo(b[2]), bf_hi(a[2]) + sg * bf_hi(b[2]));
    o[3] = cvtpk(bf_lo(a[3]) + sg * bf_lo(b[3]), bf_hi(a[3]) + sg * bf_hi(b[3]));
    return o;
  }
};
__device__ __forceinline__ LdFold mkFold(const bf16_t* f, const bf16_t* r, int ld, float sg) {
  const int tid = tid_fresh(); const size_t o = (size_t)(tid >> 3) * ld + (tid & 7) * 8;
  LdFold l; l.f = f + o; l.r = r + o; l.rs = (size_t)64 * ld; l.sg = sg; return l;
}

template <class LA, class LB>
__device__ __forceinline__ void gemm_mainloop(const LA& la, const LB& lb, int KT, char* smem, f32x16 (&acc)[2][2]) {
  const int tid = tid_fresh(), wid = tid >> 6, lane = tid & 63, r32 = lane & 31, hi = lane >> 5, wm = wid >> 1, wn = wid & 1;
#pragma unroll
  for (int mi = 0; mi < 2; ++mi)
#pragma unroll
    for (int nj = 0; nj < 2; ++nj)
#pragma unroll
      for (int r = 0; r < 16; ++r) acc[mi][nj][r] = 0.f;
  const int st_off = (tid >> 3) * LDS_ROWB + (tid & 7) * 16;
  const int a_rd = (wm * 64 + r32) * LDS_ROWB + hi * 16;
  const int b_rd = LDS_A + (wn * 32 + r32) * LDS_ROWB + hi * 16;
  u32x4 ra0, ra1, ra2, ra3, rb0, rb1;
  ra0 = la.ld(0, 0); ra1 = la.ld(0, 1); ra2 = la.ld(0, 2); ra3 = la.ld(0, 3); rb0 = lb.ld(0, 0); rb1 = lb.ld(0, 1);
  {
    char* s = smem + st_off;
    *(u32x4*)(s) = ra0; *(u32x4*)(s + 64 * LDS_ROWB) = ra1; *(u32x4*)(s + 128 * LDS_ROWB) = ra2; *(u32x4*)(s + 192 * LDS_ROWB) = ra3;
    *(u32x4*)(s + LDS_A) = rb0; *(u32x4*)(s + LDS_A + 64 * LDS_ROWB) = rb1;
  }
  __syncthreads();
#define GEMM_COMPUTE(SB)                                                                              \
  _Pragma("unroll") for (int kk = 0; kk < 4; ++kk) {                                                  \
    const bf16x8 a0 = *(const bf16x8*)((SB) + a_rd + kk * 32);                                        \
    const bf16x8 a1 = *(const bf16x8*)((SB) + a_rd + 32 * LDS_ROWB + kk * 32);                        \
    const bf16x8 b0 = *(const bf16x8*)((SB) + b_rd + kk * 32);                                        \
    const bf16x8 b1 = *(const bf16x8*)((SB) + b_rd + 64 * LDS_ROWB + kk * 32);                        \
    acc[0][0] = __builtin_amdgcn_mfma_f32_32x32x16_bf16(b0, a0, acc[0][0], 0, 0, 0);                  \
    acc[0][1] = __builtin_amdgcn_mfma_f32_32x32x16_bf16(b1, a0, acc[0][1], 0, 0, 0);                  \
    acc[1][0] = __builtin_amdgcn_mfma_f32_32x32x16_bf16(b0, a1, acc[1][0], 0, 0, 0);                  \
    acc[1][1] = __builtin_amdgcn_mfma_f32_32x32x16_bf16(b1, a1, acc[1][1], 0, 0, 0);                  \
  }
#define GEMM_LOAD(KT_) do { ra0 = la.ld((KT_), 0); ra1 = la.ld((KT_), 1); ra2 = la.ld((KT_), 2); ra3 = la.ld((KT_), 3); rb0 = lb.ld((KT_), 0); rb1 = lb.ld((KT_), 1); } while (0)
#define GEMM_WRITE(ST) do { char* s = smem + (ST) * LDS_STAGE + st_off;                                \
    *(u32x4*)(s) = ra0; *(u32x4*)(s + 64 * LDS_ROWB) = ra1; *(u32x4*)(s + 128 * LDS_ROWB) = ra2; *(u32x4*)(s + 192 * LDS_ROWB) = ra3; \
    *(u32x4*)(s + LDS_A) = rb0; *(u32x4*)(s + LDS_A + 64 * LDS_ROWB) = rb1; } while (0)
#pragma unroll 1
  for (int kt = 0; kt < KT; kt += 2) {
    GEMM_LOAD(kt + 1);
    GEMM_COMPUTE(smem);
    GEMM_WRITE(1);
    __syncthreads();
    GEMM_LOAD(kt + 2 < KT ? kt + 2 : kt);
    GEMM_COMPUTE(smem + LDS_STAGE);
    GEMM_WRITE(0);
    __syncthreads();
  }
#undef GEMM_COMPUTE
#undef GEMM_LOAD
#undef GEMM_WRITE
}

template <class LA, class LB>
__device__ __forceinline__ void gemm2(const LA& la, const LB& lb, int KT, char* smem, f32x16 (&acc)[2][4]) {
  const int tid = tid_fresh(), wid = tid >> 6, lane = tid & 63, r32 = lane & 31, hi = lane >> 5, wm = wid >> 1, wn = wid & 1;
#pragma unroll
  for (int mi = 0; mi < 2; ++mi)
#pragma unroll
    for (int nj = 0; nj < 4; ++nj)
#pragma unroll
      for (int r = 0; r < 16; ++r) acc[mi][nj][r] = 0.f;
  const int st_off = (tid >> 3) * LDS_ROWB + (tid & 7) * 16;
  const int a_rd = (wm * 64 + r32) * LDS_ROWB + hi * 16;
  const int b_rd = L2_A + (wn * 128 + r32) * LDS_ROWB + hi * 16;
  u32x4 xa0, xa1, xa2, xa3, xb0, xb1, xb2, xb3, ya0, ya1, ya2, ya3, yb0, yb1, yb2, yb3;
#define G2_LOADX(KT_) do { xa0 = la.ld((KT_), 0); xa1 = la.ld((KT_), 1); xa2 = la.ld((KT_), 2); xa3 = la.ld((KT_), 3); xb0 = lb.ld((KT_), 0); xb1 = lb.ld((KT_), 1); xb2 = lb.ld((KT_), 2); xb3 = lb.ld((KT_), 3); } while (0)
#define G2_LOADY(KT_) do { ya0 = la.ld((KT_), 0); ya1 = la.ld((KT_), 1); ya2 = la.ld((KT_), 2); ya3 = la.ld((KT_), 3); yb0 = lb.ld((KT_), 0); yb1 = lb.ld((KT_), 1); yb2 = lb.ld((KT_), 2); yb3 = lb.ld((KT_), 3); } while (0)
#define G2_W2(ST, P, R0, R1, O0, O1) do { char* s_ = smem + (ST) * L2_STAGE + st_off; *(u32x4*)(s_ + (O0)) = P##R0; *(u32x4*)(s_ + (O1)) = P##R1; } while (0)
#define G2_WRITE(ST, P) do { G2_W2(ST, P, a0, a1, 0, 64 * LDS_ROWB); G2_W2(ST, P, a2, a3, 128 * LDS_ROWB, 192 * LDS_ROWB); \
    G2_W2(ST, P, b0, b1, L2_A, L2_A + 64 * LDS_ROWB); G2_W2(ST, P, b2, b3, L2_A + 128 * LDS_ROWB, L2_A + 192 * LDS_ROWB); } while (0)
#define G2_STEP(SB, kk) do {                                                                          \
    const bf16x8 a0 = *(const bf16x8*)((SB) + a_rd + (kk) * 32);                                      \
    const bf16x8 a1 = *(const bf16x8*)((SB) + a_rd + 32 * LDS_ROWB + (kk) * 32);                      \
    _Pragma("unroll") for (int nj = 0; nj < 4; ++nj) {                                                \
      const bf16x8 b_ = *(const bf16x8*)((SB) + b_rd + nj * 32 * LDS_ROWB + (kk) * 32);               \
      acc[0][nj] = __builtin_amdgcn_mfma_f32_32x32x16_bf16(b_, a0, acc[0][nj], 0, 0, 0);              \
      acc[1][nj] = __builtin_amdgcn_mfma_f32_32x32x16_bf16(b_, a1, acc[1][nj], 0, 0, 0);              \
    } } while (0)
#define G2_COMPUTE_W(SB, ST, P) do {                                                                  \
    G2_STEP(SB, 0); G2_W2(ST, P, a0, a1, 0, 64 * LDS_ROWB);                                           \
    G2_STEP(SB, 1); G2_W2(ST, P, a2, a3, 128 * LDS_ROWB, 192 * LDS_ROWB);                             \
    G2_STEP(SB, 2); G2_W2(ST, P, b0, b1, L2_A, L2_A + 64 * LDS_ROWB);                                 \
    G2_STEP(SB, 3); G2_W2(ST, P, b2, b3, L2_A + 128 * LDS_ROWB, L2_A + 192 * LDS_ROWB); } while (0)
  G2_LOADX(0); G2_LOADY(1);
  G2_WRITE(0, x);
  __syncthreads();
  G2_LOADX(2 < KT ? 2 : 0);
#pragma unroll 1
  for (int kt = 0; kt < KT; kt += 2) {
    G2_COMPUTE_W(smem, 1, y);
    __syncthreads();
    G2_LOADY(kt + 3 < KT ? kt + 3 : KT - 1);
    G2_COMPUTE_W(smem + L2_STAGE, 0, x);
    __syncthreads();
    G2_LOADX(kt + 4 < KT ? kt + 4 : KT - 2);
  }
#undef G2_LOADX
#undef G2_LOADY
#undef G2_WRITE
#undef G2_W2
#undef G2_STEP
#undef G2_COMPUTE_W
}
template <class F>
__device__ __forceinline__ void epi2_foreach(const f32x16 (&acc)[2][4], F&& f) {
  const int tid = tid_fresh(), wid = tid >> 6, lane = tid & 63, r32 = lane & 31, hi = lane >> 5, wm = wid >> 1, wn = wid & 1;
#pragma unroll
  for (int mi = 0; mi < 2; ++mi)
#pragma unroll
    for (int nj = 0; nj < 4; ++nj)
#pragma unroll
      for (int q = 0; q < 4; ++q)
        f(wm * 64 + mi * 32 + r32, wn * 128 + nj * 32 + q * 8 + hi * 4, acc[mi][nj][4 * q + 0], acc[mi][nj][4 * q + 1],
          acc[mi][nj][4 * q + 2], acc[mi][nj][4 * q + 3]);
}

template <class F>
__device__ __forceinline__ void epi_foreach(const f32x16 (&acc)[2][2], F&& f) {
  const int tid = tid_fresh(), wid = tid >> 6, lane = tid & 63, r32 = lane & 31, hi = lane >> 5, wm = wid >> 1, wn = wid & 1;
#pragma unroll
  for (int mi = 0; mi < 2; ++mi)
#pragma unroll
    for (int nj = 0; nj < 2; ++nj)
#pragma unroll
      for (int q = 0; q < 4; ++q)
        f(wm * 64 + mi * 32 + r32, nj * 64 + wn * 32 + q * 8 + hi * 4, acc[mi][nj][4 * q + 0], acc[mi][nj][4 * q + 1],
          acc[mi][nj][4 * q + 2], acc[mi][nj][4 * q + 3]);
}
__device__ __forceinline__ void st_bf4(bf16_t* p, float a, float b, float c, float d) {
  u32x2 w = {cvtpk(a, b), cvtpk(c, d)}; *(u32x2*)p = w;
}

__device__ __forceinline__ void tr_tile(const float* src, bf16_t* dst, int K, int N, int kt, int nt, float* tile) {
  const int tid = tid_fresh(), k0 = kt * 64, n0 = nt * 64;
#pragma unroll
  for (int j = 0; j < 8; ++j) { const int e = j * 512 + tid, r = e >> 6, c = e & 63; tile[r * 65 + c] = src[(size_t)(k0 + r) * N + n0 + c]; }
  __syncthreads();
  const int rn = tid >> 3, ck = (tid & 7) * 8;
  const float v0 = tile[(ck + 0) * 65 + rn], v1 = tile[(ck + 1) * 65 + rn], v2 = tile[(ck + 2) * 65 + rn], v3 = tile[(ck + 3) * 65 + rn];
  const float v4 = tile[(ck + 4) * 65 + rn], v5 = tile[(ck + 5) * 65 + rn], v6 = tile[(ck + 6) * 65 + rn], v7 = tile[(ck + 7) * 65 + rn];
  u32x4 w = {cvtpk(v0, v1), cvtpk(v2, v3), cvtpk(v4, v5), cvtpk(v6, v7)};
  *(u32x4*)(dst + (size_t)(n0 + rn) * K + k0 + ck) = w;
  __syncthreads();
}

__device__ __forceinline__ void phase0(const Params& p, char* smem) {
  const int tid = tid_fresh(), G = gridDim.x, bid = blockIdx.x;
  char* ws = p.ws;
  {
    float* s = (float*)smem;
    float* part = (float*)(smem + 17 * 1024 * 4);
    float* MOD = (float*)(ws + OFF_MOD);
    for (int u = bid; u < 96; u += G) {
      const int l = u / 48, j0 = (u % 48) * 64;
      for (int e = tid; e < 17 * 1024; e += 512) { const int r = e >> 10, k = e & 1023; const float cv = (r < 16) ? p.c[r * 1024 + k] : p.c_ctx[k]; s[e] = silu_f(cv); }
      __syncthreads();
      const int col = tid & 63, ks = tid >> 6;
      float a0 = 0, a1 = 0, a2 = 0, a3 = 0, a4 = 0, a5 = 0, a6 = 0, a7 = 0, a8 = 0, a9 = 0, a10 = 0, a11 = 0, a12 = 0, a13 = 0, a14 = 0, a15 = 0, a16 = 0;
      const float* w = p.w_mod + (size_t)l * 1024 * 3072 + j0 + col;
#pragma unroll 4
      for (int k = ks * 128; k < ks * 128 + 128; ++k) {
        const float wv = w[(size_t)k * 3072];
        a0 += s[0 * 1024 + k] * wv; a1 += s[1 * 1024 + k] * wv; a2 += s[2 * 1024 + k] * wv; a3 += s[3 * 1024 + k] * wv;
        a4 += s[4 * 1024 + k] * wv; a5 += s[5 * 1024 + k] * wv; a6 += s[6 * 1024 + k] * wv; a7 += s[7 * 1024 + k] * wv;
        a8 += s[8 * 1024 + k] * wv; a9 += s[9 * 1024 + k] * wv; a10 += s[10 * 1024 + k] * wv; a11 += s[11 * 1024 + k] * wv;
        a12 += s[12 * 1024 + k] * wv; a13 += s[13 * 1024 + k] * wv; a14 += s[14 * 1024 + k] * wv; a15 += s[15 * 1024 + k] * wv;
        a16 += s[16 * 1024 + k] * wv;
      }
      float* pp = part + ks * 17 * 64 + col;
      pp[0 * 64] = a0; pp[1 * 64] = a1; pp[2 * 64] = a2; pp[3 * 64] = a3; pp[4 * 64] = a4; pp[5 * 64] = a5; pp[6 * 64] = a6; pp[7 * 64] = a7;
      pp[8 * 64] = a8; pp[9 * 64] = a9; pp[10 * 64] = a10; pp[11 * 64] = a11; pp[12 * 64] = a12; pp[13 * 64] = a13; pp[14 * 64] = a14; pp[15 * 64] = a15;
      pp[16 * 64] = a16;
      __syncthreads();
      for (int e = tid; e < 17 * 64; e += 512) {
        const int r = e >> 6, cc = e & 63;
        float t = p.b_mod[l * 3072 + j0 + cc];
#pragma unroll
        for (int q = 0; q < 8; ++q) t += part[q * 17 * 64 + r * 64 + cc];
        MOD[(size_t)(l * 17 + r) * 3072 + j0 + cc] = t;
      }
      __syncthreads();
    }
  }
  {
    float* tile = (float*)smem;
    constexpr int T0 = 16 * 88, T1 = 32 * 16, T2 = 16 * 64, T3 = 32 * 16;
    auto do_tile = [&](int u) {
      if (u < T0) tr_tile(p.e_w_in, (bf16_t*)(ws + OFF_WT_EIN), 1024, EVEN_IN, u / 88, u % 88, tile);
      else if (u < T0 + T1) { const int v = u - T0; tr_tile(p.e_w_out, (bf16_t*)(ws + OFF_WT_EOUT), 2048, 1024, v / 16, v % 16, tile); }
      else if (u < T0 + T1 + T2) { const int v = u - T0 - T1; tr_tile(p.o_w_in, (bf16_t*)(ws + OFF_WT_OIN), 1024, ODD_IN, v / 64, v % 64, tile); }
      else { const int v = u - T0 - T1 - T2; tr_tile(p.o_w_out, (bf16_t*)(ws + OFF_WT_OOUT), 2048, 1024, v / 16, v % 16, tile); }
    };
    if (G == 256) {
      const int first = (bid >= 96) ? (bid - 96) : (2880 + bid), stride = (bid >= 96) ? 160 : 96, cnt = (bid >= 96) ? 18 : 6;
      for (int k = 0; k < cnt; ++k) do_tile(first + k * stride);
    } else {
      for (int u = bid; u < T0 + T1 + T2 + T3; u += G) do_tile(u);
    }
  }
  {
    const long gt = (long)bid * 512 + tid, gn = (long)G * 512;
    bf16_t* TC = (bf16_t*)(ws + OFF_TAB_C); bf16_t* TS = (bf16_t*)(ws + OFF_TAB_S);
    for (long e = gt; e < 1280L * 1024; e += gn) {
      const int tp = (int)(e >> 10), t = (int)(e & 1023);
      float v = 0.f;
      if (tp <= 1024) { const int m = (tp * t) & 2047; v = cospif((float)m * (1.f / 1024.f)); }
      TC[e] = f2bf(v);
    }
    for (long e = gt; e < 1024L * 1024; e += gn) {
      const int tp = (int)(e >> 10), t = (int)(e & 1023);
      const int m = (tp * t) & 2047;
      TS[e] = f2bf(sinpif((float)m * (1.f / 1024.f)));
    }
    bf16_t* CDM = (bf16_t*)(ws + OFF_CDM); bf16_t* CDP = (bf16_t*)(ws + OFF_CDP);
    for (long e = gt; e < 128L * 256; e += gn) {
      const int cp = (int)(e >> 8), k = (int)(e & 255);
      const int m = (cp * (k & 127)) & 127;
      const float x = (float)m * (1.f / 64.f);
      float vm, vp;
      if (k < 128) { vm = cospif(x); vp = vm; } else { vp = sinpif(x); vm = -vp; }
      CDM[e] = f2bf(vm); CDP[e] = f2bf(vp);
    }
    bf16_t* WSB = (bf16_t*)(ws + OFF_WSB);
    for (long e = gt; e < 8L * 128 * 128; e += gn) WSB[e] = f2bf(p.e_ws[e]);
    float2* ROPE = (float2*)(ws + OFF_ROPE);
    for (long e = gt; e < 64L * 32; e += gn) {
      const int pos = (int)(e >> 5), i = (int)(e & 31);
      const float inv = powf(10000.f, -(float)i / 32.f);
      const float ang = (float)pos * inv;
      ROPE[e] = make_float2(cosf(ang), sinf(ang));
    }
  }
}

__device__ __forceinline__ void ln_rows_modulate(const float* src, bf16_t* dst, int nrows, int rows_per_b, const float* mod17, int fixed_row) {
  const int tid = tid_fresh(), wid = tid >> 6, lane = tid & 63;
  const int gw = blockIdx.x * 8 + wid, nw = gridDim.x * 8;
  float4 n0, n1, n2, n3;
  { const int r0 = gw < nrows ? gw : 0; const float4* ps = (const float4*)(src + (size_t)r0 * 1024); n0 = ps[lane]; n1 = ps[lane + 64]; n2 = ps[lane + 128]; n3 = ps[lane + 192]; }
  for (int row = gw; row < nrows; row += nw) {
    float4 v0 = n0, v1 = n1, v2 = n2, v3 = n3;
    { const int nr = (row + nw < nrows) ? row + nw : row;
      const float4* ps = (const float4*)(src + (size_t)nr * 1024); n0 = ps[lane]; n1 = ps[lane + 64]; n2 = ps[lane + 128]; n3 = ps[lane + 192]; }
    float s = v0.x + v0.y + v0.z + v0.w + v1.x + v1.y + v1.z + v1.w + v2.x + v2.y + v2.z + v2.w + v3.x + v3.y + v3.z + v3.w;
    const float mu = wave_sum(s) * (1.f / 1024.f);
    v0.x -= mu; v0.y -= mu; v0.z -= mu; v0.w -= mu; v1.x -= mu; v1.y -= mu; v1.z -= mu; v1.w -= mu;
    v2.x -= mu; v2.y -= mu; v2.z -= mu; v2.w -= mu; v3.x -= mu; v3.y -= mu; v3.z -= mu; v3.w -= mu;
    float q = v0.x * v0.x + v0.y * v0.y + v0.z * v0.z + v0.w * v0.w + v1.x * v1.x + v1.y * v1.y + v1.z * v1.z + v1.w * v1.w +
              v2.x * v2.x + v2.y * v2.y + v2.z * v2.z + v2.w * v2.w + v3.x * v3.x + v3.y * v3.y + v3.z * v3.z + v3.w * v3.w;
    const float rstd = rsqrtf(wave_sum(q) * (1.f / 1024.f) + EPS);
    const int mr = (fixed_row >= 0) ? fixed_row : (row / rows_per_b);
    const float* md = mod17 + (size_t)mr * 3072;
    bf16_t* pd = dst + (size_t)row * 1024;
#define MODST(V, J) { const int col = (lane + 64 * J) * 4; const float4 sh = *(const float4*)(md + col); const float4 sc = *(const float4*)(md + 1024 + col); \
      st_bf4(pd + col, V.x * rstd * (1.f + sc.x) + sh.x, V.y * rstd * (1.f + sc.y) + sh.y, V.z * rstd * (1.f + sc.z) + sh.z, V.w * rstd * (1.f + sc.w) + sh.w); }
    MODST(v0, 0) MODST(v1, 1) MODST(v2, 2) MODST(v3, 3)
#undef MODST
  }
}

__device__ __forceinline__ void phase2(const Params& p, char* smem) {
  char* ws = p.ws;
  const bf16_t* M0 = (const bf16_t*)(ws + OFF_M0); const bf16_t* MC = (const bf16_t*)(ws + OFF_MC);
  const bf16_t* WT = (const bf16_t*)(ws + OFF_WT_EIN);
  bf16_t* Q = (bf16_t*)(ws + OFF_Q); bf16_t* KA = (bf16_t*)(ws + OFF_KALL); bf16_t* VA = (bf16_t*)(ws + OFF_VALL);
  bf16_t* BU = (bf16_t*)(ws + OFF_BU); bf16_t* BV = (bf16_t*)(ws + OFF_BV); bf16_t* SG = (bf16_t*)(ws + OFF_SG);
  const float2* ROPE = (const float2*)(ws + OFF_ROPE);
  const int tid = tid_fresh(), wid = tid >> 6, lane = tid & 63, r32 = lane & 31, hi = lane >> 5, wm = wid >> 1, wn = wid & 1;
  const int lb = logical_block();
  for (int u = lb; u < 2816 + 32; u += gridDim.x) {
    const bool isctx = (u >= 2816);
    int mt, nt;
    if (!isctx) { mt = u / 22; nt = u % 22; } else { const int v = u - 2816; mt = v >> 1; nt = 4 + (v & 1); }
    const bf16_t* A = (isctx ? MC : M0) + (size_t)mt * 256 * 1024;
    f32x16 acc[2][4];
    gemm2(mkPlain(A, 1024), mkPlain(WT + (size_t)nt * 256 * 1024, 1024), 16, smem, acc);
    if (nt < 5) {
      const bool isq = nt < 4;
      const int head = isq ? (nt * 2 + wn) : wn;
      const float* gv = isq ? p.e_qn : p.e_kn;
#pragma unroll
      for (int mi = 0; mi < 2; ++mi) {
        float ss = 0.f;
#pragma unroll
        for (int nj = 0; nj < 4; ++nj)
#pragma unroll
          for (int r = 0; r < 16; ++r) ss += acc[mi][nj][r] * acc[mi][nj][r];
        ss += __shfl_xor(ss, 32);
        const float rstd = rsqrtf(ss * (1.f / 128.f) + EPS);
        const int row = wm * 64 + mi * 32 + r32;
        int t = 0; size_t obase;
        if (!isctx) {
          const int b = mt >> 3; t = (mt & 7) * 256 + row;
          if (isq) obase = ((size_t)(b * SEQ + t) * 8 + head) * 128;
          else obase = ((size_t)(b * SKV + CTXL + t) * 2 + head) * 128;
        } else {
          obase = ((size_t)(mt * SKV + row) * 2 + head) * 128;
        }
        bf16_t* dst = (isq ? Q : KA) + obase;
#pragma unroll
        for (int nj = 0; nj < 2; ++nj) {
          const int pos = (nj == 0) ? (t >> 6) : (t & 63);
#pragma unroll
          for (int q = 0; q < 4; ++q) {
            float o1[4], o2[4];
#pragma unroll
            for (int e = 0; e < 4; ++e) {
              const int r = 4 * q + e;
              const int i = 8 * q + 4 * hi + e;
              const int d = nj * 32 + i;
              const float x1 = acc[mi][nj][r] * rstd * gv[d];
              const float x2 = acc[mi][nj + 2][r] * rstd * gv[64 + d];
              if (!isctx) {
                const float2 cs = ROPE[pos * 32 + i];
                o1[e] = x1 * cs.x - x2 * cs.y; o2[e] = x2 * cs.x + x1 * cs.y;
              } else { o1[e] = x1; o2[e] = x2; }
            }
            const int d0 = nj * 32 + 8 * q + 4 * hi;
            st_bf4(dst + d0, o1[0], o1[1], o1[2], o1[3]);
            st_bf4(dst + 64 + d0, o2[0], o2[1], o2[2], o2[3]);
          }
        }
      }
    } else if (nt == 5) {
      epi2_foreach(acc, [&](int row, int col, float a, float b, float c, float d) {
        size_t tokrow;
        if (!isctx) { const int bb = mt >> 3, t = (mt & 7) * 256 + row; tokrow = (size_t)bb * SKV + CTXL + t; } else tokrow = (size_t)mt * SKV + row;
        st_bf4(VA + tokrow * 256 + col, a, b, c, d);
      });
    } else if (nt < 14) {
      bf16_t* dst = (nt < 10) ? (BU + (size_t)(nt - 6) * 256) : (BV + (size_t)(nt - 10) * 256);
      epi2_foreach(acc, [&](int row, int col, float a, float b, float c, float d) {
        st_bf4(dst + (size_t)(mt * 256 + row) * 1024 + col, gelu_tanh_f(a), gelu_tanh_f(b), gelu_tanh_f(c), gelu_tanh_f(d));
      });
    } else {
      bf16_t* dst = SG + (size_t)(nt - 14) * 256;
      epi2_foreach(acc, [&](int row, int col, float a, float b, float c, float d) {
        st_bf4(dst + (size_t)(mt * 256 + row) * 2048 + col, silu_f(a), silu_f(b), silu_f(c), silu_f(d));
      });
    }
  }
}

namespace att {
constexpr int D = 128, NW = 8, QBLK = 32, KVBLK = 64;
constexpr float SCALE = 0.088388347648318440f;
constexpr float THR = 8.f;
constexpr int LDQ = 1024, LDK = 256;
constexpr int SHM_V = KVBLK * D * 2, SHM_K = KVBLK * D * 2;
#define KSWZ(row, colB) ((row) * 256 + ((colB) ^ (((row) & 7) << 4)))
#define SBAR() __builtin_amdgcn_sched_barrier(0)
__device__ __forceinline__ void partialSM(f32x16& p0, f32x16& p1, float& m_reg, float& mn, float& alpha) {
  constexpr float C = SCALE * 1.4426950408889634f;
  float pmax = p0[0];
#pragma unroll
  for (int r = 1; r < 16; ++r) pmax = fmaxf(pmax, p0[r]);
#pragma unroll
  for (int r = 0; r < 16; ++r) pmax = fmaxf(pmax, p1[r]);
  { auto rr = __builtin_amdgcn_permlane32_swap(__float_as_uint(pmax), __float_as_uint(pmax), false, false);
    pmax = fmaxf(__uint_as_float(rr[0]), __uint_as_float(rr[1])); }
  if (__builtin_expect(__all(pmax - m_reg <= THR / SCALE), 1)) { mn = m_reg; alpha = 1.f; }
  else { mn = fmaxf(m_reg, pmax); alpha = __builtin_amdgcn_exp2f((m_reg - mn) * C); m_reg = mn; }
  const float mnC = -mn * C;
#pragma unroll
  for (int r = 0; r < 16; ++r) p0[r] = fmaf(p0[r], C, mnC);
#pragma unroll
  for (int r = 0; r < 16; ++r) p1[r] = fmaf(p1[r], C, mnC);
#pragma unroll
  for (int r = 0; r < 16; ++r) p0[r] = __builtin_amdgcn_exp2f(p0[r]);
}
__device__ __forceinline__ void finishSM(f32x16& p0, f32x16& p1, float alpha, float& l_reg, bf16x8& pa0, bf16x8& pa1, bf16x8& pa2, bf16x8& pa3) {
#pragma unroll
  for (int r = 0; r < 16; ++r) p1[r] = __builtin_amdgcn_exp2f(p1[r]);
  float ps = 0;
#pragma unroll
  for (int r = 0; r < 16; ++r) ps += p0[r];
#pragma unroll
  for (int r = 0; r < 16; ++r) ps += p1[r];
  { auto rr = __builtin_amdgcn_permlane32_swap(__float_as_uint(ps), __float_as_uint(ps), false, false);
    ps = __uint_as_float(rr[0]) + __uint_as_float(rr[1]); }
  l_reg = l_reg * alpha + ps;
#define PK4(P, BASE, OUT) do { unsigned a0 = cvtpk(P[BASE + 0], P[BASE + 1]), a1 = cvtpk(P[BASE + 2], P[BASE + 3]);   \
    unsigned b0 = cvtpk(P[BASE + 4], P[BASE + 5]), b1 = cvtpk(P[BASE + 6], P[BASE + 7]);                              \
    auto r0 = __builtin_amdgcn_permlane32_swap(a0, b0, false, false); auto r1 = __builtin_amdgcn_permlane32_swap(a1, b1, false, false); \
    u32x4 w = {r0[0], r1[0], r0[1], r1[1]}; OUT = *reinterpret_cast<bf16x8*>(&w); } while (0)
  PK4(p0, 0, pa0); PK4(p0, 8, pa1); PK4(p1, 0, pa2); PK4(p1, 8, pa3);
#undef PK4
}
__device__ __forceinline__ void qkt(f32x16& p0, f32x16& p1, const bf16_t* Ks, const bf16x8* qr, int r32, int hi) {
#pragma unroll
  for (int r = 0; r < 16; ++r) { p0[r] = 0.f; p1[r] = 0.f; }
#pragma unroll
  for (int d0 = 0; d0 < 8; ++d0) { const int cb = (d0 * 16 + hi * 8) * 2;
    bf16x8 b0 = *reinterpret_cast<const bf16x8*>((const char*)Ks + KSWZ(r32, cb));
    bf16x8 b1 = *reinterpret_cast<const bf16x8*>((const char*)Ks + KSWZ(32 + r32, cb));
    p0 = __builtin_amdgcn_mfma_f32_32x32x16_bf16(b0, qr[d0], p0, 0, 0, 0);
    p1 = __builtin_amdgcn_mfma_f32_32x32x16_bf16(b1, qr[d0], p1, 0, 0, 0); }
}
__device__ __forceinline__ int v_st(int k, int c) { const int kk = (k & ~0xC) | ((k & 4) << 1) | ((k & 8) >> 1); return ((kk >> 3) * 4 + (c >> 5)) * 512 + ((kk & 7) * 32 + (c & 31)) * 2; }
__device__ __forceinline__ int v_rd_base(int lane) { return ((lane & 3) << 3) | (((lane >> 2) & 3) << 6) | (((lane >> 4) & 1) << 5) | (((lane >> 5) & 1) << 8); }
constexpr int v_rd_off(int d0, int ks, int half) { return d0 * 512 + ks * 4096 + half * 2048; }
template <int OFF> __device__ __forceinline__ s16x4 tr_read(int vb) {
  s16x4 r; asm volatile("ds_read_b64_tr_b16 %0, %1 offset:%2" : "=&v"(r) : "v"(vb), "i"(OFF) : "memory"); return r;
}
template <int D0> __device__ __forceinline__ void pv_one(f32x16& od, int vb, bf16x8 pa0, bf16x8 pa1, bf16x8 pa2, bf16x8 pa3) {
  const s16x4 l0 = tr_read<v_rd_off(D0, 0, 0)>(vb), h0 = tr_read<v_rd_off(D0, 0, 1)>(vb), l1 = tr_read<v_rd_off(D0, 1, 0)>(vb), h1 = tr_read<v_rd_off(D0, 1, 1)>(vb);
  const s16x4 l2 = tr_read<v_rd_off(D0, 2, 0)>(vb), h2 = tr_read<v_rd_off(D0, 2, 1)>(vb), l3 = tr_read<v_rd_off(D0, 3, 0)>(vb), h3 = tr_read<v_rd_off(D0, 3, 1)>(vb);
  asm volatile("s_waitcnt lgkmcnt(0)" ::: "memory"); SBAR();
#define PK(L, H) (bf16x8){L[0], L[1], L[2], L[3], H[0], H[1], H[2], H[3]}
  od = __builtin_amdgcn_mfma_f32_32x32x16_bf16(pa0, PK(l0, h0), od, 0, 0, 0);
  od = __builtin_amdgcn_mfma_f32_32x32x16_bf16(pa1, PK(l1, h1), od, 0, 0, 0);
  od = __builtin_amdgcn_mfma_f32_32x32x16_bf16(pa2, PK(l2, h2), od, 0, 0, 0);
  od = __builtin_amdgcn_mfma_f32_32x32x16_bf16(pa3, PK(l3, h3), od, 0, 0, 0);
#undef PK
}
__device__ __forceinline__ void pv_d0(f32x16* o, int vb, bf16x8 pa0, bf16x8 pa1, bf16x8 pa2, bf16x8 pa3) {
  pv_one<0>(o[0], vb, pa0, pa1, pa2, pa3); pv_one<1>(o[1], vb, pa0, pa1, pa2, pa3); pv_one<2>(o[2], vb, pa0, pa1, pa2, pa3); pv_one<3>(o[3], vb, pa0, pa1, pa2, pa3);
}
__device__ __forceinline__ void attn_body(const bf16_t* __restrict__ Qb, const bf16_t* __restrict__ Kh, const bf16_t* __restrict__ Vh,
                                          bf16_t* GO, int seq, char* lds) {
  const int tid = tid_fresh(), wid = tid >> 6, lane = tid & 63, r32 = lane & 31, hi = lane >> 5;
  bf16_t* V_lds = (bf16_t*)lds; bf16_t* K_lds = (bf16_t*)(lds + 2 * SHM_V);
  float* wsx = (float*)(lds + 2 * SHM_V + 2 * SHM_K) + wid * 64; float* li_l = wsx; float* al_l = wsx + 32;
  float m_reg = -1e30f, l_reg = 0; f32x16 o[4]; bf16x8 qr[8];
#pragma unroll
  for (int d = 0; d < 4; ++d)
#pragma unroll
    for (int r = 0; r < 16; ++r) o[d][r] = 0.f;
  const bf16_t* Qw = Qb + (long)(wid * QBLK + r32) * LDQ + hi * 8;
#pragma unroll
  for (int d0 = 0; d0 < 8; ++d0) qr[d0] = *reinterpret_cast<const bf16x8*>(Qw + d0 * 16);
  const int sr = tid >> 4, sc = (tid & 15) * 8, vst0 = v_st(sr, sc), vst1 = v_st(32 + sr, sc);
  const int vb0 = (int)(uintptr_t)V_lds + v_rd_base(lane);
  constexpr int SDEPTH = 1;
  bf16x8 sv0[SDEPTH], sv1[SDEPTH], sk0[SDEPTH], sk1[SDEPTH];
#define SLOAD(i, k0) do { sv0[i] = *reinterpret_cast<const bf16x8*>(&Vh[(long)((k0) + sr) * LDK + sc]); sv1[i] = *reinterpret_cast<const bf16x8*>(&Vh[(long)((k0) + 32 + sr) * LDK + sc]); \
    sk0[i] = *reinterpret_cast<const bf16x8*>(&Kh[(long)((k0) + sr) * LDK + sc]); sk1[i] = *reinterpret_cast<const bf16x8*>(&Kh[(long)((k0) + 32 + sr) * LDK + sc]); } while (0)
#define SWRITE(b, i) do { *(bf16x8*)((char*)V_lds + (b) * SHM_V + vst0) = sv0[i];          \
    *(bf16x8*)((char*)V_lds + (b) * SHM_V + vst1) = sv1[i]; const int kc = sc * 2;               \
    *(bf16x8*)((char*)K_lds + (b) * SHM_K + KSWZ(sr, kc)) = sk0[i];                       \
    *(bf16x8*)((char*)K_lds + (b) * SHM_K + KSWZ(32 + sr, kc)) = sk1[i]; } while (0)
#define SWAIT() do { if (SDEPTH == 2) asm volatile("s_waitcnt vmcnt(4)" ::: "memory"); else asm volatile("s_waitcnt vmcnt(0)" ::: "memory"); } while (0)
#define RESC(a) do { if (__any((a) < 1.f)) { if (hi == 0) al_l[r32] = (a); asm volatile("s_waitcnt lgkmcnt(0)" ::: "memory"); \
    _Pragma("unroll") for (int d = 0; d < 4; ++d) _Pragma("unroll") for (int r = 0; r < 16; ++r) o[d][r] *= al_l[crow(r, hi)]; } } while (0)
  f32x16 pA0, pA1, pB0, pB1; float mnA, mnB, alA, alB; bf16x8 pa0, pa1, pa2, pa3; const int NT = seq / KVBLK;
  constexpr int SE = 0, SO = SDEPTH - 1;
  SLOAD(SE, 0); asm volatile("s_waitcnt vmcnt(0)" ::: "memory"); SWRITE(0, SE); __syncthreads();
  qkt(pA0, pA1, K_lds, qr, r32, hi); partialSM(pA0, pA1, m_reg, mnA, alA);
  SLOAD(SO, KVBLK); if (SDEPTH == 2) { if (2 < NT) SLOAD(SE, 2 * KVBLK); }
  SWAIT(); SWRITE(1, SO); __syncthreads();
  for (int j = 1; j + 1 < NT; j += 2) {
    SBAR(); qkt(pB0, pB1, (bf16_t*)((char*)K_lds + SHM_K), qr, r32, hi);
    finishSM(pA0, pA1, alA, l_reg, pa0, pa1, pa2, pa3); SBAR();
    SLOAD(SO, (j + SDEPTH) * KVBLK); SBAR();
    pv_d0(o, vb0, pa0, pa1, pa2, pa3); partialSM(pB0, pB1, m_reg, mnB, alB);
    __syncthreads(); SWAIT(); SWRITE(0, SE);
    RESC(alB); __syncthreads();
    SBAR(); qkt(pA0, pA1, K_lds, qr, r32, hi);
    finishSM(pB0, pB1, alB, l_reg, pa0, pa1, pa2, pa3); SBAR();
    if (SDEPTH == 1 || j + 3 < NT) SLOAD(SE, (j + 1 + SDEPTH) * KVBLK); SBAR();
    pv_d0(o, vb0 + (int)SHM_V, pa0, pa1, pa2, pa3); partialSM(pA0, pA1, m_reg, mnA, alA);
    __syncthreads(); SWAIT(); SWRITE(1, SO);
    RESC(alA); __syncthreads();
  }
  SBAR(); qkt(pB0, pB1, (bf16_t*)((char*)K_lds + SHM_K), qr, r32, hi);
  finishSM(pA0, pA1, alA, l_reg, pa0, pa1, pa2, pa3); SBAR();
  pv_d0(o, vb0, pa0, pa1, pa2, pa3); partialSM(pB0, pB1, m_reg, mnB, alB);
  __syncthreads(); RESC(alB);
  finishSM(pB0, pB1, alB, l_reg, pa0, pa1, pa2, pa3); SBAR();
  pv_d0(o, vb0 + (int)SHM_V, pa0, pa1, pa2, pa3);
  if (hi == 0) li_l[r32] = l_reg; asm volatile("s_waitcnt lgkmcnt(0)" ::: "memory");
  float rli[16];
#pragma unroll
  for (int r = 0; r < 16; ++r) rli[r] = __builtin_amdgcn_rcpf(li_l[crow(r, hi)]);
  bf16_t* Ow = GO + (long)(wid * QBLK) * 2048;
#pragma unroll
  for (int r = 0; r < 16; ++r) { const int orow = crow(r, hi);
#pragma unroll
    for (int d0 = 0; d0 < 4; ++d0) { bf16_t* q = Ow + (long)orow * 2048 + d0 * 32 + r32; *q = f2bf(o[d0][r] * rli[r] * bf2f(*q)); }
    SBAR(); }
  __syncthreads();
#undef SLOAD
#undef SWRITE
#undef SWAIT
#undef RESC
}
}

__device__ __forceinline__ void chunk_gate_unit(const Params& p, int b, int n, char* smem) {
  char* ws = p.ws;
  const bf16_t* BU = (const bf16_t*)(ws + OFF_BU); const bf16_t* BV = (const bf16_t*)(ws + OFF_BV);
  bf16_t* SG = (bf16_t*)(ws + OFF_SG); const bf16_t* WSB = (const bf16_t*)(ws + OFF_WSB);
  const int tid = tid_fresh(), wid = tid >> 6, lane = tid & 63, r32 = lane & 31, hi = lane >> 5;
  constexpr int RS = 272;
  char* sW = smem; char* sV = smem + 128 * RS;
  float* smu = (float*)(smem + 2 * 128 * RS); float* srs = smu + 128;
  const size_t tok0 = (size_t)b * SEQ + (size_t)n * 128;
  {
    const int q = tid >> 2, part = tid & 3;
    const u32x4* src = (const u32x4*)(BV + (tok0 + q) * 1024 + part * 256);
    float s = 0.f, s2 = 0.f;
#pragma unroll 4
    for (int i = 0; i < 32; ++i) {
      const u32x4 w = src[i];
#pragma unroll
      for (int e = 0; e < 4; ++e) { const float a = bf_lo(w[e]), c = bf_hi(w[e]); s += a + c; s2 += a * a + c * c; }
    }
    s += __shfl_xor(s, 1); s2 += __shfl_xor(s2, 1); s += __shfl_xor(s, 2); s2 += __shfl_xor(s2, 2);
    const float mu = s * (1.f / 1024.f);
    const float var = fmaxf(s2 * (1.f / 1024.f) - mu * mu, 0.f);
    if (part == 0) { smu[q] = mu; srs[q] = rsqrtf(var + EPS); }
  }
  __syncthreads();
  const int wp = wid >> 1, wc = wid & 1;
  for (int g = 0; g < 8; ++g) {
#pragma unroll
    for (int i = 0; i < 4; ++i) {
      const int id = tid + 512 * i, row = id >> 4, ck = (id & 15) * 8;
      *(u32x4*)(sW + row * RS + ck * 2) = *(const u32x4*)(WSB + (size_t)g * 16384 + row * 128 + ck);
    }
#pragma unroll
    for (int i = 0; i < 4; ++i) {
      const int id = tid + 512 * i, q = id & 127, cc = (id >> 7) * 8;
      const u32x4 w = *(const u32x4*)(BV + (tok0 + q) * 1024 + g * 128 + cc);
      const float mu = smu[q], rs = srs[q];
      const float* lg = p.e_vg + g * 128 + cc; const float* lbp = p.e_vb + g * 128 + cc;
#pragma unroll
      for (int e = 0; e < 4; ++e) {
        const float a = (bf_lo(w[e]) - mu) * rs * lg[2 * e] + lbp[2 * e];
        const float c = (bf_hi(w[e]) - mu) * rs * lg[2 * e + 1] + lbp[2 * e + 1];
        *(bf16_t*)(sV + (cc + 2 * e) * RS + q * 2) = f2bf(a);
        *(bf16_t*)(sV + (cc + 2 * e + 1) * RS + q * 2) = f2bf(c);
      }
    }
    __syncthreads();
    f32x16 acc0, acc1;
#pragma unroll
    for (int r = 0; r < 16; ++r) { acc0[r] = 0.f; acc1[r] = 0.f; }
#pragma unroll
    for (int kk = 0; kk < 8; ++kk) {
      const bf16x8 af = *(const bf16x8*)(sW + (wp * 32 + r32) * RS + kk * 32 + hi * 16);
      const bf16x8 b0 = *(const bf16x8*)(sV + (wc * 64 + r32) * RS + kk * 32 + hi * 16);
      const bf16x8 b1 = *(const bf16x8*)(sV + (wc * 64 + 32 + r32) * RS + kk * 32 + hi * 16);
      acc0 = __builtin_amdgcn_mfma_f32_32x32x16_bf16(b0, af, acc0, 0, 0, 0);
      acc1 = __builtin_amdgcn_mfma_f32_32x32x16_bf16(b1, af, acc1, 0, 0, 0);
    }
    const int pr = wp * 32 + r32;
    const float bias = p.e_bs[g * 128 + pr];
    const size_t tok = tok0 + pr;
#pragma unroll
    for (int nj = 0; nj < 2; ++nj)
#pragma unroll
      for (int q = 0; q < 4; ++q) {
        const int col = g * 128 + wc * 64 + nj * 32 + q * 8 + hi * 4;
        const u32x2 bu = *(const u32x2*)(BU + tok * 1024 + col);
        bf16_t* gp = SG + tok * 2048 + 1024 + col;
        const u32x2 sg = *(const u32x2*)gp;
        const float m0 = (nj ? acc1[4 * q + 0] : acc0[4 * q + 0]) + bias, m1 = (nj ? acc1[4 * q + 1] : acc0[4 * q + 1]) + bias;
        const float m2 = (nj ? acc1[4 * q + 2] : acc0[4 * q + 2]) + bias, m3 = (nj ? acc1[4 * q + 3] : acc0[4 * q + 3]) + bias;
        st_bf4(gp, bf_lo(bu[0]) * m0 * bf_lo(sg[0]), bf_hi(bu[0]) * m1 * bf_hi(sg[0]), bf_lo(bu[1]) * m2 * bf_lo(sg[1]), bf_hi(bu[1]) * m3 * bf_hi(sg[1]));
      }
    __syncthreads();
  }
}

__device__ __forceinline__ void post_ln_rows(const float* src, float* dst, const float* pg, const float* pb, bf16_t* m1, const float* mod17) {
  const int tid = tid_fresh(), wid = tid >> 6, lane = tid & 63;
  const int gw = blockIdx.x * 8 + wid, nw = gridDim.x * 8;
  float4 nx[4];
  { const float4* ps = (const float4*)(src + (size_t)gw * 1024);
#pragma unroll
    for (int j = 0; j < 4; ++j) nx[j] = ps[lane + 64 * j]; }
  for (int row = gw; row < NTOK; row += nw) {
    float4 v[4];
#pragma unroll
    for (int j = 0; j < 4; ++j) v[j] = nx[j];
    { const int nr = (row + nw < NTOK) ? row + nw : row;
      const float4* ps = (const float4*)(src + (size_t)nr * 1024);
#pragma unroll
      for (int j = 0; j < 4; ++j) nx[j] = ps[lane + 64 * j]; }
    float s = 0.f;
#pragma unroll
    for (int j = 0; j < 4; ++j) s += v[j].x + v[j].y + v[j].z + v[j].w;
    float mu = wave_sum(s) * (1.f / 1024.f);
    float q = 0.f;
#pragma unroll
    for (int j = 0; j < 4; ++j) { v[j].x -= mu; v[j].y -= mu; v[j].z -= mu; v[j].w -= mu; q += v[j].x * v[j].x + v[j].y * v[j].y + v[j].z * v[j].z + v[j].w * v[j].w; }
    float rstd = rsqrtf(wave_sum(q) * (1.f / 1024.f) + EPS);
    float4* pd = (float4*)(dst + (size_t)row * 1024);
    s = 0.f;
#pragma unroll
    for (int j = 0; j < 4; ++j) {
      const int col = (lane + 64 * j) * 4;
      const float4 g4 = *(const float4*)(pg + col), b4 = *(const float4*)(pb + col);
      v[j].x = v[j].x * rstd * g4.x + b4.x; v[j].y = v[j].y * rstd * g4.y + b4.y; v[j].z = v[j].z * rstd * g4.z + b4.z; v[j].w = v[j].w * rstd * g4.w + b4.w;
      pd[lane + 64 * j] = v[j];
      s += v[j].x + v[j].y + v[j].z + v[j].w;
    }
    if (m1) {
      mu = wave_sum(s) * (1.f / 1024.f);
      q = 0.f;
#pragma unroll
      for (int j = 0; j < 4; ++j) { v[j].x -= mu; v[j].y -= mu; v[j].z -= mu; v[j].w -= mu; q += v[j].x * v[j].x + v[j].y * v[j].y + v[j].z * v[j].z + v[j].w * v[j].w; }
      rstd = rsqrtf(wave_sum(q) * (1.f / 1024.f) + EPS);
      const float* md = mod17 + (size_t)(row >> 11) * 3072;
      bf16_t* pm = m1 + (size_t)row * 1024;
#pragma unroll
      for (int j = 0; j < 4; ++j) {
        const int col = (lane + 64 * j) * 4;
        const float4 sh = *(const float4*)(md + col), sc = *(const float4*)(md + 1024 + col);
        st_bf4(pm + col, v[j].x * rstd * (1.f + sc.x) + sh.x, v[j].y * rstd * (1.f + sc.y) + sh.y, v[j].z * rstd * (1.f + sc.z) + sh.z, v[j].w * rstd * (1.f + sc.w) + sh.w);
      }
    }
  }
}

__device__ __forceinline__ void out_proj(const bf16_t* A, const bf16_t* WT, const float* resid, const float* gate17, float* dst, char* smem) {
  const int lb = logical_block();
  for (int u = lb; u < 512; u += gridDim.x) {
    const int mt = u >> 2, nt = u & 3;
    f32x16 acc[2][4];
    gemm2(mkPlain(A + (size_t)mt * 256 * 2048, 2048), mkPlain(WT + (size_t)nt * 256 * 2048, 2048), 32, smem, acc);
    const float* gt = gate17 + (size_t)(mt >> 3) * 3072 + 2048 + nt * 256;
    epi2_foreach(acc, [&](int row, int col, float a, float b, float c, float d) {
      const size_t idx = (size_t)(mt * 256 + row) * 1024 + nt * 256 + col;
      const float4 xr = *(const float4*)(resid + idx); const float4 g4 = *(const float4*)(gt + col);
      float4 o; o.x = ALPHA * xr.x + g4.x * a; o.y = ALPHA * xr.y + g4.y * b; o.z = ALPHA * xr.z + g4.z * c; o.w = ALPHA * xr.w + g4.w * d;
      *(float4*)(dst + idx) = o;
    });
  }
}

#define XB_TMO      128
#define XB_XCNT(j)  (256  + 64 * (j))
#define XB_XSUB(j)  (1280 + 64 * (j))
#define XB_XGEN(j)  (2304 + 64 * (j))
#define XB_TOP      3328
#define XB_TOPGEN   3392
#define XCD_BAR_WORDS 3456
#define XB_SPIN_CAP (1u << 18)
#define LAS __attribute__((address_space(3)))

__device__ __forceinline__ unsigned xb_ld(unsigned* p)              { return __hip_atomic_load(p, __ATOMIC_RELAXED, __HIP_MEMORY_SCOPE_AGENT); }
__device__ __forceinline__ unsigned xb_add(unsigned* p, unsigned v) { return __hip_atomic_fetch_add(p, v, __ATOMIC_RELAXED, __HIP_MEMORY_SCOPE_AGENT); }
__device__ __forceinline__ unsigned xb_xcc_id() { return (unsigned)__builtin_amdgcn_s_getreg((3 << 11) | 20) & 0xFu; }
#define XB_SPIN(cond, bar) do { unsigned _sp = 0; while (cond) { __builtin_amdgcn_s_sleep(1); \
    if ((++_sp & 255u) == 0u) { if (xb_ld(&(bar)[XB_TMO])) break; if (_sp > XB_SPIN_CAP) { atomicAdd(&(bar)[XB_TMO], 1u); break; } } } } while (0)

struct XcdBarrier {
    unsigned* bar; unsigned x;
    volatile LAS unsigned* st;
};

__device__ __forceinline__ XcdBarrier xcd_barrier_post(unsigned* bar, volatile LAS unsigned* st) {
    XcdBarrier b; b.bar = bar; b.x = xb_xcc_id(); b.st = st;
    if (threadIdx.x == 0) (void)xb_add(&bar[XB_XCNT(b.x)], 1u);
    return b;
}
__device__ __forceinline__ void xcd_barrier_complete(unsigned* bar, unsigned x, unsigned& nloc, unsigned& nx) {
    const unsigned G = gridDim.x * gridDim.y * gridDim.z;
    unsigned sum, cnt, mine, sp = 0u;
    for (;;) {
        sum = 0u; cnt = 0u; mine = 0u;
#pragma unroll
        for (unsigned j = 0; j < 16; ++j) { const unsigned c = xb_ld(&bar[XB_XCNT(j)]); sum += c; cnt += (c > 0u) ? 1u : 0u; mine = (j == x) ? c : mine; }
        if (sum == G) break;
        __builtin_amdgcn_s_sleep(1);
        if ((++sp & 255u) == 0u) { if (xb_ld(&bar[XB_TMO])) break; if (sp > XB_SPIN_CAP) { atomicAdd(&bar[XB_TMO], 1u); break; } }
    }
    nloc = mine > 0u ? mine : 1u; nx = cnt > 0u ? cnt : 1u;
}

__device__ __forceinline__ void xcd_barrier(const XcdBarrier& b) {
    asm volatile("s_waitcnt vmcnt(0)" ::: "memory");
    __syncthreads();
    if (threadIdx.x == 0) {
        unsigned* bar = b.bar;
        __builtin_amdgcn_s_waitcnt(0);
        unsigned nloc = b.st[0], nx = b.st[1];
        if (nloc == 0u) { xcd_barrier_complete(bar, b.x, nloc, nx); b.st[0] = nloc; b.st[1] = nx; }
        const unsigned old = xb_add(&bar[XB_XSUB(b.x)], 1u);
        const unsigned gen = old / nloc;
        if (old + 1u == (gen + 1u) * nloc) {
            __builtin_amdgcn_fence(__ATOMIC_RELEASE, "agent");
            asm volatile("s_waitcnt vmcnt(0)" ::: "memory");
            const unsigned og = xb_add(&bar[XB_TOP], 1u);
            const unsigned tg = og / nx;
            if (og + 1u == (tg + 1u) * nx) xb_add(&bar[XB_TOPGEN], 1u);
            else XB_SPIN(xb_ld(&bar[XB_TOPGEN]) == tg, bar);
            __builtin_amdgcn_fence(__ATOMIC_ACQUIRE, "agent");
            xb_add(&bar[XB_XGEN(b.x)], 1u);
            asm volatile("s_waitcnt vmcnt(0)" ::: "memory");
        } else {
            XB_SPIN(xb_ld(&bar[XB_XGEN(b.x)]) == gen, bar);
            __builtin_amdgcn_fence(__ATOMIC_ACQUIRE, "agent");
            asm volatile("s_waitcnt vmcnt(0)" ::: "memory");
        }
    }
    __syncthreads();
}


constexpr size_t OFF_XBAR = OFF_SMALL + 1536 * 1024;
constexpr size_t OFF_PX = OFF_SMALL + 1152 * 1024;
#define GSYNC_CG() do { __threadfence(); grid.sync(); __threadfence(); } while (0)
#define GSYNC() xcd_barrier(xbar)
#ifndef LAUNCH_SPLITS
#define LAUNCH_SPLITS {{0,0},{1,1},{2,2},{3,3},{4,4},{5,5},{6,6},{7,7},{8,8},{9,9},{10,10}}
#endif
template <int PLO, int PHI>
__global__ void __launch_bounds__(512) mega(Params p) {
  cg::grid_group grid = cg::this_grid();
  __shared__ __attribute__((aligned(16))) char smem[SMEM_BYTES];
  char* ws = p.ws;
  float* MOD = (float*)(ws + OFF_MOD);
  const int lb = logical_block();
  volatile LAS unsigned* xst = (volatile LAS unsigned*)(smem + LDS_RED + 2048);
  if (tid_fresh() < 4) xst[tid_fresh()] = 0u;
  __syncthreads();
  XcdBarrier xbar = xcd_barrier_post((unsigned*)(ws + OFF_XBAR), xst);
  if (PLO < PHI) grid.sync();

  if (PLO <= 0 && 0 <= PHI) {
  phase0(p, smem);
  }
  if (PLO <= 0 && 0 < PHI) { GSYNC(); }
  if (PLO <= 1 && 1 <= PHI) {

  ln_rows_modulate(p.x, (bf16_t*)(ws + OFF_M0), NTOK, SEQ, MOD, -1);
  ln_rows_modulate(p.ctx, (bf16_t*)(ws + OFF_MC), NCTX, CTXL, MOD, 16);
  }
  if (PLO <= 1 && 1 < PHI) { GSYNC(); }
  if (PLO <= 2 && 2 <= PHI) {

  phase2(p, smem);
  }
  if (PLO <= 2 && 2 < PHI) { GSYNC(); }
  if (PLO <= 3 && 3 <= PHI) {

  for (int u = lb; u < 1024; u += gridDim.x) {
      const int grp = u >> 5, j = u & 31, b = grp >> 1, kvh = grp & 1, hq = kvh * 4 + (j >> 3), qb = j & 7;
      const bf16_t* Qb = (const bf16_t*)(ws + OFF_Q) + ((size_t)(b * SEQ + qb * 256) * 8 + hq) * 128;
      const bf16_t* Kh = (const bf16_t*)(ws + OFF_KALL) + ((size_t)b * SKV * 2 + kvh) * 128;
      const bf16_t* Vh = (const bf16_t*)(ws + OFF_VALL) + ((size_t)b * SKV * 2 + kvh) * 128;
      bf16_t* GO = (bf16_t*)(ws + OFF_SG) + (size_t)(b * SEQ + qb * 256) * 2048 + hq * 128;
      att::attn_body(Qb, Kh, Vh, GO, SKV, smem);
  }
  for (int v = lb; v < 256; v += gridDim.x) chunk_gate_unit(p, v >> 4, v & 15, smem);
  }
  if (PLO <= 3 && 3 < PHI) { GSYNC(); }
  if (PLO <= 4 && 4 <= PHI) {

  out_proj((const bf16_t*)(ws + OFF_SG), (const bf16_t*)(ws + OFF_WT_EOUT), p.x, MOD, (float*)(ws + OFF_Q), smem);
  }
  if (PLO <= 4 && 4 < PHI) { GSYNC(); }
  if (PLO <= 5 && 5 <= PHI) {

  post_ln_rows((const float*)(ws + OFF_Q), (float*)(ws + OFF_Q), p.post_g, p.post_b, (bf16_t*)(ws + OFF_M0), MOD + 17 * 3072);
  }
  if (PLO <= 5 && 5 < PHI) { GSYNC(); }
  if (PLO <= 6 && 6 <= PHI) {

  {
    const bf16_t* M1 = (const bf16_t*)(ws + OFF_M0); const bf16_t* WT = (const bf16_t*)(ws + OFF_WT_OIN);
    bf16_t* F = (bf16_t*)(ws + OFF_F); bf16_t* RV = (bf16_t*)(ws + OFF_RV); bf16_t* XM = (bf16_t*)(ws + OFF_XM);
    bf16_t* SG1 = (bf16_t*)(ws + OFF_SG);
    for (int u = lb; u < 2048; u += gridDim.x) {
      f32x16 acc[2][4];
      if (u < 1024) {
        const int tt = u >> 3, ct = u & 7, b = tt >> 3, t0 = (tt & 7) * 256;
        gemm2(mkPlain(WT + (size_t)ct * 256 * 1024, 1024), mkPlain(M1 + (size_t)tt * 256 * 1024, 1024), 16, smem, acc);
        epi2_foreach(acc, [&](int row, int col, float a, float bq, float c, float d) {
          const int ch = ct * 256 + row, t = t0 + col;
          const size_t base = ((size_t)b * 2048 + ch) * 1024;
          if (t < 1024) {
            st_bf4(F + base + t, a, bq, c, d);
            if (t == 0) RV[base] = 0;
          } else if (t == 1024) {
            XM[(size_t)b * 2048 + ch] = f2bf(a);
            RV[base + 1023] = f2bf(bq); RV[base + 1022] = f2bf(c); RV[base + 1021] = f2bf(d);
          } else {
            RV[base + 2048 - t] = f2bf(a); RV[base + 2047 - t] = f2bf(bq); RV[base + 2046 - t] = f2bf(c); RV[base + 2045 - t] = f2bf(d);
          }
        });
      } else {
        const int v = u - 1024, mt = v >> 3, nt = v & 7;
        gemm2(mkPlain(M1 + (size_t)mt * 256 * 1024, 1024), mkPlain(WT + (size_t)(2048 + nt * 256) * 1024, 1024), 16, smem, acc);
        epi2_foreach(acc, [&](int row, int col, float a, float bq, float c, float d) {
          st_bf4(SG1 + (size_t)(mt * 256 + row) * 2048 + nt * 256 + col, silu_f(a), silu_f(bq), silu_f(c), silu_f(d));
        });
      }
    }
  }
  }
  if (PLO <= 6 && 6 < PHI) { GSYNC(); }
  if (PLO <= 7 && 7 <= PHI) {

  {
    {
      const int tid = tid_fresh(), wid = tid >> 6, lane = tid & 63;
      const int gw = blockIdx.x * 8 + wid, nw = gridDim.x * 8;
      const bf16_t* XMr = (const bf16_t*)(ws + OFF_XM); float* PX = (float*)(ws + OFF_PX);
      u32x4 na0, na1, nb0, nb1;
      { const size_t ro = (size_t)gw * 128; const u32x4* Fr = (const u32x4*)(ws + OFF_F) + ro; const u32x4* Rr = (const u32x4*)(ws + OFF_RV) + ro;
        na0 = Fr[lane]; na1 = Fr[lane + 64]; nb0 = Rr[lane]; nb1 = Rr[lane + 64]; }
      for (int row = gw; row < 16 * 2048; row += nw) {
        const u32x4 a0 = na0, a1 = na1, b0 = nb0, b1 = nb1;
        { const int nr = (row + nw < 16 * 2048) ? row + nw : row; const size_t ro = (size_t)nr * 128;
          const u32x4* Fr = (const u32x4*)(ws + OFF_F) + ro; const u32x4* Rr = (const u32x4*)(ws + OFF_RV) + ro;
          na0 = Fr[lane]; na1 = Fr[lane + 64]; nb0 = Rr[lane]; nb1 = Rr[lane + 64]; }
        u32x4 e0, e1, o0, o1; float alt = 0.f;
#pragma unroll
        for (int k = 0; k < 4; ++k) {
          { const float al = bf_lo(a0[k]), ah = bf_hi(a0[k]), bl = bf_lo(b0[k]), bh = bf_hi(b0[k]);
            e0[k] = cvtpk(al + bl, ah + bh); o0[k] = cvtpk(al - bl, ah - bh); alt += (al + bl) - (ah + bh); }
          { const float al = bf_lo(a1[k]), ah = bf_hi(a1[k]), bl = bf_lo(b1[k]), bh = bf_hi(b1[k]);
            e1[k] = cvtpk(al + bl, ah + bh); o1[k] = cvtpk(al - bl, ah - bh); alt += (al + bl) - (ah + bh); }
        }
        u32x4* Fw = (u32x4*)(ws + OFF_F) + (size_t)row * 128; u32x4* Rw = (u32x4*)(ws + OFF_RV) + (size_t)row * 128;
        Fw[lane] = e0; Fw[lane + 64] = e1; Rw[lane] = o0; Rw[lane + 64] = o1;
        alt = wave_sum(alt);
        if (lane == 0) PX[row] = alt + bf2f(XMr[row]);
      }
    }
    if (PLO < PHI) { GSYNC(); }
    const bf16_t* F = (const bf16_t*)(ws + OFF_F); const bf16_t* RV = (const bf16_t*)(ws + OFF_RV); const bf16_t* XM = (const bf16_t*)(ws + OFF_XM);
    const bf16_t* TC = (const bf16_t*)(ws + OFF_TAB_C); const bf16_t* TS = (const bf16_t*)(ws + OFF_TAB_S);
    bf16_t* PC = (bf16_t*)p.out; bf16_t* PS = (bf16_t*)(ws + OFF_M0);
    for (int u = lb; u < 1024; u += gridDim.x) {
      f32x16 acc[2][4];
      const int v = u & 511, b = v >> 5, mt = (v & 31) >> 3, nt = v & 7;
      const size_t bo = ((size_t)b * 2048 + nt * 256) * 1024;
      if (u < 512) {
        gemm2(mkPlain(TC + (size_t)mt * 256 * 1024, 1024), mkPlain(F + bo, 1024), 16, smem, acc);
        epi2_foreach(acc, [&](int row, int col, float a, float bq, float c, float d) {
          const int tp = mt * 256 + row, ch = nt * 256 + col;
          const u32x2 xm = *(const u32x2*)(XM + (size_t)b * 2048 + ch);
          const float sg = (tp & 1) ? -1.f : 1.f;
          a += sg * bf_lo(xm[0]); bq += sg * bf_hi(xm[0]); c += sg * bf_lo(xm[1]); d += sg * bf_hi(xm[1]);
          st_bf4(PC + ((size_t)b * 1024 + tp) * 2048 + ch, a, bq, c, d);
        });
      } else {
        gemm2(mkPlain(TS + (size_t)mt * 256 * 1024, 1024), mkPlain(RV + bo, 1024), 16, smem, acc);
        epi2_foreach(acc, [&](int row, int col, float a, float bq, float c, float d) {
          st_bf4(PS + ((size_t)b * 1024 + mt * 256 + row) * 2048 + nt * 256 + col, a, bq, c, d);
        });
      }
    }
  }
  }
  if (PLO <= 7 && 7 < PHI) { GSYNC(); }
  if (PLO <= 8 && 8 <= PHI) {

  {
    const bf16_t* PC = (const bf16_t*)p.out; const bf16_t* PS = (const bf16_t*)(ws + OFF_M0);
    const bf16_t* CDP = (const bf16_t*)(ws + OFF_CDP);
    bf16_t* SG1 = (bf16_t*)(ws + OFF_SG);
    const int tid = tid_fresh(), wid = tid >> 6, lane = tid & 63, r32 = lane & 31, hi = lane >> 5, wm = wid >> 1, wn = wid & 1;
    constexpr int TBS = 528;
    constexpr int TB_BYTES = 128 * TBS;
    char* sT = smem; char* sA = smem + TB_BYTES;
#pragma unroll
    for (int i = 0; i < 8; ++i) {
      const int id = tid + 512 * i, row = id >> 5, ck = id & 31;
      *(u32x4*)(sT + row * TBS + ck * 16) = *(const u32x4*)(CDP + row * 256 + ck * 8);
    }
    const int st_off = (tid >> 3) * LDS_ROWB + (tid & 7) * 16;
    const int a_rd = (wm * 64 + r32) * LDS_ROWB + hi * 16;
    const int b_rd = (wn * 32 + r32) * TBS + hi * 16;
    const size_t rowoff = (size_t)(tid >> 3) * 2048 + (tid & 7) * 8;
    u32x4 r00, r01, r02, r03, r10, r11, r12, r13, r20, r21, r22, r23, r30, r31, r32_, r33;
    auto a_base = [&](int u_, int s_) -> const bf16_t* {
      const int b_ = u_ >> 6, j_ = (u_ >> 4) & 3, G_ = u_ & 15;
      return ((s_ < 2) ? PC : PS) + ((size_t)b_ * 1024 + j_ * 256) * 2048 + G_ * 128 + (s_ & 1) * 64 + rowoff;
    };
#define P8_LOAD(S, U, A, B, C, D) do { const bf16_t* q_ = a_base((U), (S)); A = *(const u32x4*)(q_); B = *(const u32x4*)(q_ + (size_t)64 * 2048); \
      C = *(const u32x4*)(q_ + (size_t)128 * 2048); D = *(const u32x4*)(q_ + (size_t)192 * 2048); } while (0)
#define P8_WRITE(ST, A, B, C, D) do { char* s_ = sA + (ST) * L2_A + st_off; *(u32x4*)(s_) = A; *(u32x4*)(s_ + 64 * LDS_ROWB) = B; \
      *(u32x4*)(s_ + 128 * LDS_ROWB) = C; *(u32x4*)(s_ + 192 * LDS_ROWB) = D; } while (0)
#define P8_COMPUTE(ST, S, ACC) do { const char* sb_ = sA + (ST) * L2_A;                                              \
      _Pragma("unroll") for (int kk = 0; kk < 4; ++kk) {                                                               \
        const bf16x8 fa0 = *(const bf16x8*)(sb_ + a_rd + kk * 32);                                                      \
        const bf16x8 fa1 = *(const bf16x8*)(sb_ + a_rd + 32 * LDS_ROWB + kk * 32);                                      \
        const bf16x8 fb0 = *(const bf16x8*)(sT + b_rd + ((S) * 64 + kk * 16) * 2);                                      \
        const bf16x8 fb1 = *(const bf16x8*)(sT + b_rd + 64 * TBS + ((S) * 64 + kk * 16) * 2);                           \
        ACC[0][0] = __builtin_amdgcn_mfma_f32_32x32x16_bf16(fb0, fa0, ACC[0][0], 0, 0, 0);                              \
        ACC[0][1] = __builtin_amdgcn_mfma_f32_32x32x16_bf16(fb1, fa0, ACC[0][1], 0, 0, 0);                              \
        ACC[1][0] = __builtin_amdgcn_mfma_f32_32x32x16_bf16(fb0, fa1, ACC[1][0], 0, 0, 0);                              \
        ACC[1][1] = __builtin_amdgcn_mfma_f32_32x32x16_bf16(fb1, fa1, ACC[1][1], 0, 0, 0);                              \
      } } while (0)
    P8_LOAD(0, lb, r00, r01, r02, r03); P8_LOAD(1, lb, r10, r11, r12, r13); P8_LOAD(2, lb, r20, r21, r22, r23); P8_LOAD(3, lb, r30, r31, r32_, r33);
    for (int u = lb; u < 1024; u += gridDim.x) {
      const int un = (u + (int)gridDim.x < 1024) ? u + (int)gridDim.x : u;
      f32x16 acc1[2][2], acc2[2][2];
#pragma unroll
      for (int mi = 0; mi < 2; ++mi)
#pragma unroll
        for (int nj = 0; nj < 2; ++nj)
#pragma unroll
          for (int r = 0; r < 16; ++r) { acc1[mi][nj][r] = 0.f; acc2[mi][nj][r] = 0.f; }
      P8_WRITE(0, r00, r01, r02, r03); __syncthreads(); P8_LOAD(0, un, r00, r01, r02, r03); P8_COMPUTE(0, 0, acc1);
      P8_WRITE(1, r10, r11, r12, r13); __syncthreads(); P8_LOAD(1, un, r10, r11, r12, r13); P8_COMPUTE(1, 1, acc1);
      P8_WRITE(0, r20, r21, r22, r23); __syncthreads(); P8_LOAD(2, un, r20, r21, r22, r23); P8_COMPUTE(0, 2, acc2);
      P8_WRITE(1, r30, r31, r32_, r33); __syncthreads(); P8_LOAD(3, un, r30, r31, r32_, r33); P8_COMPUTE(1, 3, acc2);
      const int b = u >> 6, j = (u >> 4) & 3, G = u & 15;
      const float sc = 1.f / 512.f;
#pragma unroll
      for (int mi = 0; mi < 2; ++mi) {
        const int tp = j * 256 + wm * 64 + mi * 32 + r32;
#pragma unroll
        for (int nj = 0; nj < 2; ++nj)
#pragma unroll
          for (int q = 0; q < 4; ++q) {
            const int col = G * 128 + nj * 64 + wn * 32 + q * 8 + hi * 4;
            const float p0 = acc1[mi][nj][4 * q + 0], p1 = acc1[mi][nj][4 * q + 1], p2 = acc1[mi][nj][4 * q + 2], p3 = acc1[mi][nj][4 * q + 3];
            const float m0 = acc2[mi][nj][4 * q + 0], m1 = acc2[mi][nj][4 * q + 1], m2 = acc2[mi][nj][4 * q + 2], m3 = acc2[mi][nj][4 * q + 3];
            { bf16_t* gp = SG1 + ((size_t)b * 2048 + tp) * 2048 + col; const u32x2 sg = *(const u32x2*)gp;
              st_bf4(gp, (p0 - m0) * sc * bf_lo(sg[0]), (p1 - m1) * sc * bf_hi(sg[0]), (p2 - m2) * sc * bf_lo(sg[1]), (p3 - m3) * sc * bf_hi(sg[1])); }
            if (tp >= 1) { bf16_t* gp = SG1 + ((size_t)b * 2048 + (2048 - tp)) * 2048 + col; const u32x2 sg = *(const u32x2*)gp;
              st_bf4(gp, (p0 + m0) * sc * bf_lo(sg[0]), (p1 + m1) * sc * bf_hi(sg[0]), (p2 + m2) * sc * bf_lo(sg[1]), (p3 + m3) * sc * bf_hi(sg[1])); }
          }
      }
    }
#undef P8_LOAD
#undef P8_WRITE
#undef P8_COMPUTE
    {
      const float* PX = (const float*)(ws + OFF_PX);
      for (int i = blockIdx.x; i < 256; i += gridDim.x) {
        if (tid < 128) {
          const int b = i >> 4, G = i & 15;
          const float* px = PX + (size_t)b * 2048 + G * 128;
          float y = 0.f;
          for (int c = 0; c < 128; ++c) y += px[c] * bf2f(*(const bf16_t*)(sT + tid * TBS + c * 2));
          bf16_t* gp = SG1 + ((size_t)b * 2048 + 1024) * 2048 + G * 128 + tid;
          *gp = f2bf(y * (1.f / 512.f) * bf2f(*gp));
        }
      }
    }
  }
  }
  if (PLO <= 8 && 8 < PHI) { GSYNC(); }
  if (PLO <= 9 && 9 <= PHI) {

  out_proj((const bf16_t*)(ws + OFF_SG), (const bf16_t*)(ws + OFF_WT_OOUT), (const float*)(ws + OFF_Q), MOD + 17 * 3072, p.out, smem);
  }
  if (PLO <= 9 && 9 < PHI) { GSYNC(); }
  if (PLO <= 10 && 10 <= PHI) {

  post_ln_rows(p.out, p.out, p.post_g + 1024, p.post_b + 1024, nullptr, nullptr);
  }
}

extern "C" void kernel_launch(void* const* d_in, const int* in_sizes, int n_in, void* d_out, int out_size, void* d_ws, size_t ws_size,
                              hipStream_t stream) {
  static int grid_blocks = 0;
  if (!grid_blocks) {
    int dev = 0, cus = 0, per_cu = 0;
    hipGetDevice(&dev);
    hipDeviceGetAttribute(&cus, hipDeviceAttributeMultiprocessorCount, dev);
    hipOccupancyMaxActiveBlocksPerMultiprocessor(&per_cu, mega<0, 10>, 512, 0);
    if (per_cu > 1) per_cu = 1;
    grid_blocks = cus * per_cu;
    if (n_in != 18 || ws_size < WS_NEED) fprintf(stderr, "kernel_launch: unexpected n_in %d or ws_size %zu (need %zu)\n", n_in, ws_size, (size_t)WS_NEED);
  }
  Params p{};
  p.x = (const float*)d_in[0]; p.c = (const float*)d_in[1]; p.ctx = (const float*)d_in[2]; p.c_ctx = (const float*)d_in[3];
  p.w_mod = (const float*)d_in[4]; p.b_mod = (const float*)d_in[5]; p.post_g = (const float*)d_in[6]; p.post_b = (const float*)d_in[7];
  p.e_w_in = (const float*)d_in[8]; p.e_qn = (const float*)d_in[9]; p.e_kn = (const float*)d_in[10]; p.e_vg = (const float*)d_in[11];
  p.e_vb = (const float*)d_in[12]; p.e_ws = (const float*)d_in[13]; p.e_bs = (const float*)d_in[14]; p.e_w_out = (const float*)d_in[15];
  p.o_w_in = (const float*)d_in[16]; p.o_w_out = (const float*)d_in[17];
  p.out = (float*)d_out; p.ws = (char*)d_ws;
#define ONE_LAUNCH 1
#ifdef ONE_LAUNCH
  hipMemsetAsync((char*)d_ws + OFF_XBAR, 0, XCD_BAR_WORDS * 4, stream);
  { void* args[] = {&p};
    hipError_t e = hipLaunchCooperativeKernel((void*)mega<0, 10>, dim3(grid_blocks), dim3(512), args, 0, stream);
    if (e != hipSuccess) fprintf(stderr, "cooperative launch failed: %s (grid %d)\n", hipGetErrorString(e), grid_blocks); }
#else
  hipLaunchKernelGGL((mega<0, 0>), dim3(grid_blocks), dim3(512), 0, stream, p);
  hipLaunchKernelGGL((mega<1, 1>), dim3(grid_blocks), dim3(512), 0, stream, p);
  hipLaunchKernelGGL((mega<2, 2>), dim3(grid_blocks), dim3(512), 0, stream, p);
  hipLaunchKernelGGL((mega<3, 3>), dim3(grid_blocks), dim3(512), 0, stream, p);
  hipLaunchKernelGGL((mega<4, 4>), dim3(grid_blocks), dim3(512), 0, stream, p);
  hipLaunchKernelGGL((mega<5, 5>), dim3(grid_blocks), dim3(512), 0, stream, p);
  hipLaunchKernelGGL((mega<6, 6>), dim3(grid_blocks), dim3(512), 0, stream, p);
  hipLaunchKernelGGL((mega<7, 7>), dim3(grid_blocks), dim3(512), 0, stream, p);
  hipLaunchKernelGGL((mega<8, 8>), dim3(grid_blocks), dim3(512), 0, stream, p);
  hipLaunchKernelGGL((mega<9, 9>), dim3(grid_blocks), dim3(512), 0, stream, p);
  hipLaunchKernelGGL((mega<10, 10>), dim3(grid_blocks), dim3(512), 0, stream, p);
#endif
}
```

```cpp
#include <hip/hip_runtime.h>
#include <hip/hip_cooperative_groups.h>
#include <cstdio>
#include <cstdint>
namespace cg = cooperative_groups;

typedef unsigned short bf16_t;
using bf16x8 = __attribute__((ext_vector_type(8))) short;
using s16x4  = __attribute__((ext_vector_type(4))) short;
using f32x16 = __attribute__((ext_vector_type(16))) float;
using u32x4  = __attribute__((ext_vector_type(4))) unsigned;
using u32x2  = __attribute__((ext_vector_type(2))) unsigned;

constexpr int DM = 1024, NB = 16, SEQ = 2048, CTXL = 256, SKV = SEQ + CTXL;
constexpr int NTOK = NB * SEQ;
constexpr int NCTX = NB * CTXL;
constexpr int EVEN_IN = 5632, ODD_IN = 4096, DIN = 2048;
constexpr float ALPHA = 1.4142135623730951f;
constexpr float EPS = 1e-6f;

constexpr size_t MiB = 1ull << 20;
constexpr size_t OFF_WT_EIN = 0, OFF_WT_EOUT = 11 * MiB, OFF_WT_OIN = 15 * MiB, OFF_WT_OOUT = 23 * MiB;
constexpr size_t OFF_TAB_C = 27 * MiB, OFF_TAB_S = 30 * MiB, OFF_SMALL = 33 * MiB;
constexpr size_t OFF_CDM = OFF_SMALL, OFF_CDP = OFF_SMALL + 64 * 1024, OFF_WSB = OFF_SMALL + 128 * 1024;
constexpr size_t OFF_ROPE = OFF_SMALL + 384 * 1024, OFF_MOD = OFF_SMALL + 512 * 1024, OFF_XM = OFF_SMALL + 1024 * 1024;
constexpr size_t OFF_M0 = 36 * MiB, OFF_MC = 100 * MiB;
constexpr size_t OFF_SG = 108 * MiB;
constexpr size_t OFF_Q = 236 * MiB, OFF_BU = 300 * MiB;
constexpr size_t OFF_KALL = 364 * MiB, OFF_VALL = 382 * MiB, OFF_BV = 400 * MiB;
constexpr size_t OFF_F = 364 * MiB, OFF_RV = 428 * MiB;
constexpr size_t OFF_YG = 364 * MiB;
constexpr size_t WS_NEED = 492 * MiB;

struct Params {
  const float *x, *c, *ctx, *c_ctx, *w_mod, *b_mod, *post_g, *post_b, *e_w_in, *e_qn, *e_kn, *e_vg, *e_vb, *e_ws, *e_bs,
      *e_w_out, *o_w_in, *o_w_out;
  float* out;
  char* ws;
  long pad_;
};

typedef float f32x2_t __attribute__((ext_vector_type(2)));
typedef __bf16 bf16x2_t __attribute__((ext_vector_type(2)));
__device__ __forceinline__ unsigned cvtpk(float lo, float hi) {
  f32x2_t v = {lo, hi}; bf16x2_t h = __builtin_convertvector(v, bf16x2_t); return __builtin_bit_cast(unsigned, h);
}
__device__ __forceinline__ int tid_fresh() { int t = (int)__builtin_amdgcn_workitem_id_x(); asm volatile("" : "+v"(t)); return t; }
__device__ __forceinline__ float bf_lo(unsigned w) { return __uint_as_float(w << 16); }
__device__ __forceinline__ float bf_hi(unsigned w) { return __uint_as_float(w & 0xffff0000u); }
__device__ __forceinline__ bf16_t f2bf(float x) { return (bf16_t)(cvtpk(x, 0.f) & 0xffffu); }
__device__ __forceinline__ float bf2f(bf16_t h) { return __uint_as_float(((unsigned)h) << 16); }
__device__ __forceinline__ int crow(int r, int hi) { return (r & 3) + 8 * (r >> 2) + 4 * hi; }
__device__ __forceinline__ float wave_sum(float v) {
#pragma unroll
  for (int o = 32; o >= 1; o >>= 1) v += __shfl_xor(v, o);
  return v;
}
__device__ __forceinline__ float silu_f(float x) { return x * __builtin_amdgcn_rcpf(1.f + __expf(-x)); }
__device__ __forceinline__ float gelu_tanh_f(float x) {
  const float u = 0.7978845608028654f * (x + 0.044715f * x * x * x);
  const float t = 1.f - 2.f * __builtin_amdgcn_rcpf(__expf(2.f * u) + 1.f);
  return 0.5f * x * (1.f + t);
}
__device__ __forceinline__ int logical_block() {
  const int g = gridDim.x, b = blockIdx.x;
  return (g & 7) ? b : (b & 7) * (g >> 3) + (b >> 3);
}

constexpr int LDS_ROWB = 144;
constexpr int LDS_A = 256 * LDS_ROWB;
constexpr int LDS_B = 128 * LDS_ROWB;
constexpr int LDS_STAGE = LDS_A + LDS_B;
constexpr int L2_A = 256 * LDS_ROWB;
constexpr int L2_STAGE = 2 * L2_A;
constexpr int LDS_RED = 2 * L2_STAGE;
constexpr int SMEM_BYTES = LDS_RED + 2048 + 2048;

struct LdPlain {
  const bf16_t* p; size_t rs;
  __device__ __forceinline__ u32x4 ld(int kt, int i) const { return *(const u32x4*)(p + (size_t)i * rs + kt * 64); }
};
__device__ __forceinline__ LdPlain mkPlain(const bf16_t* base, int ld) {
  const int tid = tid_fresh();
  LdPlain l; l.p = base + (size_t)(tid >> 3) * ld + (tid & 7) * 8; l.rs = (size_t)64 * ld; return l;
}
struct LdSplit {
  const bf16_t* p0; const bf16_t* p1; size_t rs; int kts;
  __device__ __forceinline__ u32x4 ld(int kt, int i) const {
    const bf16_t* q = (kt < kts) ? (p0 + kt * 64) : (p1 + (kt - kts) * 64);
    return *(const u32x4*)(q + (size_t)i * rs);
  }
};
__device__ __forceinline__ LdSplit mkSplit(const bf16_t* b0, const bf16_t* b1, int ld, int kts) {
  const int tid = tid_fresh(); const size_t o = (size_t)(tid >> 3) * ld + (tid & 7) * 8;
  LdSplit l; l.p0 = b0 + o; l.p1 = b1 + o; l.rs = (size_t)64 * ld; l.kts = kts; return l;
}
struct LdFold {
  const bf16_t* f; const bf16_t* r; size_t rs; float sg;
  __device__ __forceinline__ u32x4 ld(int kt, int i) const {
    const u32x4 a = *(const u32x4*)(f + (size_t)i * rs + kt * 64);
    const u32x4 b = *(const u32x4*)(r + (size_t)i * rs + kt * 64);
    u32x4 o;
    o[0] = cvtpk(bf_lo(a[0]) + sg * bf_lo(b[0]), bf_hi(a[0]) + sg * bf_hi(b[0]));
    o[1] = cvtpk(bf_lo(a[1]) + sg * bf_lo(b[1]), bf_hi(a[1]) + sg * bf_hi(b[1]));
    o[2] = cvtpk(bf_lo(a[2]) + sg * bf_lo(b[2]), bf_hi(a[2]) + sg * bf_hi(b[2]));
    o[3] = cvtpk(bf_lo(a[3]) + sg * bf_lo(b[3]), bf_hi(a[3]) + sg * bf_hi(b[3]));
    return o;
  }
};
__device__ __forceinline__ LdFold mkFold(const bf16_t* f, const bf16_t* r, int ld, float sg) {
  const int tid = tid_fresh(); const size_t o = (size_t)(tid >> 3) * ld + (tid & 7) * 8;
  LdFold l; l.f = f + o; l.r = r + o; l.rs = (size_t)64 * ld; l.sg = sg; return l;
}

template <class LA, class LB>
__device__ __forceinline__ void gemm_mainloop(const LA& la, const LB& lb, int KT, char* smem, f32x16 (&acc)[2][2]) {
  const int tid = tid_fresh(), wid = tid >> 6, lane = tid & 63, r32 = lane & 31, hi = lane >> 5, wm = wid >> 1, wn = wid & 1;
#pragma unroll
  for (int mi = 0; mi < 2; ++mi)
#pragma unroll
    for (int nj = 0; nj < 2; ++nj)
#pragma unroll
      for (int r = 0; r < 16; ++r) acc[mi][nj][r] = 0.f;
  const int st_off = (tid >> 3) * LDS_ROWB + (tid & 7) * 16;
  const int a_rd = (wm * 64 + r32) * LDS_ROWB + hi * 16;
  const int b_rd = LDS_A + (wn * 32 + r32) * LDS_ROWB + hi * 16;
  u32x4 ra0, ra1, ra2, ra3, rb0, rb1;
  ra0 = la.ld(0, 0); ra1 = la.ld(0, 1); ra2 = la.ld(0, 2); ra3 = la.ld(0, 3); rb0 = lb.ld(0, 0); rb1 = lb.ld(0, 1);
  {
    char* s = smem + st_off;
    *(u32x4*)(s) = ra0; *(u32x4*)(s + 64 * LDS_ROWB) = ra1; *(u32x4*)(s + 128 * LDS_ROWB) = ra2; *(u32x4*)(s + 192 * LDS_ROWB) = ra3;
    *(u32x4*)(s + LDS_A) = rb0; *(u32x4*)(s + LDS_A + 64 * LDS_ROWB) = rb1;
  }
  __syncthreads();
#define GEMM_COMPUTE(SB)                                                                              \
  _Pragma("unroll") for (int kk = 0; kk < 4; ++kk) {                                                  \
    const bf16x8 a0 = *(const bf16x8*)((SB) + a_rd + kk * 32);                                        \
    const bf16x8 a1 = *(const bf16x8*)((SB) + a_rd + 32 * LDS_ROWB + kk * 32);                        \
    const bf16x8 b0 = *(const bf16x8*)((SB) + b_rd + kk * 32);                                        \
    const bf16x8 b1 = *(const bf16x8*)((SB) + b_rd + 64 * LDS_ROWB + kk * 32);                        \
    acc[0][0] = __builtin_amdgcn_mfma_f32_32x32x16_bf16(b0, a0, acc[0][0], 0, 0, 0);                  \
    acc[0][1] = __builtin_amdgcn_mfma_f32_32x32x16_bf16(b1, a0, acc[0][1], 0, 0, 0);                  \
    acc[1][0] = __builtin_amdgcn_mfma_f32_32x32x16_bf16(b0, a1, acc[1][0], 0, 0, 0);                  \
    acc[1][1] = __builtin_amdgcn_mfma_f32_32x32x16_bf16(b1, a1, acc[1][1], 0, 0, 0);                  \
  }
#define GEMM_LOAD(KT_) do { ra0 = la.ld((KT_), 0); ra1 = la.ld((KT_), 1); ra2 = la.ld((KT_), 2); ra3 = la.ld((KT_), 3); rb0 = lb.ld((KT_), 0); rb1 = lb.ld((KT_), 1); } while (0)
#define GEMM_WRITE(ST) do { char* s = smem + (ST) * LDS_STAGE + st_off;                                \
    *(u32x4*)(s) = ra0; *(u32x4*)(s + 64 * LDS_ROWB) = ra1; *(u32x4*)(s + 128 * LDS_ROWB) = ra2; *(u32x4*)(s + 192 * LDS_ROWB) = ra3; \
    *(u32x4*)(s + LDS_A) = rb0; *(u32x4*)(s + LDS_A + 64 * LDS_ROWB) = rb1; } while (0)
#pragma unroll 1
  for (int kt = 0; kt < KT; kt += 2) {
    GEMM_LOAD(kt + 1);
    GEMM_COMPUTE(smem);
    GEMM_WRITE(1);
    __syncthreads();
    GEMM_LOAD(kt + 2 < KT ? kt + 2 : kt);
    GEMM_COMPUTE(smem + LDS_STAGE);
    GEMM_WRITE(0);
    __syncthreads();
  }
#undef GEMM_COMPUTE
#undef GEMM_LOAD
#undef GEMM_WRITE
}

template <class LA, class LB>
__device__ __forceinline__ void gemm2(const LA& la, const LB& lb, int KT, char* smem, f32x16 (&acc)[2][4]) {
  const int tid = tid_fresh(), wid = tid >> 6, lane = tid & 63, r32 = lane & 31, hi = lane >> 5, wm = wid >> 1, wn = wid & 1;
#pragma unroll
  for (int mi = 0; mi < 2; ++mi)
#pragma unroll
    for (int nj = 0; nj < 4; ++nj)
#pragma unroll
      for (int r = 0; r < 16; ++r) acc[mi][nj][r] = 0.f;
  const int st_off = (tid >> 3) * LDS_ROWB + (tid & 7) * 16;
  const int a_rd = (wm * 64 + r32) * LDS_ROWB + hi * 16;
  const int b_rd = L2_A + (wn * 128 + r32) * LDS_ROWB + hi * 16;
  u32x4 xa0, xa1, xa2, xa3, xb0, xb1, xb2, xb3, ya0, ya1, ya2, ya3, yb0, yb1, yb2, yb3;
#define G2_LOADX(KT_) do { xa0 = la.ld((KT_), 0); xa1 = la.ld((KT_), 1); xa2 = la.ld((KT_), 2); xa3 = la.ld((KT_), 3); xb0 = lb.ld((KT_), 0); xb1 = lb.ld((KT_), 1); xb2 = lb.ld((KT_), 2); xb3 = lb.ld((KT_), 3); } while (0)
#define G2_LOADY(KT_) do { ya0 = la.ld((KT_), 0); ya1 = la.ld((KT_), 1); ya2 = la.ld((KT_), 2); ya3 = la.ld((KT_), 3); yb0 = lb.ld((KT_), 0); yb1 = lb.ld((KT_), 1); yb2 = lb.ld((KT_), 2); yb3 = lb.ld((KT_), 3); } while (0)
#define G2_W2(ST, P, R0, R1, O0, O1) do { char* s_ = smem + (ST) * L2_STAGE + st_off; *(u32x4*)(s_ + (O0)) = P##R0; *(u32x4*)(s_ + (O1)) = P##R1; } while (0)
#define G2_WRITE(ST, P) do { G2_W2(ST, P, a0, a1, 0, 64 * LDS_ROWB); G2_W2(ST, P, a2, a3, 128 * LDS_ROWB, 192 * LDS_ROWB); \
    G2_W2(ST, P, b0, b1, L2_A, L2_A + 64 * LDS_ROWB); G2_W2(ST, P, b2, b3, L2_A + 128 * LDS_ROWB, L2_A + 192 * LDS_ROWB); } while (0)
#define G2_STEP(SB, kk) do {                                                                          \
    const bf16x8 a0 = *(const bf16x8*)((SB) + a_rd + (kk) * 32);                                      \
    const bf16x8 a1 = *(const bf16x8*)((SB) + a_rd + 32 * LDS_ROWB + (kk) * 32);                      \
    _Pragma("unroll") for (int nj = 0; nj < 4; ++nj) {                                                \
      const bf16x8 b_ = *(const bf16x8*)((SB) + b_rd + nj * 32 * LDS_ROWB + (kk) * 32);               \
      acc[0][nj] = __builtin_amdgcn_mfma_f32_32x32x16_bf16(b_, a0, acc[0][nj], 0, 0, 0);              \
      acc[1][nj] = __builtin_amdgcn_mfma_f32_32x32x16_bf16(b_, a1, acc[1][nj], 0, 0, 0);              \
    } } while (0)
#define G2_COMPUTE_W(SB, ST, P) do {                                                                  \
    G2_STEP(SB, 0); G2_W2(ST, P, a0, a1, 0, 64 * LDS_ROWB);                                           \
    G2_STEP(SB, 1); G2_W2(ST, P, a2, a3, 128 * LDS_ROWB, 192 * LDS_ROWB);                             \
    G2_STEP(SB, 2); G2_W2(ST, P, b0, b1, L2_A, L2_A + 64 * LDS_ROWB);                                 \
    G2_STEP(SB, 3); G2_W2(ST, P, b2, b3, L2_A + 128 * LDS_ROWB, L2_A + 192 * LDS_ROWB); } while (0)
  G2_LOADX(0); G2_LOADY(1);
  G2_WRITE(0, x);
  __syncthreads();
  G2_LOADX(2 < KT ? 2 : 0);
#pragma unroll 1
  for (int kt = 0; kt < KT; kt += 2) {
    G2_COMPUTE_W(smem, 1, y);
    __syncthreads();
    G2_LOADY(kt + 3 < KT ? kt + 3 : KT - 1);
    G2_COMPUTE_W(smem + L2_STAGE, 0, x);
    __syncthreads();
    G2_LOADX(kt + 4 < KT ? kt + 4 : KT - 2);
  }
#undef G2_LOADX
#undef G2_LOADY
#undef G2_WRITE
#undef G2_W2
#undef G2_STEP
#undef G2_COMPUTE_W
}
template <class F>
__device__ __forceinline__ void epi2_foreach(const f32x16 (&acc)[2][4], F&& f) {
  const int tid = tid_fresh(), wid = tid >> 6, lane = tid & 63, r32 = lane & 31, hi = lane >> 5, wm = wid >> 1, wn = wid & 1;
#pragma unroll
  for (int mi = 0; mi < 2; ++mi)
#pragma unroll
    for (int nj = 0; nj < 4; ++nj)
#pragma unroll
      for (int q = 0; q < 4; ++q)
        f(wm * 64 + mi * 32 + r32, wn * 128 + nj * 32 + q * 8 + hi * 4, acc[mi][nj][4 * q + 0], acc[mi][nj][4 * q + 1],
          acc[mi][nj][4 * q + 2], acc[mi][nj][4 * q + 3]);
}

template <class F>
__device__ __forceinline__ void epi_foreach(const f32x16 (&acc)[2][2], F&& f) {
  const int tid = tid_fresh(), wid = tid >> 6, lane = tid & 63, r32 = lane & 31, hi = lane >> 5, wm = wid >> 1, wn = wid & 1;
#pragma unroll
  for (int mi = 0; mi < 2; ++mi)
#pragma unroll
    for (int nj = 0; nj < 2; ++nj)
#pragma unroll
      for (int q = 0; q < 4; ++q)
        f(wm * 64 + mi * 32 + r32, nj * 64 + wn * 32 + q * 8 + hi * 4, acc[mi][nj][4 * q + 0], acc[mi][nj][4 * q + 1],
          acc[mi][nj][4 * q + 2], acc[mi][nj][4 * q + 3]);
}
__device__ __forceinline__ void st_bf4(bf16_t* p, float a, float b, float c, float d) {
  u32x2 w = {cvtpk(a, b), cvtpk(c, d)}; *(u32x2*)p = w;
}

__device__ __forceinline__ void tr_tile(const float* src, bf16_t* dst, int K, int N, int kt, int nt, float* tile) {
  const int tid = tid_fresh(), k0 = kt * 64, n0 = nt * 64;
#pragma unroll
  for (int j = 0; j < 8; ++j) { const int e = j * 512 + tid, r = e >> 6, c = e & 63; tile[r * 65 + c] = src[(size_t)(k0 + r) * N + n0 + c]; }
  __syncthreads();
  const int rn = tid >> 3, ck = (tid & 7) * 8;
  const float v0 = tile[(ck + 0) * 65 + rn], v1 = tile[(ck + 1) * 65 + rn], v2 = tile[(ck + 2) * 65 + rn], v3 = tile[(ck + 3) * 65 + rn];
  const float v4 = tile[(ck + 4) * 65 + rn], v5 = tile[(ck + 5) * 65 + rn], v6 = tile[(ck + 6) * 65 + rn], v7 = tile[(ck + 7) * 65 + rn];
  u32x4 w = {cvtpk(v0, v1), cvtpk(v2, v3), cvtpk(v4, v5), cvtpk(v6, v7)};
  *(u32x4*)(dst + (size_t)(n0 + rn) * K + k0 + ck) = w;
  __syncthreads();
}

__device__ __forceinline__ void phase0(const Params& p, char* smem) {
  const int tid = tid_fresh(), G = gridDim.x, bid = blockIdx.x;
  char* ws = p.ws;
  {
    float* s = (float*)smem;
    float* part = (float*)(smem + 17 * 1024 * 4);
    float* MOD = (float*)(ws + OFF_MOD);
    for (int u = bid; u < 96; u += G) {
      const int l = u / 48, j0 = (u % 48) * 64;
      for (int e = tid; e < 17 * 1024; e += 512) { const int r = e >> 10, k = e & 1023; const float cv = (r < 16) ? p.c[r * 1024 + k] : p.c_ctx[k]; s[e] = silu_f(cv); }
      __syncthreads();
      const int col = tid & 63, ks = tid >> 6;
      float a0 = 0, a1 = 0, a2 = 0, a3 = 0, a4 = 0, a5 = 0, a6 = 0, a7 = 0, a8 = 0, a9 = 0, a10 = 0, a11 = 0, a12 = 0, a13 = 0, a14 = 0, a15 = 0, a16 = 0;
      const float* w = p.w_mod + (size_t)l * 1024 * 3072 + j0 + col;
#pragma unroll 4
      for (int k = ks * 128; k < ks * 128 + 128; ++k) {
        const float wv = w[(size_t)k * 3072];
        a0 += s[0 * 1024 + k] * wv; a1 += s[1 * 1024 + k] * wv; a2 += s[2 * 1024 + k] * wv; a3 += s[3 * 1024 + k] * wv;
        a4 += s[4 * 1024 + k] * wv; a5 += s[5 * 1024 + k] * wv; a6 += s[6 * 1024 + k] * wv; a7 += s[7 * 1024 + k] * wv;
        a8 += s[8 * 1024 + k] * wv; a9 += s[9 * 1024 + k] * wv; a10 += s[10 * 1024 + k] * wv; a11 += s[11 * 1024 + k] * wv;
        a12 += s[12 * 1024 + k] * wv; a13 += s[13 * 1024 + k] * wv; a14 += s[14 * 1024 + k] * wv; a15 += s[15 * 1024 + k] * wv;
        a16 += s[16 * 1024 + k] * wv;
      }
      float* pp = part + ks * 17 * 64 + col;
      pp[0 * 64] = a0; pp[1 * 64] = a1; pp[2 * 64] = a2; pp[3 * 64] = a3; pp[4 * 64] = a4; pp[5 * 64] = a5; pp[6 * 64] = a6; pp[7 * 64] = a7;
      pp[8 * 64] = a8; pp[9 * 64] = a9; pp[10 * 64] = a10; pp[11 * 64] = a11; pp[12 * 64] = a12; pp[13 * 64] = a13; pp[14 * 64] = a14; pp[15 * 64] = a15;
      pp[16 * 64] = a16;
      __syncthreads();
      for (int e = tid; e < 17 * 64; e += 512) {
        const int r = e >> 6, cc = e & 63;
        float t = p.b_mod[l * 3072 + j0 + cc];
#pragma unroll
        for (int q = 0; q < 8; ++q) t += part[q * 17 * 64 + r * 64 + cc];
        MOD[(size_t)(l * 17 + r) * 3072 + j0 + cc] = t;
      }
      __syncthreads();
    }
  }
  {
    float* tile = (float*)smem;
    constexpr int T0 = 16 * 88, T1 = 32 * 16, T2 = 16 * 64, T3 = 32 * 16;
    for (int u = bid; u < T0 + T1 + T2 + T3; u += G) {
      if (u < T0) tr_tile(p.e_w_in, (bf16_t*)(ws + OFF_WT_EIN), 1024, EVEN_IN, u / 88, u % 88, tile);
      else if (u < T0 + T1) { const int v = u - T0; tr_tile(p.e_w_out, (bf16_t*)(ws + OFF_WT_EOUT), 2048, 1024, v / 16, v % 16, tile); }
      else if (u < T0 + T1 + T2) { const int v = u - T0 - T1; tr_tile(p.o_w_in, (bf16_t*)(ws + OFF_WT_OIN), 1024, ODD_IN, v / 64, v % 64, tile); }
      else { const int v = u - T0 - T1 - T2; tr_tile(p.o_w_out, (bf16_t*)(ws + OFF_WT_OOUT), 2048, 1024, v / 16, v % 16, tile); }
    }
  }
  {
    const long gt = (long)bid * 512 + tid, gn = (long)G * 512;
    bf16_t* TC = (bf16_t*)(ws + OFF_TAB_C); bf16_t* TS = (bf16_t*)(ws + OFF_TAB_S);
    for (long e = gt; e < 1280L * 1024; e += gn) {
      const int tp = (int)(e >> 10), t = (int)(e & 1023);
      float v = 0.f;
      if (tp <= 1024) { const int m = (tp * t) & 2047; v = cospif((float)m * (1.f / 1024.f)); }
      TC[e] = f2bf(v);
    }
    for (long e = gt; e < 1024L * 1024; e += gn) {
      const int tp = (int)(e >> 10), t = (int)(e & 1023);
      const int m = (tp * t) & 2047;
      TS[e] = f2bf(sinpif((float)m * (1.f / 1024.f)));
    }
    bf16_t* CDM = (bf16_t*)(ws + OFF_CDM); bf16_t* CDP = (bf16_t*)(ws + OFF_CDP);
    for (long e = gt; e < 128L * 256; e += gn) {
      const int cp = (int)(e >> 8), k = (int)(e & 255);
      const int m = (cp * (k & 127)) & 127;
      const float x = (float)m * (1.f / 64.f);
      float vm, vp;
      if (k < 128) { vm = cospif(x); vp = vm; } else { vp = sinpif(x); vm = -vp; }
      CDM[e] = f2bf(vm); CDP[e] = f2bf(vp);
    }
    bf16_t* WSB = (bf16_t*)(ws + OFF_WSB);
    for (long e = gt; e < 8L * 128 * 128; e += gn) WSB[e] = f2bf(p.e_ws[e]);
    float2* ROPE = (float2*)(ws + OFF_ROPE);
    for (long e = gt; e < 64L * 32; e += gn) {
      const int pos = (int)(e >> 5), i = (int)(e & 31);
      const float inv = powf(10000.f, -(float)i / 32.f);
      const float ang = (float)pos * inv;
      ROPE[e] = make_float2(cosf(ang), sinf(ang));
    }
  }
}

__device__ __forceinline__ void ln_rows_modulate(const float* src, bf16_t* dst, int nrows, int rows_per_b, const float* mod17, int fixed_row) {
  const int tid = tid_fresh(), wid = tid >> 6, lane = tid & 63;
  const int gw = blockIdx.x * 8 + wid, nw = gridDim.x * 8;
  float4 n0, n1, n2, n3;
  { const int r0 = gw < nrows ? gw : 0; const float4* ps = (const float4*)(src + (size_t)r0 * 1024); n0 = ps[lane]; n1 = ps[lane + 64]; n2 = ps[lane + 128]; n3 = ps[lane + 192]; }
  for (int row = gw; row < nrows; row += nw) {
    float4 v0 = n0, v1 = n1, v2 = n2, v3 = n3;
    { const int nr = (row + nw < nrows) ? row + nw : row;
      const float4* ps = (const float4*)(src + (size_t)nr * 1024); n0 = ps[lane]; n1 = ps[lane + 64]; n2 = ps[lane + 128]; n3 = ps[lane + 192]; }
    float s = v0.x + v0.y + v0.z + v0.w + v1.x + v1.y + v1.z + v1.w + v2.x + v2.y + v2.z + v2.w + v3.x + v3.y + v3.z + v3.w;
    const float mu = wave_sum(s) * (1.f / 1024.f);
    v0.x -= mu; v0.y -= mu; v0.z -= mu; v0.w -= mu; v1.x -= mu; v1.y -= mu; v1.z -= mu; v1.w -= mu;
    v2.x -= mu; v2.y -= mu; v2.z -= mu; v2.w -= mu; v3.x -= mu; v3.y -= mu; v3.z -= mu; v3.w -= mu;
    float q = v0.x * v0.x + v0.y * v0.y + v0.z * v0.z + v0.w * v0.w + v1.x * v1.x + v1.y * v1.y + v1.z * v1.z + v1.w * v1.w +
              v2.x * v2.x + v2.y * v2.y + v2.z * v2.z + v2.w * v2.w + v3.x * v3.x + v3.y * v3.y + v3.z * v3.z + v3.w * v3.w;
    const float rstd = rsqrtf(wave_sum(q) * (1.f / 1024.f) + EPS);
    const int mr = (fixed_row >= 0) ? fixed_row : (row / rows_per_b);
    const float* md = mod17 + (size_t)mr * 3072;
    bf16_t* pd = dst + (size_t)row * 1024;
#define MODST(V, J) { const int col = (lane + 64 * J) * 4; const float4 sh = *(const float4*)(md + col); const float4 sc = *(const float4*)(md + 1024 + col); \
      st_bf4(pd + col, V.x * rstd * (1.f + sc.x) + sh.x, V.y * rstd * (1.f + sc.y) + sh.y, V.z * rstd * (1.f + sc.z) + sh.z, V.w * rstd * (1.f + sc.w) + sh.w); }
    MODST(v0, 0) MODST(v1, 1) MODST(v2, 2) MODST(v3, 3)
#undef MODST
  }
}

__device__ __forceinline__ void phase2(const Params& p, char* smem) {
  char* ws = p.ws;
  const bf16_t* M0 = (const bf16_t*)(ws + OFF_M0); const bf16_t* MC = (const bf16_t*)(ws + OFF_MC);
  const bf16_t* WT = (const bf16_t*)(ws + OFF_WT_EIN);
  bf16_t* Q = (bf16_t*)(ws + OFF_Q); bf16_t* KA = (bf16_t*)(ws + OFF_KALL); bf16_t* VA = (bf16_t*)(ws + OFF_VALL);
  bf16_t* BU = (bf16_t*)(ws + OFF_BU); bf16_t* BV = (bf16_t*)(ws + OFF_BV); bf16_t* SG = (bf16_t*)(ws + OFF_SG);
  const float2* ROPE = (const float2*)(ws + OFF_ROPE);
  const int tid = tid_fresh(), wid = tid >> 6, lane = tid & 63, r32 = lane & 31, hi = lane >> 5, wm = wid >> 1, wn = wid & 1;
  const int lb = logical_block();
  for (int u = lb; u < 2816 + 32; u += gridDim.x) {
    const bool isctx = (u >= 2816);
    int mt, nt;
    if (!isctx) { mt = u / 22; nt = u % 22; } else { const int v = u - 2816; mt = v >> 1; nt = 4 + (v & 1); }
    const bf16_t* A = (isctx ? MC : M0) + (size_t)mt * 256 * 1024;
    f32x16 acc[2][4];
    gemm2(mkPlain(A, 1024), mkPlain(WT + (size_t)nt * 256 * 1024, 1024), 16, smem, acc);
    if (nt < 5) {
      const bool isq = nt < 4;
      const int head = isq ? (nt * 2 + wn) : wn;
      const float* gv = isq ? p.e_qn : p.e_kn;
#pragma unroll
      for (int mi = 0; mi < 2; ++mi) {
        float ss = 0.f;
#pragma unroll
        for (int nj = 0; nj < 4; ++nj)
#pragma unroll
          for (int r = 0; r < 16; ++r) ss += acc[mi][nj][r] * acc[mi][nj][r];
        ss += __shfl_xor(ss, 32);
        const float rstd = rsqrtf(ss * (1.f / 128.f) + EPS);
        const int row = wm * 64 + mi * 32 + r32;
        int t = 0; size_t obase;
        if (!isctx) {
          const int b = mt >> 3; t = (mt & 7) * 256 + row;
          if (isq) obase = ((size_t)(b * SEQ + t) * 8 + head) * 128;
          else obase = ((size_t)(b * SKV + CTXL + t) * 2 + head) * 128;
        } else {
          obase = ((size_t)(mt * SKV + row) * 2 + head) * 128;
        }
        bf16_t* dst = (isq ? Q : KA) + obase;
#pragma unroll
        for (int nj = 0; nj < 2; ++nj) {
          const int pos = (nj == 0) ? (t >> 6) : (t & 63);
#pragma unroll
          for (int q = 0; q < 4; ++q) {
            float o1[4], o2[4];
#pragma unroll
            for (int e = 0; e < 4; ++e) {
              const int r = 4 * q + e;
              const int i = 8 * q + 4 * hi + e;
              const int d = nj * 32 + i;
              const float x1 = acc[mi][nj][r] * rstd * gv[d];
              const float x2 = acc[mi][nj + 2][r] * rstd * gv[64 + d];
              if (!isctx) {
                const float2 cs = ROPE[pos * 32 + i];
                o1[e] = x1 * cs.x - x2 * cs.y; o2[e] = x2 * cs.x + x1 * cs.y;
              } else { o1[e] = x1; o2[e] = x2; }
            }
            const int d0 = nj * 32 + 8 * q + 4 * hi;
            st_bf4(dst + d0, o1[0], o1[1], o1[2], o1[3]);
            st_bf4(dst + 64 + d0, o2[0], o2[1], o2[2], o2[3]);
          }
        }
      }
    } else if (nt == 5) {
      epi2_foreach(acc, [&](int row, int col, float a, float b, float c, float d) {
        size_t tokrow;
        if (!isctx) { const int bb = mt >> 3, t = (mt & 7) * 256 + row; tokrow = (size_t)bb * SKV + CTXL + t; } else tokrow = (size_t)mt * SKV + row;
        st_bf4(VA + tokrow * 256 + col, a, b, c, d);
      });
    } else if (nt < 14) {
      bf16_t* dst = (nt < 10) ? (BU + (size_t)(nt - 6) * 256) : (BV + (size_t)(nt - 10) * 256);
      epi2_foreach(acc, [&](int row, int col, float a, float b, float c, float d) {
        st_bf4(dst + (size_t)(mt * 256 + row) * 1024 + col, gelu_tanh_f(a), gelu_tanh_f(b), gelu_tanh_f(c), gelu_tanh_f(d));
      });
    } else {
      bf16_t* dst = SG + (size_t)(nt - 14) * 256;
      epi2_foreach(acc, [&](int row, int col, float a, float b, float c, float d) {
        st_bf4(dst + (size_t)(mt * 256 + row) * 2048 + col, silu_f(a), silu_f(b), silu_f(c), silu_f(d));
      });
    }
  }
}

namespace att {
constexpr int D = 128, NW = 8, QBLK = 32, KVBLK = 64;
constexpr float SCALE = 0.088388347648318440f;
constexpr float THR = 8.f;
constexpr int LDQ = 1024, LDK = 256;
constexpr int SHM_V = KVBLK * D * 2, SHM_K = KVBLK * D * 2;
#define KSWZ(row, colB) ((row) * 256 + ((colB) ^ (((row) & 7) << 4)))
#define SBAR() __builtin_amdgcn_sched_barrier(0)
__device__ __forceinline__ void partialSM(f32x16& p0, f32x16& p1, float& m_reg, float& mn, float& alpha) {
  constexpr float C = SCALE * 1.4426950408889634f;
  float pmax = p0[0];
#pragma unroll
  for (int r = 1; r < 16; ++r) pmax = fmaxf(pmax, p0[r]);
#pragma unroll
  for (int r = 0; r < 16; ++r) pmax = fmaxf(pmax, p1[r]);
  { auto rr = __builtin_amdgcn_permlane32_swap(__float_as_uint(pmax), __float_as_uint(pmax), false, false);
    pmax = fmaxf(__uint_as_float(rr[0]), __uint_as_float(rr[1])); }
  if (__builtin_expect(__all(pmax - m_reg <= THR / SCALE), 1)) { mn = m_reg; alpha = 1.f; }
  else { mn = fmaxf(m_reg, pmax); alpha = __builtin_amdgcn_exp2f((m_reg - mn) * C); m_reg = mn; }
  const float mnC = -mn * C;
#pragma unroll
  for (int r = 0; r < 16; ++r) p0[r] = fmaf(p0[r], C, mnC);
#pragma unroll
  for (int r = 0; r < 16; ++r) p1[r] = fmaf(p1[r], C, mnC);
#pragma unroll
  for (int r = 0; r < 16; ++r) p0[r] = __builtin_amdgcn_exp2f(p0[r]);
}
__device__ __forceinline__ void finishSM(f32x16& p0, f32x16& p1, float alpha, float& l_reg, bf16x8& pa0, bf16x8& pa1, bf16x8& pa2, bf16x8& pa3) {
#pragma unroll
  for (int r = 0; r < 16; ++r) p1[r] = __builtin_amdgcn_exp2f(p1[r]);
  float ps = 0;
#pragma unroll
  for (int r = 0; r < 16; ++r) ps += p0[r];
#pragma unroll
  for (int r = 0; r < 16; ++r) ps += p1[r];
  { auto rr = __builtin_amdgcn_permlane32_swap(__float_as_uint(ps), __float_as_uint(ps), false, false);
    ps = __uint_as_float(rr[0]) + __uint_as_float(rr[1]); }
  l_reg = l_reg * alpha + ps;
#define PK4(P, BASE, OUT) do { unsigned a0 = cvtpk(P[BASE + 0], P[BASE + 1]), a1 = cvtpk(P[BASE + 2], P[BASE + 3]);   \
    unsigned b0 = cvtpk(P[BASE + 4], P[BASE + 5]), b1 = cvtpk(P[BASE + 6], P[BASE + 7]);                              \
    auto r0 = __builtin_amdgcn_permlane32_swap(a0, b0, false, false); auto r1 = __builtin_amdgcn_permlane32_swap(a1, b1, false, false); \
    u32x4 w = {r0[0], r1[0], r0[1], r1[1]}; OUT = *reinterpret_cast<bf16x8*>(&w); } while (0)
  PK4(p0, 0, pa0); PK4(p0, 8, pa1); PK4(p1, 0, pa2); PK4(p1, 8, pa3);
#undef PK4
}
__device__ __forceinline__ void qkt(f32x16& p0, f32x16& p1, const bf16_t* Ks, const bf16x8* qr, int r32, int hi) {
#pragma unroll
  for (int r = 0; r < 16; ++r) { p0[r] = 0.f; p1[r] = 0.f; }
#pragma unroll
  for (int d0 = 0; d0 < 8; ++d0) { const int cb = (d0 * 16 + hi * 8) * 2;
    bf16x8 b0 = *reinterpret_cast<const bf16x8*>((const char*)Ks + KSWZ(r32, cb));
    bf16x8 b1 = *reinterpret_cast<const bf16x8*>((const char*)Ks + KSWZ(32 + r32, cb));
    p0 = __builtin_amdgcn_mfma_f32_32x32x16_bf16(b0, qr[d0], p0, 0, 0, 0);
    p1 = __builtin_amdgcn_mfma_f32_32x32x16_bf16(b1, qr[d0], p1, 0, 0, 0); }
}
__device__ __forceinline__ int v_st(int k, int c) { const int kk = (k & ~0xC) | ((k & 4) << 1) | ((k & 8) >> 1); return ((kk >> 3) * 4 + (c >> 5)) * 512 + ((kk & 7) * 32 + (c & 31)) * 2; }
__device__ __forceinline__ int v_rd_base(int lane) { return ((lane & 3) << 3) | (((lane >> 2) & 3) << 6) | (((lane >> 4) & 1) << 5) | (((lane >> 5) & 1) << 8); }
constexpr int v_rd_off(int d0, int ks, int half) { return d0 * 512 + ks * 4096 + half * 2048; }
template <int OFF> __device__ __forceinline__ s16x4 tr_read(int vb) {
  s16x4 r; asm volatile("ds_read_b64_tr_b16 %0, %1 offset:%2" : "=&v"(r) : "v"(vb), "i"(OFF) : "memory"); return r;
}
template <int D0> __device__ __forceinline__ void pv_one(f32x16& od, int vb, bf16x8 pa0, bf16x8 pa1, bf16x8 pa2, bf16x8 pa3) {
  const s16x4 l0 = tr_read<v_rd_off(D0, 0, 0)>(vb), h0 = tr_read<v_rd_off(D0, 0, 1)>(vb), l1 = tr_read<v_rd_off(D0, 1, 0)>(vb), h1 = tr_read<v_rd_off(D0, 1, 1)>(vb);
  const s16x4 l2 = tr_read<v_rd_off(D0, 2, 0)>(vb), h2 = tr_read<v_rd_off(D0, 2, 1)>(vb), l3 = tr_read<v_rd_off(D0, 3, 0)>(vb), h3 = tr_read<v_rd_off(D0, 3, 1)>(vb);
  asm volatile("s_waitcnt lgkmcnt(0)" ::: "memory"); SBAR();
#define PK(L, H) (bf16x8){L[0], L[1], L[2], L[3], H[0], H[1], H[2], H[3]}
  od = __builtin_amdgcn_mfma_f32_32x32x16_bf16(pa0, PK(l0, h0), od, 0, 0, 0);
  od = __builtin_amdgcn_mfma_f32_32x32x16_bf16(pa1, PK(l1, h1), od, 0, 0, 0);
  od = __builtin_amdgcn_mfma_f32_32x32x16_bf16(pa2, PK(l2, h2), od, 0, 0, 0);
  od = __builtin_amdgcn_mfma_f32_32x32x16_bf16(pa3, PK(l3, h3), od, 0, 0, 0);
#undef PK
}
__device__ __forceinline__ void pv_d0(f32x16* o, int vb, bf16x8 pa0, bf16x8 pa1, bf16x8 pa2, bf16x8 pa3) {
  pv_one<0>(o[0], vb, pa0, pa1, pa2, pa3); pv_one<1>(o[1], vb, pa0, pa1, pa2, pa3); pv_one<2>(o[2], vb, pa0, pa1, pa2, pa3); pv_one<3>(o[3], vb, pa0, pa1, pa2, pa3);
}
__device__ __forceinline__ void attn_body(const bf16_t* __restrict__ Qb, const bf16_t* __restrict__ Kh, const bf16_t* __restrict__ Vh,
                                          bf16_t* GO, int seq, char* lds) {
  const int tid = tid_fresh(), wid = tid >> 6, lane = tid & 63, r32 = lane & 31, hi = lane >> 5;
  bf16_t* V_lds = (bf16_t*)lds; bf16_t* K_lds = (bf16_t*)(lds + 2 * SHM_V);
  float* wsx = (float*)(lds + 2 * SHM_V + 2 * SHM_K) + wid * 64; float* li_l = wsx; float* al_l = wsx + 32;
  float m_reg = -1e30f, l_reg = 0; f32x16 o[4]; bf16x8 qr[8];
#pragma unroll
  for (int d = 0; d < 4; ++d)
#pragma unroll
    for (int r = 0; r < 16; ++r) o[d][r] = 0.f;
  const bf16_t* Qw = Qb + (long)(wid * QBLK + r32) * LDQ + hi * 8;
#pragma unroll
  for (int d0 = 0; d0 < 8; ++d0) qr[d0] = *reinterpret_cast<const bf16x8*>(Qw + d0 * 16);
  const int sr = tid >> 4, sc = (tid & 15) * 8, vst0 = v_st(sr, sc), vst1 = v_st(32 + sr, sc);
  const int vb0 = (int)(uintptr_t)V_lds + v_rd_base(lane);
  constexpr int SDEPTH = 1;
  bf16x8 sv0[SDEPTH], sv1[SDEPTH], sk0[SDEPTH], sk1[SDEPTH];
#define SLOAD(i, k0) do { sv0[i] = *reinterpret_cast<const bf16x8*>(&Vh[(long)((k0) + sr) * LDK + sc]); sv1[i] = *reinterpret_cast<const bf16x8*>(&Vh[(long)((k0) + 32 + sr) * LDK + sc]); \
    sk0[i] = *reinterpret_cast<const bf16x8*>(&Kh[(long)((k0) + sr) * LDK + sc]); sk1[i] = *reinterpret_cast<const bf16x8*>(&Kh[(long)((k0) + 32 + sr) * LDK + sc]); } while (0)
#define SWRITE(b, i) do { *(bf16x8*)((char*)V_lds + (b) * SHM_V + vst0) = sv0[i];          \
    *(bf16x8*)((char*)V_lds + (b) * SHM_V + vst1) = sv1[i]; const int kc = sc * 2;               \
    *(bf16x8*)((char*)K_lds + (b) * SHM_K + KSWZ(sr, kc)) = sk0[i];                       \
    *(bf16x8*)((char*)K_lds + (b) * SHM_K + KSWZ(32 + sr, kc)) = sk1[i]; } while (0)
#define SWAIT() do { if (SDEPTH == 2) asm volatile("s_waitcnt vmcnt(4)" ::: "memory"); else asm volatile("s_waitcnt vmcnt(0)" ::: "memory"); } while (0)
#define RESC(a) do { if (__any((a) < 1.f)) { if (hi == 0) al_l[r32] = (a); asm volatile("s_waitcnt lgkmcnt(0)" ::: "memory"); \
    _Pragma("unroll") for (int d = 0; d < 4; ++d) _Pragma("unroll") for (int r = 0; r < 16; ++r) o[d][r] *= al_l[crow(r, hi)]; } } while (0)
  f32x16 pA0, pA1, pB0, pB1; float mnA, mnB, alA, alB; bf16x8 pa0, pa1, pa2, pa3; const int NT = seq / KVBLK;
  constexpr int SE = 0, SO = SDEPTH - 1;
  SLOAD(SE, 0); asm volatile("s_waitcnt vmcnt(0)" ::: "memory"); SWRITE(0, SE); __syncthreads();
  qkt(pA0, pA1, K_lds, qr, r32, hi); partialSM(pA0, pA1, m_reg, mnA, alA);
  SLOAD(SO, KVBLK); if (SDEPTH == 2) { if (2 < NT) SLOAD(SE, 2 * KVBLK); }
  SWAIT(); SWRITE(1, SO); __syncthreads();
  for (int j = 1; j + 1 < NT; j += 2) {
    SBAR(); qkt(pB0, pB1, (bf16_t*)((char*)K_lds + SHM_K), qr, r32, hi);
    finishSM(pA0, pA1, alA, l_reg, pa0, pa1, pa2, pa3); SBAR();
    SLOAD(SO, (j + SDEPTH) * KVBLK); SBAR();
    pv_d0(o, vb0, pa0, pa1, pa2, pa3); partialSM(pB0, pB1, m_reg, mnB, alB);
    __syncthreads(); SWAIT(); SWRITE(0, SE);
    RESC(alB); __syncthreads();
    SBAR(); qkt(pA0, pA1, K_lds, qr, r32, hi);
    finishSM(pB0, pB1, alB, l_reg, pa0, pa1, pa2, pa3); SBAR();
    if (SDEPTH == 1 || j + 3 < NT) SLOAD(SE, (j + 1 + SDEPTH) * KVBLK); SBAR();
    pv_d0(o, vb0 + (int)SHM_V, pa0, pa1, pa2, pa3); partialSM(pA0, pA1, m_reg, mnA, alA);
    __syncthreads(); SWAIT(); SWRITE(1, SO);
    RESC(alA); __syncthreads();
  }
  SBAR(); qkt(pB0, pB1, (bf16_t*)((char*)K_lds + SHM_K), qr, r32, hi);
  finishSM(pA0, pA1, alA, l_reg, pa0, pa1, pa2, pa3); SBAR();
  pv_d0(o, vb0, pa0, pa1, pa2, pa3); partialSM(pB0, pB1, m_reg, mnB, alB);
  __syncthreads(); RESC(alB);
  finishSM(pB0, pB1, alB, l_reg, pa0, pa1, pa2, pa3); SBAR();
  pv_d0(o, vb0 + (int)SHM_V, pa0, pa1, pa2, pa3);
  if (hi == 0) li_l[r32] = l_reg; asm volatile("s_waitcnt lgkmcnt(0)" ::: "memory");
  float rli[16];
#pragma unroll
  for (int r = 0; r < 16; ++r) rli[r] = __builtin_amdgcn_rcpf(li_l[crow(r, hi)]);
  bf16_t* Ow = GO + (long)(wid * QBLK) * 2048;
#pragma unroll
  for (int r = 0; r < 16; ++r) { const int orow = crow(r, hi);
#pragma unroll
    for (int d0 = 0; d0 < 4; ++d0) { bf16_t* q = Ow + (long)orow * 2048 + d0 * 32 + r32; *q = f2bf(o[d0][r] * rli[r] * bf2f(*q)); }
    SBAR(); }
  __syncthreads();
#undef SLOAD
#undef SWRITE
#undef SWAIT
#undef RESC
}
}

__device__ __forceinline__ void chunk_gate_unit(const Params& p, int b, int n, char* smem) {
  char* ws = p.ws;
  const bf16_t* BU = (const bf16_t*)(ws + OFF_BU); const bf16_t* BV = (const bf16_t*)(ws + OFF_BV);
  bf16_t* SG = (bf16_t*)(ws + OFF_SG); const bf16_t* WSB = (const bf16_t*)(ws + OFF_WSB);
  const int tid = tid_fresh(), wid = tid >> 6, lane = tid & 63, r32 = lane & 31, hi = lane >> 5;
  constexpr int RS = 272;
  char* sW = smem; char* sV = smem + 128 * RS;
  float* smu = (float*)(smem + 2 * 128 * RS); float* srs = smu + 128;
  const size_t tok0 = (size_t)b * SEQ + (size_t)n * 128;
  {
    const int q = tid >> 2, part = tid & 3;
    const u32x4* src = (const u32x4*)(BV + (tok0 + q) * 1024 + part * 256);
    float s = 0.f, s2 = 0.f;
#pragma unroll 4
    for (int i = 0; i < 32; ++i) {
      const u32x4 w = src[i];
#pragma unroll
      for (int e = 0; e < 4; ++e) { const float a = bf_lo(w[e]), c = bf_hi(w[e]); s += a + c; s2 += a * a + c * c; }
    }
    s += __shfl_xor(s, 1); s2 += __shfl_xor(s2, 1); s += __shfl_xor(s, 2); s2 += __shfl_xor(s2, 2);
    const float mu = s * (1.f / 1024.f);
    const float var = fmaxf(s2 * (1.f / 1024.f) - mu * mu, 0.f);
    if (part == 0) { smu[q] = mu; srs[q] = rsqrtf(var + EPS); }
  }
  __syncthreads();
  const int wp = wid >> 1, wc = wid & 1;
  for (int g = 0; g < 8; ++g) {
#pragma unroll
    for (int i = 0; i < 4; ++i) {
      const int id = tid + 512 * i, row = id >> 4, ck = (id & 15) * 8;
      *(u32x4*)(sW + row * RS + ck * 2) = *(const u32x4*)(WSB + (size_t)g * 16384 + row * 128 + ck);
    }
#pragma unroll
    for (int i = 0; i < 4; ++i) {
      const int id = tid + 512 * i, q = id & 127, cc = (id >> 7) * 8;
      const u32x4 w = *(const u32x4*)(BV + (tok0 + q) * 1024 + g * 128 + cc);
      const float mu = smu[q], rs = srs[q];
      const float* lg = p.e_vg + g * 128 + cc; const float* lbp = p.e_vb + g * 128 + cc;
#pragma unroll
      for (int e = 0; e < 4; ++e) {
        const float a = (bf_lo(w[e]) - mu) * rs * lg[2 * e] + lbp[2 * e];
        const float c = (bf_hi(w[e]) - mu) * rs * lg[2 * e + 1] + lbp[2 * e + 1];
        *(bf16_t*)(sV + (cc + 2 * e) * RS + q * 2) = f2bf(a);
        *(bf16_t*)(sV + (cc + 2 * e + 1) * RS + q * 2) = f2bf(c);
      }
    }
    __syncthreads();
    f32x16 acc0, acc1;
#pragma unroll
    for (int r = 0; r < 16; ++r) { acc0[r] = 0.f; acc1[r] = 0.f; }
#pragma unroll
    for (int kk = 0; kk < 8; ++kk) {
      const bf16x8 af = *(const bf16x8*)(sW + (wp * 32 + r32) * RS + kk * 32 + hi * 16);
      const bf16x8 b0 = *(const bf16x8*)(sV + (wc * 64 + r32) * RS + kk * 32 + hi * 16);
      const bf16x8 b1 = *(const bf16x8*)(sV + (wc * 64 + 32 + r32) * RS + kk * 32 + hi * 16);
      acc0 = __builtin_amdgcn_mfma_f32_32x32x16_bf16(b0, af, acc0, 0, 0, 0);
      acc1 = __builtin_amdgcn_mfma_f32_32x32x16_bf16(b1, af, acc1, 0, 0, 0);
    }
    const int pr = wp * 32 + r32;
    const float bias = p.e_bs[g * 128 + pr];
    const size_t tok = tok0 + pr;
#pragma unroll
    for (int nj = 0; nj < 2; ++nj)
#pragma unroll
      for (int q = 0; q < 4; ++q) {
        const int col = g * 128 + wc * 64 + nj * 32 + q * 8 + hi * 4;
        const u32x2 bu = *(const u32x2*)(BU + tok * 1024 + col);
        bf16_t* gp = SG + tok * 2048 + 1024 + col;
        const u32x2 sg = *(const u32x2*)gp;
        const float m0 = (nj ? acc1[4 * q + 0] : acc0[4 * q + 0]) + bias, m1 = (nj ? acc1[4 * q + 1] : acc0[4 * q + 1]) + bias;
        const float m2 = (nj ? acc1[4 * q + 2] : acc0[4 * q + 2]) + bias, m3 = (nj ? acc1[4 * q + 3] : acc0[4 * q + 3]) + bias;
        st_bf4(gp, bf_lo(bu[0]) * m0 * bf_lo(sg[0]), bf_hi(bu[0]) * m1 * bf_hi(sg[0]), bf_lo(bu[1]) * m2 * bf_lo(sg[1]), bf_hi(bu[1]) * m3 * bf_hi(sg[1]));
      }
    __syncthreads();
  }
}

__device__ __forceinline__ void post_ln_rows(const float* resid, const bf16_t* yg, float* dst, const float* pg, const float* pb, bf16_t* m1, const float* mod17) {
  const int tid = tid_fresh(), wid = tid >> 6, lane = tid & 63;
  const int gw = blockIdx.x * 8 + wid, nw = gridDim.x * 8;
  float4 nx[4]; u32x2 ny[4];
  { const float4* ps = (const float4*)(resid + (size_t)gw * 1024); const u32x2* py = (const u32x2*)(yg + (size_t)gw * 1024);
#pragma unroll
    for (int j = 0; j < 4; ++j) { nx[j] = ps[lane + 64 * j]; ny[j] = py[lane + 64 * j]; } }
  for (int row = gw; row < NTOK; row += nw) {
    float4 v[4];
#pragma unroll
    for (int j = 0; j < 4; ++j) {
      v[j].x = ALPHA * nx[j].x + bf_lo(ny[j][0]); v[j].y = ALPHA * nx[j].y + bf_hi(ny[j][0]);
      v[j].z = ALPHA * nx[j].z + bf_lo(ny[j][1]); v[j].w = ALPHA * nx[j].w + bf_hi(ny[j][1]);
    }
    { const int nr = (row + nw < NTOK) ? row + nw : row;
      const float4* ps = (const float4*)(resid + (size_t)nr * 1024); const u32x2* py = (const u32x2*)(yg + (size_t)nr * 1024);
#pragma unroll
      for (int j = 0; j < 4; ++j) { nx[j] = ps[lane + 64 * j]; ny[j] = py[lane + 64 * j]; } }
    float s = 0.f;
#pragma unroll
    for (int j = 0; j < 4; ++j) s += v[j].x + v[j].y + v[j].z + v[j].w;
    float mu = wave_sum(s) * (1.f / 1024.f);
    float q = 0.f;
#pragma unroll
    for (int j = 0; j < 4; ++j) { v[j].x -= mu; v[j].y -= mu; v[j].z -= mu; v[j].w -= mu; q += v[j].x * v[j].x + v[j].y * v[j].y + v[j].z * v[j].z + v[j].w * v[j].w; }
    float rstd = rsqrtf(wave_sum(q) * (1.f / 1024.f) + EPS);
    float4* pd = (float4*)(dst + (size_t)row * 1024);
    s = 0.f;
#pragma unroll
    for (int j = 0; j < 4; ++j) {
      const int col = (lane + 64 * j) * 4;
      const float4 g4 = *(const float4*)(pg + col), b4 = *(const float4*)(pb + col);
      v[j].x = v[j].x * rstd * g4.x + b4.x; v[j].y = v[j].y * rstd * g4.y + b4.y; v[j].z = v[j].z * rstd * g4.z + b4.z; v[j].w = v[j].w * rstd * g4.w + b4.w;
      pd[lane + 64 * j] = v[j];
      s += v[j].x + v[j].y + v[j].z + v[j].w;
    }
    if (m1) {
      mu = wave_sum(s) * (1.f / 1024.f);
      q = 0.f;
#pragma unroll
      for (int j = 0; j < 4; ++j) { v[j].x -= mu; v[j].y -= mu; v[j].z -= mu; v[j].w -= mu; q += v[j].x * v[j].x + v[j].y * v[j].y + v[j].z * v[j].z + v[j].w * v[j].w; }
      rstd = rsqrtf(wave_sum(q) * (1.f / 1024.f) + EPS);
      const float* md = mod17 + (size_t)(row >> 11) * 3072;
      bf16_t* pm = m1 + (size_t)row * 1024;
#pragma unroll
      for (int j = 0; j < 4; ++j) {
        const int col = (lane + 64 * j) * 4;
        const float4 sh = *(const float4*)(md + col), sc = *(const float4*)(md + 1024 + col);
        st_bf4(pm + col, v[j].x * rstd * (1.f + sc.x) + sh.x, v[j].y * rstd * (1.f + sc.y) + sh.y, v[j].z * rstd * (1.f + sc.z) + sh.z, v[j].w * rstd * (1.f + sc.w) + sh.w);
      }
    }
  }
}

__device__ __forceinline__ void out_proj(const bf16_t* A, const bf16_t* WT, const float* gate17, bf16_t* dst, char* smem) {
  const int lb = logical_block();
  for (int u = lb; u < 512; u += gridDim.x) {
    const int mt = u >> 2, nt = u & 3;
    f32x16 acc[2][4];
    gemm2(mkPlain(A + (size_t)mt * 256 * 2048, 2048), mkPlain(WT + (size_t)nt * 256 * 2048, 2048), 32, smem, acc);
    const float* gt = gate17 + (size_t)(mt >> 3) * 3072 + 2048 + nt * 256;
    epi2_foreach(acc, [&](int row, int col, float a, float b, float c, float d) {
      const size_t idx = (size_t)(mt * 256 + row) * 1024 + nt * 256 + col;
      const float4 g4 = *(const float4*)(gt + col);
      st_bf4(dst + idx, g4.x * a, g4.y * b, g4.z * c, g4.w * d);
    });
  }
}

#define XB_TMO      128
#define XB_XCNT(j)  (256  + 64 * (j))
#define XB_XSUB(j)  (1280 + 64 * (j))
#define XB_XGEN(j)  (2304 + 64 * (j))
#define XB_TOP      3328
#define XB_TOPGEN   3392
#define XCD_BAR_WORDS 3456
#define XB_SPIN_CAP (1u << 18)
#define LAS __attribute__((address_space(3)))

__device__ __forceinline__ unsigned xb_ld(unsigned* p)              { return __hip_atomic_load(p, __ATOMIC_RELAXED, __HIP_MEMORY_SCOPE_AGENT); }
__device__ __forceinline__ unsigned xb_add(unsigned* p, unsigned v) { return __hip_atomic_fetch_add(p, v, __ATOMIC_RELAXED, __HIP_MEMORY_SCOPE_AGENT); }
__device__ __forceinline__ unsigned xb_xcc_id() { return (unsigned)__builtin_amdgcn_s_getreg((3 << 11) | 20) & 0xFu; }
#define XB_SPIN(cond, bar) do { unsigned _sp = 0; while (cond) { __builtin_amdgcn_s_sleep(1); \
    if ((++_sp & 255u) == 0u) { if (xb_ld(&(bar)[XB_TMO])) break; if (_sp > XB_SPIN_CAP) { atomicAdd(&(bar)[XB_TMO], 1u); break; } } } } while (0)

struct XcdBarrier {
    unsigned* bar; unsigned x;
    volatile LAS unsigned* st;
};

__device__ __forceinline__ XcdBarrier xcd_barrier_post(unsigned* bar, volatile LAS unsigned* st) {
    XcdBarrier b; b.bar = bar; b.x = xb_xcc_id(); b.st = st;
    if (threadIdx.x == 0) (void)xb_add(&bar[XB_XCNT(b.x)], 1u);
    return b;
}
__device__ __forceinline__ void xcd_barrier_complete(unsigned* bar, unsigned x, unsigned& nloc, unsigned& nx) {
    const unsigned G = gridDim.x * gridDim.y * gridDim.z;
    unsigned sum, cnt, mine, sp = 0u;
    for (;;) {
        sum = 0u; cnt = 0u; mine = 0u;
#pragma unroll
        for (unsigned j = 0; j < 16; ++j) { const unsigned c = xb_ld(&bar[XB_XCNT(j)]); sum += c; cnt += (c > 0u) ? 1u : 0u; mine = (j == x) ? c : mine; }
        if (sum == G) break;
        __builtin_amdgcn_s_sleep(1);
        if ((++sp & 255u) == 0u) { if (xb_ld(&bar[XB_TMO])) break; if (sp > XB_SPIN_CAP) { atomicAdd(&bar[XB_TMO], 1u); break; } }
    }
    nloc = mine > 0u ? mine : 1u; nx = cnt > 0u ? cnt : 1u;
}

__device__ __forceinline__ void xcd_barrier(const XcdBarrier& b) {
    asm volatile("s_waitcnt vmcnt(0)" ::: "memory");
    __syncthreads();
    if (threadIdx.x == 0) {
        unsigned* bar = b.bar;
        __builtin_amdgcn_s_waitcnt(0);
        unsigned nloc = b.st[0], nx = b.st[1];
        if (nloc == 0u) { xcd_barrier_complete(bar, b.x, nloc, nx); b.st[0] = nloc; b.st[1] = nx; }
        const unsigned old = xb_add(&bar[XB_XSUB(b.x)], 1u);
        const unsigned gen = old / nloc;
        if (old + 1u == (gen + 1u) * nloc) {
            __builtin_amdgcn_fence(__ATOMIC_RELEASE, "agent");
            asm volatile("s_waitcnt vmcnt(0)" ::: "memory");
            const unsigned og = xb_add(&bar[XB_TOP], 1u);
            const unsigned tg = og / nx;
            if (og + 1u == (tg + 1u) * nx) xb_add(&bar[XB_TOPGEN], 1u);
            else XB_SPIN(xb_ld(&bar[XB_TOPGEN]) == tg, bar);
            __builtin_amdgcn_fence(__ATOMIC_ACQUIRE, "agent");
            xb_add(&bar[XB_XGEN(b.x)], 1u);
            asm volatile("s_waitcnt vmcnt(0)" ::: "memory");
        } else {
            XB_SPIN(xb_ld(&bar[XB_XGEN(b.x)]) == gen, bar);
            __builtin_amdgcn_fence(__ATOMIC_ACQUIRE, "agent");
            asm volatile("s_waitcnt vmcnt(0)" ::: "memory");
        }
    }
    __syncthreads();
}


constexpr size_t OFF_XBAR = OFF_SMALL + 1536 * 1024;
constexpr size_t OFF_PX = OFF_SMALL + 1152 * 1024;
#define GSYNC_CG() do { __threadfence(); grid.sync(); __threadfence(); } while (0)
#define GSYNC() xcd_barrier(xbar)
#ifndef LAUNCH_SPLITS
#define LAUNCH_SPLITS {{0,0},{1,1},{2,2},{3,3},{4,4},{5,5},{6,6},{7,7},{8,8},{9,9},{10,10}}
#endif
template <int PLO, int PHI>
__global__ void __launch_bounds__(512) mega(Params p) {
  cg::grid_group grid = cg::this_grid();
  __shared__ __attribute__((aligned(16))) char smem[SMEM_BYTES];
  char* ws = p.ws;
  float* MOD = (float*)(ws + OFF_MOD);
  const int lb = logical_block();
  volatile LAS unsigned* xst = (volatile LAS unsigned*)(smem + LDS_RED + 2048);
  if (tid_fresh() < 4) xst[tid_fresh()] = 0u;
  __syncthreads();
  XcdBarrier xbar = xcd_barrier_post((unsigned*)(ws + OFF_XBAR), xst);
  if (PLO < PHI) grid.sync();

  if (PLO <= 0 && 0 <= PHI) {
  phase0(p, smem);
  }
  if (PLO <= 0 && 0 < PHI) { GSYNC(); }
  if (PLO <= 1 && 1 <= PHI) {

  ln_rows_modulate(p.x, (bf16_t*)(ws + OFF_M0), NTOK, SEQ, MOD, -1);
  ln_rows_modulate(p.ctx, (bf16_t*)(ws + OFF_MC), NCTX, CTXL, MOD, 16);
  }
  if (PLO <= 1 && 1 < PHI) { GSYNC(); }
  if (PLO <= 2 && 2 <= PHI) {

  phase2(p, smem);
  }
  if (PLO <= 2 && 2 < PHI) { GSYNC(); }
  if (PLO <= 3 && 3 <= PHI) {

  for (int u = lb; u < 1024; u += gridDim.x) {
      const int grp = u >> 5, j = u & 31, b = grp >> 1, kvh = grp & 1, hq = kvh * 4 + (j >> 3), qb = j & 7;
      const bf16_t* Qb = (const bf16_t*)(ws + OFF_Q) + ((size_t)(b * SEQ + qb * 256) * 8 + hq) * 128;
      const bf16_t* Kh = (const bf16_t*)(ws + OFF_KALL) + ((size_t)b * SKV * 2 + kvh) * 128;
      const bf16_t* Vh = (const bf16_t*)(ws + OFF_VALL) + ((size_t)b * SKV * 2 + kvh) * 128;
      bf16_t* GO = (bf16_t*)(ws + OFF_SG) + (size_t)(b * SEQ + qb * 256) * 2048 + hq * 128;
      att::attn_body(Qb, Kh, Vh, GO, SKV, smem);
  }
  for (int v = lb; v < 256; v += gridDim.x) chunk_gate_unit(p, v >> 4, v & 15, smem);
  }
  if (PLO <= 3 && 3 < PHI) { GSYNC(); }
  if (PLO <= 4 && 4 <= PHI) {

  out_proj((const bf16_t*)(ws + OFF_SG), (const bf16_t*)(ws + OFF_WT_EOUT), MOD, (bf16_t*)(ws + OFF_YG), smem);
  }
  if (PLO <= 4 && 4 < PHI) { GSYNC(); }
  if (PLO <= 5 && 5 <= PHI) {

  post_ln_rows(p.x, (const bf16_t*)(ws + OFF_YG), (float*)(ws + OFF_Q), p.post_g, p.post_b, (bf16_t*)(ws + OFF_M0), MOD + 17 * 3072);
  }
  if (PLO <= 5 && 5 < PHI) { GSYNC(); }
  if (PLO <= 6 && 6 <= PHI) {

  {
    const bf16_t* M1 = (const bf16_t*)(ws + OFF_M0); const bf16_t* WT = (const bf16_t*)(ws + OFF_WT_OIN);
    bf16_t* F = (bf16_t*)(ws + OFF_F); bf16_t* RV = (bf16_t*)(ws + OFF_RV); bf16_t* XM = (bf16_t*)(ws + OFF_XM);
    bf16_t* SG1 = (bf16_t*)(ws + OFF_SG);
    for (int u = lb; u < 2048; u += gridDim.x) {
      f32x16 acc[2][4];
      if (u < 1024) {
        const int tt = u >> 3, ct = u & 7, b = tt >> 3, t0 = (tt & 7) * 256;
        gemm2(mkPlain(WT + (size_t)ct * 256 * 1024, 1024), mkPlain(M1 + (size_t)tt * 256 * 1024, 1024), 16, smem, acc);
        epi2_foreach(acc, [&](int row, int col, float a, float bq, float c, float d) {
          const int ch = ct * 256 + row, t = t0 + col;
          const size_t base = ((size_t)b * 2048 + ch) * 1024;
          if (t < 1024) {
            st_bf4(F + base + t, a, bq, c, d);
            if (t == 0) RV[base] = 0;
          } else if (t == 1024) {
            XM[(size_t)b * 2048 + ch] = f2bf(a);
            RV[base + 1023] = f2bf(bq); RV[base + 1022] = f2bf(c); RV[base + 1021] = f2bf(d);
          } else {
            RV[base + 2048 - t] = f2bf(a); RV[base + 2047 - t] = f2bf(bq); RV[base + 2046 - t] = f2bf(c); RV[base + 2045 - t] = f2bf(d);
          }
        });
      } else {
        const int v = u - 1024, mt = v >> 3, nt = v & 7;
        gemm2(mkPlain(M1 + (size_t)mt * 256 * 1024, 1024), mkPlain(WT + (size_t)(2048 + nt * 256) * 1024, 1024), 16, smem, acc);
        epi2_foreach(acc, [&](int row, int col, float a, float bq, float c, float d) {
          st_bf4(SG1 + (size_t)(mt * 256 + row) * 2048 + nt * 256 + col, silu_f(a), silu_f(bq), silu_f(c), silu_f(d));
        });
      }
    }
  }
  }
  if (PLO <= 6 && 6 < PHI) { GSYNC(); }
  if (PLO <= 7 && 7 <= PHI) {

  {
    {
      const int tid = tid_fresh(), wid = tid >> 6, lane = tid & 63;
      const int gw = blockIdx.x * 8 + wid, nw = gridDim.x * 8;
      const bf16_t* XMr = (const bf16_t*)(ws + OFF_XM); float* PX = (float*)(ws + OFF_PX);
      u32x4 na0, na1, nb0, nb1;
      { const size_t ro = (size_t)gw * 128; const u32x4* Fr = (const u32x4*)(ws + OFF_F) + ro; const u32x4* Rr = (const u32x4*)(ws + OFF_RV) + ro;
        na0 = Fr[lane]; na1 = Fr[lane + 64]; nb0 = Rr[lane]; nb1 = Rr[lane + 64]; }
      for (int row = gw; row < 16 * 2048; row += nw) {
        const u32x4 a0 = na0, a1 = na1, b0 = nb0, b1 = nb1;
        { const int nr = (row + nw < 16 * 2048) ? row + nw : row; const size_t ro = (size_t)nr * 128;
          const u32x4* Fr = (const u32x4*)(ws + OFF_F) + ro; const u32x4* Rr = (const u32x4*)(ws + OFF_RV) + ro;
          na0 = Fr[lane]; na1 = Fr[lane + 64]; nb0 = Rr[lane]; nb1 = Rr[lane + 64]; }
        u32x4 e0, e1, o0, o1; float alt = 0.f;
#pragma unroll
        for (int k = 0; k < 4; ++k) {
          { const float al = bf_lo(a0[k]), ah = bf_hi(a0[k]), bl = bf_lo(b0[k]), bh = bf_hi(b0[k]);
            e0[k] = cvtpk(al + bl, ah + bh); o0[k] = cvtpk(al - bl, ah - bh); alt += (al + bl) - (ah + bh); }
          { const float al = bf_lo(a1[k]), ah = bf_hi(a1[k]), bl = bf_lo(b1[k]), bh = bf_hi(b1[k]);
            e1[k] = cvtpk(al + bl, ah + bh); o1[k] = cvtpk(al - bl, ah - bh); alt += (al + bl) - (ah + bh); }
        }
        u32x4* Fw = (u32x4*)(ws + OFF_F) + (size_t)row * 128; u32x4* Rw = (u32x4*)(ws + OFF_RV) + (size_t)row * 128;
        Fw[lane] = e0; Fw[lane + 64] = e1; Rw[lane] = o0; Rw[lane + 64] = o1;
        alt = wave_sum(alt);
        if (lane == 0) PX[row] = alt + bf2f(XMr[row]);
      }
    }
    if (PLO < PHI) { GSYNC(); }
    const bf16_t* F = (const bf16_t*)(ws + OFF_F); const bf16_t* RV = (const bf16_t*)(ws + OFF_RV); const bf16_t* XM = (const bf16_t*)(ws + OFF_XM);
    const bf16_t* TC = (const bf16_t*)(ws + OFF_TAB_C); const bf16_t* TS = (const bf16_t*)(ws + OFF_TAB_S);
    bf16_t* PC = (bf16_t*)p.out; bf16_t* PS = (bf16_t*)(ws + OFF_M0);
    for (int u = lb; u < 1024; u += gridDim.x) {
      f32x16 acc[2][4];
      const int v = u & 511, b = v >> 5, mt = (v & 31) >> 3, nt = v & 7;
      const size_t bo = ((size_t)b * 2048 + nt * 256) * 1024;
      if (u < 512) {
        gemm2(mkPlain(TC + (size_t)mt * 256 * 1024, 1024), mkPlain(F + bo, 1024), 16, smem, acc);
        epi2_foreach(acc, [&](int row, int col, float a, float bq, float c, float d) {
          const int tp = mt * 256 + row, ch = nt * 256 + col;
          const u32x2 xm = *(const u32x2*)(XM + (size_t)b * 2048 + ch);
          const float sg = (tp & 1) ? -1.f : 1.f;
          a += sg * bf_lo(xm[0]); bq += sg * bf_hi(xm[0]); c += sg * bf_lo(xm[1]); d += sg * bf_hi(xm[1]);
          st_bf4(PC + ((size_t)b * 1024 + tp) * 2048 + ch, a, bq, c, d);
        });
      } else {
        gemm2(mkPlain(TS + (size_t)mt * 256 * 1024, 1024), mkPlain(RV + bo, 1024), 16, smem, acc);
        epi2_foreach(acc, [&](int row, int col, float a, float bq, float c, float d) {
          st_bf4(PS + ((size_t)b * 1024 + mt * 256 + row) * 2048 + nt * 256 + col, a, bq, c, d);
        });
      }
    }
  }
  }
  if (PLO <= 7 && 7 < PHI) { GSYNC(); }
  if (PLO <= 8 && 8 <= PHI) {

  {
    const bf16_t* PC = (const bf16_t*)p.out; const bf16_t* PS = (const bf16_t*)(ws + OFF_M0);
    const bf16_t* CDP = (const bf16_t*)(ws + OFF_CDP);
    bf16_t* SG1 = (bf16_t*)(ws + OFF_SG);
    const int tid = tid_fresh(), wid = tid >> 6, lane = tid & 63, r32 = lane & 31, hi = lane >> 5, wm = wid >> 1, wn = wid & 1;
    constexpr int TBS = 528;
    constexpr int TB_BYTES = 128 * TBS;
    char* sT = smem; char* sA = smem + TB_BYTES;
#pragma unroll
    for (int i = 0; i < 8; ++i) {
      const int id = tid + 512 * i, row = id >> 5, ck = id & 31;
      *(u32x4*)(sT + row * TBS + ck * 16) = *(const u32x4*)(CDP + row * 256 + ck * 8);
    }
    const int st_off = (tid >> 3) * LDS_ROWB + (tid & 7) * 16;
    const int a_rd = (wm * 64 + r32) * LDS_ROWB + hi * 16;
    const int b_rd = (wn * 32 + r32) * TBS + hi * 16;
    const size_t rowoff = (size_t)(tid >> 3) * 2048 + (tid & 7) * 8;
    u32x4 r00, r01, r02, r03, r10, r11, r12, r13, r20, r21, r22, r23, r30, r31, r32_, r33;
    auto a_base = [&](int u_, int s_) -> const bf16_t* {
      const int b_ = u_ >> 6, j_ = (u_ >> 4) & 3, G_ = u_ & 15;
      return ((s_ < 2) ? PC : PS) + ((size_t)b_ * 1024 + j_ * 256) * 2048 + G_ * 128 + (s_ & 1) * 64 + rowoff;
    };
#define P8_LOAD(S, U, A, B, C, D) do { const bf16_t* q_ = a_base((U), (S)); A = *(const u32x4*)(q_); B = *(const u32x4*)(q_ + (size_t)64 * 2048); \
      C = *(const u32x4*)(q_ + (size_t)128 * 2048); D = *(const u32x4*)(q_ + (size_t)192 * 2048); } while (0)
#define P8_WRITE(ST, A, B, C, D) do { char* s_ = sA + (ST) * L2_A + st_off; *(u32x4*)(s_) = A; *(u32x4*)(s_ + 64 * LDS_ROWB) = B; \
      *(u32x4*)(s_ + 128 * LDS_ROWB) = C; *(u32x4*)(s_ + 192 * LDS_ROWB) = D; } while (0)
#define P8_COMPUTE(ST, S, ACC) do { const char* sb_ = sA + (ST) * L2_A;                                              \
      _Pragma("unroll") for (int kk = 0; kk < 4; ++kk) {                                                               \
        const bf16x8 fa0 = *(const bf16x8*)(sb_ + a_rd + kk * 32);                                                      \
        const bf16x8 fa1 = *(const bf16x8*)(sb_ + a_rd + 32 * LDS_ROWB + kk * 32);                                      \
        const bf16x8 fb0 = *(const bf16x8*)(sT + b_rd + ((S) * 64 + kk * 16) * 2);                                      \
        const bf16x8 fb1 = *(const bf16x8*)(sT + b_rd + 64 * TBS + ((S) * 64 + kk * 16) * 2);                           \
        ACC[0][0] = __builtin_amdgcn_mfma_f32_32x32x16_bf16(fb0, fa0, ACC[0][0], 0, 0, 0);                              \
        ACC[0][1] = __builtin_amdgcn_mfma_f32_32x32x16_bf16(fb1, fa0, ACC[0][1], 0, 0, 0);                              \
        ACC[1][0] = __builtin_amdgcn_mfma_f32_32x32x16_bf16(fb0, fa1, ACC[1][0], 0, 0, 0);                              \
        ACC[1][1] = __builtin_amdgcn_mfma_f32_32x32x16_bf16(fb1, fa1, ACC[1][1], 0, 0, 0);                              \
      } } while (0)
    P8_LOAD(0, lb, r00, r01, r02, r03); P8_LOAD(1, lb, r10, r11, r12, r13); P8_LOAD(2, lb, r20, r21, r22, r23); P8_LOAD(3, lb, r30, r31, r32_, r33);
    for (int u = lb; u < 1024; u += gridDim.x) {
      const int un = (u + (int)gridDim.x < 1024) ? u + (int)gridDim.x : u;
      f32x16 acc1[2][2], acc2[2][2];
#pragma unroll
      for (int mi = 0; mi < 2; ++mi)
#pragma unroll
        for (int nj = 0; nj < 2; ++nj)
#pragma unroll
          for (int r = 0; r < 16; ++r) { acc1[mi][nj][r] = 0.f; acc2[mi][nj][r] = 0.f; }
      P8_WRITE(0, r00, r01, r02, r03); __syncthreads(); P8_LOAD(0, un, r00, r01, r02, r03); P8_COMPUTE(0, 0, acc1);
      P8_WRITE(1, r10, r11, r12, r13); __syncthreads(); P8_LOAD(1, un, r10, r11, r12, r13); P8_COMPUTE(1, 1, acc1);
      P8_WRITE(0, r20, r21, r22, r23); __syncthreads(); P8_LOAD(2, un, r20, r21, r22, r23); P8_COMPUTE(0, 2, acc2);
      P8_WRITE(1, r30, r31, r32_, r33); __syncthreads(); P8_LOAD(3, un, r30, r31, r32_, r33); P8_COMPUTE(1, 3, acc2);
      const int b = u >> 6, j = (u >> 4) & 3, G = u & 15;
      const float sc = 1.f / 512.f;
#pragma unroll
      for (int mi = 0; mi < 2; ++mi) {
        const int tp = j * 256 + wm * 64 + mi * 32 + r32;
#pragma unroll
        for (int nj = 0; nj < 2; ++nj)
#pragma unroll
          for (int q = 0; q < 4; ++q) {
            const int col = G * 128 + nj * 64 + wn * 32 + q * 8 + hi * 4;
            const float p0 = acc1[mi][nj][4 * q + 0], p1 = acc1[mi][nj][4 * q + 1], p2 = acc1[mi][nj][4 * q + 2], p3 = acc1[mi][nj][4 * q + 3];
            const float m0 = acc2[mi][nj][4 * q + 0], m1 = acc2[mi][nj][4 * q + 1], m2 = acc2[mi][nj][4 * q + 2], m3 = acc2[mi][nj][4 * q + 3];
            { bf16_t* gp = SG1 + ((size_t)b * 2048 + tp) * 2048 + col; const u32x2 sg = *(const u32x2*)gp;
              st_bf4(gp, (p0 - m0) * sc * bf_lo(sg[0]), (p1 - m1) * sc * bf_hi(sg[0]), (p2 - m2) * sc * bf_lo(sg[1]), (p3 - m3) * sc * bf_hi(sg[1])); }
            if (tp >= 1) { bf16_t* gp = SG1 + ((size_t)b * 2048 + (2048 - tp)) * 2048 + col; const u32x2 sg = *(const u32x2*)gp;
              st_bf4(gp, (p0 + m0) * sc * bf_lo(sg[0]), (p1 + m1) * sc * bf_hi(sg[0]), (p2 + m2) * sc * bf_lo(sg[1]), (p3 + m3) * sc * bf_hi(sg[1])); }
          }
      }
    }
#undef P8_LOAD
#undef P8_WRITE
#undef P8_COMPUTE
    {
      const float* PX = (const float*)(ws + OFF_PX);
      for (int i = blockIdx.x; i < 256; i += gridDim.x) {
        if (tid < 128) {
          const int b = i >> 4, G = i & 15;
          const float* px = PX + (size_t)b * 2048 + G * 128;
          float y = 0.f;
          for (int c = 0; c < 128; ++c) y += px[c] * bf2f(*(const bf16_t*)(sT + tid * TBS + c * 2));
          bf16_t* gp = SG1 + ((size_t)b * 2048 + 1024) * 2048 + G * 128 + tid;
          *gp = f2bf(y * (1.f / 512.f) * bf2f(*gp));
        }
      }
    }
  }
  }
  if (PLO <= 8 && 8 < PHI) { GSYNC(); }
  if (PLO <= 9 && 9 <= PHI) {

  out_proj((const bf16_t*)(ws + OFF_SG), (const bf16_t*)(ws + OFF_WT_OOUT), MOD + 17 * 3072, (bf16_t*)(ws + OFF_YG), smem);
  }
  if (PLO <= 9 && 9 < PHI) { GSYNC(); }
  if (PLO <= 10 && 10 <= PHI) {

  post_ln_rows((const float*)(ws + OFF_Q), (const bf16_t*)(ws + OFF_YG), p.out, p.post_g + 1024, p.post_b + 1024, nullptr, nullptr);
  }
}

extern "C" void kernel_launch(void* const* d_in, const int* in_sizes, int n_in, void* d_out, int out_size, void* d_ws, size_t ws_size,
                              hipStream_t stream) {
  static int grid_blocks = 0;
  if (!grid_blocks) {
    int dev = 0, cus = 0, per_cu = 0;
    hipGetDevice(&dev);
    hipDeviceGetAttribute(&cus, hipDeviceAttributeMultiprocessorCount, dev);
    hipOccupancyMaxActiveBlocksPerMultiprocessor(&per_cu, mega<0, 10>, 512, 0);
    if (per_cu > 1) per_cu = 1;
    grid_blocks = cus * per_cu;
    if (n_in != 18 || ws_size < WS_NEED) fprintf(stderr, "kernel_launch: unexpected n_in %d or ws_size %zu (need %zu)\n", n_in, ws_size, (size_t)WS_NEED);
  }
  Params p{};
  p.x = (const float*)d_in[0]; p.c = (const float*)d_in[1]; p.ctx = (const float*)d_in[2]; p.c_ctx = (const float*)d_in[3];
  p.w_mod = (const float*)d_in[4]; p.b_mod = (const float*)d_in[5]; p.post_g = (const float*)d_in[6]; p.post_b = (const float*)d_in[7];
  p.e_w_in = (const float*)d_in[8]; p.e_qn = (const float*)d_in[9]; p.e_kn = (const float*)d_in[10]; p.e_vg = (const float*)d_in[11];
  p.e_vb = (const float*)d_in[12]; p.e_ws = (const float*)d_in[13]; p.e_bs = (const float*)d_in[14]; p.e_w_out = (const float*)d_in[15];
  p.o_w_in = (const float*)d_in[16]; p.o_w_out = (const float*)d_in[17];
  p.out = (float*)d_out; p.ws = (char*)d_ws;
#define ONE_LAUNCH 1
#ifdef ONE_LAUNCH
  hipMemsetAsync((char*)d_ws + OFF_XBAR, 0, XCD_BAR_WORDS * 4, stream);
  { void* args[] = {&p};
    hipError_t e = hipLaunchCooperativeKernel((void*)mega<0, 10>, dim3(grid_blocks), dim3(512), args, 0, stream);
    if (e != hipSuccess) fprintf(stderr, "cooperative launch failed: %s (grid %d)\n", hipGetErrorString(e), grid_blocks); }
#else
  hipLaunchKernelGGL((mega<0, 0>), dim3(grid_blocks), dim3(512), 0, stream, p);
  hipLaunchKernelGGL((mega<1, 1>), dim3(grid_blocks), dim3(512), 0, stream, p);
  hipLaunchKernelGGL((mega<2, 2>), dim3(grid_blocks), dim3(512), 0, stream, p);
  hipLaunchKernelGGL((mega<3, 3>), dim3(grid_blocks), dim3(512), 0, stream, p);
  hipLaunchKernelGGL((mega<4, 4>), dim3(grid_blocks), dim3(512), 0, stream, p);
  hipLaunchKernelGGL((mega<5, 5>), dim3(grid_blocks), dim3(512), 0, stream, p);
  hipLaunchKernelGGL((mega<6, 6>), dim3(grid_blocks), dim3(512), 0, stream, p);
  hipLaunchKernelGGL((mega<7, 7>), dim3(grid_blocks), dim3(512), 0, stream, p);
  hipLaunchKernelGGL((mega<8, 8>), dim3(grid_blocks), dim3(512), 0, stream, p);
  hipLaunchKernelGGL((mega<9, 9>), dim3(grid_blocks), dim3(512), 0, stream, p);
  hipLaunchKernelGGL((mega<10, 10>), dim3(grid_blocks), dim3(512), 0, stream, p);
#endif
}
```

```cpp
#include <hip/hip_runtime.h>
#include <hip/hip_cooperative_groups.h>
#include <cstdio>
#include <cstdint>
namespace cg = cooperative_groups;

typedef unsigned short bf16_t;
using bf16x8 = __attribute__((ext_vector_type(8))) short;
using s16x4  = __attribute__((ext_vector_type(4))) short;
using f32x16 = __attribute__((ext_vector_type(16))) float;
using u32x4  = __attribute__((ext_vector_type(4))) unsigned;
using u32x2  = __attribute__((ext_vector_type(2))) unsigned;

constexpr int DM = 1024, NB = 16, SEQ = 2048, CTXL = 256, SKV = SEQ + CTXL;
constexpr int NTOK = NB * SEQ;
constexpr int NCTX = NB * CTXL;
constexpr int EVEN_IN = 5632, ODD_IN = 4096, DIN = 2048;
constexpr float ALPHA = 1.4142135623730951f;
constexpr float EPS = 1e-6f;

constexpr size_t MiB = 1ull << 20;
constexpr size_t OFF_WT_EIN = 0, OFF_WT_EOUT = 11 * MiB, OFF_WT_OIN = 15 * MiB, OFF_WT_OOUT = 23 * MiB;
constexpr size_t OFF_TAB_C = 27 * MiB, OFF_TAB_S = 30 * MiB, OFF_SMALL = 33 * MiB;
constexpr size_t OFF_CDM = OFF_SMALL, OFF_CDP = OFF_SMALL + 64 * 1024, OFF_WSB = OFF_SMALL + 128 * 1024;
constexpr size_t OFF_ROPE = OFF_SMALL + 384 * 1024, OFF_MOD = OFF_SMALL + 512 * 1024, OFF_XM = OFF_SMALL + 1024 * 1024;
constexpr size_t OFF_M0 = 36 * MiB, OFF_MC = 100 * MiB;
constexpr size_t OFF_SG = 108 * MiB;
constexpr size_t OFF_Q = 236 * MiB, OFF_BU = 300 * MiB;
constexpr size_t OFF_KALL = 364 * MiB, OFF_VALL = 382 * MiB, OFF_BV = 400 * MiB;
constexpr size_t OFF_F = 364 * MiB, OFF_RV = 428 * MiB;
constexpr size_t OFF_YG = 364 * MiB;
constexpr size_t WS_NEED = 492 * MiB;

struct Params {
  const float *x, *c, *ctx, *c_ctx, *w_mod, *b_mod, *post_g, *post_b, *e_w_in, *e_qn, *e_kn, *e_vg, *e_vb, *e_ws, *e_bs,
      *e_w_out, *o_w_in, *o_w_out;
  float* out;
  char* ws;
  long pad_;
};

typedef float f32x2_t __attribute__((ext_vector_type(2)));
typedef __bf16 bf16x2_t __attribute__((ext_vector_type(2)));
__device__ __forceinline__ unsigned cvtpk(float lo, float hi) {
  f32x2_t v = {lo, hi}; bf16x2_t h = __builtin_convertvector(v, bf16x2_t); return __builtin_bit_cast(unsigned, h);
}
__device__ __forceinline__ int tid_fresh() { int t = (int)__builtin_amdgcn_workitem_id_x(); asm volatile("" : "+v"(t)); return t; }
__device__ __forceinline__ float bf_lo(unsigned w) { return __uint_as_float(w << 16); }
__device__ __forceinline__ float bf_hi(unsigned w) { return __uint_as_float(w & 0xffff0000u); }
__device__ __forceinline__ bf16_t f2bf(float x) { return (bf16_t)(cvtpk(x, 0.f) & 0xffffu); }
__device__ __forceinline__ float bf2f(bf16_t h) { return __uint_as_float(((unsigned)h) << 16); }
__device__ __forceinline__ int crow(int r, int hi) { return (r & 3) + 8 * (r >> 2) + 4 * hi; }
__device__ __forceinline__ float wave_sum(float v) {
#pragma unroll
  for (int o = 32; o >= 1; o >>= 1) v += __shfl_xor(v, o);
  return v;
}
__device__ __forceinline__ float silu_f(float x) { return x * __builtin_amdgcn_rcpf(1.f + __expf(-x)); }
__device__ __forceinline__ float gelu_tanh_f(float x) {
  const float u = 0.7978845608028654f * (x + 0.044715f * x * x * x);
  const float t = 1.f - 2.f * __builtin_amdgcn_rcpf(__expf(2.f * u) + 1.f);
  return 0.5f * x * (1.f + t);
}
__device__ __forceinline__ int logical_block() {
  const int g = gridDim.x, b = blockIdx.x;
  return (g & 7) ? b : (b & 7) * (g >> 3) + (b >> 3);
}

constexpr int LDS_ROWB = 144;
constexpr int LDS_A = 256 * LDS_ROWB;
constexpr int LDS_B = 128 * LDS_ROWB;
constexpr int LDS_STAGE = LDS_A + LDS_B;
constexpr int L2_A = 256 * LDS_ROWB;
constexpr int L2_STAGE = 2 * L2_A;
constexpr int LDS_RED = 2 * L2_STAGE;
constexpr int SMEM_BYTES = LDS_RED + 2048 + 2048;

struct LdPlain {
  const bf16_t* p; size_t rs;
  __device__ __forceinline__ u32x4 ld(int kt, int i) const { return *(const u32x4*)(p + (size_t)i * rs + kt * 64); }
};
__device__ __forceinline__ LdPlain mkPlain(const bf16_t* base, int ld) {
  const int tid = tid_fresh();
  LdPlain l; l.p = base + (size_t)(tid >> 3) * ld + (tid & 7) * 8; l.rs = (size_t)64 * ld; return l;
}
struct LdSplit {
  const bf16_t* p0; const bf16_t* p1; size_t rs; int kts;
  __device__ __forceinline__ u32x4 ld(int kt, int i) const {
    const bf16_t* q = (kt < kts) ? (p0 + kt * 64) : (p1 + (kt - kts) * 64);
    return *(const u32x4*)(q + (size_t)i * rs);
  }
};
__device__ __forceinline__ LdSplit mkSplit(const bf16_t* b0, const bf16_t* b1, int ld, int kts) {
  const int tid = tid_fresh(); const size_t o = (size_t)(tid >> 3) * ld + (tid & 7) * 8;
  LdSplit l; l.p0 = b0 + o; l.p1 = b1 + o; l.rs = (size_t)64 * ld; l.kts = kts; return l;
}
struct LdFold {
  const bf16_t* f; const bf16_t* r; size_t rs; float sg;
  __device__ __forceinline__ u32x4 ld(int kt, int i) const {
    const u32x4 a = *(const u32x4*)(f + (size_t)i * rs + kt * 64);
    const u32x4 b = *(const u32x4*)(r + (size_t)i * rs + kt * 64);
    u32x4 o;
    o[0] = cvtpk(bf_lo(a[0]) + sg * bf_lo(b[0]), bf_hi(a[0]) + sg * bf_hi(b[0]));
    o[1] = cvtpk(bf_lo(a[1]) + sg * bf_lo(b[1]), bf_hi(a[1]) + sg * bf_hi(b[1]));
    o[2] = cvtpk(bf_lo(a[2]) + sg * bf_lo(b[2]), bf_hi(a[2]) + sg * bf_hi(b[2]));
    o[3] = cvtpk(bf_lo(a[3]) + sg * bf_lo(b[3]), bf_hi(a[3]) + sg * bf_hi(b[3]));
    return o;
  }
};
__device__ __forceinline__ LdFold mkFold(const bf16_t* f, const bf16_t* r, int ld, float sg) {
  const int tid = tid_fresh(); const size_t o = (size_t)(tid >> 3) * ld + (tid & 7) * 8;
  LdFold l; l.f = f + o; l.r = r + o; l.rs = (size_t)64 * ld; l.sg = sg; return l;
}

template <class LA, class LB>
__device__ __forceinline__ void gemm_mainloop(const LA& la, const LB& lb, int KT, char* smem, f32x16 (&acc)[2][2]) {
  const int tid = tid_fresh(), wid = tid >> 6, lane = tid & 63, r32 = lane & 31, hi = lane >> 5, wm = wid >> 1, wn = wid & 1;
#pragma unroll
  for (int mi = 0; mi < 2; ++mi)
#pragma unroll
    for (int nj = 0; nj < 2; ++nj)
#pragma unroll
      for (int r = 0; r < 16; ++r) acc[mi][nj][r] = 0.f;
  const int st_off = (tid >> 3) * LDS_ROWB + (tid & 7) * 16;
  const int a_rd = (wm * 64 + r32) * LDS_ROWB + hi * 16;
  const int b_rd = LDS_A + (wn * 32 + r32) * LDS_ROWB + hi * 16;
  u32x4 ra0, ra1, ra2, ra3, rb0, rb1;
  ra0 = la.ld(0, 0); ra1 = la.ld(0, 1); ra2 = la.ld(0, 2); ra3 = la.ld(0, 3); rb0 = lb.ld(0, 0); rb1 = lb.ld(0, 1);
  {
    char* s = smem + st_off;
    *(u32x4*)(s) = ra0; *(u32x4*)(s + 64 * LDS_ROWB) = ra1; *(u32x4*)(s + 128 * LDS_ROWB) = ra2; *(u32x4*)(s + 192 * LDS_ROWB) = ra3;
    *(u32x4*)(s + LDS_A) = rb0; *(u32x4*)(s + LDS_A + 64 * LDS_ROWB) = rb1;
  }
  __syncthreads();
#define GEMM_COMPUTE(SB)                                                                              \
  _Pragma("unroll") for (int kk = 0; kk < 4; ++kk) {                                                  \
    const bf16x8 a0 = *(const bf16x8*)((SB) + a_rd + kk * 32);                                        \
    const bf16x8 a1 = *(const bf16x8*)((SB) + a_rd + 32 * LDS_ROWB + kk * 32);                        \
    const bf16x8 b0 = *(const bf16x8*)((SB) + b_rd + kk * 32);                                        \
    const bf16x8 b1 = *(const bf16x8*)((SB) + b_rd + 64 * LDS_ROWB + kk * 32);                        \
    acc[0][0] = __builtin_amdgcn_mfma_f32_32x32x16_bf16(b0, a0, acc[0][0], 0, 0, 0);                  \
    acc[0][1] = __builtin_amdgcn_mfma_f32_32x32x16_bf16(b1, a0, acc[0][1], 0, 0, 0);                  \
    acc[1][0] = __builtin_amdgcn_mfma_f32_32x32x16_bf16(b0, a1, acc[1][0], 0, 0, 0);                  \
    acc[1][1] = __builtin_amdgcn_mfma_f32_32x32x16_bf16(b1, a1, acc[1][1], 0, 0, 0);                  \
  }
#define GEMM_LOAD(KT_) do { ra0 = la.ld((KT_), 0); ra1 = la.ld((KT_), 1); ra2 = la.ld((KT_), 2); ra3 = la.ld((KT_), 3); rb0 = lb.ld((KT_), 0); rb1 = lb.ld((KT_), 1); } while (0)
#define GEMM_WRITE(ST) do { char* s = smem + (ST) * LDS_STAGE + st_off;                                \
    *(u32x4*)(s) = ra0; *(u32x4*)(s + 64 * LDS_ROWB) = ra1; *(u32x4*)(s + 128 * LDS_ROWB) = ra2; *(u32x4*)(s + 192 * LDS_ROWB) = ra3; \
    *(u32x4*)(s + LDS_A) = rb0; *(u32x4*)(s + LDS_A + 64 * LDS_ROWB) = rb1; } while (0)
#pragma unroll 1
  for (int kt = 0; kt < KT; kt += 2) {
    GEMM_LOAD(kt + 1);
    GEMM_COMPUTE(smem);
    GEMM_WRITE(1);
    __syncthreads();
    GEMM_LOAD(kt + 2 < KT ? kt + 2 : kt);
    GEMM_COMPUTE(smem + LDS_STAGE);
    GEMM_WRITE(0);
    __syncthreads();
  }
#undef GEMM_COMPUTE
#undef GEMM_LOAD
#undef GEMM_WRITE
}

template <class LA, class LB>
__device__ __forceinline__ void gemm2(const LA& la, const LB& lb, int KT, char* smem, f32x16 (&acc)[2][4]) {
  const int tid = tid_fresh(), wid = tid >> 6, lane = tid & 63, r32 = lane & 31, hi = lane >> 5, wm = wid >> 1, wn = wid & 1;
#pragma unroll
  for (int mi = 0; mi < 2; ++mi)
#pragma unroll
    for (int nj = 0; nj < 4; ++nj)
#pragma unroll
      for (int r = 0; r < 16; ++r) acc[mi][nj][r] = 0.f;
  const int st_off = (tid >> 3) * LDS_ROWB + (tid & 7) * 16;
  const int a_rd = (wm * 64 + r32) * LDS_ROWB + hi * 16;
  const int b_rd = L2_A + (wn * 128 + r32) * LDS_ROWB + hi * 16;
  u32x4 xa0, xa1, xa2, xa3, xb0, xb1, xb2, xb3, ya0, ya1, ya2, ya3, yb0, yb1, yb2, yb3;
#define G2_LOADX(KT_) do { xa0 = la.ld((KT_), 0); xa1 = la.ld((KT_), 1); xa2 = la.ld((KT_), 2); xa3 = la.ld((KT_), 3); xb0 = lb.ld((KT_), 0); xb1 = lb.ld((KT_), 1); xb2 = lb.ld((KT_), 2); xb3 = lb.ld((KT_), 3); } while (0)
#define G2_LOADY(KT_) do { ya0 = la.ld((KT_), 0); ya1 = la.ld((KT_), 1); ya2 = la.ld((KT_), 2); ya3 = la.ld((KT_), 3); yb0 = lb.ld((KT_), 0); yb1 = lb.ld((KT_), 1); yb2 = lb.ld((KT_), 2); yb3 = lb.ld((KT_), 3); } while (0)
#define G2_W2(ST, P, R0, R1, O0, O1) do { char* s_ = smem + (ST) * L2_STAGE + st_off; *(u32x4*)(s_ + (O0)) = P##R0; *(u32x4*)(s_ + (O1)) = P##R1; } while (0)
#define G2_WRITE(ST, P) do { G2_W2(ST, P, a0, a1, 0, 64 * LDS_ROWB); G2_W2(ST, P, a2, a3, 128 * LDS_ROWB, 192 * LDS_ROWB); \
    G2_W2(ST, P, b0, b1, L2_A, L2_A + 64 * LDS_ROWB); G2_W2(ST, P, b2, b3, L2_A + 128 * LDS_ROWB, L2_A + 192 * LDS_ROWB); } while (0)
#define G2_LDA(SB, kk, A0, A1) do { A0 = *(const bf16x8*)((SB) + a_rd + (kk) * 32); A1 = *(const bf16x8*)((SB) + a_rd + 32 * LDS_ROWB + (kk) * 32); } while (0)
#define G2_STEPP(SB, kk, A0, A1, N0, N1, HASNEXT) do {                                                \
    if (HASNEXT) G2_LDA(SB, (kk) + 1, N0, N1);                                                        \
    _Pragma("unroll") for (int nj = 0; nj < 4; ++nj) {                                                \
      const bf16x8 b_ = *(const bf16x8*)((SB) + b_rd + nj * 32 * LDS_ROWB + (kk) * 32);               \
      acc[0][nj] = __builtin_amdgcn_mfma_f32_32x32x16_bf16(b_, A0, acc[0][nj], 0, 0, 0);              \
      acc[1][nj] = __builtin_amdgcn_mfma_f32_32x32x16_bf16(b_, A1, acc[1][nj], 0, 0, 0);              \
    } } while (0)
#define G2_COMPUTE_W(SB, ST, P) do { bf16x8 p0_, p1_, q0_, q1_;                                        \
    G2_LDA(SB, 0, p0_, p1_);                                                                          \
    G2_STEPP(SB, 0, p0_, p1_, q0_, q1_, 1); G2_W2(ST, P, a0, a1, 0, 64 * LDS_ROWB);                   \
    G2_STEPP(SB, 1, q0_, q1_, p0_, p1_, 1); G2_W2(ST, P, a2, a3, 128 * LDS_ROWB, 192 * LDS_ROWB);     \
    G2_STEPP(SB, 2, p0_, p1_, q0_, q1_, 1); G2_W2(ST, P, b0, b1, L2_A, L2_A + 64 * LDS_ROWB);         \
    G2_STEPP(SB, 3, q0_, q1_, p0_, p1_, 0); G2_W2(ST, P, b2, b3, L2_A + 128 * LDS_ROWB, L2_A + 192 * LDS_ROWB); } while (0)
  G2_LOADX(0); G2_LOADY(1);
  G2_WRITE(0, x);
  __syncthreads();
  G2_LOADX(2 < KT ? 2 : 0);
#pragma unroll 1
  for (int kt = 0; kt < KT; kt += 2) {
    G2_COMPUTE_W(smem, 1, y);
    __syncthreads();
    G2_LOADY(kt + 3 < KT ? kt + 3 : KT - 1);
    G2_COMPUTE_W(smem + L2_STAGE, 0, x);
    __syncthreads();
    G2_LOADX(kt + 4 < KT ? kt + 4 : KT - 2);
  }
#undef G2_LOADX
#undef G2_LOADY
#undef G2_WRITE
#undef G2_W2
#undef G2_STEPP
#undef G2_LDA
#undef G2_COMPUTE_W
}
template <class F>
__device__ __forceinline__ void epi2_foreach(const f32x16 (&acc)[2][4], F&& f) {
  const int tid = tid_fresh(), wid = tid >> 6, lane = tid & 63, r32 = lane & 31, hi = lane >> 5, wm = wid >> 1, wn = wid & 1;
#pragma unroll
  for (int mi = 0; mi < 2; ++mi)
#pragma unroll
    for (int nj = 0; nj < 4; ++nj)
#pragma unroll
      for (int q = 0; q < 4; ++q)
        f(wm * 64 + mi * 32 + r32, wn * 128 + nj * 32 + q * 8 + hi * 4, acc[mi][nj][4 * q + 0], acc[mi][nj][4 * q + 1],
          acc[mi][nj][4 * q + 2], acc[mi][nj][4 * q + 3]);
}

template <class F>
__device__ __forceinline__ void epi_foreach(const f32x16 (&acc)[2][2], F&& f) {
  const int tid = tid_fresh(), wid = tid >> 6, lane = tid & 63, r32 = lane & 31, hi = lane >> 5, wm = wid >> 1, wn = wid & 1;
#pragma unroll
  for (int mi = 0; mi < 2; ++mi)
#pragma unroll
    for (int nj = 0; nj < 2; ++nj)
#pragma unroll
      for (int q = 0; q < 4; ++q)
        f(wm * 64 + mi * 32 + r32, nj * 64 + wn * 32 + q * 8 + hi * 4, acc[mi][nj][4 * q + 0], acc[mi][nj][4 * q + 1],
          acc[mi][nj][4 * q + 2], acc[mi][nj][4 * q + 3]);
}
__device__ __forceinline__ void st_bf4(bf16_t* p, float a, float b, float c, float d) {
  u32x2 w = {cvtpk(a, b), cvtpk(c, d)}; *(u32x2*)p = w;
}

__device__ __forceinline__ void tr_tile(const float* src, bf16_t* dst, int K, int N, int kt, int nt, float* tile) {
  const int tid = tid_fresh(), k0 = kt * 64, n0 = nt * 64;
#pragma unroll
  for (int j = 0; j < 8; ++j) { const int e = j * 512 + tid, r = e >> 6, c = e & 63; tile[r * 65 + c] = src[(size_t)(k0 + r) * N + n0 + c]; }
  __syncthreads();
  const int rn = tid >> 3, ck = (tid & 7) * 8;
  const float v0 = tile[(ck + 0) * 65 + rn], v1 = tile[(ck + 1) * 65 + rn], v2 = tile[(ck + 2) * 65 + rn], v3 = tile[(ck + 3) * 65 + rn];
  const float v4 = tile[(ck + 4) * 65 + rn], v5 = tile[(ck + 5) * 65 + rn], v6 = tile[(ck + 6) * 65 + rn], v7 = tile[(ck + 7) * 65 + rn];
  u32x4 w = {cvtpk(v0, v1), cvtpk(v2, v3), cvtpk(v4, v5), cvtpk(v6, v7)};
  *(u32x4*)(dst + (size_t)(n0 + rn) * K + k0 + ck) = w;
  __syncthreads();
}

__device__ __forceinline__ void phase0(const Params& p, char* smem) {
  const int tid = tid_fresh(), G = gridDim.x, bid = blockIdx.x;
  char* ws = p.ws;
  {
    float* s = (float*)smem;
    float* part = (float*)(smem + 17 * 1024 * 4);
    float* MOD = (float*)(ws + OFF_MOD);
    for (int u = bid; u < 96; u += G) {
      const int l = u / 48, j0 = (u % 48) * 64;
      for (int e = tid; e < 17 * 1024; e += 512) { const int r = e >> 10, k = e & 1023; const float cv = (r < 16) ? p.c[r * 1024 + k] : p.c_ctx[k]; s[e] = silu_f(cv); }
      __syncthreads();
      const int col = tid & 63, ks = tid >> 6;
      float a0 = 0, a1 = 0, a2 = 0, a3 = 0, a4 = 0, a5 = 0, a6 = 0, a7 = 0, a8 = 0, a9 = 0, a10 = 0, a11 = 0, a12 = 0, a13 = 0, a14 = 0, a15 = 0, a16 = 0;
      const float* w = p.w_mod + (size_t)l * 1024 * 3072 + j0 + col;
#pragma unroll 4
      for (int k = ks * 128; k < ks * 128 + 128; ++k) {
        const float wv = w[(size_t)k * 3072];
        a0 += s[0 * 1024 + k] * wv; a1 += s[1 * 1024 + k] * wv; a2 += s[2 * 1024 + k] * wv; a3 += s[3 * 1024 + k] * wv;
        a4 += s[4 * 1024 + k] * wv; a5 += s[5 * 1024 + k] * wv; a6 += s[6 * 1024 + k] * wv; a7 += s[7 * 1024 + k] * wv;
        a8 += s[8 * 1024 + k] * wv; a9 += s[9 * 1024 + k] * wv; a10 += s[10 * 1024 + k] * wv; a11 += s[11 * 1024 + k] * wv;
        a12 += s[12 * 1024 + k] * wv; a13 += s[13 * 1024 + k] * wv; a14 += s[14 * 1024 + k] * wv; a15 += s[15 * 1024 + k] * wv;
        a16 += s[16 * 1024 + k] * wv;
      }
      float* pp = part + ks * 17 * 64 + col;
      pp[0 * 64] = a0; pp[1 * 64] = a1; pp[2 * 64] = a2; pp[3 * 64] = a3; pp[4 * 64] = a4; pp[5 * 64] = a5; pp[6 * 64] = a6; pp[7 * 64] = a7;
      pp[8 * 64] = a8; pp[9 * 64] = a9; pp[10 * 64] = a10; pp[11 * 64] = a11; pp[12 * 64] = a12; pp[13 * 64] = a13; pp[14 * 64] = a14; pp[15 * 64] = a15;
      pp[16 * 64] = a16;
      __syncthreads();
      for (int e = tid; e < 17 * 64; e += 512) {
        const int r = e >> 6, cc = e & 63;
        float t = p.b_mod[l * 3072 + j0 + cc];
#pragma unroll
        for (int q = 0; q < 8; ++q) t += part[q * 17 * 64 + r * 64 + cc];
        MOD[(size_t)(l * 17 + r) * 3072 + j0 + cc] = t;
      }
      __syncthreads();
    }
  }
  {
    float* tile = (float*)smem;
    constexpr int T0 = 16 * 88, T1 = 32 * 16, T2 = 16 * 64, T3 = 32 * 16;
    for (int u = bid; u < T0 + T1 + T2 + T3; u += G) {
      if (u < T0) tr_tile(p.e_w_in, (bf16_t*)(ws + OFF_WT_EIN), 1024, EVEN_IN, u / 88, u % 88, tile);
      else if (u < T0 + T1) { const int v = u - T0; tr_tile(p.e_w_out, (bf16_t*)(ws + OFF_WT_EOUT), 2048, 1024, v / 16, v % 16, tile); }
      else if (u < T0 + T1 + T2) { const int v = u - T0 - T1; tr_tile(p.o_w_in, (bf16_t*)(ws + OFF_WT_OIN), 1024, ODD_IN, v / 64, v % 64, tile); }
      else { const int v = u - T0 - T1 - T2; tr_tile(p.o_w_out, (bf16_t*)(ws + OFF_WT_OOUT), 2048, 1024, v / 16, v % 16, tile); }
    }
  }
  {
    const long gt = (long)bid * 512 + tid, gn = (long)G * 512;
    bf16_t* TC = (bf16_t*)(ws + OFF_TAB_C); bf16_t* TS = (bf16_t*)(ws + OFF_TAB_S);
    for (long e = gt; e < 1280L * 1024; e += gn) {
      const int tp = (int)(e >> 10), t = (int)(e & 1023);
      float v = 0.f;
      if (tp <= 1024) { const int m = (tp * t) & 2047; v = cospif((float)m * (1.f / 1024.f)); }
      TC[e] = f2bf(v);
    }
    for (long e = gt; e < 1024L * 1024; e += gn) {
      const int tp = (int)(e >> 10), t = (int)(e & 1023);
      const int m = (tp * t) & 2047;
      TS[e] = f2bf(sinpif((float)m * (1.f / 1024.f)));
    }
    bf16_t* CDM = (bf16_t*)(ws + OFF_CDM); bf16_t* CDP = (bf16_t*)(ws + OFF_CDP);
    for (long e = gt; e < 128L * 256; e += gn) {
      const int cp = (int)(e >> 8), k = (int)(e & 255);
      const int m = (cp * (k & 127)) & 127;
      const float x = (float)m * (1.f / 64.f);
      float vm, vp;
      if (k < 128) { vm = cospif(x); vp = vm; } else { vp = sinpif(x); vm = -vp; }
      CDM[e] = f2bf(vm); CDP[e] = f2bf(vp);
    }
    bf16_t* WSB = (bf16_t*)(ws + OFF_WSB);
    for (long e = gt; e < 8L * 128 * 128; e += gn) WSB[e] = f2bf(p.e_ws[e]);
    float2* ROPE = (float2*)(ws + OFF_ROPE);
    for (long e = gt; e < 64L * 32; e += gn) {
      const int pos = (int)(e >> 5), i = (int)(e & 31);
      const float inv = powf(10000.f, -(float)i / 32.f);
      const float ang = (float)pos * inv;
      ROPE[e] = make_float2(cosf(ang), sinf(ang));
    }
  }
}

__device__ __forceinline__ void ln_rows_modulate(const float* src, bf16_t* dst, int nrows, int rows_per_b, const float* mod17, int fixed_row) {
  const int tid = tid_fresh(), wid = tid >> 6, lane = tid & 63;
  const int gw = blockIdx.x * 8 + wid, nw = gridDim.x * 8;
  float4 n0, n1, n2, n3;
  { const int r0 = gw < nrows ? gw : 0; const float4* ps = (const float4*)(src + (size_t)r0 * 1024); n0 = ps[lane]; n1 = ps[lane + 64]; n2 = ps[lane + 128]; n3 = ps[lane + 192]; }
  for (int row = gw; row < nrows; row += nw) {
    float4 v0 = n0, v1 = n1, v2 = n2, v3 = n3;
    { const int nr = (row + nw < nrows) ? row + nw : row;
      const float4* ps = (const float4*)(src + (size_t)nr * 1024); n0 = ps[lane]; n1 = ps[lane + 64]; n2 = ps[lane + 128]; n3 = ps[lane + 192]; }
    float s = v0.x + v0.y + v0.z + v0.w + v1.x + v1.y + v1.z + v1.w + v2.x + v2.y + v2.z + v2.w + v3.x + v3.y + v3.z + v3.w;
    const float mu = wave_sum(s) * (1.f / 1024.f);
    v0.x -= mu; v0.y -= mu; v0.z -= mu; v0.w -= mu; v1.x -= mu; v1.y -= mu; v1.z -= mu; v1.w -= mu;
    v2.x -= mu; v2.y -= mu; v2.z -= mu; v2.w -= mu; v3.x -= mu; v3.y -= mu; v3.z -= mu; v3.w -= mu;
    float q = v0.x * v0.x + v0.y * v0.y + v0.z * v0.z + v0.w * v0.w + v1.x * v1.x + v1.y * v1.y + v1.z * v1.z + v1.w * v1.w +
              v2.x * v2.x + v2.y * v2.y + v2.z * v2.z + v2.w * v2.w + v3.x * v3.x + v3.y * v3.y + v3.z * v3.z + v3.w * v3.w;
    const float rstd = rsqrtf(wave_sum(q) * (1.f / 1024.f) + EPS);
    const int mr = (fixed_row >= 0) ? fixed_row : (row / rows_per_b);
    const float* md = mod17 + (size_t)mr * 3072;
    bf16_t* pd = dst + (size_t)row * 1024;
#define MODST(V, J) { const int col = (lane + 64 * J) * 4; const float4 sh = *(const float4*)(md + col); const float4 sc = *(const float4*)(md + 1024 + col); \
      st_bf4(pd + col, V.x * rstd * (1.f + sc.x) + sh.x, V.y * rstd * (1.f + sc.y) + sh.y, V.z * rstd * (1.f + sc.z) + sh.z, V.w * rstd * (1.f + sc.w) + sh.w); }
    MODST(v0, 0) MODST(v1, 1) MODST(v2, 2) MODST(v3, 3)
#undef MODST
  }
}

__device__ __forceinline__ void phase2(const Params& p, char* smem) {
  char* ws = p.ws;
  const bf16_t* M0 = (const bf16_t*)(ws + OFF_M0); const bf16_t* MC = (const bf16_t*)(ws + OFF_MC);
  const bf16_t* WT = (const bf16_t*)(ws + OFF_WT_EIN);
  bf16_t* Q = (bf16_t*)(ws + OFF_Q); bf16_t* KA = (bf16_t*)(ws + OFF_KALL); bf16_t* VA = (bf16_t*)(ws + OFF_VALL);
  bf16_t* BU = (bf16_t*)(ws + OFF_BU); bf16_t* BV = (bf16_t*)(ws + OFF_BV); bf16_t* SG = (bf16_t*)(ws + OFF_SG);
  const float2* ROPE = (const float2*)(ws + OFF_ROPE);
  const int tid = tid_fresh(), wid = tid >> 6, lane = tid & 63, r32 = lane & 31, hi = lane >> 5, wm = wid >> 1, wn = wid & 1;
  const int lb = logical_block();
  for (int u = lb; u < 2816 + 32; u += gridDim.x) {
    const bool isctx = (u >= 2816);
    int mt, nt;
    if (!isctx) { mt = u / 22; nt = u % 22; } else { const int v = u - 2816; mt = v >> 1; nt = 4 + (v & 1); }
    const bf16_t* A = (isctx ? MC : M0) + (size_t)mt * 256 * 1024;
    f32x16 acc[2][4];
    gemm2(mkPlain(A, 1024), mkPlain(WT + (size_t)nt * 256 * 1024, 1024), 16, smem, acc);
    if (nt < 5) {
      const bool isq = nt < 4;
      const int head = isq ? (nt * 2 + wn) : wn;
      const float* gv = isq ? p.e_qn : p.e_kn;
#pragma unroll
      for (int mi = 0; mi < 2; ++mi) {
        float ss = 0.f;
#pragma unroll
        for (int nj = 0; nj < 4; ++nj)
#pragma unroll
          for (int r = 0; r < 16; ++r) ss += acc[mi][nj][r] * acc[mi][nj][r];
        ss += __shfl_xor(ss, 32);
        const float rstd = rsqrtf(ss * (1.f / 128.f) + EPS);
        const int row = wm * 64 + mi * 32 + r32;
        int t = 0; size_t obase;
        if (!isctx) {
          const int b = mt >> 3; t = (mt & 7) * 256 + row;
          if (isq) obase = ((size_t)(b * SEQ + t) * 8 + head) * 128;
          else obase = ((size_t)(b * SKV + CTXL + t) * 2 + head) * 128;
        } else {
          obase = ((size_t)(mt * SKV + row) * 2 + head) * 128;
        }
        bf16_t* dst = (isq ? Q : KA) + obase;
#pragma unroll
        for (int nj = 0; nj < 2; ++nj) {
          const int pos = (nj == 0) ? (t >> 6) : (t & 63);
#pragma unroll
          for (int q = 0; q < 4; ++q) {
            float o1[4], o2[4];
#pragma unroll
            for (int e = 0; e < 4; ++e) {
              const int r = 4 * q + e;
              const int i = 8 * q + 4 * hi + e;
              const int d = nj * 32 + i;
              const float x1 = acc[mi][nj][r] * rstd * gv[d];
              const float x2 = acc[mi][nj + 2][r] * rstd * gv[64 + d];
              if (!isctx) {
                const float2 cs = ROPE[pos * 32 + i];
                o1[e] = x1 * cs.x - x2 * cs.y; o2[e] = x2 * cs.x + x1 * cs.y;
              } else { o1[e] = x1; o2[e] = x2; }
            }
            const int d0 = nj * 32 + 8 * q + 4 * hi;
            st_bf4(dst + d0, o1[0], o1[1], o1[2], o1[3]);
            st_bf4(dst + 64 + d0, o2[0], o2[1], o2[2], o2[3]);
          }
        }
      }
    } else if (nt == 5) {
      epi2_foreach(acc, [&](int row, int col, float a, float b, float c, float d) {
        size_t tokrow;
        if (!isctx) { const int bb = mt >> 3, t = (mt & 7) * 256 + row; tokrow = (size_t)bb * SKV + CTXL + t; } else tokrow = (size_t)mt * SKV + row;
        st_bf4(VA + tokrow * 256 + col, a, b, c, d);
      });
    } else if (nt < 14) {
      bf16_t* dst = (nt < 10) ? (BU + (size_t)(nt - 6) * 256) : (BV + (size_t)(nt - 10) * 256);
      epi2_foreach(acc, [&](int row, int col, float a, float b, float c, float d) {
        st_bf4(dst + (size_t)(mt * 256 + row) * 1024 + col, gelu_tanh_f(a), gelu_tanh_f(b), gelu_tanh_f(c), gelu_tanh_f(d));
      });
    } else {
      bf16_t* dst = SG + (size_t)(nt - 14) * 256;
      epi2_foreach(acc, [&](int row, int col, float a, float b, float c, float d) {
        st_bf4(dst + (size_t)(mt * 256 + row) * 2048 + col, silu_f(a), silu_f(b), silu_f(c), silu_f(d));
      });
    }
  }
}

namespace att {
constexpr int D = 128, NW = 8, QBLK = 32, KVBLK = 64;
constexpr float SCALE = 0.088388347648318440f;
constexpr float THR = 8.f;
constexpr int LDQ = 1024, LDK = 256;
constexpr int SHM_V = KVBLK * D * 2, SHM_K = KVBLK * D * 2;
#define KSWZ(row, colB) ((row) * 256 + ((colB) ^ (((row) & 7) << 4)))
#define SBAR() __builtin_amdgcn_sched_barrier(0)
__device__ __forceinline__ void partialSM(f32x16& p0, f32x16& p1, float& m_reg, float& mn, float& alpha) {
  constexpr float C = SCALE * 1.4426950408889634f;
  float pmax = p0[0];
#pragma unroll
  for (int r = 1; r < 16; ++r) pmax = fmaxf(pmax, p0[r]);
#pragma unroll
  for (int r = 0; r < 16; ++r) pmax = fmaxf(pmax, p1[r]);
  { auto rr = __builtin_amdgcn_permlane32_swap(__float_as_uint(pmax), __float_as_uint(pmax), false, false);
    pmax = fmaxf(__uint_as_float(rr[0]), __uint_as_float(rr[1])); }
  if (__builtin_expect(__all(pmax - m_reg <= THR / SCALE), 1)) { mn = m_reg; alpha = 1.f; }
  else { mn = fmaxf(m_reg, pmax); alpha = __builtin_amdgcn_exp2f((m_reg - mn) * C); m_reg = mn; }
  const float mnC = -mn * C;
#pragma unroll
  for (int r = 0; r < 16; ++r) p0[r] = fmaf(p0[r], C, mnC);
#pragma unroll
  for (int r = 0; r < 16; ++r) p1[r] = fmaf(p1[r], C, mnC);
#pragma unroll
  for (int r = 0; r < 16; ++r) p0[r] = __builtin_amdgcn_exp2f(p0[r]);
}
__device__ __forceinline__ void finishSM(f32x16& p0, f32x16& p1, float alpha, float& l_reg, bf16x8& pa0, bf16x8& pa1, bf16x8& pa2, bf16x8& pa3) {
#pragma unroll
  for (int r = 0; r < 16; ++r) p1[r] = __builtin_amdgcn_exp2f(p1[r]);
  float ps = 0;
#pragma unroll
  for (int r = 0; r < 16; ++r) ps += p0[r];
#pragma unroll
  for (int r = 0; r < 16; ++r) ps += p1[r];
  { auto rr = __builtin_amdgcn_permlane32_swap(__float_as_uint(ps), __float_as_uint(ps), false, false);
    ps = __uint_as_float(rr[0]) + __uint_as_float(rr[1]); }
  l_reg = l_reg * alpha + ps;
#define PK4(P, BASE, OUT) do { unsigned a0 = cvtpk(P[BASE + 0], P[BASE + 1]), a1 = cvtpk(P[BASE + 2], P[BASE + 3]);   \
    unsigned b0 = cvtpk(P[BASE + 4], P[BASE + 5]), b1 = cvtpk(P[BASE + 6], P[BASE + 7]);                              \
    auto r0 = __builtin_amdgcn_permlane32_swap(a0, b0, false, false); auto r1 = __builtin_amdgcn_permlane32_swap(a1, b1, false, false); \
    u32x4 w = {r0[0], r1[0], r0[1], r1[1]}; OUT = *reinterpret_cast<bf16x8*>(&w); } while (0)
  PK4(p0, 0, pa0); PK4(p0, 8, pa1); PK4(p1, 0, pa2); PK4(p1, 8, pa3);
#undef PK4
}
__device__ __forceinline__ void qkt(f32x16& p0, f32x16& p1, const bf16_t* Ks, const bf16x8* qr, int r32, int hi) {
#pragma unroll
  for (int r = 0; r < 16; ++r) { p0[r] = 0.f; p1[r] = 0.f; }
#pragma unroll
  for (int d0 = 0; d0 < 8; ++d0) { const int cb = (d0 * 16 + hi * 8) * 2;
    bf16x8 b0 = *reinterpret_cast<const bf16x8*>((const char*)Ks + KSWZ(r32, cb));
    bf16x8 b1 = *reinterpret_cast<const bf16x8*>((const char*)Ks + KSWZ(32 + r32, cb));
    p0 = __builtin_amdgcn_mfma_f32_32x32x16_bf16(b0, qr[d0], p0, 0, 0, 0);
    p1 = __builtin_amdgcn_mfma_f32_32x32x16_bf16(b1, qr[d0], p1, 0, 0, 0); }
}
__device__ __forceinline__ int v_st(int k, int c) { const int kk = (k & ~0xC) | ((k & 4) << 1) | ((k & 8) >> 1); return ((kk >> 3) * 4 + (c >> 5)) * 512 + ((kk & 7) * 32 + (c & 31)) * 2; }
__device__ __forceinline__ int v_rd_base(int lane) { return ((lane & 3) << 3) | (((lane >> 2) & 3) << 6) | (((lane >> 4) & 1) << 5) | (((lane >> 5) & 1) << 8); }
constexpr int v_rd_off(int d0, int ks, int half) { return d0 * 512 + ks * 4096 + half * 2048; }
template <int OFF> __device__ __forceinline__ s16x4 tr_read(int vb) {
  s16x4 r; asm volatile("ds_read_b64_tr_b16 %0, %1 offset:%2" : "=&v"(r) : "v"(vb), "i"(OFF) : "memory"); return r;
}
template <int D0> __device__ __forceinline__ void pv_one(f32x16& od, int vb, bf16x8 pa0, bf16x8 pa1, bf16x8 pa2, bf16x8 pa3) {
  const s16x4 l0 = tr_read<v_rd_off(D0, 0, 0)>(vb), h0 = tr_read<v_rd_off(D0, 0, 1)>(vb), l1 = tr_read<v_rd_off(D0, 1, 0)>(vb), h1 = tr_read<v_rd_off(D0, 1, 1)>(vb);
  const s16x4 l2 = tr_read<v_rd_off(D0, 2, 0)>(vb), h2 = tr_read<v_rd_off(D0, 2, 1)>(vb), l3 = tr_read<v_rd_off(D0, 3, 0)>(vb), h3 = tr_read<v_rd_off(D0, 3, 1)>(vb);
  asm volatile("s_waitcnt lgkmcnt(0)" ::: "memory"); SBAR();
#define PK(L, H) (bf16x8){L[0], L[1], L[2], L[3], H[0], H[1], H[2], H[3]}
  od = __builtin_amdgcn_mfma_f32_32x32x16_bf16(pa0, PK(l0, h0), od, 0, 0, 0);
  od = __builtin_amdgcn_mfma_f32_32x32x16_bf16(pa1, PK(l1, h1), od, 0, 0, 0);
  od = __builtin_amdgcn_mfma_f32_32x32x16_bf16(pa2, PK(l2, h2), od, 0, 0, 0);
  od = __builtin_amdgcn_mfma_f32_32x32x16_bf16(pa3, PK(l3, h3), od, 0, 0, 0);
#undef PK
}
__device__ __forceinline__ void pv_d0(f32x16* o, int vb, bf16x8 pa0, bf16x8 pa1, bf16x8 pa2, bf16x8 pa3) {
  pv_one<0>(o[0], vb, pa0, pa1, pa2, pa3); pv_one<1>(o[1], vb, pa0, pa1, pa2, pa3); pv_one<2>(o[2], vb, pa0, pa1, pa2, pa3); pv_one<3>(o[3], vb, pa0, pa1, pa2, pa3);
}
__device__ __forceinline__ void attn_body(const bf16_t* __restrict__ Qb, const bf16_t* __restrict__ Kh, const bf16_t* __restrict__ Vh,
                                          bf16_t* GO, int seq, char* lds) {
  const int tid = tid_fresh(), wid = tid >> 6, lane = tid & 63, r32 = lane & 31, hi = lane >> 5;
  bf16_t* V_lds = (bf16_t*)lds; bf16_t* K_lds = (bf16_t*)(lds + 2 * SHM_V);
  float* wsx = (float*)(lds + 2 * SHM_V + 2 * SHM_K) + wid * 64; float* li_l = wsx; float* al_l = wsx + 32;
  float m_reg = -1e30f, l_reg = 0; f32x16 o[4]; bf16x8 qr[8];
#pragma unroll
  for (int d = 0; d < 4; ++d)
#pragma unroll
    for (int r = 0; r < 16; ++r) o[d][r] = 0.f;
  const bf16_t* Qw = Qb + (long)(wid * QBLK + r32) * LDQ + hi * 8;
#pragma unroll
  for (int d0 = 0; d0 < 8; ++d0) qr[d0] = *reinterpret_cast<const bf16x8*>(Qw + d0 * 16);
  const int sr = tid >> 4, sc = (tid & 15) * 8, vst0 = v_st(sr, sc), vst1 = v_st(32 + sr, sc);
  const int vb0 = (int)(uintptr_t)V_lds + v_rd_base(lane);
  constexpr int SDEPTH = 1;
  bf16x8 sv0[SDEPTH], sv1[SDEPTH], sk0[SDEPTH], sk1[SDEPTH];
#define SLOAD(i, k0) do { sv0[i] = *reinterpret_cast<const bf16x8*>(&Vh[(long)((k0) + sr) * LDK + sc]); sv1[i] = *reinterpret_cast<const bf16x8*>(&Vh[(long)((k0) + 32 + sr) * LDK + sc]); \
    sk0[i] = *reinterpret_cast<const bf16x8*>(&Kh[(long)((k0) + sr) * LDK + sc]); sk1[i] = *reinterpret_cast<const bf16x8*>(&Kh[(long)((k0) + 32 + sr) * LDK + sc]); } while (0)
#define SWRITE(b, i) do { *(bf16x8*)((char*)V_lds + (b) * SHM_V + vst0) = sv0[i];          \
    *(bf16x8*)((char*)V_lds + (b) * SHM_V + vst1) = sv1[i]; const int kc = sc * 2;               \
    *(bf16x8*)((char*)K_lds + (b) * SHM_K + KSWZ(sr, kc)) = sk0[i];                       \
    *(bf16x8*)((char*)K_lds + (b) * SHM_K + KSWZ(32 + sr, kc)) = sk1[i]; } while (0)
#define SWAIT() do { if (SDEPTH == 2) asm volatile("s_waitcnt vmcnt(4)" ::: "memory"); else asm volatile("s_waitcnt vmcnt(0)" ::: "memory"); } while (0)
#define RESC(a) do { if (__any((a) < 1.f)) { if (hi == 0) al_l[r32] = (a); asm volatile("s_waitcnt lgkmcnt(0)" ::: "memory"); \
    _Pragma("unroll") for (int d = 0; d < 4; ++d) _Pragma("unroll") for (int r = 0; r < 16; ++r) o[d][r] *= al_l[crow(r, hi)]; } } while (0)
  f32x16 pA0, pA1, pB0, pB1; float mnA, mnB, alA, alB; bf16x8 pa0, pa1, pa2, pa3; const int NT = seq / KVBLK;
  constexpr int SE = 0, SO = SDEPTH - 1;
  SLOAD(SE, 0); asm volatile("s_waitcnt vmcnt(0)" ::: "memory"); SWRITE(0, SE); __syncthreads();
  qkt(pA0, pA1, K_lds, qr, r32, hi); partialSM(pA0, pA1, m_reg, mnA, alA);
  SLOAD(SO, KVBLK); if (SDEPTH == 2) { if (2 < NT) SLOAD(SE, 2 * KVBLK); }
  SWAIT(); SWRITE(1, SO); __syncthreads();
  for (int j = 1; j + 1 < NT; j += 2) {
    SBAR(); qkt(pB0, pB1, (bf16_t*)((char*)K_lds + SHM_K), qr, r32, hi);
    finishSM(pA0, pA1, alA, l_reg, pa0, pa1, pa2, pa3); SBAR();
    SLOAD(SO, (j + SDEPTH) * KVBLK); SBAR();
    pv_d0(o, vb0, pa0, pa1, pa2, pa3); partialSM(pB0, pB1, m_reg, mnB, alB);
    __syncthreads(); SWAIT(); SWRITE(0, SE);
    RESC(alB); __syncthreads();
    SBAR(); qkt(pA0, pA1, K_lds, qr, r32, hi);
    finishSM(pB0, pB1, alB, l_reg, pa0, pa1, pa2, pa3); SBAR();
    if (SDEPTH == 1 || j + 3 < NT) SLOAD(SE, (j + 1 + SDEPTH) * KVBLK); SBAR();
    pv_d0(o, vb0 + (int)SHM_V, pa0, pa1, pa2, pa3); partialSM(pA0, pA1, m_reg, mnA, alA);
    __syncthreads(); SWAIT(); SWRITE(1, SO);
    RESC(alA); __syncthreads();
  }
  SBAR(); qkt(pB0, pB1, (bf16_t*)((char*)K_lds + SHM_K), qr, r32, hi);
  finishSM(pA0, pA1, alA, l_reg, pa0, pa1, pa2, pa3); SBAR();
  pv_d0(o, vb0, pa0, pa1, pa2, pa3); partialSM(pB0, pB1, m_reg, mnB, alB);
  __syncthreads(); RESC(alB);
  finishSM(pB0, pB1, alB, l_reg, pa0, pa1, pa2, pa3); SBAR();
  pv_d0(o, vb0 + (int)SHM_V, pa0, pa1, pa2, pa3);
  if (hi == 0) li_l[r32] = l_reg; asm volatile("s_waitcnt lgkmcnt(0)" ::: "memory");
  float rli[16];
#pragma unroll
  for (int r = 0; r < 16; ++r) rli[r] = __builtin_amdgcn_rcpf(li_l[crow(r, hi)]);
  bf16_t* Ow = GO + (long)(wid * QBLK) * 2048;
#pragma unroll
  for (int r = 0; r < 16; ++r) { const int orow = crow(r, hi);
#pragma unroll
    for (int d0 = 0; d0 < 4; ++d0) { bf16_t* q = Ow + (long)orow * 2048 + d0 * 32 + r32; *q = f2bf(o[d0][r] * rli[r] * bf2f(*q)); }
    SBAR(); }
  __syncthreads();
#undef SLOAD
#undef SWRITE
#undef SWAIT
#undef RESC
}
}

__device__ __forceinline__ void chunk_gate_unit(const Params& p, int b, int n, char* smem) {
  char* ws = p.ws;
  const bf16_t* BU = (const bf16_t*)(ws + OFF_BU); const bf16_t* BV = (const bf16_t*)(ws + OFF_BV);
  bf16_t* SG = (bf16_t*)(ws + OFF_SG); const bf16_t* WSB = (const bf16_t*)(ws + OFF_WSB);
  const int tid = tid_fresh(), wid = tid >> 6, lane = tid & 63, r32 = lane & 31, hi = lane >> 5;
  constexpr int RS = 272;
  char* sW = smem; char* sV = smem + 128 * RS;
  float* smu = (float*)(smem + 2 * 128 * RS); float* srs = smu + 128;
  const size_t tok0 = (size_t)b * SEQ + (size_t)n * 128;
  {
    const int q = tid >> 2, part = tid & 3;
    const u32x4* src = (const u32x4*)(BV + (tok0 + q) * 1024 + part * 256);
    float s = 0.f, s2 = 0.f;
#pragma unroll 4
    for (int i = 0; i < 32; ++i) {
      const u32x4 w = src[i];
#pragma unroll
      for (int e = 0; e < 4; ++e) { const float a = bf_lo(w[e]), c = bf_hi(w[e]); s += a + c; s2 += a * a + c * c; }
    }
    s += __shfl_xor(s, 1); s2 += __shfl_xor(s2, 1); s += __shfl_xor(s, 2); s2 += __shfl_xor(s2, 2);
    const float mu = s * (1.f / 1024.f);
    const float var = fmaxf(s2 * (1.f / 1024.f) - mu * mu, 0.f);
    if (part == 0) { smu[q] = mu; srs[q] = rsqrtf(var + EPS); }
  }
  __syncthreads();
  const int wp = wid >> 1, wc = wid & 1;
  for (int g = 0; g < 8; ++g) {
#pragma unroll
    for (int i = 0; i < 4; ++i) {
      const int id = tid + 512 * i, row = id >> 4, ck = (id & 15) * 8;
      *(u32x4*)(sW + row * RS + ck * 2) = *(const u32x4*)(WSB + (size_t)g * 16384 + row * 128 + ck);
    }
#pragma unroll
    for (int i = 0; i < 4; ++i) {
      const int id = tid + 512 * i, q = id & 127, cc = (id >> 7) * 8;
      const u32x4 w = *(const u32x4*)(BV + (tok0 + q) * 1024 + g * 128 + cc);
      const float mu = smu[q], rs = srs[q];
      const float* lg = p.e_vg + g * 128 + cc; const float* lbp = p.e_vb + g * 128 + cc;
#pragma unroll
      for (int e = 0; e < 4; ++e) {
        const float a = (bf_lo(w[e]) - mu) * rs * lg[2 * e] + lbp[2 * e];
        const float c = (bf_hi(w[e]) - mu) * rs * lg[2 * e + 1] + lbp[2 * e + 1];
        *(bf16_t*)(sV + (cc + 2 * e) * RS + q * 2) = f2bf(a);
        *(bf16_t*)(sV + (cc + 2 * e + 1) * RS + q * 2) = f2bf(c);
      }
    }
    __syncthreads();
    f32x16 acc0, acc1;
#pragma unroll
    for (int r = 0; r < 16; ++r) { acc0[r] = 0.f; acc1[r] = 0.f; }
#pragma unroll
    for (int kk = 0; kk < 8; ++kk) {
      const bf16x8 af = *(const bf16x8*)(sW + (wp * 32 + r32) * RS + kk * 32 + hi * 16);
      const bf16x8 b0 = *(const bf16x8*)(sV + (wc * 64 + r32) * RS + kk * 32 + hi * 16);
      const bf16x8 b1 = *(const bf16x8*)(sV + (wc * 64 + 32 + r32) * RS + kk * 32 + hi * 16);
      acc0 = __builtin_amdgcn_mfma_f32_32x32x16_bf16(b0, af, acc0, 0, 0, 0);
      acc1 = __builtin_amdgcn_mfma_f32_32x32x16_bf16(b1, af, acc1, 0, 0, 0);
    }
    const int pr = wp * 32 + r32;
    const float bias = p.e_bs[g * 128 + pr];
    const size_t tok = tok0 + pr;
#pragma unroll
    for (int nj = 0; nj < 2; ++nj)
#pragma unroll
      for (int q = 0; q < 4; ++q) {
        const int col = g * 128 + wc * 64 + nj * 32 + q * 8 + hi * 4;
        const u32x2 bu = *(const u32x2*)(BU + tok * 1024 + col);
        bf16_t* gp = SG + tok * 2048 + 1024 + col;
        const u32x2 sg = *(const u32x2*)gp;
        const float m0 = (nj ? acc1[4 * q + 0] : acc0[4 * q + 0]) + bias, m1 = (nj ? acc1[4 * q + 1] : acc0[4 * q + 1]) + bias;
        const float m2 = (nj ? acc1[4 * q + 2] : acc0[4 * q + 2]) + bias, m3 = (nj ? acc1[4 * q + 3] : acc0[4 * q + 3]) + bias;
        st_bf4(gp, bf_lo(bu[0]) * m0 * bf_lo(sg[0]), bf_hi(bu[0]) * m1 * bf_hi(sg[0]), bf_lo(bu[1]) * m2 * bf_lo(sg[1]), bf_hi(bu[1]) * m3 * bf_hi(sg[1]));
      }
    __syncthreads();
  }
}

__device__ __forceinline__ void post_ln_rows(const float* resid, const bf16_t* yg, float* dst, const float* pg, const float* pb, bf16_t* m1, const float* mod17) {
  const int tid = tid_fresh(), wid = tid >> 6, lane = tid & 63;
  const int gw = blockIdx.x * 8 + wid, nw = gridDim.x * 8;
  float4 nx[4]; u32x2 ny[4];
  { const float4* ps = (const float4*)(resid + (size_t)gw * 1024); const u32x2* py = (const u32x2*)(yg + (size_t)gw * 1024);
#pragma unroll
    for (int j = 0; j < 4; ++j) { nx[j] = ps[lane + 64 * j]; ny[j] = py[lane + 64 * j]; } }
  for (int row = gw; row < NTOK; row += nw) {
    float4 v[4];
#pragma unroll
    for (int j = 0; j < 4; ++j) {
      v[j].x = ALPHA * nx[j].x + bf_lo(ny[j][0]); v[j].y = ALPHA * nx[j].y + bf_hi(ny[j][0]);
      v[j].z = ALPHA * nx[j].z + bf_lo(ny[j][1]); v[j].w = ALPHA * nx[j].w + bf_hi(ny[j][1]);
    }
    { const int nr = (row + nw < NTOK) ? row + nw : row;
      const float4* ps = (const float4*)(resid + (size_t)nr * 1024); const u32x2* py = (const u32x2*)(yg + (size_t)nr * 1024);
#pragma unroll
      for (int j = 0; j < 4; ++j) { nx[j] = ps[lane + 64 * j]; ny[j] = py[lane + 64 * j]; } }
    float s = 0.f;
#pragma unroll
    for (int j = 0; j < 4; ++j) s += v[j].x + v[j].y + v[j].z + v[j].w;
    float mu = wave_sum(s) * (1.f / 1024.f);
    float q = 0.f;
#pragma unroll
    for (int j = 0; j < 4; ++j) { v[j].x -= mu; v[j].y -= mu; v[j].z -= mu; v[j].w -= mu; q += v[j].x * v[j].x + v[j].y * v[j].y + v[j].z * v[j].z + v[j].w * v[j].w; }
    float rstd = rsqrtf(wave_sum(q) * (1.f / 1024.f) + EPS);
    float4* pd = (float4*)(dst + (size_t)row * 1024);
    s = 0.f;
#pragma unroll
    for (int j = 0; j < 4; ++j) {
      const int col = (lane + 64 * j) * 4;
      const float4 g4 = *(const float4*)(pg + col), b4 = *(const float4*)(pb + col);
      v[j].x = v[j].x * rstd * g4.x + b4.x; v[j].y = v[j].y * rstd * g4.y + b4.y; v[j].z = v[j].z * rstd * g4.z + b4.z; v[j].w = v[j].w * rstd * g4.w + b4.w;
      pd[lane + 64 * j] = v[j];
      s += v[j].x + v[j].y + v[j].z + v[j].w;
    }
    if (m1) {
      mu = wave_sum(s) * (1.f / 1024.f);
      q = 0.f;
#pragma unroll
      for (int j = 0; j < 4; ++j) { v[j].x -= mu; v[j].y -= mu; v[j].z -= mu; v[j].w -= mu; q += v[j].x * v[j].x + v[j].y * v[j].y + v[j].z * v[j].z + v[j].w * v[j].w; }
      rstd = rsqrtf(wave_sum(q) * (1.f / 1024.f) + EPS);
      const float* md = mod17 + (size_t)(row >> 11) * 3072;
      bf16_t* pm = m1 + (size_t)row * 1024;
#pragma unroll
      for (int j = 0; j < 4; ++j) {
        const int col = (lane + 64 * j) * 4;
        const float4 sh = *(const float4*)(md + col), sc = *(const float4*)(md + 1024 + col);
        st_bf4(pm + col, v[j].x * rstd * (1.f + sc.x) + sh.x, v[j].y * rstd * (1.f + sc.y) + sh.y, v[j].z * rstd * (1.f + sc.z) + sh.z, v[j].w * rstd * (1.f + sc.w) + sh.w);
      }
    }
  }
}

__device__ __forceinline__ void out_proj(const bf16_t* A, const bf16_t* WT, const float* gate17, bf16_t* dst, char* smem) {
  const int lb = logical_block();
  for (int u = lb; u < 512; u += gridDim.x) {
    const int mt = u >> 2, nt = u & 3;
    f32x16 acc[2][4];
    gemm2(mkPlain(A + (size_t)mt * 256 * 2048, 2048), mkPlain(WT + (size_t)nt * 256 * 2048, 2048), 32, smem, acc);
    const float* gt = gate17 + (size_t)(mt >> 3) * 3072 + 2048 + nt * 256;
    epi2_foreach(acc, [&](int row, int col, float a, float b, float c, float d) {
      const size_t idx = (size_t)(mt * 256 + row) * 1024 + nt * 256 + col;
      const float4 g4 = *(const float4*)(gt + col);
      st_bf4(dst + idx, g4.x * a, g4.y * b, g4.z * c, g4.w * d);
    });
  }
}

#define XB_TMO      128
#define XB_XCNT(j)  (256  + 64 * (j))
#define XB_XSUB(j)  (1280 + 64 * (j))
#define XB_XGEN(j)  (2304 + 64 * (j))
#define XB_TOP      3328
#define XB_TOPGEN   3392
#define XCD_BAR_WORDS 3456
#define XB_SPIN_CAP (1u << 18)
#define LAS __attribute__((address_space(3)))

__device__ __forceinline__ unsigned xb_ld(unsigned* p)              { return __hip_atomic_load(p, __ATOMIC_RELAXED, __HIP_MEMORY_SCOPE_AGENT); }
__device__ __forceinline__ unsigned xb_add(unsigned* p, unsigned v) { return __hip_atomic_fetch_add(p, v, __ATOMIC_RELAXED, __HIP_MEMORY_SCOPE_AGENT); }
__device__ __forceinline__ unsigned xb_xcc_id() { return (unsigned)__builtin_amdgcn_s_getreg((3 << 11) | 20) & 0xFu; }
#define XB_SPIN(cond, bar) do { unsigned _sp = 0; while (cond) { __builtin_amdgcn_s_sleep(1); \
    if ((++_sp & 255u) == 0u) { if (xb_ld(&(bar)[XB_TMO])) break; if (_sp > XB_SPIN_CAP) { atomicAdd(&(bar)[XB_TMO], 1u); break; } } } } while (0)

struct XcdBarrier {
    unsigned* bar; unsigned x;
    volatile LAS unsigned* st;
};

__device__ __forceinline__ XcdBarrier xcd_barrier_post(unsigned* bar, volatile LAS unsigned* st) {
    XcdBarrier b; b.bar = bar; b.x = xb_xcc_id(); b.st = st;
    if (threadIdx.x == 0) (void)xb_add(&bar[XB_XCNT(b.x)], 1u);
    return b;
}
__device__ __forceinline__ void xcd_barrier_complete(unsigned* bar, unsigned x, unsigned& nloc, unsigned& nx) {
    const unsigned G = gridDim.x * gridDim.y * gridDim.z;
    unsigned sum, cnt, mine, sp = 0u;
    for (;;) {
        sum = 0u; cnt = 0u; mine = 0u;
#pragma unroll
        for (unsigned j = 0; j < 16; ++j) { const unsigned c = xb_ld(&bar[XB_XCNT(j)]); sum += c; cnt += (c > 0u) ? 1u : 0u; mine = (j == x) ? c : mine; }
        if (sum == G) break;
        __builtin_amdgcn_s_sleep(1);
        if ((++sp & 255u) == 0u) { if (xb_ld(&bar[XB_TMO])) break; if (sp > XB_SPIN_CAP) { atomicAdd(&bar[XB_TMO], 1u); break; } }
    }
    nloc = mine > 0u ? mine : 1u; nx = cnt > 0u ? cnt : 1u;
}

__device__ __forceinline__ void xcd_barrier(const XcdBarrier& b) {
    asm volatile("s_waitcnt vmcnt(0)" ::: "memory");
    __syncthreads();
    if (threadIdx.x == 0) {
        unsigned* bar = b.bar;
        __builtin_amdgcn_s_waitcnt(0);
        unsigned nloc = b.st[0], nx = b.st[1];
        if (nloc == 0u) { xcd_barrier_complete(bar, b.x, nloc, nx); b.st[0] = nloc; b.st[1] = nx; }
        const unsigned old = xb_add(&bar[XB_XSUB(b.x)], 1u);
        const unsigned gen = old / nloc;
        if (old + 1u == (gen + 1u) * nloc) {
            __builtin_amdgcn_fence(__ATOMIC_RELEASE, "agent");
            asm volatile("s_waitcnt vmcnt(0)" ::: "memory");
            const unsigned og = xb_add(&bar[XB_TOP], 1u);
            const unsigned tg = og / nx;
            if (og + 1u == (tg + 1u) * nx) xb_add(&bar[XB_TOPGEN], 1u);
            else XB_SPIN(xb_ld(&bar[XB_TOPGEN]) == tg, bar);
            __builtin_amdgcn_fence(__ATOMIC_ACQUIRE, "agent");
            xb_add(&bar[XB_XGEN(b.x)], 1u);
            asm volatile("s_waitcnt vmcnt(0)" ::: "memory");
        } else {
            XB_SPIN(xb_ld(&bar[XB_XGEN(b.x)]) == gen, bar);
            __builtin_amdgcn_fence(__ATOMIC_ACQUIRE, "agent");
            asm volatile("s_waitcnt vmcnt(0)" ::: "memory");
        }
    }
    __syncthreads();
}


constexpr size_t OFF_XBAR = OFF_SMALL + 1536 * 1024;
constexpr size_t OFF_PX = OFF_SMALL + 1152 * 1024;
#define GSYNC_CG() do { __threadfence(); grid.sync(); __threadfence(); } while (0)
#define GSYNC() xcd_barrier(xbar)
#ifndef LAUNCH_SPLITS
#define LAUNCH_SPLITS {{0,0},{1,1},{2,2},{3,3},{4,4},{5,5},{6,6},{7,7},{8,8},{9,9},{10,10}}
#endif
template <int PLO, int PHI>
__global__ void __launch_bounds__(512) mega(Params p) {
  cg::grid_group grid = cg::this_grid();
  __shared__ __attribute__((aligned(16))) char smem[SMEM_BYTES];
  char* ws = p.ws;
  float* MOD = (float*)(ws + OFF_MOD);
  const int lb = logical_block();
  volatile LAS unsigned* xst = (volatile LAS unsigned*)(smem + LDS_RED + 2048);
  if (tid_fresh() < 4) xst[tid_fresh()] = 0u;
  __syncthreads();
  XcdBarrier xbar = xcd_barrier_post((unsigned*)(ws + OFF_XBAR), xst);
  if (PLO < PHI) grid.sync();

  if (PLO <= 0 && 0 <= PHI) {
  phase0(p, smem);
  }
  if (PLO <= 0 && 0 < PHI) { GSYNC(); }
  if (PLO <= 1 && 1 <= PHI) {

  ln_rows_modulate(p.x, (bf16_t*)(ws + OFF_M0), NTOK, SEQ, MOD, -1);
  ln_rows_modulate(p.ctx, (bf16_t*)(ws + OFF_MC), NCTX, CTXL, MOD, 16);
  }
  if (PLO <= 1 && 1 < PHI) { GSYNC(); }
  if (PLO <= 2 && 2 <= PHI) {

  phase2(p, smem);
  }
  if (PLO <= 2 && 2 < PHI) { GSYNC(); }
  if (PLO <= 3 && 3 <= PHI) {

  for (int u = lb; u < 1024; u += gridDim.x) {
      const int grp = u >> 5, j = u & 31, b = grp >> 1, kvh = grp & 1, hq = kvh * 4 + (j >> 3), qb = j & 7;
      const bf16_t* Qb = (const bf16_t*)(ws + OFF_Q) + ((size_t)(b * SEQ + qb * 256) * 8 + hq) * 128;
      const bf16_t* Kh = (const bf16_t*)(ws + OFF_KALL) + ((size_t)b * SKV * 2 + kvh) * 128;
      const bf16_t* Vh = (const bf16_t*)(ws + OFF_VALL) + ((size_t)b * SKV * 2 + kvh) * 128;
      bf16_t* GO = (bf16_t*)(ws + OFF_SG) + (size_t)(b * SEQ + qb * 256) * 2048 + hq * 128;
      att::attn_body(Qb, Kh, Vh, GO, SKV, smem);
  }
  for (int v = lb; v < 256; v += gridDim.x) chunk_gate_unit(p, v >> 4, v & 15, smem);
  }
  if (PLO <= 3 && 3 < PHI) { GSYNC(); }
  if (PLO <= 4 && 4 <= PHI) {

  out_proj((const bf16_t*)(ws + OFF_SG), (const bf16_t*)(ws + OFF_WT_EOUT), MOD, (bf16_t*)(ws + OFF_YG), smem);
  }
  if (PLO <= 4 && 4 < PHI) { GSYNC(); }
  if (PLO <= 5 && 5 <= PHI) {

  post_ln_rows(p.x, (const bf16_t*)(ws + OFF_YG), (float*)(ws + OFF_Q), p.post_g, p.post_b, (bf16_t*)(ws + OFF_M0), MOD + 17 * 3072);
  }
  if (PLO <= 5 && 5 < PHI) { GSYNC(); }
  if (PLO <= 6 && 6 <= PHI) {

  {
    const bf16_t* M1 = (const bf16_t*)(ws + OFF_M0); const bf16_t* WT = (const bf16_t*)(ws + OFF_WT_OIN);
    bf16_t* F = (bf16_t*)(ws + OFF_F); bf16_t* RV = (bf16_t*)(ws + OFF_RV); bf16_t* XM = (bf16_t*)(ws + OFF_XM);
    bf16_t* SG1 = (bf16_t*)(ws + OFF_SG);
    for (int u = lb; u < 2048; u += gridDim.x) {
      f32x16 acc[2][4];
      if (u < 1024) {
        const int tt = u >> 3, ct = u & 7, b = tt >> 3, t0 = (tt & 7) * 256;
        gemm2(mkPlain(WT + (size_t)ct * 256 * 1024, 1024), mkPlain(M1 + (size_t)tt * 256 * 1024, 1024), 16, smem, acc);
        epi2_foreach(acc, [&](int row, int col, float a, float bq, float c, float d) {
          const int ch = ct * 256 + row, t = t0 + col;
          const size_t base = ((size_t)b * 2048 + ch) * 1024;
          if (t < 1024) {
            st_bf4(F + base + t, a, bq, c, d);
            if (t == 0) RV[base] = 0;
          } else if (t == 1024) {
            XM[(size_t)b * 2048 + ch] = f2bf(a);
            RV[base + 1023] = f2bf(bq); RV[base + 1022] = f2bf(c); RV[base + 1021] = f2bf(d);
          } else {
            RV[base + 2048 - t] = f2bf(a); RV[base + 2047 - t] = f2bf(bq); RV[base + 2046 - t] = f2bf(c); RV[base + 2045 - t] = f2bf(d);
          }
        });
      } else {
        const int v = u - 1024, mt = v >> 3, nt = v & 7;
        gemm2(mkPlain(M1 + (size_t)mt * 256 * 1024, 1024), mkPlain(WT + (size_t)(2048 + nt * 256) * 1024, 1024), 16, smem, acc);
        epi2_foreach(acc, [&](int row, int col, float a, float bq, float c, float d) {
          st_bf4(SG1 + (size_t)(mt * 256 + row) * 2048 + nt * 256 + col, silu_f(a), silu_f(bq), silu_f(c), silu_f(d));
        });
      }
    }
  }
  }
  if (PLO <= 6 && 6 < PHI) { GSYNC(); }
  if (PLO <= 7 && 7 <= PHI) {

  {
    {
      const int tid = tid_fresh(), wid = tid >> 6, lane = tid & 63;
      const int gw = blockIdx.x * 8 + wid, nw = gridDim.x * 8;
      const bf16_t* XMr = (const bf16_t*)(ws + OFF_XM); float* PX = (float*)(ws + OFF_PX);
      u32x4 na0, na1, nb0, nb1;
      { const size_t ro = (size_t)gw * 128; const u32x4* Fr = (const u32x4*)(ws + OFF_F) + ro; const u32x4* Rr = (const u32x4*)(ws + OFF_RV) + ro;
        na0 = Fr[lane]; na1 = Fr[lane + 64]; nb0 = Rr[lane]; nb1 = Rr[lane + 64]; }
      for (int row = gw; row < 16 * 2048; row += nw) {
        const u32x4 a0 = na0, a1 = na1, b0 = nb0, b1 = nb1;
        { const int nr = (row + nw < 16 * 2048) ? row + nw : row; const size_t ro = (size_t)nr * 128;
          const u32x4* Fr = (const u32x4*)(ws + OFF_F) + ro; const u32x4* Rr = (const u32x4*)(ws + OFF_RV) + ro;
          na0 = Fr[lane]; na1 = Fr[lane + 64]; nb0 = Rr[lane]; nb1 = Rr[lane + 64]; }
        u32x4 e0, e1, o0, o1; float alt = 0.f;
#pragma unroll
        for (int k = 0; k < 4; ++k) {
          { const float al = bf_lo(a0[k]), ah = bf_hi(a0[k]), bl = bf_lo(b0[k]), bh = bf_hi(b0[k]);
            e0[k] = cvtpk(al + bl, ah + bh); o0[k] = cvtpk(al - bl, ah - bh); alt += (al + bl) - (ah + bh); }
          { const float al = bf_lo(a1[k]), ah = bf_hi(a1[k]), bl = bf_lo(b1[k]), bh = bf_hi(b1[k]);
            e1[k] = cvtpk(al + bl, ah + bh); o1[k] = cvtpk(al - bl, ah - bh); alt += (al + bl) - (ah + bh); }
        }
        u32x4* Fw = (u32x4*)(ws + OFF_F) + (size_t)row * 128; u32x4* Rw = (u32x4*)(ws + OFF_RV) + (size_t)row * 128;
        Fw[lane] = e0; Fw[lane + 64] = e1; Rw[lane] = o0; Rw[lane + 64] = o1;
        alt = wave_sum(alt);
        if (lane == 0) PX[row] = alt + bf2f(XMr[row]);
      }
    }
    if (PLO < PHI) { GSYNC(); }
    const bf16_t* F = (const bf16_t*)(ws + OFF_F); const bf16_t* RV = (const bf16_t*)(ws + OFF_RV); const bf16_t* XM = (const bf16_t*)(ws + OFF_XM);
    const bf16_t* TC = (const bf16_t*)(ws + OFF_TAB_C); const bf16_t* TS = (const bf16_t*)(ws + OFF_TAB_S);
    bf16_t* PC = (bf16_t*)p.out; bf16_t* PS = (bf16_t*)(ws + OFF_M0);
    for (int u = lb; u < 1024; u += gridDim.x) {
      f32x16 acc[2][4];
      const int v = u & 511, b = v >> 5, mt = (v & 31) >> 3, nt = v & 7;
      const size_t bo = ((size_t)b * 2048 + nt * 256) * 1024;
      if (u < 512) {
        gemm2(mkPlain(TC + (size_t)mt * 256 * 1024, 1024), mkPlain(F + bo, 1024), 16, smem, acc);
        epi2_foreach(acc, [&](int row, int col, float a, float bq, float c, float d) {
          const int tp = mt * 256 + row, ch = nt * 256 + col;
          const u32x2 xm = *(const u32x2*)(XM + (size_t)b * 2048 + ch);
          const float sg = (tp & 1) ? -1.f : 1.f;
          a += sg * bf_lo(xm[0]); bq += sg * bf_hi(xm[0]); c += sg * bf_lo(xm[1]); d += sg * bf_hi(xm[1]);
          st_bf4(PC + ((size_t)b * 1024 + tp) * 2048 + ch, a, bq, c, d);
        });
      } else {
        gemm2(mkPlain(TS + (size_t)mt * 256 * 1024, 1024), mkPlain(RV + bo, 1024), 16, smem, acc);
        epi2_foreach(acc, [&](int row, int col, float a, float bq, float c, float d) {
          st_bf4(PS + ((size_t)b * 1024 + mt * 256 + row) * 2048 + nt * 256 + col, a, bq, c, d);
        });
      }
    }
  }
  }
  if (PLO <= 7 && 7 < PHI) { GSYNC(); }
  if (PLO <= 8 && 8 <= PHI) {

  {
    const bf16_t* PC = (const bf16_t*)p.out; const bf16_t* PS = (const bf16_t*)(ws + OFF_M0);
    const bf16_t* CDP = (const bf16_t*)(ws + OFF_CDP);
    bf16_t* SG1 = (bf16_t*)(ws + OFF_SG);
    const int tid = tid_fresh(), wid = tid >> 6, lane = tid & 63, r32 = lane & 31, hi = lane >> 5, wm = wid >> 1, wn = wid & 1;
    constexpr int TBS = 528;
    constexpr int TB_BYTES = 128 * TBS;
    char* sT = smem; char* sA = smem + TB_BYTES;
#pragma unroll
    for (int i = 0; i < 8; ++i) {
      const int id = tid + 512 * i, row = id >> 5, ck = id & 31;
      *(u32x4*)(sT + row * TBS + ck * 16) = *(const u32x4*)(CDP + row * 256 + ck * 8);
    }
    const int st_off = (tid >> 3) * LDS_ROWB + (tid & 7) * 16;
    const int a_rd = (wm * 64 + r32) * LDS_ROWB + hi * 16;
    const int b_rd = (wn * 32 + r32) * TBS + hi * 16;
    const size_t rowoff = (size_t)(tid >> 3) * 2048 + (tid & 7) * 8;
    u32x4 r00, r01, r02, r03, r10, r11, r12, r13, r20, r21, r22, r23, r30, r31, r32_, r33;
    auto a_base = [&](int u_, int s_) -> const bf16_t* {
      const int b_ = u_ >> 6, j_ = (u_ >> 4) & 3, G_ = u_ & 15;
      return ((s_ < 2) ? PC : PS) + ((size_t)b_ * 1024 + j_ * 256) * 2048 + G_ * 128 + (s_ & 1) * 64 + rowoff;
    };
#define P8_LOAD(S, U, A, B, C, D) do { const bf16_t* q_ = a_base((U), (S)); A = *(const u32x4*)(q_); B = *(const u32x4*)(q_ + (size_t)64 * 2048); \
      C = *(const u32x4*)(q_ + (size_t)128 * 2048); D = *(const u32x4*)(q_ + (size_t)192 * 2048); } while (0)
#define P8_WRITE(ST, A, B, C, D) do { char* s_ = sA + (ST) * L2_A + st_off; *(u32x4*)(s_) = A; *(u32x4*)(s_ + 64 * LDS_ROWB) = B; \
      *(u32x4*)(s_ + 128 * LDS_ROWB) = C; *(u32x4*)(s_ + 192 * LDS_ROWB) = D; } while (0)
#define P8_COMPUTE(ST, S, ACC) do { const char* sb_ = sA + (ST) * L2_A;                                              \
      _Pragma("unroll") for (int kk = 0; kk < 4; ++kk) {                                                               \
        const bf16x8 fa0 = *(const bf16x8*)(sb_ + a_rd + kk * 32);                                                      \
        const bf16x8 fa1 = *(const bf16x8*)(sb_ + a_rd + 32 * LDS_ROWB + kk * 32);                                      \
        const bf16x8 fb0 = *(const bf16x8*)(sT + b_rd + ((S) * 64 + kk * 16) * 2);                                      \
        const bf16x8 fb1 = *(const bf16x8*)(sT + b_rd + 64 * TBS + ((S) * 64 + kk * 16) * 2);                           \
        ACC[0][0] = __builtin_amdgcn_mfma_f32_32x32x16_bf16(fb0, fa0, ACC[0][0], 0, 0, 0);                              \
        ACC[0][1] = __builtin_amdgcn_mfma_f32_32x32x16_bf16(fb1, fa0, ACC[0][1], 0, 0, 0);                              \
        ACC[1][0] = __builtin_amdgcn_mfma_f32_32x32x16_bf16(fb0, fa1, ACC[1][0], 0, 0, 0);                              \
        ACC[1][1] = __builtin_amdgcn_mfma_f32_32x32x16_bf16(fb1, fa1, ACC[1][1], 0, 0, 0);                              \
      } } while (0)
    P8_LOAD(0, lb, r00, r01, r02, r03); P8_LOAD(1, lb, r10, r11, r12, r13); P8_LOAD(2, lb, r20, r21, r22, r23); P8_LOAD(3, lb, r30, r31, r32_, r33);
    for (int u = lb; u < 1024; u += gridDim.x) {
      const int un = (u + (int)gridDim.x < 1024) ? u + (int)gridDim.x : u;
      f32x16 acc1[2][2], acc2[2][2];
#pragma unroll
      for (int mi = 0; mi < 2; ++mi)
#pragma unroll
        for (int nj = 0; nj < 2; ++nj)
#pragma unroll
          for (int r = 0; r < 16; ++r) { acc1[mi][nj][r] = 0.f; acc2[mi][nj][r] = 0.f; }
      P8_WRITE(0, r00, r01, r02, r03); __syncthreads(); P8_LOAD(0, un, r00, r01, r02, r03); P8_COMPUTE(0, 0, acc1);
      P8_WRITE(1, r10, r11, r12, r13); __syncthreads(); P8_LOAD(1, un, r10, r11, r12, r13); P8_COMPUTE(1, 1, acc1);
      P8_WRITE(0, r20, r21, r22, r23); __syncthreads(); P8_LOAD(2, un, r20, r21, r22, r23); P8_COMPUTE(0, 2, acc2);
      P8_WRITE(1, r30, r31, r32_, r33); __syncthreads(); P8_LOAD(3, un, r30, r31, r32_, r33); P8_COMPUTE(1, 3, acc2);
      const int b = u >> 6, j = (u >> 4) & 3, G = u & 15;
      const float sc = 1.f / 512.f;
#pragma unroll
      for (int mi = 0; mi < 2; ++mi) {
        const int tp = j * 256 + wm * 64 + mi * 32 + r32;
#pragma unroll
        for (int nj = 0; nj < 2; ++nj)
#pragma unroll
          for (int q = 0; q < 4; ++q) {
            const int col = G * 128 + nj * 64 + wn * 32 + q * 8 + hi * 4;
            const float p0 = acc1[mi][nj][4 * q + 0], p1 = acc1[mi][nj][4 * q + 1], p2 = acc1[mi][nj][4 * q + 2], p3 = acc1[mi][nj][4 * q + 3];
            const float m0 = acc2[mi][nj][4 * q + 0], m1 = acc2[mi][nj][4 * q + 1], m2 = acc2[mi][nj][4 * q + 2], m3 = acc2[mi][nj][4 * q + 3];
            { bf16_t* gp = SG1 + ((size_t)b * 2048 + tp) * 2048 + col; const u32x2 sg = *(const u32x2*)gp;
              st_bf4(gp, (p0 - m0) * sc * bf_lo(sg[0]), (p1 - m1) * sc * bf_hi(sg[0]), (p2 - m2) * sc * bf_lo(sg[1]), (p3 - m3) * sc * bf_hi(sg[1])); }
            if (tp >= 1) { bf16_t* gp = SG1 + ((size_t)b * 2048 + (2048 - tp)) * 2048 + col; const u32x2 sg = *(const u32x2*)gp;
              st_bf4(gp, (p0 + m0) * sc * bf_lo(sg[0]), (p1 + m1) * sc * bf_hi(sg[0]), (p2 + m2) * sc * bf_lo(sg[1]), (p3 + m3) * sc * bf_hi(sg[1])); }
          }
      }
    }
#undef P8_LOAD
#undef P8_WRITE
#undef P8_COMPUTE
    {
      const float* PX = (const float*)(ws + OFF_PX);
      for (int i = blockIdx.x; i < 256; i += gridDim.x) {
        if (tid < 128) {
          const int b = i >> 4, G = i & 15;
          const float* px = PX + (size_t)b * 2048 + G * 128;
          float y = 0.f;
          for (int c = 0; c < 128; ++c) y += px[c] * bf2f(*(const bf16_t*)(sT + tid * TBS + c * 2));
          bf16_t* gp = SG1 + ((size_t)b * 2048 + 1024) * 2048 + G * 128 + tid;
          *gp = f2bf(y * (1.f / 512.f) * bf2f(*gp));
        }
      }
    }
  }
  }
  if (PLO <= 8 && 8 < PHI) { GSYNC(); }
  if (PLO <= 9 && 9 <= PHI) {

  out_proj((const bf16_t*)(ws + OFF_SG), (const bf16_t*)(ws + OFF_WT_OOUT), MOD + 17 * 3072, (bf16_t*)(ws + OFF_YG), smem);
  }
  if (PLO <= 9 && 9 < PHI) { GSYNC(); }
  if (PLO <= 10 && 10 <= PHI) {

  post_ln_rows((const float*)(ws + OFF_Q), (const bf16_t*)(ws + OFF_YG), p.out, p.post_g + 1024, p.post_b + 1024, nullptr, nullptr);
  }
}

extern "C" void kernel_launch(void* const* d_in, const int* in_sizes, int n_in, void* d_out, int out_size, void* d_ws, size_t ws_size,
                              hipStream_t stream) {
  static int grid_blocks = 0;
  if (!grid_blocks) {
    int dev = 0, cus = 0, per_cu = 0;
    hipGetDevice(&dev);
    hipDeviceGetAttribute(&cus, hipDeviceAttributeMultiprocessorCount, dev);
    hipOccupancyMaxActiveBlocksPerMultiprocessor(&per_cu, mega<0, 10>, 512, 0);
    if (per_cu > 1) per_cu = 1;
    grid_blocks = cus * per_cu;
    if (n_in != 18 || ws_size < WS_NEED) fprintf(stderr, "kernel_launch: unexpected n_in %d or ws_size %zu (need %zu)\n", n_in, ws_size, (size_t)WS_NEED);
  }
  Params p{};
  p.x = (const float*)d_in[0]; p.c = (const float*)d_in[1]; p.ctx = (const float*)d_in[2]; p.c_ctx = (const float*)d_in[3];
  p.w_mod = (const float*)d_in[4]; p.b_mod = (const float*)d_in[5]; p.post_g = (const float*)d_in[6]; p.post_b = (const float*)d_in[7];
  p.e_w_in = (const float*)d_in[8]; p.e_qn = (const float*)d_in[9]; p.e_kn = (const float*)d_in[10]; p.e_vg = (const float*)d_in[11];
  p.e_vb = (const float*)d_in[12]; p.e_ws = (const float*)d_in[13]; p.e_bs = (const float*)d_in[14]; p.e_w_out = (const float*)d_in[15];
  p.o_w_in = (const float*)d_in[16]; p.o_w_out = (const float*)d_in[17];
  p.out = (float*)d_out; p.ws = (char*)d_ws;
#define ONE_LAUNCH 1
#ifdef ONE_LAUNCH
  hipMemsetAsync((char*)d_ws + OFF_XBAR, 0, XCD_BAR_WORDS * 4, stream);
  { void* args[] = {&p};
    hipError_t e = hipLaunchCooperativeKernel((void*)mega<0, 10>, dim3(grid_blocks), dim3(512), args, 0, stream);
    if (e != hipSuccess) fprintf(stderr, "cooperative launch failed: %s (grid %d)\n", hipGetErrorString(e), grid_blocks); }
#else
  hipLaunchKernelGGL((mega<0, 0>), dim3(grid_blocks), dim3(512), 0, stream, p);
  hipLaunchKernelGGL((mega<1, 1>), dim3(grid_blocks), dim3(512), 0, stream, p);
  hipLaunchKernelGGL((mega<2, 2>), dim3(grid_blocks), dim3(512), 0, stream, p);
  hipLaunchKernelGGL((mega<3, 3>), dim3(grid_blocks), dim3(512), 0, stream, p);
  hipLaunchKernelGGL((mega<4, 4>), dim3(grid_blocks), dim3(512), 0, stream, p);
  hipLaunchKernelGGL((mega<5, 5>), dim3(grid_blocks), dim3(512), 0, stream, p);
  hipLaunchKernelGGL((mega<6, 6>), dim3(grid_blocks), dim3(512), 0, stream, p);
  hipLaunchKernelGGL((mega<7, 7>), dim3(grid_blocks), dim3(512), 0, stream, p);
  hipLaunchKernelGGL((mega<8, 8>), dim3(grid_blocks), dim3(512), 0, stream, p);
  hipLaunchKernelGGL((mega<9, 9>), dim3(grid_blocks), dim3(512), 0, stream, p);
  hipLaunchKernelGGL((mega<10, 10>), dim3(grid_blocks), dim3(512), 0, stream, p);
#endif
}
```

```cpp
#include <hip/hip_runtime.h>
#include <hip/hip_cooperative_groups.h>
#include <cstdio>
#include <cstdint>
namespace cg = cooperative_groups;

typedef unsigned short bf16_t;
using bf16x8 = __attribute__((ext_vector_type(8))) short;
using s16x4  = __attribute__((ext_vector_type(4))) short;
using f32x16 = __attribute__((ext_vector_type(16))) float;
using u32x4  = __attribute__((ext_vector_type(4))) unsigned;
using u32x2  = __attribute__((ext_vector_type(2))) unsigned;

constexpr int DM = 1024, NB = 16, SEQ = 2048, CTXL = 256, SKV = SEQ + CTXL;
constexpr int NTOK = NB * SEQ;
constexpr int NCTX = NB * CTXL;
constexpr int EVEN_IN = 5632, ODD_IN = 4096, DIN = 2048;
constexpr float ALPHA = 1.4142135623730951f;
constexpr float EPS = 1e-6f;

constexpr size_t MiB = 1ull << 20;
constexpr size_t OFF_WT_EIN = 0, OFF_WT_EOUT = 11 * MiB, OFF_WT_OIN = 15 * MiB, OFF_WT_OOUT = 23 * MiB;
constexpr size_t OFF_TAB_C = 27 * MiB, OFF_TAB_S = 30 * MiB, OFF_SMALL = 33 * MiB;
constexpr size_t OFF_CDM = OFF_SMALL, OFF_CDP = OFF_SMALL + 64 * 1024, OFF_WSB = OFF_SMALL + 128 * 1024;
constexpr size_t OFF_ROPE = OFF_SMALL + 384 * 1024, OFF_MOD = OFF_SMALL + 512 * 1024, OFF_XM = OFF_SMALL + 1024 * 1024;
constexpr size_t OFF_M0 = 36 * MiB, OFF_MC = 100 * MiB;
constexpr size_t OFF_SG = 108 * MiB;
constexpr size_t OFF_Q = 236 * MiB, OFF_BU = 300 * MiB;
constexpr size_t OFF_KALL = 364 * MiB, OFF_VALL = 382 * MiB, OFF_BV = 400 * MiB;
constexpr size_t OFF_F = 364 * MiB, OFF_RV = 428 * MiB;
constexpr size_t OFF_YG = 364 * MiB;
constexpr size_t WS_NEED = 492 * MiB;

struct Params {
  const float *x, *c, *ctx, *c_ctx, *w_mod, *b_mod, *post_g, *post_b, *e_w_in, *e_qn, *e_kn, *e_vg, *e_vb, *e_ws, *e_bs,
      *e_w_out, *o_w_in, *o_w_out;
  float* out;
  char* ws;
  long pad_;
};

typedef float f32x2_t __attribute__((ext_vector_type(2)));
typedef __bf16 bf16x2_t __attribute__((ext_vector_type(2)));
__device__ __forceinline__ unsigned cvtpk(float lo, float hi) {
  f32x2_t v = {lo, hi}; bf16x2_t h = __builtin_convertvector(v, bf16x2_t); return __builtin_bit_cast(unsigned, h);
}
__device__ __forceinline__ int tid_fresh() { int t = (int)__builtin_amdgcn_workitem_id_x(); asm volatile("" : "+v"(t)); return t; }
__device__ __forceinline__ float bf_lo(unsigned w) { return __uint_as_float(w << 16); }
__device__ __forceinline__ float bf_hi(unsigned w) { return __uint_as_float(w & 0xffff0000u); }
__device__ __forceinline__ bf16_t f2bf(float x) { return (bf16_t)(cvtpk(x, 0.f) & 0xffffu); }
__device__ __forceinline__ float bf2f(bf16_t h) { return __uint_as_float(((unsigned)h) << 16); }
__device__ __forceinline__ int crow(int r, int hi) { return (r & 3) + 8 * (r >> 2) + 4 * hi; }
__device__ __forceinline__ float wave_sum(float v) {
#pragma unroll
  for (int o = 32; o >= 1; o >>= 1) v += __shfl_xor(v, o);
  return v;
}
__device__ __forceinline__ float silu_f(float x) { return x * __builtin_amdgcn_rcpf(1.f + __expf(-x)); }
__device__ __forceinline__ float gelu_tanh_f(float x) {
  const float u = 0.7978845608028654f * (x + 0.044715f * x * x * x);
  const float t = 1.f - 2.f * __builtin_amdgcn_rcpf(__expf(2.f * u) + 1.f);
  return 0.5f * x * (1.f + t);
}
__device__ __forceinline__ int logical_block() {
  const int g = gridDim.x, b = blockIdx.x;
  return (g & 7) ? b : (b & 7) * (g >> 3) + (b >> 3);
}

constexpr int LDS_ROWB = 144;
constexpr int LDS_A = 256 * LDS_ROWB;
constexpr int LDS_B = 128 * LDS_ROWB;
constexpr int LDS_STAGE = LDS_A + LDS_B;
constexpr int L2_A = 256 * LDS_ROWB;
constexpr int L2_STAGE = 2 * L2_A;
constexpr int LDS_RED = 2 * L2_STAGE;
constexpr int SMEM_BYTES = LDS_RED + 2048 + 2048;

struct LdPlain {
  const bf16_t* p; size_t rs;
  __device__ __forceinline__ u32x4 ld(int kt, int i) const { return *(const u32x4*)(p + (size_t)i * rs + kt * 64); }
};
__device__ __forceinline__ LdPlain mkPlain(const bf16_t* base, int ld) {
  const int tid = tid_fresh();
  LdPlain l; l.p = base + (size_t)(tid >> 3) * ld + (tid & 7) * 8; l.rs = (size_t)64 * ld; return l;
}
struct LdSplit {
  const bf16_t* p0; const bf16_t* p1; size_t rs; int kts;
  __device__ __forceinline__ u32x4 ld(int kt, int i) const {
    const bf16_t* q = (kt < kts) ? (p0 + kt * 64) : (p1 + (kt - kts) * 64);
    return *(const u32x4*)(q + (size_t)i * rs);
  }
};
__device__ __forceinline__ LdSplit mkSplit(const bf16_t* b0, const bf16_t* b1, int ld, int kts) {
  const int tid = tid_fresh(); const size_t o = (size_t)(tid >> 3) * ld + (tid & 7) * 8;
  LdSplit l; l.p0 = b0 + o; l.p1 = b1 + o; l.rs = (size_t)64 * ld; l.kts = kts; return l;
}
struct LdFold {
  const bf16_t* f; const bf16_t* r; size_t rs; float sg;
  __device__ __forceinline__ u32x4 ld(int kt, int i) const {
    const u32x4 a = *(const u32x4*)(f + (size_t)i * rs + kt * 64);
    const u32x4 b = *(const u32x4*)(r + (size_t)i * rs + kt * 64);
    u32x4 o;
    o[0] = cvtpk(bf_lo(a[0]) + sg * bf_lo(b[0]), bf_hi(a[0]) + sg * bf_hi(b[0]));
    o[1] = cvtpk(bf_lo(a[1]) + sg * bf_lo(b[1]), bf_hi(a[1]) + sg * bf_hi(b[1]));
    o[2] = cvtpk(bf_lo(a[2]) + sg * bf_lo(b[2]), bf_hi(a[2]) + sg * bf_hi(b[2]));
    o[3] = cvtpk(bf_lo(a[3]) + sg * bf_lo(b[3]), bf_hi(a[3]) + sg * bf_hi(b[3]));
    return o;
  }
};
__device__ __forceinline__ LdFold mkFold(const bf16_t* f, const bf16_t* r, int ld, float sg) {
  const int tid = tid_fresh(); const size_t o = (size_t)(tid >> 3) * ld + (tid & 7) * 8;
  LdFold l; l.f = f + o; l.r = r + o; l.rs = (size_t)64 * ld; l.sg = sg; return l;
}

template <class LA, class LB>
__device__ __forceinline__ void gemm_mainloop(const LA& la, const LB& lb, int KT, char* smem, f32x16 (&acc)[2][2]) {
  const int tid = tid_fresh(), wid = tid >> 6, lane = tid & 63, r32 = lane & 31, hi = lane >> 5, wm = wid >> 1, wn = wid & 1;
#pragma unroll
  for (int mi = 0; mi < 2; ++mi)
#pragma unroll
    for (int nj = 0; nj < 2; ++nj)
#pragma unroll
      for (int r = 0; r < 16; ++r) acc[mi][nj][r] = 0.f;
  const int st_off = (tid >> 3) * LDS_ROWB + (tid & 7) * 16;
  const int a_rd = (wm * 64 + r32) * LDS_ROWB + hi * 16;
  const int b_rd = LDS_A + (wn * 32 + r32) * LDS_ROWB + hi * 16;
  u32x4 ra0, ra1, ra2, ra3, rb0, rb1;
  ra0 = la.ld(0, 0); ra1 = la.ld(0, 1); ra2 = la.ld(0, 2); ra3 = la.ld(0, 3); rb0 = lb.ld(0, 0); rb1 = lb.ld(0, 1);
  {
    char* s = smem + st_off;
    *(u32x4*)(s) = ra0; *(u32x4*)(s + 64 * LDS_ROWB) = ra1; *(u32x4*)(s + 128 * LDS_ROWB) = ra2; *(u32x4*)(s + 192 * LDS_ROWB) = ra3;
    *(u32x4*)(s + LDS_A) = rb0; *(u32x4*)(s + LDS_A + 64 * LDS_ROWB) = rb1;
  }
  __syncthreads();
#define GEMM_COMPUTE(SB)                                                                              \
  _Pragma("unroll") for (int kk = 0; kk < 4; ++kk) {                                                  \
    const bf16x8 a0 = *(const bf16x8*)((SB) + a_rd + kk * 32);                                        \
    const bf16x8 a1 = *(const bf16x8*)((SB) + a_rd + 32 * LDS_ROWB + kk * 32);                        \
    const bf16x8 b0 = *(const bf16x8*)((SB) + b_rd + kk * 32);                                        \
    const bf16x8 b1 = *(const bf16x8*)((SB) + b_rd + 64 * LDS_ROWB + kk * 32);                        \
    acc[0][0] = __builtin_amdgcn_mfma_f32_32x32x16_bf16(b0, a0, acc[0][0], 0, 0, 0);                  \
    acc[0][1] = __builtin_amdgcn_mfma_f32_32x32x16_bf16(b1, a0, acc[0][1], 0, 0, 0);                  \
    acc[1][0] = __builtin_amdgcn_mfma_f32_32x32x16_bf16(b0, a1, acc[1][0], 0, 0, 0);                  \
    acc[1][1] = __builtin_amdgcn_mfma_f32_32x32x16_bf16(b1, a1, acc[1][1], 0, 0, 0);                  \
  }
#define GEMM_LOAD(KT_) do { ra0 = la.ld((KT_), 0); ra1 = la.ld((KT_), 1); ra2 = la.ld((KT_), 2); ra3 = la.ld((KT_), 3); rb0 = lb.ld((KT_), 0); rb1 = lb.ld((KT_), 1); } while (0)
#define GEMM_WRITE(ST) do { char* s = smem + (ST) * LDS_STAGE + st_off;                                \
    *(u32x4*)(s) = ra0; *(u32x4*)(s + 64 * LDS_ROWB) = ra1; *(u32x4*)(s + 128 * LDS_ROWB) = ra2; *(u32x4*)(s + 192 * LDS_ROWB) = ra3; \
    *(u32x4*)(s + LDS_A) = rb0; *(u32x4*)(s + LDS_A + 64 * LDS_ROWB) = rb1; } while (0)
#pragma unroll 1
  for (int kt = 0; kt < KT; kt += 2) {
    GEMM_LOAD(kt + 1);
    GEMM_COMPUTE(smem);
    GEMM_WRITE(1);
    __syncthreads();
    GEMM_LOAD(kt + 2 < KT ? kt + 2 : kt);
    GEMM_COMPUTE(smem + LDS_STAGE);
    GEMM_WRITE(0);
    __syncthreads();
  }
#undef GEMM_COMPUTE
#undef GEMM_LOAD
#undef GEMM_WRITE
}

template <class LA, class LB>
__device__ __forceinline__ void gemm2(const LA& la, const LB& lb, int KT, char* smem, f32x16 (&acc)[2][4]) {
  const int tid = tid_fresh(), wid = tid >> 6, lane = tid & 63, r32 = lane & 31, hi = lane >> 5, wm = wid >> 1, wn = wid & 1;
#pragma unroll
  for (int mi = 0; mi < 2; ++mi)
#pragma unroll
    for (int nj = 0; nj < 4; ++nj)
#pragma unroll
      for (int r = 0; r < 16; ++r) acc[mi][nj][r] = 0.f;
  const int st_off = (tid >> 3) * LDS_ROWB + (tid & 7) * 16;
  const int a_rd = (wm * 64 + r32) * LDS_ROWB + hi * 16;
  const int b_rd = L2_A + (wn * 128 + r32) * LDS_ROWB + hi * 16;
  u32x4 xa0, xa1, xa2, xa3, xb0, xb1, xb2, xb3, ya0, ya1, ya2, ya3, yb0, yb1, yb2, yb3;
#define G2_LOADX(KT_) do { xa0 = la.ld((KT_), 0); xa1 = la.ld((KT_), 1); xa2 = la.ld((KT_), 2); xa3 = la.ld((KT_), 3); xb0 = lb.ld((KT_), 0); xb1 = lb.ld((KT_), 1); xb2 = lb.ld((KT_), 2); xb3 = lb.ld((KT_), 3); } while (0)
#define G2_LOADY(KT_) do { ya0 = la.ld((KT_), 0); ya1 = la.ld((KT_), 1); ya2 = la.ld((KT_), 2); ya3 = la.ld((KT_), 3); yb0 = lb.ld((KT_), 0); yb1 = lb.ld((KT_), 1); yb2 = lb.ld((KT_), 2); yb3 = lb.ld((KT_), 3); } while (0)
#define G2_W2(ST, P, R0, R1, O0, O1) do { char* s_ = smem + (ST) * L2_STAGE + st_off; *(u32x4*)(s_ + (O0)) = P##R0; *(u32x4*)(s_ + (O1)) = P##R1; } while (0)
#define G2_WRITE(ST, P) do { G2_W2(ST, P, a0, a1, 0, 64 * LDS_ROWB); G2_W2(ST, P, a2, a3, 128 * LDS_ROWB, 192 * LDS_ROWB); \
    G2_W2(ST, P, b0, b1, L2_A, L2_A + 64 * LDS_ROWB); G2_W2(ST, P, b2, b3, L2_A + 128 * LDS_ROWB, L2_A + 192 * LDS_ROWB); } while (0)
#define G2_LDA(SB, kk, A0, A1) do { A0 = *(const bf16x8*)((SB) + a_rd + (kk) * 32); A1 = *(const bf16x8*)((SB) + a_rd + 32 * LDS_ROWB + (kk) * 32); } while (0)
#define G2_STEPP(SB, kk, A0, A1, N0, N1, HASNEXT) do {                                                \
    if (HASNEXT) G2_LDA(SB, (kk) + 1, N0, N1);                                                        \
    _Pragma("unroll") for (int nj = 0; nj < 4; ++nj) {                                                \
      const bf16x8 b_ = *(const bf16x8*)((SB) + b_rd + nj * 32 * LDS_ROWB + (kk) * 32);               \
      acc[0][nj] = __builtin_amdgcn_mfma_f32_32x32x16_bf16(b_, A0, acc[0][nj], 0, 0, 0);              \
      acc[1][nj] = __builtin_amdgcn_mfma_f32_32x32x16_bf16(b_, A1, acc[1][nj], 0, 0, 0);              \
    } } while (0)
#define G2_COMPUTE_W(SB, ST, P) do { bf16x8 p0_, p1_, q0_, q1_;                                        \
    G2_LDA(SB, 0, p0_, p1_);                                                                          \
    G2_STEPP(SB, 0, p0_, p1_, q0_, q1_, 1); G2_W2(ST, P, a0, a1, 0, 64 * LDS_ROWB);                   \
    G2_STEPP(SB, 1, q0_, q1_, p0_, p1_, 1); G2_W2(ST, P, a2, a3, 128 * LDS_ROWB, 192 * LDS_ROWB);     \
    G2_STEPP(SB, 2, p0_, p1_, q0_, q1_, 1); G2_W2(ST, P, b0, b1, L2_A, L2_A + 64 * LDS_ROWB);         \
    G2_STEPP(SB, 3, q0_, q1_, p0_, p1_, 0); G2_W2(ST, P, b2, b3, L2_A + 128 * LDS_ROWB, L2_A + 192 * LDS_ROWB); } while (0)
  G2_LOADX(0); G2_LOADY(1);
  G2_WRITE(0, x);
  __syncthreads();
  G2_LOADX(2 < KT ? 2 : 0);
#pragma unroll 1
  for (int kt = 0; kt < KT; kt += 2) {
    G2_COMPUTE_W(smem, 1, y);
    __syncthreads();
    G2_LOADY(kt + 3 < KT ? kt + 3 : KT - 1);
    G2_COMPUTE_W(smem + L2_STAGE, 0, x);
    __syncthreads();
    G2_LOADX(kt + 4 < KT ? kt + 4 : KT - 2);
  }
#undef G2_LOADX
#undef G2_LOADY
#undef G2_WRITE
#undef G2_W2
#undef G2_STEPP
#undef G2_LDA
#undef G2_COMPUTE_W
}
template <class F>
__device__ __forceinline__ void epi2_foreach(const f32x16 (&acc)[2][4], F&& f) {
  const int tid = tid_fresh(), wid = tid >> 6, lane = tid & 63, r32 = lane & 31, hi = lane >> 5, wm = wid >> 1, wn = wid & 1;
#pragma unroll
  for (int mi = 0; mi < 2; ++mi)
#pragma unroll
    for (int nj = 0; nj < 4; ++nj)
#pragma unroll
      for (int q = 0; q < 4; ++q)
        f(wm * 64 + mi * 32 + r32, wn * 128 + nj * 32 + q * 8 + hi * 4, acc[mi][nj][4 * q + 0], acc[mi][nj][4 * q + 1],
          acc[mi][nj][4 * q + 2], acc[mi][nj][4 * q + 3]);
}

template <class F>
__device__ __forceinline__ void epi_foreach(const f32x16 (&acc)[2][2], F&& f) {
  const int tid = tid_fresh(), wid = tid >> 6, lane = tid & 63, r32 = lane & 31, hi = lane >> 5, wm = wid >> 1, wn = wid & 1;
#pragma unroll
  for (int mi = 0; mi < 2; ++mi)
#pragma unroll
    for (int nj = 0; nj < 2; ++nj)
#pragma unroll
      for (int q = 0; q < 4; ++q)
        f(wm * 64 + mi * 32 + r32, nj * 64 + wn * 32 + q * 8 + hi * 4, acc[mi][nj][4 * q + 0], acc[mi][nj][4 * q + 1],
          acc[mi][nj][4 * q + 2], acc[mi][nj][4 * q + 3]);
}
__device__ __forceinline__ void st_bf4(bf16_t* p, float a, float b, float c, float d) {
  u32x2 w = {cvtpk(a, b), cvtpk(c, d)}; *(u32x2*)p = w;
}

__device__ __forceinline__ void tr_tile(const float* src, bf16_t* dst, int K, int N, int kt, int nt, float* tile) {
  const int tid = tid_fresh(), k0 = kt * 64, n0 = nt * 64;
#pragma unroll
  for (int j = 0; j < 8; ++j) { const int e = j * 512 + tid, r = e >> 6, c = e & 63; tile[r * 65 + c] = src[(size_t)(k0 + r) * N + n0 + c]; }
  __syncthreads();
  const int rn = tid >> 3, ck = (tid & 7) * 8;
  const float v0 = tile[(ck + 0) * 65 + rn], v1 = tile[(ck + 1) * 65 + rn], v2 = tile[(ck + 2) * 65 + rn], v3 = tile[(ck + 3) * 65 + rn];
  const float v4 = tile[(ck + 4) * 65 + rn], v5 = tile[(ck + 5) * 65 + rn], v6 = tile[(ck + 6) * 65 + rn], v7 = tile[(ck + 7) * 65 + rn];
  u32x4 w = {cvtpk(v0, v1), cvtpk(v2, v3), cvtpk(v4, v5), cvtpk(v6, v7)};
  *(u32x4*)(dst + (size_t)(n0 + rn) * K + k0 + ck) = w;
  __syncthreads();
}

__device__ __forceinline__ void phase0(const Params& p, char* smem) {
  const int tid = tid_fresh(), G = gridDim.x, bid = blockIdx.x;
  char* ws = p.ws;
  {
    float* s = (float*)smem;
    float* part = (float*)(smem + 17 * 1024 * 4);
    float* MOD = (float*)(ws + OFF_MOD);
    for (int u = bid; u < 96; u += G) {
      const int l = u / 48, j0 = (u % 48) * 64;
      for (int e = tid; e < 17 * 1024; e += 512) { const int r = e >> 10, k = e & 1023; const float cv = (r < 16) ? p.c[r * 1024 + k] : p.c_ctx[k]; s[e] = silu_f(cv); }
      __syncthreads();
      const int col = tid & 63, ks = tid >> 6;
      float a0 = 0, a1 = 0, a2 = 0, a3 = 0, a4 = 0, a5 = 0, a6 = 0, a7 = 0, a8 = 0, a9 = 0, a10 = 0, a11 = 0, a12 = 0, a13 = 0, a14 = 0, a15 = 0, a16 = 0;
      const float* w = p.w_mod + (size_t)l * 1024 * 3072 + j0 + col;
#pragma unroll 4
      for (int k = ks * 128; k < ks * 128 + 128; ++k) {
        const float wv = w[(size_t)k * 3072];
        a0 += s[0 * 1024 + k] * wv; a1 += s[1 * 1024 + k] * wv; a2 += s[2 * 1024 + k] * wv; a3 += s[3 * 1024 + k] * wv;
        a4 += s[4 * 1024 + k] * wv; a5 += s[5 * 1024 + k] * wv; a6 += s[6 * 1024 + k] * wv; a7 += s[7 * 1024 + k] * wv;
        a8 += s[8 * 1024 + k] * wv; a9 += s[9 * 1024 + k] * wv; a10 += s[10 * 1024 + k] * wv; a11 += s[11 * 1024 + k] * wv;
        a12 += s[12 * 1024 + k] * wv; a13 += s[13 * 1024 + k] * wv; a14 += s[14 * 1024 + k] * wv; a15 += s[15 * 1024 + k] * wv;
        a16 += s[16 * 1024 + k] * wv;
      }
      float* pp = part + ks * 17 * 64 + col;
      pp[0 * 64] = a0; pp[1 * 64] = a1; pp[2 * 64] = a2; pp[3 * 64] = a3; pp[4 * 64] = a4; pp[5 * 64] = a5; pp[6 * 64] = a6; pp[7 * 64] = a7;
      pp[8 * 64] = a8; pp[9 * 64] = a9; pp[10 * 64] = a10; pp[11 * 64] = a11; pp[12 * 64] = a12; pp[13 * 64] = a13; pp[14 * 64] = a14; pp[15 * 64] = a15;
      pp[16 * 64] = a16;
      __syncthreads();
      for (int e = tid; e < 17 * 64; e += 512) {
        const int r = e >> 6, cc = e & 63;
        float t = p.b_mod[l * 3072 + j0 + cc];
#pragma unroll
        for (int q = 0; q < 8; ++q) t += part[q * 17 * 64 + r * 64 + cc];
        MOD[(size_t)(l * 17 + r) * 3072 + j0 + cc] = t;
      }
      __syncthreads();
    }
  }
  {
    float* tile = (float*)smem;
    constexpr int T0 = 16 * 88, T1 = 32 * 16, T2 = 16 * 64, T3 = 32 * 16;
    for (int u = bid; u < T0 + T1 + T2 + T3; u += G) {
      if (u < T0) tr_tile(p.e_w_in, (bf16_t*)(ws + OFF_WT_EIN), 1024, EVEN_IN, u / 88, u % 88, tile);
      else if (u < T0 + T1) { const int v = u - T0; tr_tile(p.e_w_out, (bf16_t*)(ws + OFF_WT_EOUT), 2048, 1024, v / 16, v % 16, tile); }
      else if (u < T0 + T1 + T2) { const int v = u - T0 - T1; tr_tile(p.o_w_in, (bf16_t*)(ws + OFF_WT_OIN), 1024, ODD_IN, v / 64, v % 64, tile); }
      else { const int v = u - T0 - T1 - T2; tr_tile(p.o_w_out, (bf16_t*)(ws + OFF_WT_OOUT), 2048, 1024, v / 16, v % 16, tile); }
    }
  }
  {
    const long gt = (long)bid * 512 + tid, gn = (long)G * 512;
    bf16_t* TC = (bf16_t*)(ws + OFF_TAB_C); bf16_t* TS = (bf16_t*)(ws + OFF_TAB_S);
    (void)TS;
    for (long e = gt; e < 4L * 512 * 512; e += gn) {
      const int ty = (int)(e >> 18), sidx = (int)((e >> 9) & 511), t = (int)(e & 511);
      float v;
      if (ty == 0) v = cospif((float)((sidx * t) & 1023) * (1.f / 512.f));
      else if (ty == 1) v = cospif((float)(((2 * sidx + 1) * t) & 2047) * (1.f / 1024.f));
      else if (ty == 2) v = sinpif((float)((sidx * t) & 1023) * (1.f / 512.f));
      else v = sinpif((float)(((2 * sidx + 1) * t) & 2047) * (1.f / 1024.f));
      TC[e] = f2bf(v);
    }
    bf16_t* CDM = (bf16_t*)(ws + OFF_CDM); bf16_t* CDP = (bf16_t*)(ws + OFF_CDP);
    for (long e = gt; e < 128L * 256; e += gn) {
      const int cp = (int)(e >> 8), k = (int)(e & 255);
      const int m = (cp * (k & 127)) & 127;
      const float x = (float)m * (1.f / 64.f);
      float vm, vp;
      if (k < 128) { vm = cospif(x); vp = vm; } else { vp = sinpif(x); vm = -vp; }
      CDM[e] = f2bf(vm); CDP[e] = f2bf(vp);
    }
    bf16_t* WSB = (bf16_t*)(ws + OFF_WSB);
    for (long e = gt; e < 8L * 128 * 128; e += gn) WSB[e] = f2bf(p.e_ws[e]);
    float2* ROPE = (float2*)(ws + OFF_ROPE);
    for (long e = gt; e < 64L * 32; e += gn) {
      const int pos = (int)(e >> 5), i = (int)(e & 31);
      const float inv = powf(10000.f, -(float)i / 32.f);
      const float ang = (float)pos * inv;
      ROPE[e] = make_float2(cosf(ang), sinf(ang));
    }
  }
}

__device__ __forceinline__ void ln_rows_modulate(const float* src, bf16_t* dst, int nrows, int rows_per_b, const float* mod17, int fixed_row) {
  const int tid = tid_fresh(), wid = tid >> 6, lane = tid & 63;
  const int gw = blockIdx.x * 8 + wid, nw = gridDim.x * 8;
  float4 n0, n1, n2, n3;
  { const int r0 = gw < nrows ? gw : 0; const float4* ps = (const float4*)(src + (size_t)r0 * 1024); n0 = ps[lane]; n1 = ps[lane + 64]; n2 = ps[lane + 128]; n3 = ps[lane + 192]; }
  for (int row = gw; row < nrows; row += nw) {
    float4 v0 = n0, v1 = n1, v2 = n2, v3 = n3;
    { const int nr = (row + nw < nrows) ? row + nw : row;
      const float4* ps = (const float4*)(src + (size_t)nr * 1024); n0 = ps[lane]; n1 = ps[lane + 64]; n2 = ps[lane + 128]; n3 = ps[lane + 192]; }
    float s = v0.x + v0.y + v0.z + v0.w + v1.x + v1.y + v1.z + v1.w + v2.x + v2.y + v2.z + v2.w + v3.x + v3.y + v3.z + v3.w;
    const float mu = wave_sum(s) * (1.f / 1024.f);
    v0.x -= mu; v0.y -= mu; v0.z -= mu; v0.w -= mu; v1.x -= mu; v1.y -= mu; v1.z -= mu; v1.w -= mu;
    v2.x -= mu; v2.y -= mu; v2.z -= mu; v2.w -= mu; v3.x -= mu; v3.y -= mu; v3.z -= mu; v3.w -= mu;
    float q = v0.x * v0.x + v0.y * v0.y + v0.z * v0.z + v0.w * v0.w + v1.x * v1.x + v1.y * v1.y + v1.z * v1.z + v1.w * v1.w +
              v2.x * v2.x + v2.y * v2.y + v2.z * v2.z + v2.w * v2.w + v3.x * v3.x + v3.y * v3.y + v3.z * v3.z + v3.w * v3.w;
    const float rstd = rsqrtf(wave_sum(q) * (1.f / 1024.f) + EPS);
    const int mr = (fixed_row >= 0) ? fixed_row : (row / rows_per_b);
    const float* md = mod17 + (size_t)mr * 3072;
    bf16_t* pd = dst + (size_t)row * 1024;
#define MODST(V, J) { const int col = (lane + 64 * J) * 4; const float4 sh = *(const float4*)(md + col); const float4 sc = *(const float4*)(md + 1024 + col); \
      st_bf4(pd + col, V.x * rstd * (1.f + sc.x) + sh.x, V.y * rstd * (1.f + sc.y) + sh.y, V.z * rstd * (1.f + sc.z) + sh.z, V.w * rstd * (1.f + sc.w) + sh.w); }
    MODST(v0, 0) MODST(v1, 1) MODST(v2, 2) MODST(v3, 3)
#undef MODST
  }
}

__device__ __forceinline__ void phase2(const Params& p, char* smem) {
  char* ws = p.ws;
  const bf16_t* M0 = (const bf16_t*)(ws + OFF_M0); const bf16_t* MC = (const bf16_t*)(ws + OFF_MC);
  const bf16_t* WT = (const bf16_t*)(ws + OFF_WT_EIN);
  bf16_t* Q = (bf16_t*)(ws + OFF_Q); bf16_t* KA = (bf16_t*)(ws + OFF_KALL); bf16_t* VA = (bf16_t*)(ws + OFF_VALL);
  bf16_t* BU = (bf16_t*)(ws + OFF_BU); bf16_t* BV = (bf16_t*)(ws + OFF_BV); bf16_t* SG = (bf16_t*)(ws + OFF_SG);
  const float2* ROPE = (const float2*)(ws + OFF_ROPE);
  const int tid = tid_fresh(), wid = tid >> 6, lane = tid & 63, r32 = lane & 31, hi = lane >> 5, wm = wid >> 1, wn = wid & 1;
  const int lb = logical_block();
  for (int u = lb; u < 2816 + 32; u += gridDim.x) {
    const bool isctx = (u >= 2816);
    int mt, nt;
    if (!isctx) { mt = u / 22; nt = u % 22; } else { const int v = u - 2816; mt = v >> 1; nt = 4 + (v & 1); }
    const bf16_t* A = (isctx ? MC : M0) + (size_t)mt * 256 * 1024;
    f32x16 acc[2][4];
    gemm2(mkPlain(A, 1024), mkPlain(WT + (size_t)nt * 256 * 1024, 1024), 16, smem, acc);
    if (nt < 5) {
      const bool isq = nt < 4;
      const int head = isq ? (nt * 2 + wn) : wn;
      const float* gv = isq ? p.e_qn : p.e_kn;
#pragma unroll
      for (int mi = 0; mi < 2; ++mi) {
        float ss = 0.f;
#pragma unroll
        for (int nj = 0; nj < 4; ++nj)
#pragma unroll
          for (int r = 0; r < 16; ++r) ss += acc[mi][nj][r] * acc[mi][nj][r];
        ss += __shfl_xor(ss, 32);
        const float rstd = rsqrtf(ss * (1.f / 128.f) + EPS);
        const int row = wm * 64 + mi * 32 + r32;
        int t = 0; size_t obase;
        if (!isctx) {
          const int b = mt >> 3; t = (mt & 7) * 256 + row;
          if (isq) obase = ((size_t)(b * SEQ + t) * 8 + head) * 128;
          else obase = ((size_t)(b * SKV + CTXL + t) * 2 + head) * 128;
        } else {
          obase = ((size_t)(mt * SKV + row) * 2 + head) * 128;
        }
        bf16_t* dst = (isq ? Q : KA) + obase;
#pragma unroll
        for (int nj = 0; nj < 2; ++nj) {
          const int pos = (nj == 0) ? (t >> 6) : (t & 63);
#pragma unroll
          for (int q = 0; q < 4; ++q) {
            float o1[4], o2[4];
#pragma unroll
            for (int e = 0; e < 4; ++e) {
              const int r = 4 * q + e;
              const int i = 8 * q + 4 * hi + e;
              const int d = nj * 32 + i;
              const float x1 = acc[mi][nj][r] * rstd * gv[d];
              const float x2 = acc[mi][nj + 2][r] * rstd * gv[64 + d];
              if (!isctx) {
                const float2 cs = ROPE[pos * 32 + i];
                o1[e] = x1 * cs.x - x2 * cs.y; o2[e] = x2 * cs.x + x1 * cs.y;
              } else { o1[e] = x1; o2[e] = x2; }
            }
            const int d0 = nj * 32 + 8 * q + 4 * hi;
            st_bf4(dst + d0, o1[0], o1[1], o1[2], o1[3]);
            st_bf4(dst + 64 + d0, o2[0], o2[1], o2[2], o2[3]);
          }
        }
      }
    } else if (nt == 5) {
      epi2_foreach(acc, [&](int row, int col, float a, float b, float c, float d) {
        size_t tokrow;
        if (!isctx) { const int bb = mt >> 3, t = (mt & 7) * 256 + row; tokrow = (size_t)bb * SKV + CTXL + t; } else tokrow = (size_t)mt * SKV + row;
        st_bf4(VA + tokrow * 256 + col, a, b, c, d);
      });
    } else if (nt < 14) {
      bf16_t* dst = (nt < 10) ? (BU + (size_t)(nt - 6) * 256) : (BV + (size_t)(nt - 10) * 256);
      epi2_foreach(acc, [&](int row, int col, float a, float b, float c, float d) {
        st_bf4(dst + (size_t)(mt * 256 + row) * 1024 + col, gelu_tanh_f(a), gelu_tanh_f(b), gelu_tanh_f(c), gelu_tanh_f(d));
      });
    } else {
      bf16_t* dst = SG + (size_t)(nt - 14) * 256;
      epi2_foreach(acc, [&](int row, int col, float a, float b, float c, float d) {
        st_bf4(dst + (size_t)(mt * 256 + row) * 2048 + col, silu_f(a), silu_f(b), silu_f(c), silu_f(d));
      });
    }
  }
}

namespace att {
constexpr int D = 128, NW = 8, QBLK = 32, KVBLK = 64;
constexpr float SCALE = 0.088388347648318440f;
constexpr float THR = 8.f;
constexpr int LDQ = 1024, LDK = 256;
constexpr int SHM_V = KVBLK * D * 2, SHM_K = KVBLK * D * 2;
#define KSWZ(row, colB) ((row) * 256 + ((colB) ^ (((row) & 7) << 4)))
#define SBAR() __builtin_amdgcn_sched_barrier(0)
__device__ __forceinline__ void partialSM(f32x16& p0, f32x16& p1, float& m_reg, float& mn, float& alpha) {
  constexpr float C = SCALE * 1.4426950408889634f;
  float pmax = p0[0];
#pragma unroll
  for (int r = 1; r < 16; ++r) pmax = fmaxf(pmax, p0[r]);
#pragma unroll
  for (int r = 0; r < 16; ++r) pmax = fmaxf(pmax, p1[r]);
  { auto rr = __builtin_amdgcn_permlane32_swap(__float_as_uint(pmax), __float_as_uint(pmax), false, false);
    pmax = fmaxf(__uint_as_float(rr[0]), __uint_as_float(rr[1])); }
  if (__builtin_expect(__all(pmax - m_reg <= THR / SCALE), 1)) { mn = m_reg; alpha = 1.f; }
  else { mn = fmaxf(m_reg, pmax); alpha = __builtin_amdgcn_exp2f((m_reg - mn) * C); m_reg = mn; }
  const float mnC = -mn * C;
#pragma unroll
  for (int r = 0; r < 16; ++r) p0[r] = fmaf(p0[r], C, mnC);
#pragma unroll
  for (int r = 0; r < 16; ++r) p1[r] = fmaf(p1[r], C, mnC);
#pragma unroll
  for (int r = 0; r < 16; ++r) p0[r] = __builtin_amdgcn_exp2f(p0[r]);
}
__device__ __forceinline__ void finishSM(f32x16& p0, f32x16& p1, float alpha, float& l_reg, bf16x8& pa0, bf16x8& pa1, bf16x8& pa2, bf16x8& pa3) {
#pragma unroll
  for (int r = 0; r < 16; ++r) p1[r] = __builtin_amdgcn_exp2f(p1[r]);
  float ps = 0;
#pragma unroll
  for (int r = 0; r < 16; ++r) ps += p0[r];
#pragma unroll
  for (int r = 0; r < 16; ++r) ps += p1[r];
  { auto rr = __builtin_amdgcn_permlane32_swap(__float_as_uint(ps), __float_as_uint(ps), false, false);
    ps = __uint_as_float(rr[0]) + __uint_as_float(rr[1]); }
  l_reg = l_reg * alpha + ps;
#define PK4(P, BASE, OUT) do { unsigned a0 = cvtpk(P[BASE + 0], P[BASE + 1]), a1 = cvtpk(P[BASE + 2], P[BASE + 3]);   \
    unsigned b0 = cvtpk(P[BASE + 4], P[BASE + 5]), b1 = cvtpk(P[BASE + 6], P[BASE + 7]);                              \
    auto r0 = __builtin_amdgcn_permlane32_swap(a0, b0, false, false); auto r1 = __builtin_amdgcn_permlane32_swap(a1, b1, false, false); \
    u32x4 w = {r0[0], r1[0], r0[1], r1[1]}; OUT = *reinterpret_cast<bf16x8*>(&w); } while (0)
  PK4(p0, 0, pa0); PK4(p0, 8, pa1); PK4(p1, 0, pa2); PK4(p1, 8, pa3);
#undef PK4
}
__device__ __forceinline__ void qkt(f32x16& p0, f32x16& p1, const bf16_t* Ks, const bf16x8* qr, int r32, int hi) {
#pragma unroll
  for (int r = 0; r < 16; ++r) { p0[r] = 0.f; p1[r] = 0.f; }
#pragma unroll
  for (int d0 = 0; d0 < 8; ++d0) { const int cb = (d0 * 16 + hi * 8) * 2;
    bf16x8 b0 = *reinterpret_cast<const bf16x8*>((const char*)Ks + KSWZ(r32, cb));
    bf16x8 b1 = *reinterpret_cast<const bf16x8*>((const char*)Ks + KSWZ(32 + r32, cb));
    p0 = __builtin_amdgcn_mfma_f32_32x32x16_bf16(b0, qr[d0], p0, 0, 0, 0);
    p1 = __builtin_amdgcn_mfma_f32_32x32x16_bf16(b1, qr[d0], p1, 0, 0, 0); }
}
__device__ __forceinline__ int v_st(int k, int c) { const int kk = (k & ~0xC) | ((k & 4) << 1) | ((k & 8) >> 1); return ((kk >> 3) * 4 + (c >> 5)) * 512 + ((kk & 7) * 32 + (c & 31)) * 2; }
__device__ __forceinline__ int v_rd_base(int lane) { return ((lane & 3) << 3) | (((lane >> 2) & 3) << 6) | (((lane >> 4) & 1) << 5) | (((lane >> 5) & 1) << 8); }
constexpr int v_rd_off(int d0, int ks, int half) { return d0 * 512 + ks * 4096 + half * 2048; }
template <int OFF> __device__ __forceinline__ s16x4 tr_read(int vb) {
  s16x4 r; asm volatile("ds_read_b64_tr_b16 %0, %1 offset:%2" : "=&v"(r) : "v"(vb), "i"(OFF) : "memory"); return r;
}
template <int D0> __device__ __forceinline__ void pv_one(f32x16& od, int vb, bf16x8 pa0, bf16x8 pa1, bf16x8 pa2, bf16x8 pa3) {
  const s16x4 l0 = tr_read<v_rd_off(D0, 0, 0)>(vb), h0 = tr_read<v_rd_off(D0, 0, 1)>(vb), l1 = tr_read<v_rd_off(D0, 1, 0)>(vb), h1 = tr_read<v_rd_off(D0, 1, 1)>(vb);
  const s16x4 l2 = tr_read<v_rd_off(D0, 2, 0)>(vb), h2 = tr_read<v_rd_off(D0, 2, 1)>(vb), l3 = tr_read<v_rd_off(D0, 3, 0)>(vb), h3 = tr_read<v_rd_off(D0, 3, 1)>(vb);
  asm volatile("s_waitcnt lgkmcnt(0)" ::: "memory"); SBAR();
#define PK(L, H) (bf16x8){L[0], L[1], L[2], L[3], H[0], H[1], H[2], H[3]}
  od = __builtin_amdgcn_mfma_f32_32x32x16_bf16(pa0, PK(l0, h0), od, 0, 0, 0);
  od = __builtin_amdgcn_mfma_f32_32x32x16_bf16(pa1, PK(l1, h1), od, 0, 0, 0);
  od = __builtin_amdgcn_mfma_f32_32x32x16_bf16(pa2, PK(l2, h2), od, 0, 0, 0);
  od = __builtin_amdgcn_mfma_f32_32x32x16_bf16(pa3, PK(l3, h3), od, 0, 0, 0);
#undef PK
}
__device__ __forceinline__ void pv_d0(f32x16* o, int vb, bf16x8 pa0, bf16x8 pa1, bf16x8 pa2, bf16x8 pa3) {
  pv_one<0>(o[0], vb, pa0, pa1, pa2, pa3); pv_one<1>(o[1], vb, pa0, pa1, pa2, pa3); pv_one<2>(o[2], vb, pa0, pa1, pa2, pa3); pv_one<3>(o[3], vb, pa0, pa1, pa2, pa3);
}
__device__ __forceinline__ void attn_body(const bf16_t* __restrict__ Qb, const bf16_t* __restrict__ Kh, const bf16_t* __restrict__ Vh,
                                          bf16_t* GO, int seq, char* lds) {
  const int tid = tid_fresh(), wid = tid >> 6, lane = tid & 63, r32 = lane & 31, hi = lane >> 5;
  bf16_t* V_lds = (bf16_t*)lds; bf16_t* K_lds = (bf16_t*)(lds + 2 * SHM_V);
  float* wsx = (float*)(lds + 2 * SHM_V + 2 * SHM_K) + wid * 64; float* li_l = wsx; float* al_l = wsx + 32;
  float m_reg = -1e30f, l_reg = 0; f32x16 o[4]; bf16x8 qr[8];
#pragma unroll
  for (int d = 0; d < 4; ++d)
#pragma unroll
    for (int r = 0; r < 16; ++r) o[d][r] = 0.f;
  const bf16_t* Qw = Qb + (long)(wid * QBLK + r32) * LDQ + hi * 8;
#pragma unroll
  for (int d0 = 0; d0 < 8; ++d0) qr[d0] = *reinterpret_cast<const bf16x8*>(Qw + d0 * 16);
  const int sr = tid >> 4, sc = (tid & 15) * 8, vst0 = v_st(sr, sc), vst1 = v_st(32 + sr, sc);
  const int vb0 = (int)(uintptr_t)V_lds + v_rd_base(lane);
  constexpr int SDEPTH = 1;
  bf16x8 sv0[SDEPTH], sv1[SDEPTH], sk0[SDEPTH], sk1[SDEPTH];
#define SLOAD(i, k0) do { sv0[i] = *reinterpret_cast<const bf16x8*>(&Vh[(long)((k0) + sr) * LDK + sc]); sv1[i] = *reinterpret_cast<const bf16x8*>(&Vh[(long)((k0) + 32 + sr) * LDK + sc]); \
    sk0[i] = *reinterpret_cast<const bf16x8*>(&Kh[(long)((k0) + sr) * LDK + sc]); sk1[i] = *reinterpret_cast<const bf16x8*>(&Kh[(long)((k0) + 32 + sr) * LDK + sc]); } while (0)
#define SWRITE(b, i) do { *(bf16x8*)((char*)V_lds + (b) * SHM_V + vst0) = sv0[i];          \
    *(bf16x8*)((char*)V_lds + (b) * SHM_V + vst1) = sv1[i]; const int kc = sc * 2;               \
    *(bf16x8*)((char*)K_lds + (b) * SHM_K + KSWZ(sr, kc)) = sk0[i];                       \
    *(bf16x8*)((char*)K_lds + (b) * SHM_K + KSWZ(32 + sr, kc)) = sk1[i]; } while (0)
#define SWAIT() do { if (SDEPTH == 2) asm volatile("s_waitcnt vmcnt(4)" ::: "memory"); else asm volatile("s_waitcnt vmcnt(0)" ::: "memory"); } while (0)
#define RESC(a) do { if (__any((a) < 1.f)) { if (hi == 0) al_l[r32] = (a); asm volatile("s_waitcnt lgkmcnt(0)" ::: "memory"); \
    _Pragma("unroll") for (int d = 0; d < 4; ++d) _Pragma("unroll") for (int r = 0; r < 16; ++r) o[d][r] *= al_l[crow(r, hi)]; } } while (0)
  f32x16 pA0, pA1, pB0, pB1; float mnA, mnB, alA, alB; bf16x8 pa0, pa1, pa2, pa3; const int NT = seq / KVBLK;
  constexpr int SE = 0, SO = SDEPTH - 1;
  SLOAD(SE, 0); asm volatile("s_waitcnt vmcnt(0)" ::: "memory"); SWRITE(0, SE); __syncthreads();
  qkt(pA0, pA1, K_lds, qr, r32, hi); partialSM(pA0, pA1, m_reg, mnA, alA);
  SLOAD(SO, KVBLK); if (SDEPTH == 2) { if (2 < NT) SLOAD(SE, 2 * KVBLK); }
  SWAIT(); SWRITE(1, SO); __syncthreads();
  for (int j = 1; j + 1 < NT; j += 2) {
    SBAR(); qkt(pB0, pB1, (bf16_t*)((char*)K_lds + SHM_K), qr, r32, hi);
    finishSM(pA0, pA1, alA, l_reg, pa0, pa1, pa2, pa3); SBAR();
    SLOAD(SO, (j + SDEPTH) * KVBLK); SBAR();
    pv_d0(o, vb0, pa0, pa1, pa2, pa3); partialSM(pB0, pB1, m_reg, mnB, alB);
    __syncthreads(); SWAIT(); SWRITE(0, SE);
    RESC(alB); __syncthreads();
    SBAR(); qkt(pA0, pA1, K_lds, qr, r32, hi);
    finishSM(pB0, pB1, alB, l_reg, pa0, pa1, pa2, pa3); SBAR();
    if (SDEPTH == 1 || j + 3 < NT) SLOAD(SE, (j + 1 + SDEPTH) * KVBLK); SBAR();
    pv_d0(o, vb0 + (int)SHM_V, pa0, pa1, pa2, pa3); partialSM(pA0, pA1, m_reg, mnA, alA);
    __syncthreads(); SWAIT(); SWRITE(1, SO);
    RESC(alA); __syncthreads();
  }
  SBAR(); qkt(pB0, pB1, (bf16_t*)((char*)K_lds + SHM_K), qr, r32, hi);
  finishSM(pA0, pA1, alA, l_reg, pa0, pa1, pa2, pa3); SBAR();
  pv_d0(o, vb0, pa0, pa1, pa2, pa3); partialSM(pB0, pB1, m_reg, mnB, alB);
  __syncthreads(); RESC(alB);
  finishSM(pB0, pB1, alB, l_reg, pa0, pa1, pa2, pa3); SBAR();
  pv_d0(o, vb0 + (int)SHM_V, pa0, pa1, pa2, pa3);
  if (hi == 0) li_l[r32] = l_reg; asm volatile("s_waitcnt lgkmcnt(0)" ::: "memory");
  float rli[16];
#pragma unroll
  for (int r = 0; r < 16; ++r) rli[r] = __builtin_amdgcn_rcpf(li_l[crow(r, hi)]);
  bf16_t* Ow = GO + (long)(wid * QBLK) * 2048;
#pragma unroll
  for (int r = 0; r < 16; ++r) { const int orow = crow(r, hi);
#pragma unroll
    for (int d0 = 0; d0 < 4; ++d0) { bf16_t* q = Ow + (long)orow * 2048 + d0 * 32 + r32; *q = f2bf(o[d0][r] * rli[r] * bf2f(*q)); }
    SBAR(); }
  __syncthreads();
#undef SLOAD
#undef SWRITE
#undef SWAIT
#undef RESC
}
}

__device__ __forceinline__ void chunk_gate_unit(const Params& p, int b, int n, char* smem) {
  char* ws = p.ws;
  const bf16_t* BU = (const bf16_t*)(ws + OFF_BU); const bf16_t* BV = (const bf16_t*)(ws + OFF_BV);
  bf16_t* SG = (bf16_t*)(ws + OFF_SG); const bf16_t* WSB = (const bf16_t*)(ws + OFF_WSB);
  const int tid = tid_fresh(), wid = tid >> 6, lane = tid & 63, r32 = lane & 31, hi = lane >> 5;
  constexpr int RS = 272;
  char* sW = smem; char* sV = smem + 128 * RS;
  float* smu = (float*)(smem + 2 * 128 * RS); float* srs = smu + 128;
  const size_t tok0 = (size_t)b * SEQ + (size_t)n * 128;
  {
    const int q = tid >> 2, part = tid & 3;
    const u32x4* src = (const u32x4*)(BV + (tok0 + q) * 1024 + part * 256);
    float s = 0.f, s2 = 0.f;
#pragma unroll 4
    for (int i = 0; i < 32; ++i) {
      const u32x4 w = src[i];
#pragma unroll
      for (int e = 0; e < 4; ++e) { const float a = bf_lo(w[e]), c = bf_hi(w[e]); s += a + c; s2 += a * a + c * c; }
    }
    s += __shfl_xor(s, 1); s2 += __shfl_xor(s2, 1); s += __shfl_xor(s, 2); s2 += __shfl_xor(s2, 2);
    const float mu = s * (1.f / 1024.f);
    const float var = fmaxf(s2 * (1.f / 1024.f) - mu * mu, 0.f);
    if (part == 0) { smu[q] = mu; srs[q] = rsqrtf(var + EPS); }
  }
  __syncthreads();
  const int wp = wid >> 1, wc = wid & 1;
  for (int g = 0; g < 8; ++g) {
#pragma unroll
    for (int i = 0; i < 4; ++i) {
      const int id = tid + 512 * i, row = id >> 4, ck = (id & 15) * 8;
      *(u32x4*)(sW + row * RS + ck * 2) = *(const u32x4*)(WSB + (size_t)g * 16384 + row * 128 + ck);
    }
#pragma unroll
    for (int i = 0; i < 4; ++i) {
      const int id = tid + 512 * i, q = id & 127, cc = (id >> 7) * 8;
      const u32x4 w = *(const u32x4*)(BV + (tok0 + q) * 1024 + g * 128 + cc);
      const float mu = smu[q], rs = srs[q];
      const float* lg = p.e_vg + g * 128 + cc; const float* lbp = p.e_vb + g * 128 + cc;
#pragma unroll
      for (int e = 0; e < 4; ++e) {
        const float a = (bf_lo(w[e]) - mu) * rs * lg[2 * e] + lbp[2 * e];
        const float c = (bf_hi(w[e]) - mu) * rs * lg[2 * e + 1] + lbp[2 * e + 1];
        *(bf16_t*)(sV + (cc + 2 * e) * RS + q * 2) = f2bf(a);
        *(bf16_t*)(sV + (cc + 2 * e + 1) * RS + q * 2) = f2bf(c);
      }
    }
    __syncthreads();
    f32x16 acc0, acc1;
#pragma unroll
    for (int r = 0; r < 16; ++r) { acc0[r] = 0.f; acc1[r] = 0.f; }
#pragma unroll
    for (int kk = 0; kk < 8; ++kk) {
      const bf16x8 af = *(const bf16x8*)(sW + (wp * 32 + r32) * RS + kk * 32 + hi * 16);
      const bf16x8 b0 = *(const bf16x8*)(sV + (wc * 64 + r32) * RS + kk * 32 + hi * 16);
      const bf16x8 b1 = *(const bf16x8*)(sV + (wc * 64 + 32 + r32) * RS + kk * 32 + hi * 16);
      acc0 = __builtin_amdgcn_mfma_f32_32x32x16_bf16(b0, af, acc0, 0, 0, 0);
      acc1 = __builtin_amdgcn_mfma_f32_32x32x16_bf16(b1, af, acc1, 0, 0, 0);
    }
    const int pr = wp * 32 + r32;
    const float bias = p.e_bs[g * 128 + pr];
    const size_t tok = tok0 + pr;
#pragma unroll
    for (int nj = 0; nj < 2; ++nj)
#pragma unroll
      for (int q = 0; q < 4; ++q) {
        const int col = g * 128 + wc * 64 + nj * 32 + q * 8 + hi * 4;
        const u32x2 bu = *(const u32x2*)(BU + tok * 1024 + col);
        bf16_t* gp = SG + tok * 2048 + 1024 + col;
        const u32x2 sg = *(const u32x2*)gp;
        const float m0 = (nj ? acc1[4 * q + 0] : acc0[4 * q + 0]) + bias, m1 = (nj ? acc1[4 * q + 1] : acc0[4 * q + 1]) + bias;
        const float m2 = (nj ? acc1[4 * q + 2] : acc0[4 * q + 2]) + bias, m3 = (nj ? acc1[4 * q + 3] : acc0[4 * q + 3]) + bias;
        st_bf4(gp, bf_lo(bu[0]) * m0 * bf_lo(sg[0]), bf_hi(bu[0]) * m1 * bf_hi(sg[0]), bf_lo(bu[1]) * m2 * bf_lo(sg[1]), bf_hi(bu[1]) * m3 * bf_hi(sg[1]));
      }
    __syncthreads();
  }
}

__device__ __forceinline__ void post_ln_rows(const float* resid, const bf16_t* yg, float* dst, const float* pg, const float* pb, bf16_t* m1, const float* mod17) {
  const int tid = tid_fresh(), wid = tid >> 6, lane = tid & 63;
  const int gw = blockIdx.x * 8 + wid, nw = gridDim.x * 8;
  float4 nx[4]; u32x2 ny[4];
  { const float4* ps = (const float4*)(resid + (size_t)gw * 1024); const u32x2* py = (const u32x2*)(yg + (size_t)gw * 1024);
#pragma unroll
    for (int j = 0; j < 4; ++j) { nx[j] = ps[lane + 64 * j]; ny[j] = py[lane + 64 * j]; } }
  for (int row = gw; row < NTOK; row += nw) {
    float4 v[4];
#pragma unroll
    for (int j = 0; j < 4; ++j) {
      v[j].x = ALPHA * nx[j].x + bf_lo(ny[j][0]); v[j].y = ALPHA * nx[j].y + bf_hi(ny[j][0]);
      v[j].z = ALPHA * nx[j].z + bf_lo(ny[j][1]); v[j].w = ALPHA * nx[j].w + bf_hi(ny[j][1]);
    }
    { const int nr = (row + nw < NTOK) ? row + nw : row;
      const float4* ps = (const float4*)(resid + (size_t)nr * 1024); const u32x2* py = (const u32x2*)(yg + (size_t)nr * 1024);
#pragma unroll
      for (int j = 0; j < 4; ++j) { nx[j] = ps[lane + 64 * j]; ny[j] = py[lane + 64 * j]; } }
    float s = 0.f;
#pragma unroll
    for (int j = 0; j < 4; ++j) s += v[j].x + v[j].y + v[j].z + v[j].w;
    float mu = wave_sum(s) * (1.f / 1024.f);
    float q = 0.f;
#pragma unroll
    for (int j = 0; j < 4; ++j) { v[j].x -= mu; v[j].y -= mu; v[j].z -= mu; v[j].w -= mu; q += v[j].x * v[j].x + v[j].y * v[j].y + v[j].z * v[j].z + v[j].w * v[j].w; }
    float rstd = rsqrtf(wave_sum(q) * (1.f / 1024.f) + EPS);
    float4* pd = (float4*)(dst + (size_t)row * 1024);
    s = 0.f;
#pragma unroll
    for (int j = 0; j < 4; ++j) {
      const int col = (lane + 64 * j) * 4;
      const float4 g4 = *(const float4*)(pg + col), b4 = *(const float4*)(pb + col);
      v[j].x = v[j].x * rstd * g4.x + b4.x; v[j].y = v[j].y * rstd * g4.y + b4.y; v[j].z = v[j].z * rstd * g4.z + b4.z; v[j].w = v[j].w * rstd * g4.w + b4.w;
      pd[lane + 64 * j] = v[j];
      s += v[j].x + v[j].y + v[j].z + v[j].w;
    }
    if (m1) {
      mu = wave_sum(s) * (1.f / 1024.f);
      q = 0.f;
#pragma unroll
      for (int j = 0; j < 4; ++j) { v[j].x -= mu; v[j].y -= mu; v[j].z -= mu; v[j].w -= mu; q += v[j].x * v[j].x + v[j].y * v[j].y + v[j].z * v[j].z + v[j].w * v[j].w; }
      rstd = rsqrtf(wave_sum(q) * (1.f / 1024.f) + EPS);
      const float* md = mod17 + (size_t)(row >> 11) * 3072;
      bf16_t* pm = m1 + (size_t)row * 1024;
#pragma unroll
      for (int j = 0; j < 4; ++j) {
        const int col = (lane + 64 * j) * 4;
        const float4 sh = *(const float4*)(md + col), sc = *(const float4*)(md + 1024 + col);
        st_bf4(pm + col, v[j].x * rstd * (1.f + sc.x) + sh.x, v[j].y * rstd * (1.f + sc.y) + sh.y, v[j].z * rstd * (1.f + sc.z) + sh.z, v[j].w * rstd * (1.f + sc.w) + sh.w);
      }
    }
  }
}

__device__ __forceinline__ void out_proj(const bf16_t* A, const bf16_t* WT, const float* gate17, bf16_t* dst, char* smem) {
  const int lb = logical_block();
  for (int u = lb; u < 512; u += gridDim.x) {
    const int mt = u >> 2, nt = u & 3;
    f32x16 acc[2][4];
    gemm2(mkPlain(A + (size_t)mt * 256 * 2048, 2048), mkPlain(WT + (size_t)nt * 256 * 2048, 2048), 32, smem, acc);
    const float* gt = gate17 + (size_t)(mt >> 3) * 3072 + 2048 + nt * 256;
    epi2_foreach(acc, [&](int row, int col, float a, float b, float c, float d) {
      const size_t idx = (size_t)(mt * 256 + row) * 1024 + nt * 256 + col;
      const float4 g4 = *(const float4*)(gt + col);
      st_bf4(dst + idx, g4.x * a, g4.y * b, g4.z * c, g4.w * d);
    });
  }
}

#define XB_TMO      128
#define XB_XCNT(j)  (256  + 64 * (j))
#define XB_XSUB(j)  (1280 + 64 * (j))
#define XB_XGEN(j)  (2304 + 64 * (j))
#define XB_TOP      3328
#define XB_TOPGEN   3392
#define XCD_BAR_WORDS 3456
#define XB_SPIN_CAP (1u << 18)
#define LAS __attribute__((address_space(3)))

__device__ __forceinline__ unsigned xb_ld(unsigned* p)              { return __hip_atomic_load(p, __ATOMIC_RELAXED, __HIP_MEMORY_SCOPE_AGENT); }
__device__ __forceinline__ unsigned xb_add(unsigned* p, unsigned v) { return __hip_atomic_fetch_add(p, v, __ATOMIC_RELAXED, __HIP_MEMORY_SCOPE_AGENT); }
__device__ __forceinline__ unsigned xb_xcc_id() { return (unsigned)__builtin_amdgcn_s_getreg((3 << 11) | 20) & 0xFu; }
#define XB_SPIN(cond, bar) do { unsigned _sp = 0; while (cond) { __builtin_amdgcn_s_sleep(1); \
    if ((++_sp & 255u) == 0u) { if (xb_ld(&(bar)[XB_TMO])) break; if (_sp > XB_SPIN_CAP) { atomicAdd(&(bar)[XB_TMO], 1u); break; } } } } while (0)

struct XcdBarrier {
    unsigned* bar; unsigned x;
    volatile LAS unsigned* st;
};

__device__ __forceinline__ XcdBarrier xcd_barrier_post(unsigned* bar, volatile LAS unsigned* st) {
    XcdBarrier b; b.bar = bar; b.x = xb_xcc_id(); b.st = st;
    if (threadIdx.x == 0) (void)xb_add(&bar[XB_XCNT(b.x)], 1u);
    return b;
}
__device__ __forceinline__ void xcd_barrier_complete(unsigned* bar, unsigned x, unsigned& nloc, unsigned& nx) {
    const unsigned G = gridDim.x * gridDim.y * gridDim.z;
    unsigned sum, cnt, mine, sp = 0u;
    for (;;) {
        sum = 0u; cnt = 0u; mine = 0u;
#pragma unroll
        for (unsigned j = 0; j < 16; ++j) { const unsigned c = xb_ld(&bar[XB_XCNT(j)]); sum += c; cnt += (c > 0u) ? 1u : 0u; mine = (j == x) ? c : mine; }
        if (sum == G) break;
        __builtin_amdgcn_s_sleep(1);
        if ((++sp & 255u) == 0u) { if (xb_ld(&bar[XB_TMO])) break; if (sp > XB_SPIN_CAP) { atomicAdd(&bar[XB_TMO], 1u); break; } }
    }
    nloc = mine > 0u ? mine : 1u; nx = cnt > 0u ? cnt : 1u;
}

__device__ __forceinline__ void xcd_barrier(const XcdBarrier& b) {
    asm volatile("s_waitcnt vmcnt(0)" ::: "memory");
    __syncthreads();
    if (threadIdx.x == 0) {
        unsigned* bar = b.bar;
        __builtin_amdgcn_s_waitcnt(0);
        unsigned nloc = b.st[0], nx = b.st[1];
        if (nloc == 0u) { xcd_barrier_complete(bar, b.x, nloc, nx); b.st[0] = nloc; b.st[1] = nx; }
        const unsigned old = xb_add(&bar[XB_XSUB(b.x)], 1u);
        const unsigned gen = old / nloc;
        if (old + 1u == (gen + 1u) * nloc) {
            __builtin_amdgcn_fence(__ATOMIC_RELEASE, "agent");
            asm volatile("s_waitcnt vmcnt(0)" ::: "memory");
            const unsigned og = xb_add(&bar[XB_TOP], 1u);
            const unsigned tg = og / nx;
            if (og + 1u == (tg + 1u) * nx) xb_add(&bar[XB_TOPGEN], 1u);
            else XB_SPIN(xb_ld(&bar[XB_TOPGEN]) == tg, bar);
            __builtin_amdgcn_fence(__ATOMIC_ACQUIRE, "agent");
            xb_add(&bar[XB_XGEN(b.x)], 1u);
            asm volatile("s_waitcnt vmcnt(0)" ::: "memory");
        } else {
            XB_SPIN(xb_ld(&bar[XB_XGEN(b.x)]) == gen, bar);
            __builtin_amdgcn_fence(__ATOMIC_ACQUIRE, "agent");
            asm volatile("s_waitcnt vmcnt(0)" ::: "memory");
        }
    }
    __syncthreads();
}


constexpr size_t OFF_XBAR = OFF_SMALL + 1536 * 1024;
constexpr size_t OFF_PX = OFF_SMALL + 1152 * 1024;
#define GSYNC_CG() do { __threadfence(); grid.sync(); __threadfence(); } while (0)
#define GSYNC() xcd_barrier(xbar)
#ifndef LAUNCH_SPLITS
#define LAUNCH_SPLITS {{0,0},{1,1},{2,2},{3,3},{4,4},{5,5},{6,6},{7,7},{8,8},{9,9},{10,10}}
#endif
template <int PLO, int PHI>
__global__ void __launch_bounds__(512) mega(Params p) {
  cg::grid_group grid = cg::this_grid();
  __shared__ __attribute__((aligned(16))) char smem[SMEM_BYTES];
  char* ws = p.ws;
  float* MOD = (float*)(ws + OFF_MOD);
  const int lb = logical_block();
  volatile LAS unsigned* xst = (volatile LAS unsigned*)(smem + LDS_RED + 2048);
  if (tid_fresh() < 4) xst[tid_fresh()] = 0u;
  __syncthreads();
  XcdBarrier xbar = xcd_barrier_post((unsigned*)(ws + OFF_XBAR), xst);
  if (PLO < PHI) grid.sync();

  if (PLO <= 0 && 0 <= PHI) {
  phase0(p, smem);
  }
  if (PLO <= 0 && 0 < PHI) { GSYNC(); }
  if (PLO <= 1 && 1 <= PHI) {

  ln_rows_modulate(p.x, (bf16_t*)(ws + OFF_M0), NTOK, SEQ, MOD, -1);
  ln_rows_modulate(p.ctx, (bf16_t*)(ws + OFF_MC), NCTX, CTXL, MOD, 16);
  }
  if (PLO <= 1 && 1 < PHI) { GSYNC(); }
  if (PLO <= 2 && 2 <= PHI) {

  phase2(p, smem);
  }
  if (PLO <= 2 && 2 < PHI) { GSYNC(); }
  if (PLO <= 3 && 3 <= PHI) {

  for (int u = lb; u < 1024; u += gridDim.x) {
      const int grp = u >> 5, j = u & 31, b = grp >> 1, kvh = grp & 1, hq = kvh * 4 + (j >> 3), qb = j & 7;
      const bf16_t* Qb = (const bf16_t*)(ws + OFF_Q) + ((size_t)(b * SEQ + qb * 256) * 8 + hq) * 128;
      const bf16_t* Kh = (const bf16_t*)(ws + OFF_KALL) + ((size_t)b * SKV * 2 + kvh) * 128;
      const bf16_t* Vh = (const bf16_t*)(ws + OFF_VALL) + ((size_t)b * SKV * 2 + kvh) * 128;
      bf16_t* GO = (bf16_t*)(ws + OFF_SG) + (size_t)(b * SEQ + qb * 256) * 2048 + hq * 128;
      att::attn_body(Qb, Kh, Vh, GO, SKV, smem);
  }
  for (int v = lb; v < 256; v += gridDim.x) chunk_gate_unit(p, v >> 4, v & 15, smem);
  }
  if (PLO <= 3 && 3 < PHI) { GSYNC(); }
  if (PLO <= 4 && 4 <= PHI) {

  out_proj((const bf16_t*)(ws + OFF_SG), (const bf16_t*)(ws + OFF_WT_EOUT), MOD, (bf16_t*)(ws + OFF_YG), smem);
  }
  if (PLO <= 4 && 4 < PHI) { GSYNC(); }
  if (PLO <= 5 && 5 <= PHI) {

  post_ln_rows(p.x, (const bf16_t*)(ws + OFF_YG), (float*)(ws + OFF_Q), p.post_g, p.post_b, (bf16_t*)(ws + OFF_M0), MOD + 17 * 3072);
  }
  if (PLO <= 5 && 5 < PHI) { GSYNC(); }
  if (PLO <= 6 && 6 <= PHI) {

  {
    const bf16_t* M1 = (const bf16_t*)(ws + OFF_M0); const bf16_t* WT = (const bf16_t*)(ws + OFF_WT_OIN);
    bf16_t* F = (bf16_t*)(ws + OFF_F); bf16_t* RV = (bf16_t*)(ws + OFF_RV); bf16_t* XM = (bf16_t*)(ws + OFF_XM);
    bf16_t* SG1 = (bf16_t*)(ws + OFF_SG);
    for (int u = lb; u < 2048; u += gridDim.x) {
      f32x16 acc[2][4];
      if (u < 1024) {
        const int tt = u >> 3, ct = u & 7, b = tt >> 3, t0 = (tt & 7) * 256;
        gemm2(mkPlain(WT + (size_t)ct * 256 * 1024, 1024), mkPlain(M1 + (size_t)tt * 256 * 1024, 1024), 16, smem, acc);
        epi2_foreach(acc, [&](int row, int col, float a, float bq, float c, float d) {
          const int ch = ct * 256 + row, t = t0 + col;
          const size_t base = ((size_t)b * 2048 + ch) * 1024;
          if (t < 1024) {
            st_bf4(F + base + t, a, bq, c, d);
            if (t == 0) RV[base] = 0;
          } else if (t == 1024) {
            XM[(size_t)b * 2048 + ch] = f2bf(a);
            RV[base + 1023] = f2bf(bq); RV[base + 1022] = f2bf(c); RV[base + 1021] = f2bf(d);
          } else {
            RV[base + 2048 - t] = f2bf(a); RV[base + 2047 - t] = f2bf(bq); RV[base + 2046 - t] = f2bf(c); RV[base + 2045 - t] = f2bf(d);
          }
        });
      } else {
        const int v = u - 1024, mt = v >> 3, nt = v & 7;
        gemm2(mkPlain(M1 + (size_t)mt * 256 * 1024, 1024), mkPlain(WT + (size_t)(2048 + nt * 256) * 1024, 1024), 16, smem, acc);
        epi2_foreach(acc, [&](int row, int col, float a, float bq, float c, float d) {
          st_bf4(SG1 + (size_t)(mt * 256 + row) * 2048 + nt * 256 + col, silu_f(a), silu_f(bq), silu_f(c), silu_f(d));
        });
      }
    }
  }
  }
  if (PLO <= 6 && 6 < PHI) { GSYNC(); }
  if (PLO <= 7 && 7 <= PHI) {

  {
    bf16_t* EE = (bf16_t*)p.out + (size_t)32 * MiB;
    bf16_t* EO = EE + (size_t)16 * MiB;
    bf16_t* OE = (bf16_t*)(ws + OFF_M0); bf16_t* OO = OE + (size_t)16 * MiB;
    float* PX = (float*)(ws + OFF_PX); float* E512 = PX + 32768; float* O512 = PX + 65536;
    {
      const int tid = tid_fresh(), wid = tid >> 6, lane = tid & 63;
      const int gw = blockIdx.x * 8 + wid, nw = gridDim.x * 8;
      const bf16_t* XMr = (const bf16_t*)(ws + OFF_XM);
      u32x4 na0, na1, nb0, nb1;
      { const size_t ro = (size_t)gw * 128; const u32x4* Fr = (const u32x4*)(ws + OFF_F) + ro; const u32x4* Rr = (const u32x4*)(ws + OFF_RV) + ro;
        na0 = Fr[lane]; na1 = Fr[lane + 64]; nb0 = Rr[lane]; nb1 = Rr[lane + 64]; }
      const int src1 = 63 - lane, src0 = (64 - lane) & 63;
      for (int row = gw; row < 16 * 2048; row += nw) {
        const u32x4 a0 = na0, a1 = na1, b0 = nb0, b1 = nb1;
        { const int nr = (row + nw < 16 * 2048) ? row + nw : row; const size_t ro = (size_t)nr * 128;
          const u32x4* Fr = (const u32x4*)(ws + OFF_F) + ro; const u32x4* Rr = (const u32x4*)(ws + OFF_RV) + ro;
          na0 = Fr[lane]; na1 = Fr[lane + 64]; nb0 = Rr[lane]; nb1 = Rr[lane + 64]; }
        float e1[8], o1[8], e2[8], o2[8];
#pragma unroll
        for (int k = 0; k < 4; ++k) {
          { const float al = bf_lo(a0[k]), ah = bf_hi(a0[k]), bl = bf_lo(b0[k]), bh = bf_hi(b0[k]);
            e1[2 * k] = al + bl; e1[2 * k + 1] = ah + bh; o1[2 * k] = al - bl; o1[2 * k + 1] = ah - bh; }
          { const float al = bf_lo(a1[k]), ah = bf_hi(a1[k]), bl = bf_lo(b1[k]), bh = bf_hi(b1[k]);
            e2[2 * k] = al + bl; e2[2 * k + 1] = ah + bh; o2[2 * k] = al - bl; o2[2 * k + 1] = ah - bh; }
        }
        float alt = 0.f;
#pragma unroll
        for (int j = 0; j < 8; j += 2) alt += (e1[j] - e1[j + 1]) + (e2[j] - e2[j + 1]);
        float me[8], mo[8];
        me[0] = __shfl(e2[0], src0); mo[0] = __shfl(o2[0], src0);
        if (lane == 0) { me[0] = 0.f; mo[0] = 0.f; }
#pragma unroll
        for (int j = 1; j < 8; ++j) { me[j] = __shfl(e2[8 - j], src1); mo[j] = __shfl(o2[8 - j], src1); }
        u32x4 wee, weo, woe, woo;
#pragma unroll
        for (int k = 0; k < 4; ++k) {
          wee[k] = cvtpk(e1[2 * k] + me[2 * k], e1[2 * k + 1] + me[2 * k + 1]);
          weo[k] = cvtpk(e1[2 * k] - me[2 * k], e1[2 * k + 1] - me[2 * k + 1]);
          woe[k] = cvtpk(o1[2 * k] - mo[2 * k], o1[2 * k + 1] - mo[2 * k + 1]);
          woo[k] = cvtpk(o1[2 * k] + mo[2 * k], o1[2 * k + 1] + mo[2 * k + 1]);
        }
        const size_t wo = (size_t)row * 64 + lane;
        ((u32x4*)EE)[wo] = wee; ((u32x4*)EO)[wo] = weo; ((u32x4*)OE)[wo] = woe; ((u32x4*)OO)[wo] = woo;
        alt = wave_sum(alt);
        if (lane == 0) { PX[row] = alt + bf2f(XMr[row]); E512[row] = e2[0]; O512[row] = o2[0]; }
      }
    }
    if (PLO < PHI) { GSYNC(); }
    const bf16_t* XM = (const bf16_t*)(ws + OFF_XM);
    const bf16_t* TAB = (const bf16_t*)(ws + OFF_TAB_C);
    bf16_t* PC = (bf16_t*)p.out; bf16_t* PS = (bf16_t*)(ws + OFF_F);
    for (int u = lb; u < 1024; u += gridDim.x) {
      f32x16 acc[2][4];
      const int ty = u >> 8, v = u & 255, b = v >> 4, mt = (v >> 3) & 1, nt = v & 7;
      const bf16_t* Bsrc = (ty == 0) ? EE : (ty == 1) ? EO : (ty == 2) ? OE : OO;
      gemm2(mkPlain(TAB + (size_t)ty * 512 * 512 + (size_t)mt * 256 * 512, 512), mkPlain(Bsrc + ((size_t)b * 2048 + nt * 256) * 512, 512), 8, smem, acc);
      bf16_t* dstP = (ty < 2) ? PC : PS;
      const int par = ty & 1;
      epi2_foreach(acc, [&](int row, int col, float a, float bq, float c, float d) {
        const int sidx = mt * 256 + row, tp = 2 * sidx + par, ch = nt * 256 + col;
        const size_t vi = (size_t)b * 2048 + ch;
        const float sg = (sidx & 1) ? -1.f : 1.f;
        if (ty == 0) {
          const u32x2 xm = *(const u32x2*)(XM + vi); const float4 em = *(const float4*)(E512 + vi);
          a += sg * em.x + bf_lo(xm[0]); bq += sg * em.y + bf_hi(xm[0]); c += sg * em.z + bf_lo(xm[1]); d += sg * em.w + bf_hi(xm[1]);
        } else if (ty == 1) {
          const u32x2 xm = *(const u32x2*)(XM + vi);
          a -= bf_lo(xm[0]); bq -= bf_hi(xm[0]); c -= bf_lo(xm[1]); d -= bf_hi(xm[1]);
        } else if (ty == 3) {
          const float4 om = *(const float4*)(O512 + vi);
          a += sg * om.x; bq += sg * om.y; c += sg * om.z; d += sg * om.w;
        }
        st_bf4(dstP + ((size_t)b * 1024 + tp) * 2048 + ch, a, bq, c, d);
      });
    }
  }
  }
  if (PLO <= 7 && 7 < PHI) { GSYNC(); }
  if (PLO <= 8 && 8 <= PHI) {

  {
    const bf16_t* PC = (const bf16_t*)p.out; const bf16_t* PS = (const bf16_t*)(ws + OFF_F);
    const bf16_t* CDP = (const bf16_t*)(ws + OFF_CDP);
    bf16_t* SG1 = (bf16_t*)(ws + OFF_SG);
    const int tid = tid_fresh(), wid = tid >> 6, lane = tid & 63, r32 = lane & 31, hi = lane >> 5, wm = wid >> 1, wn = wid & 1;
    constexpr int TBS = 528;
    constexpr int TB_BYTES = 128 * TBS;
    char* sT = smem; char* sA = smem + TB_BYTES;
#pragma unroll
    for (int i = 0; i < 8; ++i) {
      const int id = tid + 512 * i, row = id >> 5, ck = id & 31;
      *(u32x4*)(sT + row * TBS + ck * 16) = *(const u32x4*)(CDP + row * 256 + ck * 8);
    }
    const int st_off = (tid >> 3) * LDS_ROWB + (tid & 7) * 16;
    const int a_rd = (wm * 64 + r32) * LDS_ROWB + hi * 16;
    const int b_rd = (wn * 32 + r32) * TBS + hi * 16;
    const size_t rowoff = (size_t)(tid >> 3) * 2048 + (tid & 7) * 8;
    u32x4 r00, r01, r02, r03, r10, r11, r12, r13, r20, r21, r22, r23, r30, r31, r32_, r33;
    auto a_base = [&](int u_, int s_) -> const bf16_t* {
      const int b_ = u_ >> 6, j_ = (u_ >> 4) & 3, G_ = u_ & 15;
      return ((s_ < 2) ? PC : PS) + ((size_t)b_ * 1024 + j_ * 256) * 2048 + G_ * 128 + (s_ & 1) * 64 + rowoff;
    };
#define P8_LOAD(S, U, A, B, C, D) do { const bf16_t* q_ = a_base((U), (S)); A = *(const u32x4*)(q_); B = *(const u32x4*)(q_ + (size_t)64 * 2048); \
      C = *(const u32x4*)(q_ + (size_t)128 * 2048); D = *(const u32x4*)(q_ + (size_t)192 * 2048); } while (0)
#define P8_WRITE(ST, A, B, C, D) do { char* s_ = sA + (ST) * L2_A + st_off; *(u32x4*)(s_) = A; *(u32x4*)(s_ + 64 * LDS_ROWB) = B; \
      *(u32x4*)(s_ + 128 * LDS_ROWB) = C; *(u32x4*)(s_ + 192 * LDS_ROWB) = D; } while (0)
#define P8_COMPUTE(ST, S, ACC) do { const char* sb_ = sA + (ST) * L2_A;                                              \
      _Pragma("unroll") for (int kk = 0; kk < 4; ++kk) {                                                               \
        const bf16x8 fa0 = *(const bf16x8*)(sb_ + a_rd + kk * 32);                                                      \
        const bf16x8 fa1 = *(const bf16x8*)(sb_ + a_rd + 32 * LDS_ROWB + kk * 32);                                      \
        const bf16x8 fb0 = *(const bf16x8*)(sT + b_rd + ((S) * 64 + kk * 16) * 2);                                      \
        const bf16x8 fb1 = *(const bf16x8*)(sT + b_rd + 64 * TBS + ((S) * 64 + kk * 16) * 2);                           \
        ACC[0][0] = __builtin_amdgcn_mfma_f32_32x32x16_bf16(fb0, fa0, ACC[0][0], 0, 0, 0);                              \
        ACC[0][1] = __builtin_amdgcn_mfma_f32_32x32x16_bf16(fb1, fa0, ACC[0][1], 0, 0, 0);                              \
        ACC[1][0] = __builtin_amdgcn_mfma_f32_32x32x16_bf16(fb0, fa1, ACC[1][0], 0, 0, 0);                              \
        ACC[1][1] = __builtin_amdgcn_mfma_f32_32x32x16_bf16(fb1, fa1, ACC[1][1], 0, 0, 0);                              \
      } } while (0)
    P8_LOAD(0, lb, r00, r01, r02, r03); P8_LOAD(1, lb, r10, r11, r12, r13); P8_LOAD(2, lb, r20, r21, r22, r23); P8_LOAD(3, lb, r30, r31, r32_, r33);
    for (int u = lb; u < 1024; u += gridDim.x) {
      const int un = (u + (int)gridDim.x < 1024) ? u + (int)gridDim.x : u;
      f32x16 acc1[2][2], acc2[2][2];
#pragma unroll
      for (int mi = 0; mi < 2; ++mi)
#pragma unroll
        for (int nj = 0; nj < 2; ++nj)
#pragma unroll
          for (int r = 0; r < 16; ++r) { acc1[mi][nj][r] = 0.f; acc2[mi][nj][r] = 0.f; }
      P8_WRITE(0, r00, r01, r02, r03); __syncthreads(); P8_LOAD(0, un, r00, r01, r02, r03); P8_COMPUTE(0, 0, acc1);
      P8_WRITE(1, r10, r11, r12, r13); __syncthreads(); P8_LOAD(1, un, r10, r11, r12, r13); P8_COMPUTE(1, 1, acc1);
      P8_WRITE(0, r20, r21, r22, r23); __syncthreads(); P8_LOAD(2, un, r20, r21, r22, r23); P8_COMPUTE(0, 2, acc2);
      P8_WRITE(1, r30, r31, r32_, r33); __syncthreads(); P8_LOAD(3, un, r30, r31, r32_, r33); P8_COMPUTE(1, 3, acc2);
      const int b = u >> 6, j = (u >> 4) & 3, G = u & 15;
      const float sc = 1.f / 512.f;
#pragma unroll
      for (int mi = 0; mi < 2; ++mi) {
        const int tp = j * 256 + wm * 64 + mi * 32 + r32;
#pragma unroll
        for (int nj = 0; nj < 2; ++nj)
#pragma unroll
          for (int q = 0; q < 4; ++q) {
            const int col = G * 128 + nj * 64 + wn * 32 + q * 8 + hi * 4;
            const float p0 = acc1[mi][nj][4 * q + 0], p1 = acc1[mi][nj][4 * q + 1], p2 = acc1[mi][nj][4 * q + 2], p3 = acc1[mi][nj][4 * q + 3];
            const float m0 = acc2[mi][nj][4 * q + 0], m1 = acc2[mi][nj][4 * q + 1], m2 = acc2[mi][nj][4 * q + 2], m3 = acc2[mi][nj][4 * q + 3];
            { bf16_t* gp = SG1 + ((size_t)b * 2048 + tp) * 2048 + col; const u32x2 sg = *(const u32x2*)gp;
              st_bf4(gp, (p0 - m0) * sc * bf_lo(sg[0]), (p1 - m1) * sc * bf_hi(sg[0]), (p2 - m2) * sc * bf_lo(sg[1]), (p3 - m3) * sc * bf_hi(sg[1])); }
            if (tp >= 1) { bf16_t* gp = SG1 + ((size_t)b * 2048 + (2048 - tp)) * 2048 + col; const u32x2 sg = *(const u32x2*)gp;
              st_bf4(gp, (p0 + m0) * sc * bf_lo(sg[0]), (p1 + m1) * sc * bf_hi(sg[0]), (p2 + m2) * sc * bf_lo(sg[1]), (p3 + m3) * sc * bf_hi(sg[1])); }
          }
      }
    }
#undef P8_LOAD
#undef P8_WRITE
#undef P8_COMPUTE
    {
      const float* PX = (const float*)(ws + OFF_PX);
      for (int i = blockIdx.x; i < 256; i += gridDim.x) {
        if (tid < 128) {
          const int b = i >> 4, G = i & 15;
          const float* px = PX + (size_t)b * 2048 + G * 128;
          float y = 0.f;
          for (int c = 0; c < 128; ++c) y += px[c] * bf2f(*(const bf16_t*)(sT + tid * TBS + c * 2));
          bf16_t* gp = SG1 + ((size_t)b * 2048 + 1024) * 2048 + G * 128 + tid;
          *gp = f2bf(y * (1.f / 512.f) * bf2f(*gp));
        }
      }
    }
  }
  }
  if (PLO <= 8 && 8 < PHI) { GSYNC(); }
  if (PLO <= 9 && 9 <= PHI) {

  out_proj((const bf16_t*)(ws + OFF_SG), (const bf16_t*)(ws + OFF_WT_OOUT), MOD + 17 * 3072, (bf16_t*)(ws + OFF_YG), smem);
  }
  if (PLO <= 9 && 9 < PHI) { GSYNC(); }
  if (PLO <= 10 && 10 <= PHI) {

  post_ln_rows((const float*)(ws + OFF_Q), (const bf16_t*)(ws + OFF_YG), p.out, p.post_g + 1024, p.post_b + 1024, nullptr, nullptr);
  }
}

extern "C" void kernel_launch(void* const* d_in, const int* in_sizes, int n_in, void* d_out, int out_size, void* d_ws, size_t ws_size,
                              hipStream_t stream) {
  static int grid_blocks = 0;
  if (!grid_blocks) {
    int dev = 0, cus = 0, per_cu = 0;
    hipGetDevice(&dev);
    hipDeviceGetAttribute(&cus, hipDeviceAttributeMultiprocessorCount, dev);
    hipOccupancyMaxActiveBlocksPerMultiprocessor(&per_cu, mega<0, 10>, 512, 0);
    if (per_cu > 1) per_cu = 1;
    grid_blocks = cus * per_cu;
    if (n_in != 18 || ws_size < WS_NEED) fprintf(stderr, "kernel_launch: unexpected n_in %d or ws_size %zu (need %zu)\n", n_in, ws_size, (size_t)WS_NEED);
  }
  Params p{};
  p.x = (const float*)d_in[0]; p.c = (const float*)d_in[1]; p.ctx = (const float*)d_in[2]; p.c_ctx = (const float*)d_in[3];
  p.w_mod = (const float*)d_in[4]; p.b_mod = (const float*)d_in[5]; p.post_g = (const float*)d_in[6]; p.post_b = (const float*)d_in[7];
  p.e_w_in = (const float*)d_in[8]; p.e_qn = (const float*)d_in[9]; p.e_kn = (const float*)d_in[10]; p.e_vg = (const float*)d_in[11];
  p.e_vb = (const float*)d_in[12]; p.e_ws = (const float*)d_in[13]; p.e_bs = (const float*)d_in[14]; p.e_w_out = (const float*)d_in[15];
  p.o_w_in = (const float*)d_in[16]; p.o_w_out = (const float*)d_in[17];
  p.out = (float*)d_out; p.ws = (char*)d_ws;
#define ONE_LAUNCH 1
#ifdef ONE_LAUNCH
  hipMemsetAsync((char*)d_ws + OFF_XBAR, 0, XCD_BAR_WORDS * 4, stream);
  { void* args[] = {&p};
    hipError_t e = hipLaunchCooperativeKernel((void*)mega<0, 10>, dim3(grid_blocks), dim3(512), args, 0, stream);
    if (e != hipSuccess) fprintf(stderr, "cooperative launch failed: %s (grid %d)\n", hipGetErrorString(e), grid_blocks); }
#else
  hipLaunchKernelGGL((mega<0, 0>), dim3(grid_blocks), dim3(512), 0, stream, p);
  hipLaunchKernelGGL((mega<1, 1>), dim3(grid_blocks), dim3(512), 0, stream, p);
  hipLaunchKernelGGL((mega<2, 2>), dim3(grid_blocks), dim3(512), 0, stream, p);
  hipLaunchKernelGGL((mega<3, 3>), dim3(grid_blocks), dim3(512), 0, stream, p);
  hipLaunchKernelGGL((mega<4, 4>), dim3(grid_blocks), dim3(512), 0, stream, p);
  hipLaunchKernelGGL((mega<5, 5>), dim3(grid_blocks), dim3(512), 0, stream, p);
  hipLaunchKernelGGL((mega<6, 6>), dim3(grid_blocks), dim3(512), 0, stream, p);
  hipLaunchKernelGGL((mega<7, 7>), dim3(grid_blocks), dim3(512), 0, stream, p);
  hipLaunchKernelGGL((mega<8, 8>), dim3(grid_blocks), dim3(512), 0, stream, p);
  hipLaunchKernelGGL((mega<9, 9>), dim3(grid_blocks), dim3(512), 0, stream, p);
  hipLaunchKernelGGL((mega<10, 10>), dim3(grid_blocks), dim3(512), 0, stream, p);
#endif
}
```

```cpp
#include <hip/hip_runtime.h>
#include <hip/hip_cooperative_groups.h>
#include <cstdio>
#include <cstdint>
namespace cg = cooperative_groups;

typedef unsigned short bf16_t;
using bf16x8 = __attribute__((ext_vector_type(8))) short;
using s16x4  = __attribute__((ext_vector_type(4))) short;
using f32x16 = __attribute__((ext_vector_type(16))) float;
using u32x4  = __attribute__((ext_vector_type(4))) unsigned;
using u32x2  = __attribute__((ext_vector_type(2))) unsigned;

constexpr int DM = 1024, NB = 16, SEQ = 2048, CTXL = 256, SKV = SEQ + CTXL;
constexpr int NTOK = NB * SEQ;
constexpr int NCTX = NB * CTXL;
constexpr int EVEN_IN = 5632, ODD_IN = 4096, DIN = 2048;
constexpr float ALPHA = 1.4142135623730951f;
constexpr float EPS = 1e-6f;

constexpr size_t MiB = 1ull << 20;
constexpr size_t OFF_WT_EIN = 0, OFF_WT_EOUT = 11 * MiB, OFF_WT_OIN = 15 * MiB, OFF_WT_OOUT = 23 * MiB;
constexpr size_t OFF_TAB_C = 27 * MiB, OFF_TAB_S = 30 * MiB, OFF_SMALL = 33 * MiB;
constexpr size_t OFF_CDM = OFF_SMALL, OFF_CDP = OFF_SMALL + 64 * 1024, OFF_WSB = OFF_SMALL + 128 * 1024;
constexpr size_t OFF_ROPE = OFF_SMALL + 384 * 1024, OFF_MOD = OFF_SMALL + 512 * 1024, OFF_XM = OFF_SMALL + 1024 * 1024;
constexpr size_t OFF_M0 = 36 * MiB, OFF_MC = 100 * MiB;
constexpr size_t OFF_SG = 108 * MiB;
constexpr size_t OFF_Q = 236 * MiB, OFF_BU = 300 * MiB;
constexpr size_t OFF_KALL = 364 * MiB, OFF_VALL = 382 * MiB, OFF_BV = 400 * MiB;
constexpr size_t OFF_F = 364 * MiB, OFF_RV = 428 * MiB;
constexpr size_t OFF_YG = 364 * MiB;
constexpr size_t WS_NEED = 492 * MiB;

struct Params {
  const float *x, *c, *ctx, *c_ctx, *w_mod, *b_mod, *post_g, *post_b, *e_w_in, *e_qn, *e_kn, *e_vg, *e_vb, *e_ws, *e_bs,
      *e_w_out, *o_w_in, *o_w_out;
  float* out;
  char* ws;
  long pad_;
};

typedef float f32x2_t __attribute__((ext_vector_type(2)));
typedef __bf16 bf16x2_t __attribute__((ext_vector_type(2)));
__device__ __forceinline__ unsigned cvtpk(float lo, float hi) {
  f32x2_t v = {lo, hi}; bf16x2_t h = __builtin_convertvector(v, bf16x2_t); return __builtin_bit_cast(unsigned, h);
}
__device__ __forceinline__ int tid_fresh() { int t = (int)__builtin_amdgcn_workitem_id_x(); asm volatile("" : "+v"(t)); return t; }
__device__ __forceinline__ float bf_lo(unsigned w) { return __uint_as_float(w << 16); }
__device__ __forceinline__ float bf_hi(unsigned w) { return __uint_as_float(w & 0xffff0000u); }
__device__ __forceinline__ bf16_t f2bf(float x) { return (bf16_t)(cvtpk(x, 0.f) & 0xffffu); }
__device__ __forceinline__ float bf2f(bf16_t h) { return __uint_as_float(((unsigned)h) << 16); }
__device__ __forceinline__ int crow(int r, int hi) { return (r & 3) + 8 * (r >> 2) + 4 * hi; }
__device__ __forceinline__ float wave_sum(float v) {
#pragma unroll
  for (int o = 32; o >= 1; o >>= 1) v += __shfl_xor(v, o);
  return v;
}
__device__ __forceinline__ float silu_f(float x) { return x * __builtin_amdgcn_rcpf(1.f + __expf(-x)); }
__device__ __forceinline__ float gelu_tanh_f(float x) {
  const float u = 0.7978845608028654f * (x + 0.044715f * x * x * x);
  const float t = 1.f - 2.f * __builtin_amdgcn_rcpf(__expf(2.f * u) + 1.f);
  return 0.5f * x * (1.f + t);
}
__device__ __forceinline__ int logical_block() {
  const int g = gridDim.x, b = blockIdx.x;
  return (g & 7) ? b : (b & 7) * (g >> 3) + (b >> 3);
}

constexpr int LDS_ROWB = 144;
constexpr int LDS_A = 256 * LDS_ROWB;
constexpr int LDS_B = 128 * LDS_ROWB;
constexpr int LDS_STAGE = LDS_A + LDS_B;
constexpr int L2_A = 256 * LDS_ROWB;
constexpr int L2_STAGE = 2 * L2_A;
constexpr int LDS_RED = 2 * L2_STAGE;
constexpr int SMEM_BYTES = LDS_RED + 2048 + 2048;

struct LdPlain {
  const bf16_t* p; size_t rs;
  __device__ __forceinline__ u32x4 ld(int kt, int i) const { return *(const u32x4*)(p + (size_t)i * rs + kt * 64); }
};
__device__ __forceinline__ LdPlain mkPlain(const bf16_t* base, int ld) {
  const int tid = tid_fresh();
  LdPlain l; l.p = base + (size_t)(tid >> 3) * ld + (tid & 7) * 8; l.rs = (size_t)64 * ld; return l;
}
struct LdSplit {
  const bf16_t* p0; const bf16_t* p1; size_t rs; int kts;
  __device__ __forceinline__ u32x4 ld(int kt, int i) const {
    const bf16_t* q = (kt < kts) ? (p0 + kt * 64) : (p1 + (kt - kts) * 64);
    return *(const u32x4*)(q + (size_t)i * rs);
  }
};
__device__ __forceinline__ LdSplit mkSplit(const bf16_t* b0, const bf16_t* b1, int ld, int kts) {
  const int tid = tid_fresh(); const size_t o = (size_t)(tid >> 3) * ld + (tid & 7) * 8;
  LdSplit l; l.p0 = b0 + o; l.p1 = b1 + o; l.rs = (size_t)64 * ld; l.kts = kts; return l;
}
struct LdFold {
  const bf16_t* f; const bf16_t* r; size_t rs; float sg;
  __device__ __forceinline__ u32x4 ld(int kt, int i) const {
    const u32x4 a = *(const u32x4*)(f + (size_t)i * rs + kt * 64);
    const u32x4 b = *(const u32x4*)(r + (size_t)i * rs + kt * 64);
    u32x4 o;
    o[0] = cvtpk(bf_lo(a[0]) + sg * bf_lo(b[0]), bf_hi(a[0]) + sg * bf_hi(b[0]));
    o[1] = cvtpk(bf_lo(a[1]) + sg * bf_lo(b[1]), bf_hi(a[1]) + sg * bf_hi(b[1]));
    o[2] = cvtpk(bf_lo(a[2]) + sg * bf_lo(b[2]), bf_hi(a[2]) + sg * bf_hi(b[2]));
    o[3] = cvtpk(bf_lo(a[3]) + sg * bf_lo(b[3]), bf_hi(a[3]) + sg * bf_hi(b[3]));
    return o;
  }
};
__device__ __forceinline__ LdFold mkFold(const bf16_t* f, const bf16_t* r, int ld, float sg) {
  const int tid = tid_fresh(); const size_t o = (size_t)(tid >> 3) * ld + (tid & 7) * 8;
  LdFold l; l.f = f + o; l.r = r + o; l.rs = (size_t)64 * ld; l.sg = sg; return l;
}

template <class LA, class LB>
__device__ __forceinline__ void gemm_mainloop(const LA& la, const LB& lb, int KT, char* smem, f32x16 (&acc)[2][2]) {
  const int tid = tid_fresh(), wid = tid >> 6, lane = tid & 63, r32 = lane & 31, hi = lane >> 5, wm = wid >> 1, wn = wid & 1;
#pragma unroll
  for (int mi = 0; mi < 2; ++mi)
#pragma unroll
    for (int nj = 0; nj < 2; ++nj)
#pragma unroll
      for (int r = 0; r < 16; ++r) acc[mi][nj][r] = 0.f;
  const int st_off = (tid >> 3) * LDS_ROWB + (tid & 7) * 16;
  const int a_rd = (wm * 64 + r32) * LDS_ROWB + hi * 16;
  const int b_rd = LDS_A + (wn * 32 + r32) * LDS_ROWB + hi * 16;
  u32x4 ra0, ra1, ra2, ra3, rb0, rb1;
  ra0 = la.ld(0, 0); ra1 = la.ld(0, 1); ra2 = la.ld(0, 2); ra3 = la.ld(0, 3); rb0 = lb.ld(0, 0); rb1 = lb.ld(0, 1);
  {
    char* s = smem + st_off;
    *(u32x4*)(s) = ra0; *(u32x4*)(s + 64 * LDS_ROWB) = ra1; *(u32x4*)(s + 128 * LDS_ROWB) = ra2; *(u32x4*)(s + 192 * LDS_ROWB) = ra3;
    *(u32x4*)(s + LDS_A) = rb0; *(u32x4*)(s + LDS_A + 64 * LDS_ROWB) = rb1;
  }
  __syncthreads();
#define GEMM_COMPUTE(SB)                                                                              \
  _Pragma("unroll") for (int kk = 0; kk < 4; ++kk) {                                                  \
    const bf16x8 a0 = *(const bf16x8*)((SB) + a_rd + kk * 32);                                        \
    const bf16x8 a1 = *(const bf16x8*)((SB) + a_rd + 32 * LDS_ROWB + kk * 32);                        \
    const bf16x8 b0 = *(const bf16x8*)((SB) + b_rd + kk * 32);                                        \
    const bf16x8 b1 = *(const bf16x8*)((SB) + b_rd + 64 * LDS_ROWB + kk * 32);                        \
    acc[0][0] = __builtin_amdgcn_mfma_f32_32x32x16_bf16(b0, a0, acc[0][0], 0, 0, 0);                  \
    acc[0][1] = __builtin_amdgcn_mfma_f32_32x32x16_bf16(b1, a0, acc[0][1], 0, 0, 0);                  \
    acc[1][0] = __builtin_amdgcn_mfma_f32_32x32x16_bf16(b0, a1, acc[1][0], 0, 0, 0);                  \
    acc[1][1] = __builtin_amdgcn_mfma_f32_32x32x16_bf16(b1, a1, acc[1][1], 0, 0, 0);                  \
  }
#define GEMM_LOAD(KT_) do { ra0 = la.ld((KT_), 0); ra1 = la.ld((KT_), 1); ra2 = la.ld((KT_), 2); ra3 = la.ld((KT_), 3); rb0 = lb.ld((KT_), 0); rb1 = lb.ld((KT_), 1); } while (0)
#define GEMM_WRITE(ST) do { char* s = smem + (ST) * LDS_STAGE + st_off;                                \
    *(u32x4*)(s) = ra0; *(u32x4*)(s + 64 * LDS_ROWB) = ra1; *(u32x4*)(s + 128 * LDS_ROWB) = ra2; *(u32x4*)(s + 192 * LDS_ROWB) = ra3; \
    *(u32x4*)(s + LDS_A) = rb0; *(u32x4*)(s + LDS_A + 64 * LDS_ROWB) = rb1; } while (0)
#pragma unroll 1
  for (int kt = 0; kt < KT; kt += 2) {
    GEMM_LOAD(kt + 1);
    GEMM_COMPUTE(smem);
    GEMM_WRITE(1);
    __syncthreads();
    GEMM_LOAD(kt + 2 < KT ? kt + 2 : kt);
    GEMM_COMPUTE(smem + LDS_STAGE);
    GEMM_WRITE(0);
    __syncthreads();
  }
#undef GEMM_COMPUTE
#undef GEMM_LOAD
#undef GEMM_WRITE
}

template <class LA, class LB>
__device__ __forceinline__ void gemm2(const LA& la, const LB& lb, int KT, char* smem, f32x16 (&acc)[2][4]) {
  const int tid = tid_fresh(), wid = tid >> 6, lane = tid & 63, r32 = lane & 31, hi = lane >> 5, wm = wid >> 1, wn = wid & 1;
#pragma unroll
  for (int mi = 0; mi < 2; ++mi)
#pragma unroll
    for (int nj = 0; nj < 4; ++nj)
#pragma unroll
      for (int r = 0; r < 16; ++r) acc[mi][nj][r] = 0.f;
  const int st_off = (tid >> 3) * LDS_ROWB + (tid & 7) * 16;
  const int a_rd = (wm * 64 + r32) * LDS_ROWB + hi * 16;
  const int b_rd = L2_A + (wn * 128 + r32) * LDS_ROWB + hi * 16;
  u32x4 xa0, xa1, xa2, xa3, xb0, xb1, xb2, xb3, ya0, ya1, ya2, ya3, yb0, yb1, yb2, yb3;
#define G2_LOADX(KT_) do { xa0 = la.ld((KT_), 0); xa1 = la.ld((KT_), 1); xa2 = la.ld((KT_), 2); xa3 = la.ld((KT_), 3); xb0 = lb.ld((KT_), 0); xb1 = lb.ld((KT_), 1); xb2 = lb.ld((KT_), 2); xb3 = lb.ld((KT_), 3); } while (0)
#define G2_LOADY(KT_) do { ya0 = la.ld((KT_), 0); ya1 = la.ld((KT_), 1); ya2 = la.ld((KT_), 2); ya3 = la.ld((KT_), 3); yb0 = lb.ld((KT_), 0); yb1 = lb.ld((KT_), 1); yb2 = lb.ld((KT_), 2); yb3 = lb.ld((KT_), 3); } while (0)
#define G2_W2(ST, P, R0, R1, O0, O1) do { char* s_ = smem + (ST) * L2_STAGE + st_off; *(u32x4*)(s_ + (O0)) = P##R0; *(u32x4*)(s_ + (O1)) = P##R1; } while (0)
#define G2_WRITE(ST, P) do { G2_W2(ST, P, a0, a1, 0, 64 * LDS_ROWB); G2_W2(ST, P, a2, a3, 128 * LDS_ROWB, 192 * LDS_ROWB); \
    G2_W2(ST, P, b0, b1, L2_A, L2_A + 64 * LDS_ROWB); G2_W2(ST, P, b2, b3, L2_A + 128 * LDS_ROWB, L2_A + 192 * LDS_ROWB); } while (0)
#define G2_LDA(SB, kk, A0, A1) do { A0 = *(const bf16x8*)((SB) + a_rd + (kk) * 32); A1 = *(const bf16x8*)((SB) + a_rd + 32 * LDS_ROWB + (kk) * 32); } while (0)
#define G2_STEPP(SB, kk, A0, A1, N0, N1, HASNEXT) do {                                                \
    if (HASNEXT) G2_LDA(SB, (kk) + 1, N0, N1);                                                        \
    _Pragma("unroll") for (int nj = 0; nj < 4; ++nj) {                                                \
      const bf16x8 b_ = *(const bf16x8*)((SB) + b_rd + nj * 32 * LDS_ROWB + (kk) * 32);               \
      acc[0][nj] = __builtin_amdgcn_mfma_f32_32x32x16_bf16(b_, A0, acc[0][nj], 0, 0, 0);              \
      acc[1][nj] = __builtin_amdgcn_mfma_f32_32x32x16_bf16(b_, A1, acc[1][nj], 0, 0, 0);              \
    } } while (0)
#define G2_COMPUTE_W(SB, ST, P) do { bf16x8 p0_, p1_, q0_, q1_;                                        \
    G2_LDA(SB, 0, p0_, p1_);                                                                          \
    G2_STEPP(SB, 0, p0_, p1_, q0_, q1_, 1); G2_W2(ST, P, a0, a1, 0, 64 * LDS_ROWB);                   \
    G2_STEPP(SB, 1, q0_, q1_, p0_, p1_, 1); G2_W2(ST, P, a2, a3, 128 * LDS_ROWB, 192 * LDS_ROWB);     \
    G2_STEPP(SB, 2, p0_, p1_, q0_, q1_, 1); G2_W2(ST, P, b0, b1, L2_A, L2_A + 64 * LDS_ROWB);         \
    G2_STEPP(SB, 3, q0_, q1_, p0_, p1_, 0); G2_W2(ST, P, b2, b3, L2_A + 128 * LDS_ROWB, L2_A + 192 * LDS_ROWB); } while (0)
  G2_LOADX(0); G2_LOADY(1);
  G2_WRITE(0, x);
  __syncthreads();
  G2_LOADX(2 < KT ? 2 : 0);
#pragma unroll 1
  for (int kt = 0; kt < KT; kt += 2) {
    G2_COMPUTE_W(smem, 1, y);
    __syncthreads();
    G2_LOADY(kt + 3 < KT ? kt + 3 : KT - 1);
    G2_COMPUTE_W(smem + L2_STAGE, 0, x);
    __syncthreads();
    G2_LOADX(kt + 4 < KT ? kt + 4 : KT - 2);
  }
#undef G2_LOADX
#undef G2_LOADY
#undef G2_WRITE
#undef G2_W2
#undef G2_STEPP
#undef G2_LDA
#undef G2_COMPUTE_W
}
template <class F>
__device__ __forceinline__ void epi2_foreach(const f32x16 (&acc)[2][4], F&& f) {
  const int tid = tid_fresh(), wid = tid >> 6, lane = tid & 63, r32 = lane & 31, hi = lane >> 5, wm = wid >> 1, wn = wid & 1;
#pragma unroll
  for (int mi = 0; mi < 2; ++mi)
#pragma unroll
    for (int nj = 0; nj < 4; ++nj)
#pragma unroll
      for (int q = 0; q < 4; ++q)
        f(wm * 64 + mi * 32 + r32, wn * 128 + nj * 32 + q * 8 + hi * 4, acc[mi][nj][4 * q + 0], acc[mi][nj][4 * q + 1],
          acc[mi][nj][4 * q + 2], acc[mi][nj][4 * q + 3]);
}

template <class F>
__device__ __forceinline__ void epi_foreach(const f32x16 (&acc)[2][2], F&& f) {
  const int tid = tid_fresh(), wid = tid >> 6, lane = tid & 63, r32 = lane & 31, hi = lane >> 5, wm = wid >> 1, wn = wid & 1;
#pragma unroll
  for (int mi = 0; mi < 2; ++mi)
#pragma unroll
    for (int nj = 0; nj < 2; ++nj)
#pragma unroll
      for (int q = 0; q < 4; ++q)
        f(wm * 64 + mi * 32 + r32, nj * 64 + wn * 32 + q * 8 + hi * 4, acc[mi][nj][4 * q + 0], acc[mi][nj][4 * q + 1],
          acc[mi][nj][4 * q + 2], acc[mi][nj][4 * q + 3]);
}
__device__ __forceinline__ void st_bf4(bf16_t* p, float a, float b, float c, float d) {
  u32x2 w = {cvtpk(a, b), cvtpk(c, d)}; *(u32x2*)p = w;
}

__device__ __forceinline__ void tr_tile(const float* src, bf16_t* dst, int K, int N, int kt, int nt, float* tile) {
  const int tid = tid_fresh(), k0 = kt * 64, n0 = nt * 64;
#pragma unroll
  for (int j = 0; j < 8; ++j) { const int e = j * 512 + tid, r = e >> 6, c = e & 63; tile[r * 65 + c] = src[(size_t)(k0 + r) * N + n0 + c]; }
  __syncthreads();
  const int rn = tid >> 3, ck = (tid & 7) * 8;
  const float v0 = tile[(ck + 0) * 65 + rn], v1 = tile[(ck + 1) * 65 + rn], v2 = tile[(ck + 2) * 65 + rn], v3 = tile[(ck + 3) * 65 + rn];
  const float v4 = tile[(ck + 4) * 65 + rn], v5 = tile[(ck + 5) * 65 + rn], v6 = tile[(ck + 6) * 65 + rn], v7 = tile[(ck + 7) * 65 + rn];
  u32x4 w = {cvtpk(v0, v1), cvtpk(v2, v3), cvtpk(v4, v5), cvtpk(v6, v7)};
  *(u32x4*)(dst + (size_t)(n0 + rn) * K + k0 + ck) = w;
  __syncthreads();
}

__device__ __forceinline__ void phase0(const Params& p, char* smem) {
  const int tid = tid_fresh(), G = gridDim.x, bid = blockIdx.x;
  char* ws = p.ws;
  {
    float* s = (float*)smem;
    float* part = (float*)(smem + 17 * 1024 * 4);
    float* MOD = (float*)(ws + OFF_MOD);
    for (int u = bid; u < 96; u += G) {
      const int l = u / 48, j0 = (u % 48) * 64;
      for (int e = tid; e < 17 * 1024; e += 512) { const int r = e >> 10, k = e & 1023; const float cv = (r < 16) ? p.c[r * 1024 + k] : p.c_ctx[k]; s[e] = silu_f(cv); }
      __syncthreads();
      const int col = tid & 63, ks = tid >> 6;
      float a0 = 0, a1 = 0, a2 = 0, a3 = 0, a4 = 0, a5 = 0, a6 = 0, a7 = 0, a8 = 0, a9 = 0, a10 = 0, a11 = 0, a12 = 0, a13 = 0, a14 = 0, a15 = 0, a16 = 0;
      const float* w = p.w_mod + (size_t)l * 1024 * 3072 + j0 + col;
#pragma unroll 4
      for (int k = ks * 128; k < ks * 128 + 128; ++k) {
        const float wv = w[(size_t)k * 3072];
        a0 += s[0 * 1024 + k] * wv; a1 += s[1 * 1024 + k] * wv; a2 += s[2 * 1024 + k] * wv; a3 += s[3 * 1024 + k] * wv;
        a4 += s[4 * 1024 + k] * wv; a5 += s[5 * 1024 + k] * wv; a6 += s[6 * 1024 + k] * wv; a7 += s[7 * 1024 + k] * wv;
        a8 += s[8 * 1024 + k] * wv; a9 += s[9 * 1024 + k] * wv; a10 += s[10 * 1024 + k] * wv; a11 += s[11 * 1024 + k] * wv;
        a12 += s[12 * 1024 + k] * wv; a13 += s[13 * 1024 + k] * wv; a14 += s[14 * 1024 + k] * wv; a15 += s[15 * 1024 + k] * wv;
        a16 += s[16 * 1024 + k] * wv;
      }
      float* pp = part + ks * 17 * 64 + col;
      pp[0 * 64] = a0; pp[1 * 64] = a1; pp[2 * 64] = a2; pp[3 * 64] = a3; pp[4 * 64] = a4; pp[5 * 64] = a5; pp[6 * 64] = a6; pp[7 * 64] = a7;
      pp[8 * 64] = a8; pp[9 * 64] = a9; pp[10 * 64] = a10; pp[11 * 64] = a11; pp[12 * 64] = a12; pp[13 * 64] = a13; pp[14 * 64] = a14; pp[15 * 64] = a15;
      pp[16 * 64] = a16;
      __syncthreads();
      for (int e = tid; e < 17 * 64; e += 512) {
        const int r = e >> 6, cc = e & 63;
        float t = p.b_mod[l * 3072 + j0 + cc];
#pragma unroll
        for (int q = 0; q < 8; ++q) t += part[q * 17 * 64 + r * 64 + cc];
        MOD[(size_t)(l * 17 + r) * 3072 + j0 + cc] = t;
      }
      __syncthreads();
    }
  }
  {
    float* tile = (float*)smem;
    constexpr int T0 = 16 * 88, T1 = 32 * 16, T2 = 16 * 64, T3 = 32 * 16;
    for (int u = bid; u < T0 + T1 + T2 + T3; u += G) {
      if (u < T0) tr_tile(p.e_w_in, (bf16_t*)(ws + OFF_WT_EIN), 1024, EVEN_IN, u / 88, u % 88, tile);
      else if (u < T0 + T1) { const int v = u - T0; tr_tile(p.e_w_out, (bf16_t*)(ws + OFF_WT_EOUT), 2048, 1024, v / 16, v % 16, tile); }
      else if (u < T0 + T1 + T2) { const int v = u - T0 - T1; tr_tile(p.o_w_in, (bf16_t*)(ws + OFF_WT_OIN), 1024, ODD_IN, v / 64, v % 64, tile); }
      else { const int v = u - T0 - T1 - T2; tr_tile(p.o_w_out, (bf16_t*)(ws + OFF_WT_OOUT), 2048, 1024, v / 16, v % 16, tile); }
    }
  }
  {
    const long gt = (long)bid * 512 + tid, gn = (long)G * 512;
    bf16_t* TC = (bf16_t*)(ws + OFF_TAB_C); bf16_t* TS = (bf16_t*)(ws + OFF_TAB_S);
    (void)TS;
    for (long e = gt; e < 4L * 512 * 512; e += gn) {
      const int ty = (int)(e >> 18), sidx = (int)((e >> 9) & 511), t = (int)(e & 511);
      float v;
      if (ty == 0) v = cospif((float)((sidx * t) & 1023) * (1.f / 512.f));
      else if (ty == 1) v = cospif((float)(((2 * sidx + 1) * t) & 2047) * (1.f / 1024.f));
      else if (ty == 2) v = sinpif((float)((sidx * t) & 1023) * (1.f / 512.f));
      else v = sinpif((float)(((2 * sidx + 1) * t) & 2047) * (1.f / 1024.f));
      TC[e] = f2bf(v);
    }
    bf16_t* CDM = (bf16_t*)(ws + OFF_CDM); bf16_t* CDP = (bf16_t*)(ws + OFF_CDP);
    for (long e = gt; e < 128L * 256; e += gn) {
      const int cp = (int)(e >> 8), k = (int)(e & 255);
      const int m = (cp * (k & 127)) & 127;
      const float x = (float)m * (1.f / 64.f);
      float vm, vp;
      if (k < 128) { vm = cospif(x); vp = vm; } else { vp = sinpif(x); vm = -vp; }
      CDM[e] = f2bf(vm); CDP[e] = f2bf(vp);
    }
    bf16_t* WSB = (bf16_t*)(ws + OFF_WSB);
    for (long e = gt; e < 8L * 128 * 128; e += gn) WSB[e] = f2bf(p.e_ws[e]);
    float2* ROPE = (float2*)(ws + OFF_ROPE);
    for (long e = gt; e < 64L * 32; e += gn) {
      const int pos = (int)(e >> 5), i = (int)(e & 31);
      const float inv = powf(10000.f, -(float)i / 32.f);
      const float ang = (float)pos * inv;
      ROPE[e] = make_float2(cosf(ang), sinf(ang));
    }
  }
}

__device__ __forceinline__ void ln_rows_modulate(const float* src, bf16_t* dst, int nrows, int rows_per_b, const float* mod17, int fixed_row) {
  const int tid = tid_fresh(), wid = tid >> 6, lane = tid & 63;
  const int gw = blockIdx.x * 8 + wid, nw = gridDim.x * 8;
  float4 n0, n1, n2, n3;
  { const int r0 = gw < nrows ? gw : 0; const float4* ps = (const float4*)(src + (size_t)r0 * 1024); n0 = ps[lane]; n1 = ps[lane + 64]; n2 = ps[lane + 128]; n3 = ps[lane + 192]; }
  for (int row = gw; row < nrows; row += nw) {
    float4 v0 = n0, v1 = n1, v2 = n2, v3 = n3;
    { const int nr = (row + nw < nrows) ? row + nw : row;
      const float4* ps = (const float4*)(src + (size_t)nr * 1024); n0 = ps[lane]; n1 = ps[lane + 64]; n2 = ps[lane + 128]; n3 = ps[lane + 192]; }
    float s = v0.x + v0.y + v0.z + v0.w + v1.x + v1.y + v1.z + v1.w + v2.x + v2.y + v2.z + v2.w + v3.x + v3.y + v3.z + v3.w;
    const float mu = wave_sum(s) * (1.f / 1024.f);
    v0.x -= mu; v0.y -= mu; v0.z -= mu; v0.w -= mu; v1.x -= mu; v1.y -= mu; v1.z -= mu; v1.w -= mu;
    v2.x -= mu; v2.y -= mu; v2.z -= mu; v2.w -= mu; v3.x -= mu; v3.y -= mu; v3.z -= mu; v3.w -= mu;
    float q = v0.x * v0.x + v0.y * v0.y + v0.z * v0.z + v0.w * v0.w + v1.x * v1.x + v1.y * v1.y + v1.z * v1.z + v1.w * v1.w +
              v2.x * v2.x + v2.y * v2.y + v2.z * v2.z + v2.w * v2.w + v3.x * v3.x + v3.y * v3.y + v3.z * v3.z + v3.w * v3.w;
    const float rstd = rsqrtf(wave_sum(q) * (1.f / 1024.f) + EPS);
    const int mr = (fixed_row >= 0) ? fixed_row : (row / rows_per_b);
    const float* md = mod17 + (size_t)mr * 3072;
    bf16_t* pd = dst + (size_t)row * 1024;
#define MODST(V, J) { const int col = (lane + 64 * J) * 4; const float4 sh = *(const float4*)(md + col); const float4 sc = *(const float4*)(md + 1024 + col); \
      st_bf4(pd + col, V.x * rstd * (1.f + sc.x) + sh.x, V.y * rstd * (1.f + sc.y) + sh.y, V.z * rstd * (1.f + sc.z) + sh.z, V.w * rstd * (1.f + sc.w) + sh.w); }
    MODST(v0, 0) MODST(v1, 1) MODST(v2, 2) MODST(v3, 3)
#undef MODST
  }
}

__device__ __forceinline__ void phase2(const Params& p, char* smem) {
  char* ws = p.ws;
  const bf16_t* M0 = (const bf16_t*)(ws + OFF_M0); const bf16_t* MC = (const bf16_t*)(ws + OFF_MC);
  const bf16_t* WT = (const bf16_t*)(ws + OFF_WT_EIN);
  bf16_t* Q = (bf16_t*)(ws + OFF_Q); bf16_t* KA = (bf16_t*)(ws + OFF_KALL); bf16_t* VA = (bf16_t*)(ws + OFF_VALL);
  bf16_t* BU = (bf16_t*)(ws + OFF_BU); bf16_t* BV = (bf16_t*)(ws + OFF_BV); bf16_t* SG = (bf16_t*)(ws + OFF_SG);
  const float2* ROPE = (const float2*)(ws + OFF_ROPE);
  const int tid = tid_fresh(), wid = tid >> 6, lane = tid & 63, r32 = lane & 31, hi = lane >> 5, wm = wid >> 1, wn = wid & 1;
  const int lb = logical_block();
  for (int u = lb; u < 2816 + 32; u += gridDim.x) {
    const bool isctx = (u >= 2816);
    int mt, nt;
    if (!isctx) { mt = u / 22; nt = u % 22; } else { const int v = u - 2816; mt = v >> 1; nt = 4 + (v & 1); }
    const bf16_t* A = (isctx ? MC : M0) + (size_t)mt * 256 * 1024;
    f32x16 acc[2][4];
    gemm2(mkPlain(A, 1024), mkPlain(WT + (size_t)nt * 256 * 1024, 1024), 16, smem, acc);
    if (nt < 5) {
      const bool isq = nt < 4;
      const int head = isq ? (nt * 2 + wn) : wn;
      const float* gv = isq ? p.e_qn : p.e_kn;
#pragma unroll
      for (int mi = 0; mi < 2; ++mi) {
        float ss = 0.f;
#pragma unroll
        for (int nj = 0; nj < 4; ++nj)
#pragma unroll
          for (int r = 0; r < 16; ++r) ss += acc[mi][nj][r] * acc[mi][nj][r];
        ss += __shfl_xor(ss, 32);
        const float rstd = rsqrtf(ss * (1.f / 128.f) + EPS);
        const int row = wm * 64 + mi * 32 + r32;
        int t = 0; size_t obase;
        if (!isctx) {
          const int b = mt >> 3; t = (mt & 7) * 256 + row;
          if (isq) obase = ((size_t)(b * SEQ + t) * 8 + head) * 128;
          else obase = ((size_t)(b * SKV + CTXL + t) * 2 + head) * 128;
        } else {
          obase = ((size_t)(mt * SKV + row) * 2 + head) * 128;
        }
        bf16_t* dst = (isq ? Q : KA) + obase;
#pragma unroll
        for (int nj = 0; nj < 2; ++nj) {
          const int pos = (nj == 0) ? (t >> 6) : (t & 63);
#pragma unroll
          for (int q = 0; q < 4; ++q) {
            float o1[4], o2[4];
#pragma unroll
            for (int e = 0; e < 4; ++e) {
              const int r = 4 * q + e;
              const int i = 8 * q + 4 * hi + e;
              const int d = nj * 32 + i;
              const float x1 = acc[mi][nj][r] * rstd * gv[d];
              const float x2 = acc[mi][nj + 2][r] * rstd * gv[64 + d];
              if (!isctx) {
                const float2 cs = ROPE[pos * 32 + i];
                o1[e] = x1 * cs.x - x2 * cs.y; o2[e] = x2 * cs.x + x1 * cs.y;
              } else { o1[e] = x1; o2[e] = x2; }
            }
            const int d0 = nj * 32 + 8 * q + 4 * hi;
            st_bf4(dst + d0, o1[0], o1[1], o1[2], o1[3]);
            st_bf4(dst + 64 + d0, o2[0], o2[1], o2[2], o2[3]);
          }
        }
      }
    } else if (nt == 5) {
      epi2_foreach(acc, [&](int row, int col, float a, float b, float c, float d) {
        size_t tokrow;
        if (!isctx) { const int bb = mt >> 3, t = (mt & 7) * 256 + row; tokrow = (size_t)bb * SKV + CTXL + t; } else tokrow = (size_t)mt * SKV + row;
        st_bf4(VA + tokrow * 256 + col, a, b, c, d);
      });
    } else if (nt < 14) {
      bf16_t* dst = (nt < 10) ? (BU + (size_t)(nt - 6) * 256) : (BV + (size_t)(nt - 10) * 256);
      epi2_foreach(acc, [&](int row, int col, float a, float b, float c, float d) {
        st_bf4(dst + (size_t)(mt * 256 + row) * 1024 + col, gelu_tanh_f(a), gelu_tanh_f(b), gelu_tanh_f(c), gelu_tanh_f(d));
      });
    } else {
      bf16_t* dst = SG + (size_t)(nt - 14) * 256;
      epi2_foreach(acc, [&](int row, int col, float a, float b, float c, float d) {
        st_bf4(dst + (size_t)(mt * 256 + row) * 2048 + col, silu_f(a), silu_f(b), silu_f(c), silu_f(d));
      });
    }
  }
}

namespace att {
constexpr int D = 128, NW = 8, QBLK = 32, KVBLK = 64;
constexpr float SCALE = 0.088388347648318440f;
constexpr float THR = 8.f;
constexpr int LDQ = 1024, LDK = 256;
constexpr int SHM_V = KVBLK * D * 2, SHM_K = KVBLK * D * 2;
#define KSWZ(row, colB) ((row) * 256 + ((colB) ^ (((row) & 7) << 4)))
#define SBAR() __builtin_amdgcn_sched_barrier(0)
__device__ __forceinline__ void partialSM(f32x16& p0, f32x16& p1, float& m_reg, float& mn, float& alpha) {
  constexpr float C = SCALE * 1.4426950408889634f;
  float pmax = p0[0];
#pragma unroll
  for (int r = 1; r < 16; ++r) pmax = fmaxf(pmax, p0[r]);
#pragma unroll
  for (int r = 0; r < 16; ++r) pmax = fmaxf(pmax, p1[r]);
  { auto rr = __builtin_amdgcn_permlane32_swap(__float_as_uint(pmax), __float_as_uint(pmax), false, false);
    pmax = fmaxf(__uint_as_float(rr[0]), __uint_as_float(rr[1])); }
  if (__builtin_expect(__all(pmax - m_reg <= THR / SCALE), 1)) { mn = m_reg; alpha = 1.f; }
  else { mn = fmaxf(m_reg, pmax); alpha = __builtin_amdgcn_exp2f((m_reg - mn) * C); m_reg = mn; }
  const float mnC = -mn * C;
#pragma unroll
  for (int r = 0; r < 16; ++r) p0[r] = fmaf(p0[r], C, mnC);
#pragma unroll
  for (int r = 0; r < 16; ++r) p1[r] = fmaf(p1[r], C, mnC);
#pragma unroll
  for (int r = 0; r < 16; ++r) p0[r] = __builtin_amdgcn_exp2f(p0[r]);
}
__device__ __forceinline__ void finishSM(f32x16& p0, f32x16& p1, float alpha, float& l_reg, bf16x8& pa0, bf16x8& pa1, bf16x8& pa2, bf16x8& pa3) {
#pragma unroll
  for (int r = 0; r < 16; ++r) p1[r] = __builtin_amdgcn_exp2f(p1[r]);
  float ps = 0;
#pragma unroll
  for (int r = 0; r < 16; ++r) ps += p0[r];
#pragma unroll
  for (int r = 0; r < 16; ++r) ps += p1[r];
  { auto rr = __builtin_amdgcn_permlane32_swap(__float_as_uint(ps), __float_as_uint(ps), false, false);
    ps = __uint_as_float(rr[0]) + __uint_as_float(rr[1]); }
  l_reg = l_reg * alpha + ps;
#define PK4(P, BASE, OUT) do { unsigned a0 = cvtpk(P[BASE + 0], P[BASE + 1]), a1 = cvtpk(P[BASE + 2], P[BASE + 3]);   \
    unsigned b0 = cvtpk(P[BASE + 4], P[BASE + 5]), b1 = cvtpk(P[BASE + 6], P[BASE + 7]);                              \
    auto r0 = __builtin_amdgcn_permlane32_swap(a0, b0, false, false); auto r1 = __builtin_amdgcn_permlane32_swap(a1, b1, false, false); \
    u32x4 w = {r0[0], r1[0], r0[1], r1[1]}; OUT = *reinterpret_cast<bf16x8*>(&w); } while (0)
  PK4(p0, 0, pa0); PK4(p0, 8, pa1); PK4(p1, 0, pa2); PK4(p1, 8, pa3);
#undef PK4
}
__device__ __forceinline__ void qkt(f32x16& p0, f32x16& p1, const bf16_t* Ks, const bf16x8* qr, int r32, int hi) {
#pragma unroll
  for (int r = 0; r < 16; ++r) { p0[r] = 0.f; p1[r] = 0.f; }
#pragma unroll
  for (int d0 = 0; d0 < 8; ++d0) { const int cb = (d0 * 16 + hi * 8) * 2;
    bf16x8 b0 = *reinterpret_cast<const bf16x8*>((const char*)Ks + KSWZ(r32, cb));
    bf16x8 b1 = *reinterpret_cast<const bf16x8*>((const char*)Ks + KSWZ(32 + r32, cb));
    p0 = __builtin_amdgcn_mfma_f32_32x32x16_bf16(b0, qr[d0], p0, 0, 0, 0);
    p1 = __builtin_amdgcn_mfma_f32_32x32x16_bf16(b1, qr[d0], p1, 0, 0, 0); }
}
__device__ __forceinline__ int v_st(int k, int c) { const int kk = (k & ~0xC) | ((k & 4) << 1) | ((k & 8) >> 1); return ((kk >> 3) * 4 + (c >> 5)) * 512 + ((kk & 7) * 32 + (c & 31)) * 2; }
__device__ __forceinline__ int v_rd_base(int lane) { return ((lane & 3) << 3) | (((lane >> 2) & 3) << 6) | (((lane >> 4) & 1) << 5) | (((lane >> 5) & 1) << 8); }
constexpr int v_rd_off(int d0, int ks, int half) { return d0 * 512 + ks * 4096 + half * 2048; }
template <int OFF> __device__ __forceinline__ s16x4 tr_read(int vb) {
  s16x4 r; asm volatile("ds_read_b64_tr_b16 %0, %1 offset:%2" : "=&v"(r) : "v"(vb), "i"(OFF) : "memory"); return r;
}
template <int D0> __device__ __forceinline__ void pv_one(f32x16& od, int vb, bf16x8 pa0, bf16x8 pa1, bf16x8 pa2, bf16x8 pa3) {
  const s16x4 l0 = tr_read<v_rd_off(D0, 0, 0)>(vb), h0 = tr_read<v_rd_off(D0, 0, 1)>(vb), l1 = tr_read<v_rd_off(D0, 1, 0)>(vb), h1 = tr_read<v_rd_off(D0, 1, 1)>(vb);
  const s16x4 l2 = tr_read<v_rd_off(D0, 2, 0)>(vb), h2 = tr_read<v_rd_off(D0, 2, 1)>(vb), l3 = tr_read<v_rd_off(D0, 3, 0)>(vb), h3 = tr_read<v_rd_off(D0, 3, 1)>(vb);
  asm volatile("s_waitcnt lgkmcnt(0)" ::: "memory"); SBAR();
#define PK(L, H) (bf16x8){L[0], L[1], L[2], L[3], H[0], H[1], H[2], H[3]}
  od = __builtin_amdgcn_mfma_f32_32x32x16_bf16(pa0, PK(l0, h0), od, 0, 0, 0);
  od = __builtin_amdgcn_mfma_f32_32x32x16_bf16(pa1, PK(l1, h1), od, 0, 0, 0);
  od = __builtin_amdgcn_mfma_f32_32x32x16_bf16(pa2, PK(l2, h2), od, 0, 0, 0);
  od = __builtin_amdgcn_mfma_f32_32x32x16_bf16(pa3, PK(l3, h3), od, 0, 0, 0);
#undef PK
}
__device__ __forceinline__ void pv_d0(f32x16* o, int vb, bf16x8 pa0, bf16x8 pa1, bf16x8 pa2, bf16x8 pa3) {
  pv_one<0>(o[0], vb, pa0, pa1, pa2, pa3); pv_one<1>(o[1], vb, pa0, pa1, pa2, pa3); pv_one<2>(o[2], vb, pa0, pa1, pa2, pa3); pv_one<3>(o[3], vb, pa0, pa1, pa2, pa3);
}
__device__ __forceinline__ void attn_body(const bf16_t* __restrict__ Qb, const bf16_t* __restrict__ Kh, const bf16_t* __restrict__ Vh,
                                          bf16_t* GO, int seq, char* lds) {
  const int tid = tid_fresh(), wid = tid >> 6, lane = tid & 63, r32 = lane & 31, hi = lane >> 5;
  bf16_t* V_lds = (bf16_t*)lds; bf16_t* K_lds = (bf16_t*)(lds + 2 * SHM_V);
  float* wsx = (float*)(lds + 2 * SHM_V + 2 * SHM_K) + wid * 64; float* li_l = wsx; float* al_l = wsx + 32;
  float m_reg = -1e30f, l_reg = 0; f32x16 o[4]; bf16x8 qr[8];
#pragma unroll
  for (int d = 0; d < 4; ++d)
#pragma unroll
    for (int r = 0; r < 16; ++r) o[d][r] = 0.f;
  const bf16_t* Qw = Qb + (long)(wid * QBLK + r32) * LDQ + hi * 8;
#pragma unroll
  for (int d0 = 0; d0 < 8; ++d0) qr[d0] = *reinterpret_cast<const bf16x8*>(Qw + d0 * 16);
  const int sr = tid >> 4, sc = (tid & 15) * 8, vst0 = v_st(sr, sc), vst1 = v_st(32 + sr, sc);
  const int vb0 = (int)(uintptr_t)V_lds + v_rd_base(lane);
  constexpr int SDEPTH = 1;
  bf16x8 sv0[SDEPTH], sv1[SDEPTH], sk0[SDEPTH], sk1[SDEPTH];
#define SLOAD(i, k0) do { sv0[i] = *reinterpret_cast<const bf16x8*>(&Vh[(long)((k0) + sr) * LDK + sc]); sv1[i] = *reinterpret_cast<const bf16x8*>(&Vh[(long)((k0) + 32 + sr) * LDK + sc]); \
    sk0[i] = *reinterpret_cast<const bf16x8*>(&Kh[(long)((k0) + sr) * LDK + sc]); sk1[i] = *reinterpret_cast<const bf16x8*>(&Kh[(long)((k0) + 32 + sr) * LDK + sc]); } while (0)
#define SWRITE(b, i) do { *(bf16x8*)((char*)V_lds + (b) * SHM_V + vst0) = sv0[i];          \
    *(bf16x8*)((char*)V_lds + (b) * SHM_V + vst1) = sv1[i]; const int kc = sc * 2;               \
    *(bf16x8*)((char*)K_lds + (b) * SHM_K + KSWZ(sr, kc)) = sk0[i];                       \
    *(bf16x8*)((char*)K_lds + (b) * SHM_K + KSWZ(32 + sr, kc)) = sk1[i]; } while (0)
#define SWAIT() do { if (SDEPTH == 2) asm volatile("s_waitcnt vmcnt(4)" ::: "memory"); else asm volatile("s_waitcnt vmcnt(0)" ::: "memory"); } while (0)
#define RESC(a) do { if (__any((a) < 1.f)) { if (hi == 0) al_l[r32] = (a); asm volatile("s_waitcnt lgkmcnt(0)" ::: "memory"); \
    _Pragma("unroll") for (int d = 0; d < 4; ++d) _Pragma("unroll") for (int r = 0; r < 16; ++r) o[d][r] *= al_l[crow(r, hi)]; } } while (0)
  f32x16 pA0, pA1, pB0, pB1; float mnA, mnB, alA, alB; bf16x8 pa0, pa1, pa2, pa3; const int NT = seq / KVBLK;
  constexpr int SE = 0, SO = SDEPTH - 1;
  SLOAD(SE, 0); asm volatile("s_waitcnt vmcnt(0)" ::: "memory"); SWRITE(0, SE); __syncthreads();
  qkt(pA0, pA1, K_lds, qr, r32, hi); partialSM(pA0, pA1, m_reg, mnA, alA);
  SLOAD(SO, KVBLK); if (SDEPTH == 2) { if (2 < NT) SLOAD(SE, 2 * KVBLK); }
  SWAIT(); SWRITE(1, SO); __syncthreads();
  for (int j = 1; j + 1 < NT; j += 2) {
    SBAR(); qkt(pB0, pB1, (bf16_t*)((char*)K_lds + SHM_K), qr, r32, hi);
    finishSM(pA0, pA1, alA, l_reg, pa0, pa1, pa2, pa3); SBAR();
    SLOAD(SO, (j + SDEPTH) * KVBLK); SBAR();
    pv_d0(o, vb0, pa0, pa1, pa2, pa3); partialSM(pB0, pB1, m_reg, mnB, alB);
    __syncthreads(); SWAIT(); SWRITE(0, SE);
    RESC(alB); __syncthreads();
    SBAR(); qkt(pA0, pA1, K_lds, qr, r32, hi);
    finishSM(pB0, pB1, alB, l_reg, pa0, pa1, pa2, pa3); SBAR();
    if (SDEPTH == 1 || j + 3 < NT) SLOAD(SE, (j + 1 + SDEPTH) * KVBLK); SBAR();
    pv_d0(o, vb0 + (int)SHM_V, pa0, pa1, pa2, pa3); partialSM(pA0, pA1, m_reg, mnA, alA);
    __syncthreads(); SWAIT(); SWRITE(1, SO);
    RESC(alA); __syncthreads();
  }
  SBAR(); qkt(pB0, pB1, (bf16_t*)((char*)K_lds + SHM_K), qr, r32, hi);
  finishSM(pA0, pA1, alA, l_reg, pa0, pa1, pa2, pa3); SBAR();
  pv_d0(o, vb0, pa0, pa1, pa2, pa3); partialSM(pB0, pB1, m_reg, mnB, alB);
  __syncthreads(); RESC(alB);
  finishSM(pB0, pB1, alB, l_reg, pa0, pa1, pa2, pa3); SBAR();
  pv_d0(o, vb0 + (int)SHM_V, pa0, pa1, pa2, pa3);
  if (hi == 0) li_l[r32] = l_reg; asm volatile("s_waitcnt lgkmcnt(0)" ::: "memory");
  float rli[16];
#pragma unroll
  for (int r = 0; r < 16; ++r) rli[r] = __builtin_amdgcn_rcpf(li_l[crow(r, hi)]);
  bf16_t* Ow = GO + (long)(wid * QBLK) * 2048;
#pragma unroll
  for (int r = 0; r < 16; ++r) { const int orow = crow(r, hi);
#pragma unroll
    for (int d0 = 0; d0 < 4; ++d0) { bf16_t* q = Ow + (long)orow * 2048 + d0 * 32 + r32; *q = f2bf(o[d0][r] * rli[r] * bf2f(*q)); }
    SBAR(); }
  __syncthreads();
#undef SLOAD
#undef SWRITE
#undef SWAIT
#undef RESC
}
}

__device__ __forceinline__ void chunk_gate_unit(const Params& p, int b, int n, char* smem) {
  char* ws = p.ws;
  const bf16_t* BU = (const bf16_t*)(ws + OFF_BU); const bf16_t* BV = (const bf16_t*)(ws + OFF_BV);
  bf16_t* SG = (bf16_t*)(ws + OFF_SG); const bf16_t* WSB = (const bf16_t*)(ws + OFF_WSB);
  const int tid = tid_fresh(), wid = tid >> 6, lane = tid & 63, r32 = lane & 31, hi = lane >> 5;
  constexpr int RS = 272;
  char* sW = smem; char* sV = smem + 128 * RS;
  float* smu = (float*)(smem + 2 * 128 * RS); float* srs = smu + 128;
  const size_t tok0 = (size_t)b * SEQ + (size_t)n * 128;
  {
    const int q = tid >> 2, part = tid & 3;
    const u32x4* src = (const u32x4*)(BV + (tok0 + q) * 1024 + part * 256);
    float s = 0.f, s2 = 0.f;
#pragma unroll 4
    for (int i = 0; i < 32; ++i) {
      const u32x4 w = src[i];
#pragma unroll
      for (int e = 0; e < 4; ++e) { const float a = bf_lo(w[e]), c = bf_hi(w[e]); s += a + c; s2 += a * a + c * c; }
    }
    s += __shfl_xor(s, 1); s2 += __shfl_xor(s2, 1); s += __shfl_xor(s, 2); s2 += __shfl_xor(s2, 2);
    const float mu = s * (1.f / 1024.f);
    const float var = fmaxf(s2 * (1.f / 1024.f) - mu * mu, 0.f);
    if (part == 0) { smu[q] = mu; srs[q] = rsqrtf(var + EPS); }
  }
  __syncthreads();
  const int wp = wid >> 1, wc = wid & 1;
  for (int g = 0; g < 8; ++g) {
#pragma unroll
    for (int i = 0; i < 4; ++i) {
      const int id = tid + 512 * i, row = id >> 4, ck = (id & 15) * 8;
      *(u32x4*)(sW + row * RS + ck * 2) = *(const u32x4*)(WSB + (size_t)g * 16384 + row * 128 + ck);
    }
#pragma unroll
    for (int i = 0; i < 4; ++i) {
      const int id = tid + 512 * i, q = id & 127, cc = (id >> 7) * 8;
      const u32x4 w = *(const u32x4*)(BV + (tok0 + q) * 1024 + g * 128 + cc);
      const float mu = smu[q], rs = srs[q];
      const float* lg = p.e_vg + g * 128 + cc; const float* lbp = p.e_vb + g * 128 + cc;
#pragma unroll
      for (int e = 0; e < 4; ++e) {
        const float a = (bf_lo(w[e]) - mu) * rs * lg[2 * e] + lbp[2 * e];
        const float c = (bf_hi(w[e]) - mu) * rs * lg[2 * e + 1] + lbp[2 * e + 1];
        *(bf16_t*)(sV + (cc + 2 * e) * RS + q * 2) = f2bf(a);
        *(bf16_t*)(sV + (cc + 2 * e + 1) * RS + q * 2) = f2bf(c);
      }
    }
    __syncthreads();
    f32x16 acc0, acc1;
#pragma unroll
    for (int r = 0; r < 16; ++r) { acc0[r] = 0.f; acc1[r] = 0.f; }
#pragma unroll
    for (int kk = 0; kk < 8; ++kk) {
      const bf16x8 af = *(const bf16x8*)(sW + (wp * 32 + r32) * RS + kk * 32 + hi * 16);
      const bf16x8 b0 = *(const bf16x8*)(sV + (wc * 64 + r32) * RS + kk * 32 + hi * 16);
      const bf16x8 b1 = *(const bf16x8*)(sV + (wc * 64 + 32 + r32) * RS + kk * 32 + hi * 16);
      acc0 = __builtin_amdgcn_mfma_f32_32x32x16_bf16(b0, af, acc0, 0, 0, 0);
      acc1 = __builtin_amdgcn_mfma_f32_32x32x16_bf16(b1, af, acc1, 0, 0, 0);
    }
    const int pr = wp * 32 + r32;
    const float bias = p.e_bs[g * 128 + pr];
    const size_t tok = tok0 + pr;
#pragma unroll
    for (int nj = 0; nj < 2; ++nj)
#pragma unroll
      for (int q = 0; q < 4; ++q) {
        const int col = g * 128 + wc * 64 + nj * 32 + q * 8 + hi * 4;
        const u32x2 bu = *(const u32x2*)(BU + tok * 1024 + col);
        bf16_t* gp = SG + tok * 2048 + 1024 + col;
        const u32x2 sg = *(const u32x2*)gp;
        const float m0 = (nj ? acc1[4 * q + 0] : acc0[4 * q + 0]) + bias, m1 = (nj ? acc1[4 * q + 1] : acc0[4 * q + 1]) + bias;
        const float m2 = (nj ? acc1[4 * q + 2] : acc0[4 * q + 2]) + bias, m3 = (nj ? acc1[4 * q + 3] : acc0[4 * q + 3]) + bias;
        st_bf4(gp, bf_lo(bu[0]) * m0 * bf_lo(sg[0]), bf_hi(bu[0]) * m1 * bf_hi(sg[0]), bf_lo(bu[1]) * m2 * bf_lo(sg[1]), bf_hi(bu[1]) * m3 * bf_hi(sg[1]));
      }
    __syncthreads();
  }
}

__device__ __forceinline__ void post_ln_rows(const float* resid, const bf16_t* yg, float* dst, const float* pg, const float* pb, bf16_t* m1, const float* mod17) {
  const int tid = tid_fresh(), wid = tid >> 6, lane = tid & 63;
  const int gw = blockIdx.x * 8 + wid, nw = gridDim.x * 8;
  float4 nx[4]; u32x2 ny[4];
  { const float4* ps = (const float4*)(resid + (size_t)gw * 1024); const u32x2* py = (const u32x2*)(yg + (size_t)gw * 1024);
#pragma unroll
    for (int j = 0; j < 4; ++j) { nx[j] = ps[lane + 64 * j]; ny[j] = py[lane + 64 * j]; } }
  for (int row = gw; row < NTOK; row += nw) {
    float4 v[4];
#pragma unroll
    for (int j = 0; j < 4; ++j) {
      v[j].x = ALPHA * nx[j].x + bf_lo(ny[j][0]); v[j].y = ALPHA * nx[j].y + bf_hi(ny[j][0]);
      v[j].z = ALPHA * nx[j].z + bf_lo(ny[j][1]); v[j].w = ALPHA * nx[j].w + bf_hi(ny[j][1]);
    }
    { const int nr = (row + nw < NTOK) ? row + nw : row;
      const float4* ps = (const float4*)(resid + (size_t)nr * 1024); const u32x2* py = (const u32x2*)(yg + (size_t)nr * 1024);
#pragma unroll
      for (int j = 0; j < 4; ++j) { nx[j] = ps[lane + 64 * j]; ny[j] = py[lane + 64 * j]; } }
    float s = 0.f;
#pragma unroll
    for (int j = 0; j < 4; ++j) s += v[j].x + v[j].y + v[j].z + v[j].w;
    float mu = wave_sum(s) * (1.f / 1024.f);
    float q = 0.f;
#pragma unroll
    for (int j = 0; j < 4; ++j) { v[j].x -= mu; v[j].y -= mu; v[j].z -= mu; v[j].w -= mu; q += v[j].x * v[j].x + v[j].y * v[j].y + v[j].z * v[j].z + v[j].w * v[j].w; }
    float rstd = rsqrtf(wave_sum(q) * (1.f / 1024.f) + EPS);
    float4* pd = (float4*)(dst + (size_t)row * 1024);
    s = 0.f;
#pragma unroll
    for (int j = 0; j < 4; ++j) {
      const int col = (lane + 64 * j) * 4;
      const float4 g4 = *(const float4*)(pg + col), b4 = *(const float4*)(pb + col);
      v[j].x = v[j].x * rstd * g4.x + b4.x; v[j].y = v[j].y * rstd * g4.y + b4.y; v[j].z = v[j].z * rstd * g4.z + b4.z; v[j].w = v[j].w * rstd * g4.w + b4.w;
      pd[lane + 64 * j] = v[j];
      s += v[j].x + v[j].y + v[j].z + v[j].w;
    }
    if (m1) {
      mu = wave_sum(s) * (1.f / 1024.f);
      q = 0.f;
#pragma unroll
      for (int j = 0; j < 4; ++j) { v[j].x -= mu; v[j].y -= mu; v[j].z -= mu; v[j].w -= mu; q += v[j].x * v[j].x + v[j].y * v[j].y + v[j].z * v[j].z + v[j].w * v[j].w; }
      rstd = rsqrtf(wave_sum(q) * (1.f / 1024.f) + EPS);
      const float* md = mod17 + (size_t)(row >> 11) * 3072;
      bf16_t* pm = m1 + (size_t)row * 1024;
#pragma unroll
      for (int j = 0; j < 4; ++j) {
        const int col = (lane + 64 * j) * 4;
        const float4 sh = *(const float4*)(md + col), sc = *(const float4*)(md + 1024 + col);
        st_bf4(pm + col, v[j].x * rstd * (1.f + sc.x) + sh.x, v[j].y * rstd * (1.f + sc.y) + sh.y, v[j].z * rstd * (1.f + sc.z) + sh.z, v[j].w * rstd * (1.f + sc.w) + sh.w);
      }
    }
  }
}

__device__ __forceinline__ void out_proj(const bf16_t* A, const bf16_t* WT, const float* gate17, bf16_t* dst, char* smem) {
  const int lb = logical_block();
  for (int u = lb; u < 512; u += gridDim.x) {
    const int mt = u >> 2, nt = u & 3;
    f32x16 acc[2][4];
    gemm2(mkPlain(A + (size_t)mt * 256 * 2048, 2048), mkPlain(WT + (size_t)nt * 256 * 2048, 2048), 32, smem, acc);
    const float* gt = gate17 + (size_t)(mt >> 3) * 3072 + 2048 + nt * 256;
    epi2_foreach(acc, [&](int row, int col, float a, float b, float c, float d) {
      const size_t idx = (size_t)(mt * 256 + row) * 1024 + nt * 256 + col;
      const float4 g4 = *(const float4*)(gt + col);
      st_bf4(dst + idx, g4.x * a, g4.y * b, g4.z * c, g4.w * d);
    });
  }
}

#define XB_TMO      128
#define XB_XCNT(j)  (256  + 64 * (j))
#define XB_XSUB(j)  (1280 + 64 * (j))
#define XB_XGEN(j)  (2304 + 64 * (j))
#define XB_TOP      3328
#define XB_TOPGEN   3392
#define XCD_BAR_WORDS 3456
#define XB_SPIN_CAP (1u << 18)
#define LAS __attribute__((address_space(3)))

__device__ __forceinline__ unsigned xb_ld(unsigned* p)              { return __hip_atomic_load(p, __ATOMIC_RELAXED, __HIP_MEMORY_SCOPE_AGENT); }
__device__ __forceinline__ unsigned xb_add(unsigned* p, unsigned v) { return __hip_atomic_fetch_add(p, v, __ATOMIC_RELAXED, __HIP_MEMORY_SCOPE_AGENT); }
__device__ __forceinline__ unsigned xb_xcc_id() { return (unsigned)__builtin_amdgcn_s_getreg((3 << 11) | 20) & 0xFu; }
#define XB_SPIN(cond, bar) do { unsigned _sp = 0; while (cond) { __builtin_amdgcn_s_sleep(1); \
    if ((++_sp & 255u) == 0u) { if (xb_ld(&(bar)[XB_TMO])) break; if (_sp > XB_SPIN_CAP) { atomicAdd(&(bar)[XB_TMO], 1u); break; } } } } while (0)

struct XcdBarrier {
    unsigned* bar; unsigned x;
    volatile LAS unsigned* st;
};

__device__ __forceinline__ XcdBarrier xcd_barrier_post(unsigned* bar, volatile LAS unsigned* st) {
    XcdBarrier b; b.bar = bar; b.x = xb_xcc_id(); b.st = st;
    if (threadIdx.x == 0) (void)xb_add(&bar[XB_XCNT(b.x)], 1u);
    return b;
}
__device__ __forceinline__ void xcd_barrier_complete(unsigned* bar, unsigned x, unsigned& nloc, unsigned& nx) {
    const unsigned G = gridDim.x * gridDim.y * gridDim.z;
    unsigned sum, cnt, mine, sp = 0u;
    for (;;) {
        sum = 0u; cnt = 0u; mine = 0u;
#pragma unroll
        for (unsigned j = 0; j < 16; ++j) { const unsigned c = xb_ld(&bar[XB_XCNT(j)]); sum += c; cnt += (c > 0u) ? 1u : 0u; mine = (j == x) ? c : mine; }
        if (sum == G) break;
        __builtin_amdgcn_s_sleep(1);
        if ((++sp & 255u) == 0u) { if (xb_ld(&bar[XB_TMO])) break; if (sp > XB_SPIN_CAP) { atomicAdd(&bar[XB_TMO], 1u); break; } }
    }
    nloc = mine > 0u ? mine : 1u; nx = cnt > 0u ? cnt : 1u;
}

__device__ __forceinline__ void xcd_barrier(const XcdBarrier& b) {
    asm volatile("s_waitcnt vmcnt(0)" ::: "memory");
    __syncthreads();
    if (threadIdx.x == 0) {
        unsigned* bar = b.bar;
        __builtin_amdgcn_s_waitcnt(0);
        unsigned nloc = b.st[0], nx = b.st[1];
        if (nloc == 0u) { xcd_barrier_complete(bar, b.x, nloc, nx); b.st[0] = nloc; b.st[1] = nx; }
        const unsigned old = xb_add(&bar[XB_XSUB(b.x)], 1u);
        const unsigned gen = old / nloc;
        if (old + 1u == (gen + 1u) * nloc) {
            __builtin_amdgcn_fence(__ATOMIC_RELEASE, "agent");
            asm volatile("s_waitcnt vmcnt(0)" ::: "memory");
            const unsigned og = xb_add(&bar[XB_TOP], 1u);
            const unsigned tg = og / nx;
            if (og + 1u == (tg + 1u) * nx) xb_add(&bar[XB_TOPGEN], 1u);
            else XB_SPIN(xb_ld(&bar[XB_TOPGEN]) == tg, bar);
            __builtin_amdgcn_fence(__ATOMIC_ACQUIRE, "agent");
            xb_add(&bar[XB_XGEN(b.x)], 1u);
            asm volatile("s_waitcnt vmcnt(0)" ::: "memory");
        } else {
            XB_SPIN(xb_ld(&bar[XB_XGEN(b.x)]) == gen, bar);
            __builtin_amdgcn_fence(__ATOMIC_ACQUIRE, "agent");
            asm volatile("s_waitcnt vmcnt(0)" ::: "memory");
        }
    }
    __syncthreads();
}


constexpr size_t OFF_XBAR = OFF_SMALL + 1536 * 1024;
constexpr size_t OFF_PX = OFF_SMALL + 1152 * 1024;
#define GSYNC_CG() do { __threadfence(); grid.sync(); __threadfence(); } while (0)
#define GSYNC() xcd_barrier(xbar)
#ifndef LAUNCH_SPLITS
#define LAUNCH_SPLITS {{0,0},{1,1},{2,2},{3,3},{4,4},{5,5},{6,6},{7,7},{8,8},{9,9},{10,10}}
#endif
template <int PLO, int PHI>
__global__ void __launch_bounds__(512) mega(Params p) {
  cg::grid_group grid = cg::this_grid();
  __shared__ __attribute__((aligned(16))) char smem[SMEM_BYTES];
  char* ws = p.ws;
  float* MOD = (float*)(ws + OFF_MOD);
  const int lb = logical_block();
  volatile LAS unsigned* xst = (volatile LAS unsigned*)(smem + LDS_RED + 2048);
  if (tid_fresh() < 4) xst[tid_fresh()] = 0u;
  __syncthreads();
  XcdBarrier xbar = xcd_barrier_post((unsigned*)(ws + OFF_XBAR), xst);
  if (PLO < PHI) grid.sync();

  if (PLO <= 0 && 0 <= PHI) {
  phase0(p, smem);
  }
  if (PLO <= 0 && 0 < PHI) { GSYNC(); }
  if (PLO <= 1 && 1 <= PHI) {

  ln_rows_modulate(p.x, (bf16_t*)(ws + OFF_M0), NTOK, SEQ, MOD, -1);
  ln_rows_modulate(p.ctx, (bf16_t*)(ws + OFF_MC), NCTX, CTXL, MOD, 16);
  }
  if (PLO <= 1 && 1 < PHI) { GSYNC(); }
  if (PLO <= 2 && 2 <= PHI) {

  phase2(p, smem);
  }
  if (PLO <= 2 && 2 < PHI) { GSYNC(); }
  if (PLO <= 3 && 3 <= PHI) {

  for (int u = lb; u < 1024; u += gridDim.x) {
      const int grp = u >> 5, j = u & 31, b = grp >> 1, kvh = grp & 1, hq = kvh * 4 + (j >> 3), qb = j & 7;
      const bf16_t* Qb = (const bf16_t*)(ws + OFF_Q) + ((size_t)(b * SEQ + qb * 256) * 8 + hq) * 128;
      const bf16_t* Kh = (const bf16_t*)(ws + OFF_KALL) + ((size_t)b * SKV * 2 + kvh) * 128;
      const bf16_t* Vh = (const bf16_t*)(ws + OFF_VALL) + ((size_t)b * SKV * 2 + kvh) * 128;
      bf16_t* GO = (bf16_t*)(ws + OFF_SG) + (size_t)(b * SEQ + qb * 256) * 2048 + hq * 128;
      att::attn_body(Qb, Kh, Vh, GO, SKV, smem);
  }
  for (int v = lb; v < 256; v += gridDim.x) chunk_gate_unit(p, v >> 4, v & 15, smem);
  }
  if (PLO <= 3 && 3 < PHI) { GSYNC(); }
  if (PLO <= 4 && 4 <= PHI) {

  out_proj((const bf16_t*)(ws + OFF_SG), (const bf16_t*)(ws + OFF_WT_EOUT), MOD, (bf16_t*)(ws + OFF_YG), smem);
  }
  if (PLO <= 4 && 4 < PHI) { GSYNC(); }
  if (PLO <= 5 && 5 <= PHI) {

  post_ln_rows(p.x, (const bf16_t*)(ws + OFF_YG), (float*)(ws + OFF_Q), p.post_g, p.post_b, (bf16_t*)(ws + OFF_M0), MOD + 17 * 3072);
  }
  if (PLO <= 5 && 5 < PHI) { GSYNC(); }
  if (PLO <= 6 && 6 <= PHI) {

  {
    const bf16_t* M1 = (const bf16_t*)(ws + OFF_M0); const bf16_t* WT = (const bf16_t*)(ws + OFF_WT_OIN);
    bf16_t* F = (bf16_t*)(ws + OFF_F); bf16_t* RV = (bf16_t*)(ws + OFF_RV); bf16_t* XM = (bf16_t*)(ws + OFF_XM);
    bf16_t* SG1 = (bf16_t*)(ws + OFF_SG);
    for (int u = lb; u < 2048; u += gridDim.x) {
      f32x16 acc[2][4];
      if (u < 1024) {
        const int tt = u >> 3, ct = u & 7, b = tt >> 3, t0 = (tt & 7) * 256;
        gemm2(mkPlain(WT + (size_t)ct * 256 * 1024, 1024), mkPlain(M1 + (size_t)tt * 256 * 1024, 1024), 16, smem, acc);
        epi2_foreach(acc, [&](int row, int col, float a, float bq, float c, float d) {
          const int ch = ct * 256 + row, t = t0 + col;
          const size_t base = ((size_t)b * 2048 + ch) * 1024;
          if (t < 1024) {
            st_bf4(F + base + t, a, bq, c, d);
            if (t == 0) RV[base] = 0;
          } else if (t == 1024) {
            XM[(size_t)b * 2048 + ch] = f2bf(a);
            RV[base + 1023] = f2bf(bq); RV[base + 1022] = f2bf(c); RV[base + 1021] = f2bf(d);
          } else {
            RV[base + 2048 - t] = f2bf(a); RV[base + 2047 - t] = f2bf(bq); RV[base + 2046 - t] = f2bf(c); RV[base + 2045 - t] = f2bf(d);
          }
        });
      } else {
        const int v = u - 1024, mt = v >> 3, nt = v & 7;
        gemm2(mkPlain(M1 + (size_t)mt * 256 * 1024, 1024), mkPlain(WT + (size_t)(2048 + nt * 256) * 1024, 1024), 16, smem, acc);
        epi2_foreach(acc, [&](int row, int col, float a, float bq, float c, float d) {
          st_bf4(SG1 + (size_t)(mt * 256 + row) * 2048 + nt * 256 + col, silu_f(a), silu_f(bq), silu_f(c), silu_f(d));
        });
      }
    }
  }
  }
  if (PLO <= 6 && 6 < PHI) { GSYNC(); }
  if (PLO <= 7 && 7 <= PHI) {

  {
    bf16_t* EE = (bf16_t*)p.out + (size_t)32 * MiB;
    bf16_t* EO = EE + (size_t)16 * MiB;
    bf16_t* OE = (bf16_t*)(ws + OFF_M0); bf16_t* OO = OE + (size_t)16 * MiB;
    float* PX = (float*)(ws + OFF_PX); float* E512 = PX + 32768; float* O512 = PX + 65536;
    {
      const int tid = tid_fresh(), wid = tid >> 6, lane = tid & 63;
      const int gw = blockIdx.x * 8 + wid, nw = gridDim.x * 8;
      const bf16_t* XMr = (const bf16_t*)(ws + OFF_XM);
      u32x4 na0, na1, nb0, nb1;
      { const size_t ro = (size_t)gw * 128; const u32x4* Fr = (const u32x4*)(ws + OFF_F) + ro; const u32x4* Rr = (const u32x4*)(ws + OFF_RV) + ro;
        na0 = Fr[lane]; na1 = Fr[lane + 64]; nb0 = Rr[lane]; nb1 = Rr[lane + 64]; }
      const int src1 = 63 - lane, src0 = (64 - lane) & 63;
      for (int row = gw; row < 16 * 2048; row += nw) {
        const u32x4 a0 = na0, a1 = na1, b0 = nb0, b1 = nb1;
        { const int nr = (row + nw < 16 * 2048) ? row + nw : row; const size_t ro = (size_t)nr * 128;
          const u32x4* Fr = (const u32x4*)(ws + OFF_F) + ro; const u32x4* Rr = (const u32x4*)(ws + OFF_RV) + ro;
          na0 = Fr[lane]; na1 = Fr[lane + 64]; nb0 = Rr[lane]; nb1 = Rr[lane + 64]; }
        float e1[8], o1[8], e2[8], o2[8];
#pragma unroll
        for (int k = 0; k < 4; ++k) {
          { const float al = bf_lo(a0[k]), ah = bf_hi(a0[k]), bl = bf_lo(b0[k]), bh = bf_hi(b0[k]);
            e1[2 * k] = al + bl; e1[2 * k + 1] = ah + bh; o1[2 * k] = al - bl; o1[2 * k + 1] = ah - bh; }
          { const float al = bf_lo(a1[k]), ah = bf_hi(a1[k]), bl = bf_lo(b1[k]), bh = bf_hi(b1[k]);
            e2[2 * k] = al + bl; e2[2 * k + 1] = ah + bh; o2[2 * k] = al - bl; o2[2 * k + 1] = ah - bh; }
        }
        float alt = 0.f;
#pragma unroll
        for (int j = 0; j < 8; j += 2) alt += (e1[j] - e1[j + 1]) + (e2[j] - e2[j + 1]);
        float me[8], mo[8];
        me[0] = __shfl(e2[0], src0); mo[0] = __shfl(o2[0], src0);
        if (lane == 0) { me[0] = 0.f; mo[0] = 0.f; }
#pragma unroll
        for (int j = 1; j < 8; ++j) { me[j] = __shfl(e2[8 - j], src1); mo[j] = __shfl(o2[8 - j], src1); }
        u32x4 wee, weo, woe, woo;
#pragma unroll
        for (int k = 0; k < 4; ++k) {
          wee[k] = cvtpk(e1[2 * k] + me[2 * k], e1[2 * k + 1] + me[2 * k + 1]);
          weo[k] = cvtpk(e1[2 * k] - me[2 * k], e1[2 * k + 1] - me[2 * k + 1]);
          woe[k] = cvtpk(o1[2 * k] - mo[2 * k], o1[2 * k + 1] - mo[2 * k + 1]);
          woo[k] = cvtpk(o1[2 * k] + mo[2 * k], o1[2 * k + 1] + mo[2 * k + 1]);
        }
        const size_t wo = (size_t)row * 64 + lane;
        ((u32x4*)EE)[wo] = wee; ((u32x4*)EO)[wo] = weo; ((u32x4*)OE)[wo] = woe; ((u32x4*)OO)[wo] = woo;
        alt = wave_sum(alt);
        if (lane == 0) { PX[row] = alt + bf2f(XMr[row]); E512[row] = e2[0]; O512[row] = o2[0]; }
      }
    }
    if (PLO < PHI) { GSYNC(); }
    const bf16_t* XM = (const bf16_t*)(ws + OFF_XM);
    const bf16_t* TAB = (const bf16_t*)(ws + OFF_TAB_C);
    bf16_t* PC = (bf16_t*)p.out; bf16_t* PS = (bf16_t*)(ws + OFF_F);
    for (int u = lb; u < 1024; u += gridDim.x) {
      f32x16 acc[2][4];
      const int ty = u >> 8, v = u & 255, b = v >> 4, mt = (v >> 3) & 1, nt = v & 7;
      const bf16_t* Bsrc = (ty == 0) ? EE : (ty == 1) ? EO : (ty == 2) ? OE : OO;
      gemm2(mkPlain(TAB + (size_t)ty * 512 * 512 + (size_t)mt * 256 * 512, 512), mkPlain(Bsrc + ((size_t)b * 2048 + nt * 256) * 512, 512), 8, smem, acc);
      bf16_t* dstP = (ty < 2) ? PC : PS;
      const int par = ty & 1;
      epi2_foreach(acc, [&](int row, int col, float a, float bq, float c, float d) {
        const int sidx = mt * 256 + row, tp = 2 * sidx + par, ch = nt * 256 + col;
        const size_t vi = (size_t)b * 2048 + ch;
        const float sg = (sidx & 1) ? -1.f : 1.f;
        if (ty == 0) {
          const u32x2 xm = *(const u32x2*)(XM + vi); const float4 em = *(const float4*)(E512 + vi);
          a += sg * em.x + bf_lo(xm[0]); bq += sg * em.y + bf_hi(xm[0]); c += sg * em.z + bf_lo(xm[1]); d += sg * em.w + bf_hi(xm[1]);
        } else if (ty == 1) {
          const u32x2 xm = *(const u32x2*)(XM + vi);
          a -= bf_lo(xm[0]); bq -= bf_hi(xm[0]); c -= bf_lo(xm[1]); d -= bf_hi(xm[1]);
        } else if (ty == 3) {
          const float4 om = *(const float4*)(O512 + vi);
          a += sg * om.x; bq += sg * om.y; c += sg * om.z; d += sg * om.w;
        }
        st_bf4(dstP + ((size_t)b * 1024 + tp) * 2048 + ch, a, bq, c, d);
      });
    }
  }
  }
  if (PLO <= 7 && 7 < PHI) { GSYNC(); }
  if (PLO <= 8 && 8 <= PHI) {

  {
    const bf16_t* PC = (const bf16_t*)p.out; const bf16_t* PS = (const bf16_t*)(ws + OFF_F);
    const bf16_t* CDP = (const bf16_t*)(ws + OFF_CDP);
    bf16_t* SG1 = (bf16_t*)(ws + OFF_SG);
    const int tid = tid_fresh(), wid = tid >> 6, lane = tid & 63, r32 = lane & 31, hi = lane >> 5, wm = wid >> 1, wn = wid & 1;
    constexpr int TBS = 528;
    constexpr int TB_BYTES = 128 * TBS;
    char* sT = smem; char* sA = smem + TB_BYTES;
#pragma unroll
    for (int i = 0; i < 8; ++i) {
      const int id = tid + 512 * i, row = id >> 5, ck = id & 31;
      *(u32x4*)(sT + row * TBS + ck * 16) = *(const u32x4*)(CDP + row * 256 + ck * 8);
    }
    const int st_off = (tid >> 3) * LDS_ROWB + (tid & 7) * 16;
    const int a_rd = (wm * 64 + r32) * LDS_ROWB + hi * 16;
    const int b_rd = (wn * 32 + r32) * TBS + hi * 16;
    const size_t rowoff = (size_t)(tid >> 3) * 2048 + (tid & 7) * 8;
    u32x4 r00, r01, r02, r03, r10, r11, r12, r13, r20, r21, r22, r23, r30, r31, r32_, r33;
    auto a_base = [&](int u_, int s_) -> const bf16_t* {
      const int b_ = u_ >> 6, j_ = (u_ >> 4) & 3, G_ = u_ & 15;
      return ((s_ < 2) ? PC : PS) + ((size_t)b_ * 1024 + j_ * 256) * 2048 + G_ * 128 + (s_ & 1) * 64 + rowoff;
    };
#define P8_LOAD(S, U, A, B, C, D) do { const bf16_t* q_ = a_base((U), (S)); A = *(const u32x4*)(q_); B = *(const u32x4*)(q_ + (size_t)64 * 2048); \
      C = *(const u32x4*)(q_ + (size_t)128 * 2048); D = *(const u32x4*)(q_ + (size_t)192 * 2048); } while (0)
#define P8_WRITE(ST, A, B, C, D) do { char* s_ = sA + (ST) * L2_A + st_off; *(u32x4*)(s_) = A; *(u32x4*)(s_ + 64 * LDS_ROWB) = B; \
      *(u32x4*)(s_ + 128 * LDS_ROWB) = C; *(u32x4*)(s_ + 192 * LDS_ROWB) = D; } while (0)
#define P8_COMPUTE(ST, S, ACC) do { const char* sb_ = sA + (ST) * L2_A;                                              \
      _Pragma("unroll") for (int kk = 0; kk < 4; ++kk) {                                                               \
        const bf16x8 fa0 = *(const bf16x8*)(sb_ + a_rd + kk * 32);                                                      \
        const bf16x8 fa1 = *(const bf16x8*)(sb_ + a_rd + 32 * LDS_ROWB + kk * 32);                                      \
        const bf16x8 fb0 = *(const bf16x8*)(sT + b_rd + ((S) * 64 + kk * 16) * 2);                                      \
        const bf16x8 fb1 = *(const bf16x8*)(sT + b_rd + 64 * TBS + ((S) * 64 + kk * 16) * 2);                           \
        ACC[0][0] = __builtin_amdgcn_mfma_f32_32x32x16_bf16(fb0, fa0, ACC[0][0], 0, 0, 0);                              \
        ACC[0][1] = __builtin_amdgcn_mfma_f32_32x32x16_bf16(fb1, fa0, ACC[0][1], 0, 0, 0);                              \
        ACC[1][0] = __builtin_amdgcn_mfma_f32_32x32x16_bf16(fb0, fa1, ACC[1][0], 0, 0, 0);                              \
        ACC[1][1] = __builtin_amdgcn_mfma_f32_32x32x16_bf16(fb1, fa1, ACC[1][1], 0, 0, 0);                              \
      } } while (0)
    P8_LOAD(0, lb, r00, r01, r02, r03); P8_LOAD(1, lb, r10, r11, r12, r13); P8_LOAD(2, lb, r20, r21, r22, r23); P8_LOAD(3, lb, r30, r31, r32_, r33);
    for (int u = lb; u < 1024; u += gridDim.x) {
      const int un = (u + (int)gridDim.x < 1024) ? u + (int)gridDim.x : u;
      f32x16 acc1[2][2], acc2[2][2];
#pragma unroll
      for (int mi = 0; mi < 2; ++mi)
#pragma unroll
        for (int nj = 0; nj < 2; ++nj)
#pragma unroll
          for (int r = 0; r < 16; ++r) { acc1[mi][nj][r] = 0.f; acc2[mi][nj][r] = 0.f; }
      P8_WRITE(0, r00, r01, r02, r03); __syncthreads(); P8_LOAD(0, un, r00, r01, r02, r03); P8_COMPUTE(0, 0, acc1);
      P8_WRITE(1, r10, r11, r12, r13); __syncthreads(); P8_LOAD(1, un, r10, r11, r12, r13); P8_COMPUTE(1, 1, acc1);
      P8_WRITE(0, r20, r21, r22, r23); __syncthreads(); P8_LOAD(2, un, r20, r21, r22, r23); P8_COMPUTE(0, 2, acc2);
      P8_WRITE(1, r30, r31, r32_, r33); __syncthreads(); P8_LOAD(3, un, r30, r31, r32_, r33); P8_COMPUTE(1, 3, acc2);
      const int b = u >> 6, j = (u >> 4) & 3, G = u & 15;
      const float sc = 1.f / 512.f;
      char* sE = sA;
      constexpr int ES = 272;
      __syncthreads();
#pragma unroll 1
      for (int pass = 0; pass < 2; ++pass) {
#pragma unroll
        for (int i = 0; i < 8; ++i) {
          const int id = tid + 512 * i, row = id >> 4, ck = id & 15, tp = j * 256 + row;
          const int tok = pass ? ((tp >= 1) ? 2048 - tp : 0) : tp;
          *(u32x4*)(sE + row * ES + ck * 16) = *(const u32x4*)(SG1 + ((size_t)b * 2048 + tok) * 2048 + G * 128 + ck * 8);
        }
        __syncthreads();
        const float sgn = pass ? 1.f : -1.f;
#pragma unroll
        for (int mi = 0; mi < 2; ++mi)
#pragma unroll
          for (int nj = 0; nj < 2; ++nj)
#pragma unroll
            for (int q = 0; q < 4; ++q) {
              char* ad = sE + (wm * 64 + mi * 32 + r32) * ES + (nj * 64 + wn * 32 + q * 8 + hi * 4) * 2;
              const u32x2 sg = *(const u32x2*)ad;
              const float y0 = (acc1[mi][nj][4 * q + 0] + sgn * acc2[mi][nj][4 * q + 0]) * sc, y1 = (acc1[mi][nj][4 * q + 1] + sgn * acc2[mi][nj][4 * q + 1]) * sc;
              const float y2 = (acc1[mi][nj][4 * q + 2] + sgn * acc2[mi][nj][4 * q + 2]) * sc, y3 = (acc1[mi][nj][4 * q + 3] + sgn * acc2[mi][nj][4 * q + 3]) * sc;
              u32x2 w = {cvtpk(y0 * bf_lo(sg[0]), y1 * bf_hi(sg[0])), cvtpk(y2 * bf_lo(sg[1]), y3 * bf_hi(sg[1]))};
              *(u32x2*)ad = w;
            }
        __syncthreads();
#pragma unroll
        for (int i = 0; i < 8; ++i) {
          const int id = tid + 512 * i, row = id >> 4, ck = id & 15, tp = j * 256 + row;
          if (!pass || tp >= 1) {
            const int tok = pass ? 2048 - tp : tp;
            *(u32x4*)(SG1 + ((size_t)b * 2048 + tok) * 2048 + G * 128 + ck * 8) = *(const u32x4*)(sE + row * ES + ck * 16);
          }
        }
        __syncthreads();
      }
    }
#undef P8_LOAD
#undef P8_WRITE
#undef P8_COMPUTE
    {
      const float* PX = (const float*)(ws + OFF_PX);
      for (int i = blockIdx.x; i < 256; i += gridDim.x) {
        if (tid < 128) {
          const int b = i >> 4, G = i & 15;
          const float* px = PX + (size_t)b * 2048 + G * 128;
          float y = 0.f;
          for (int c = 0; c < 128; ++c) y += px[c] * bf2f(*(const bf16_t*)(sT + tid * TBS + c * 2));
          bf16_t* gp = SG1 + ((size_t)b * 2048 + 1024) * 2048 + G * 128 + tid;
          *gp = f2bf(y * (1.f / 512.f) * bf2f(*gp));
        }
      }
    }
  }
  }
  if (PLO <= 8 && 8 < PHI) { GSYNC(); }
  if (PLO <= 9 && 9 <= PHI) {

  out_proj((const bf16_t*)(ws + OFF_SG), (const bf16_t*)(ws + OFF_WT_OOUT), MOD + 17 * 3072, (bf16_t*)(ws + OFF_YG), smem);
  }
  if (PLO <= 9 && 9 < PHI) { GSYNC(); }
  if (PLO <= 10 && 10 <= PHI) {

  post_ln_rows((const float*)(ws + OFF_Q), (const bf16_t*)(ws + OFF_YG), p.out, p.post_g + 1024, p.post_b + 1024, nullptr, nullptr);
  }
}

extern "C" void kernel_launch(void* const* d_in, const int* in_sizes, int n_in, void* d_out, int out_size, void* d_ws, size_t ws_size,
                              hipStream_t stream) {
  static int grid_blocks = 0;
  if (!grid_blocks) {
    int dev = 0, cus = 0, per_cu = 0;
    hipGetDevice(&dev);
    hipDeviceGetAttribute(&cus, hipDeviceAttributeMultiprocessorCount, dev);
    hipOccupancyMaxActiveBlocksPerMultiprocessor(&per_cu, mega<0, 10>, 512, 0);
    if (per_cu > 1) per_cu = 1;
    grid_blocks = cus * per_cu;
    if (n_in != 18 || ws_size < WS_NEED) fprintf(stderr, "kernel_launch: unexpected n_in %d or ws_size %zu (need %zu)\n", n_in, ws_size, (size_t)WS_NEED);
  }
  Params p{};
  p.x = (const float*)d_in[0]; p.c = (const float*)d_in[1]; p.ctx = (const float*)d_in[2]; p.c_ctx = (const float*)d_in[3];
  p.w_mod = (const float*)d_in[4]; p.b_mod = (const float*)d_in[5]; p.post_g = (const float*)d_in[6]; p.post_b = (const float*)d_in[7];
  p.e_w_in = (const float*)d_in[8]; p.e_qn = (const float*)d_in[9]; p.e_kn = (const float*)d_in[10]; p.e_vg = (const float*)d_in[11];
  p.e_vb = (const float*)d_in[12]; p.e_ws = (const float*)d_in[13]; p.e_bs = (const float*)d_in[14]; p.e_w_out = (const float*)d_in[15];
  p.o_w_in = (const float*)d_in[16]; p.o_w_out = (const float*)d_in[17];
  p.out = (float*)d_out; p.ws = (char*)d_ws;
#define ONE_LAUNCH 1
#ifdef ONE_LAUNCH
  hipMemsetAsync((char*)d_ws + OFF_XBAR, 0, XCD_BAR_WORDS * 4, stream);
  { void* args[] = {&p};
    hipError_t e = hipLaunchCooperativeKernel((void*)mega<0, 10>, dim3(grid_blocks), dim3(512), args, 0, stream);
    if (e != hipSuccess) fprintf(stderr, "cooperative launch failed: %s (grid %d)\n", hipGetErrorString(e), grid_blocks); }
#else
  hipLaunchKernelGGL((mega<0, 0>), dim3(grid_blocks), dim3(512), 0, stream, p);
  hipLaunchKernelGGL((mega<1, 1>), dim3(grid_blocks), dim3(512), 0, stream, p);
  hipLaunchKernelGGL((mega<2, 2>), dim3(grid_blocks), dim3(512), 0, stream, p);
  hipLaunchKernelGGL((mega<3, 3>), dim3(grid_blocks), dim3(512), 0, stream, p);
  hipLaunchKernelGGL((mega<4, 4>), dim3(grid_blocks), dim3(512), 0, stream, p);
  hipLaunchKernelGGL((mega<5, 5>), dim3(grid_blocks), dim3(512), 0, stream, p);
  hipLaunchKernelGGL((mega<6, 6>), dim3(grid_blocks), dim3(512), 0, stream, p);
  hipLaunchKernelGGL((mega<7, 7>), dim3(grid_blocks), dim3(512), 0, stream, p);
  hipLaunchKernelGGL((mega<8, 8>), dim3(grid_blocks), dim3(512), 0, stream, p);
  hipLaunchKernelGGL((mega<9, 9>), dim3(grid_blocks), dim3(512), 0, stream, p);
  hipLaunchKernelGGL((mega<10, 10>), dim3(grid_blocks), dim3(512), 0, stream, p);
#endif
}
```

```cpp
#include <hip/hip_runtime.h>
#include <hip/hip_cooperative_groups.h>
#include <cstdio>
#include <cstdint>
namespace cg = cooperative_groups;

typedef unsigned short bf16_t;
using bf16x8 = __attribute__((ext_vector_type(8))) short;
using s16x4  = __attribute__((ext_vector_type(4))) short;
using f32x16 = __attribute__((ext_vector_type(16))) float;
using u32x4  = __attribute__((ext_vector_type(4))) unsigned;
using u32x2  = __attribute__((ext_vector_type(2))) unsigned;

constexpr int DM = 1024, NB = 16, SEQ = 2048, CTXL = 256, SKV = SEQ + CTXL;
constexpr int NTOK = NB * SEQ;
constexpr int NCTX = NB * CTXL;
constexpr int EVEN_IN = 5632, ODD_IN = 4096, DIN = 2048;
constexpr float ALPHA = 1.4142135623730951f;
constexpr float EPS = 1e-6f;

constexpr size_t MiB = 1ull << 20;
constexpr size_t OFF_WT_EIN = 0, OFF_WT_EOUT = 11 * MiB, OFF_WT_OIN = 15 * MiB, OFF_WT_OOUT = 23 * MiB;
constexpr size_t OFF_TAB_C = 27 * MiB, OFF_TAB_S = 30 * MiB, OFF_SMALL = 33 * MiB;
constexpr size_t OFF_CDM = OFF_SMALL, OFF_CDP = OFF_SMALL + 64 * 1024, OFF_WSB = OFF_SMALL + 128 * 1024;
constexpr size_t OFF_ROPE = OFF_SMALL + 384 * 1024, OFF_MOD = OFF_SMALL + 512 * 1024, OFF_XM = OFF_SMALL + 1024 * 1024;
constexpr size_t OFF_M0 = 36 * MiB, OFF_MC = 100 * MiB;
constexpr size_t OFF_SG = 108 * MiB;
constexpr size_t OFF_Q = 236 * MiB, OFF_BU = 300 * MiB;
constexpr size_t OFF_KALL = 364 * MiB, OFF_VALL = 382 * MiB, OFF_BV = 400 * MiB;
constexpr size_t OFF_F = 364 * MiB, OFF_RV = 428 * MiB;
constexpr size_t OFF_YG = 364 * MiB;
constexpr size_t WS_NEED = 492 * MiB;

struct Params {
  const float *x, *c, *ctx, *c_ctx, *w_mod, *b_mod, *post_g, *post_b, *e_w_in, *e_qn, *e_kn, *e_vg, *e_vb, *e_ws, *e_bs,
      *e_w_out, *o_w_in, *o_w_out;
  float* out;
  char* ws;
  long pad_;
};

typedef float f32x2_t __attribute__((ext_vector_type(2)));
typedef __bf16 bf16x2_t __attribute__((ext_vector_type(2)));
__device__ __forceinline__ unsigned cvtpk(float lo, float hi) {
  f32x2_t v = {lo, hi}; bf16x2_t h = __builtin_convertvector(v, bf16x2_t); return __builtin_bit_cast(unsigned, h);
}
__device__ __forceinline__ int tid_fresh() { int t = (int)__builtin_amdgcn_workitem_id_x(); asm volatile("" : "+v"(t)); return t; }
__device__ __forceinline__ float bf_lo(unsigned w) { return __uint_as_float(w << 16); }
__device__ __forceinline__ float bf_hi(unsigned w) { return __uint_as_float(w & 0xffff0000u); }
__device__ __forceinline__ bf16_t f2bf(float x) { return (bf16_t)(cvtpk(x, 0.f) & 0xffffu); }
__device__ __forceinline__ float bf2f(bf16_t h) { return __uint_as_float(((unsigned)h) << 16); }
__device__ __forceinline__ int crow(int r, int hi) { return (r & 3) + 8 * (r >> 2) + 4 * hi; }
__device__ __forceinline__ float wave_sum(float v) {
#pragma unroll
  for (int o = 32; o >= 1; o >>= 1) v += __shfl_xor(v, o);
  return v;
}
__device__ __forceinline__ float silu_f(float x) { return x * __builtin_amdgcn_rcpf(1.f + __expf(-x)); }
__device__ __forceinline__ float gelu_tanh_f(float x) {
  const float u = 0.7978845608028654f * (x + 0.044715f * x * x * x);
  const float t = 1.f - 2.f * __builtin_amdgcn_rcpf(__expf(2.f * u) + 1.f);
  return 0.5f * x * (1.f + t);
}
__device__ __forceinline__ int logical_block() {
  const int g = gridDim.x, b = blockIdx.x;
  return (g & 7) ? b : (b & 7) * (g >> 3) + (b >> 3);
}

constexpr int LDS_ROWB = 144;
constexpr int LDS_A = 256 * LDS_ROWB;
constexpr int LDS_B = 128 * LDS_ROWB;
constexpr int LDS_STAGE = LDS_A + LDS_B;
constexpr int L2_A = 256 * LDS_ROWB;
constexpr int L2_STAGE = 2 * L2_A;
constexpr int LDS_RED = 2 * L2_STAGE;
constexpr int SMEM_BYTES = LDS_RED + 2048 + 2048;

struct LdPlain {
  const bf16_t* p; size_t rs;
  __device__ __forceinline__ u32x4 ld(int kt, int i) const { return *(const u32x4*)(p + (size_t)i * rs + kt * 64); }
};
__device__ __forceinline__ LdPlain mkPlain(const bf16_t* base, int ld) {
  const int tid = tid_fresh();
  LdPlain l; l.p = base + (size_t)(tid >> 3) * ld + (tid & 7) * 8; l.rs = (size_t)64 * ld; return l;
}
struct LdSplit {
  const bf16_t* p0; const bf16_t* p1; size_t rs; int kts;
  __device__ __forceinline__ u32x4 ld(int kt, int i) const {
    const bf16_t* q = (kt < kts) ? (p0 + kt * 64) : (p1 + (kt - kts) * 64);
    return *(const u32x4*)(q + (size_t)i * rs);
  }
};
__device__ __forceinline__ LdSplit mkSplit(const bf16_t* b0, const bf16_t* b1, int ld, int kts) {
  const int tid = tid_fresh(); const size_t o = (size_t)(tid >> 3) * ld + (tid & 7) * 8;
  LdSplit l; l.p0 = b0 + o; l.p1 = b1 + o; l.rs = (size_t)64 * ld; l.kts = kts; return l;
}
struct LdFold {
  const bf16_t* f; const bf16_t* r; size_t rs; float sg;
  __device__ __forceinline__ u32x4 ld(int kt, int i) const {
    const u32x4 a = *(const u32x4*)(f + (size_t)i * rs + kt * 64);
    const u32x4 b = *(const u32x4*)(r + (size_t)i * rs + kt * 64);
    u32x4 o;
    o[0] = cvtpk(bf_lo(a[0]) + sg * bf_lo(b[0]), bf_hi(a[0]) + sg * bf_hi(b[0]));
    o[1] = cvtpk(bf_lo(a[1]) + sg * bf_lo(b[1]), bf_hi(a[1]) + sg * bf_hi(b[1]));
    o[2] = cvtpk(bf_lo(a[2]) + sg * bf_lo(b[2]), bf_hi(a[2]) + sg * bf_hi(b[2]));
    o[3] = cvtpk(bf_lo(a[3]) + sg * bf_lo(b[3]), bf_hi(a[3]) + sg * bf_hi(b[3]));
    return o;
  }
};
__device__ __forceinline__ LdFold mkFold(const bf16_t* f, const bf16_t* r, int ld, float sg) {
  const int tid = tid_fresh(); const size_t o = (size_t)(tid >> 3) * ld + (tid & 7) * 8;
  LdFold l; l.f = f + o; l.r = r + o; l.rs = (size_t)64 * ld; l.sg = sg; return l;
}

template <class LA, class LB>
__device__ __forceinline__ void gemm_mainloop(const LA& la, const LB& lb, int KT, char* smem, f32x16 (&acc)[2][2]) {
  const int tid = tid_fresh(), wid = tid >> 6, lane = tid & 63, r32 = lane & 31, hi = lane >> 5, wm = wid >> 1, wn = wid & 1;
#pragma unroll
  for (int mi = 0; mi < 2; ++mi)
#pragma unroll
    for (int nj = 0; nj < 2; ++nj)
#pragma unroll
      for (int r = 0; r < 16; ++r) acc[mi][nj][r] = 0.f;
  const int st_off = (tid >> 3) * LDS_ROWB + (tid & 7) * 16;
  const int a_rd = (wm * 64 + r32) * LDS_ROWB + hi * 16;
  const int b_rd = LDS_A + (wn * 32 + r32) * LDS_ROWB + hi * 16;
  u32x4 ra0, ra1, ra2, ra3, rb0, rb1;
  ra0 = la.ld(0, 0); ra1 = la.ld(0, 1); ra2 = la.ld(0, 2); ra3 = la.ld(0, 3); rb0 = lb.ld(0, 0); rb1 = lb.ld(0, 1);
  {
    char* s = smem + st_off;
    *(u32x4*)(s) = ra0; *(u32x4*)(s + 64 * LDS_ROWB) = ra1; *(u32x4*)(s + 128 * LDS_ROWB) = ra2; *(u32x4*)(s + 192 * LDS_ROWB) = ra3;
    *(u32x4*)(s + LDS_A) = rb0; *(u32x4*)(s + LDS_A + 64 * LDS_ROWB) = rb1;
  }
  __syncthreads();
#define GEMM_COMPUTE(SB)                                                                              \
  _Pragma("unroll") for (int kk = 0; kk < 4; ++kk) {                                                  \
    const bf16x8 a0 = *(const bf16x8*)((SB) + a_rd + kk * 32);                                        \
    const bf16x8 a1 = *(const bf16x8*)((SB) + a_rd + 32 * LDS_ROWB + kk * 32);                        \
    const bf16x8 b0 = *(const bf16x8*)((SB) + b_rd + kk * 32);                                        \
    const bf16x8 b1 = *(const bf16x8*)((SB) + b_rd + 64 * LDS_ROWB + kk * 32);                        \
    acc[0][0] = __builtin_amdgcn_mfma_f32_32x32x16_bf16(b0, a0, acc[0][0], 0, 0, 0);                  \
    acc[0][1] = __builtin_amdgcn_mfma_f32_32x32x16_bf16(b1, a0, acc[0][1], 0, 0, 0);                  \
    acc[1][0] = __builtin_amdgcn_mfma_f32_32x32x16_bf16(b0, a1, acc[1][0], 0, 0, 0);                  \
    acc[1][1] = __builtin_amdgcn_mfma_f32_32x32x16_bf16(b1, a1, acc[1][1], 0, 0, 0);                  \
  }
#define GEMM_LOAD(KT_) do { ra0 = la.ld((KT_), 0); ra1 = la.ld((KT_), 1); ra2 = la.ld((KT_), 2); ra3 = la.ld((KT_), 3); rb0 = lb.ld((KT_), 0); rb1 = lb.ld((KT_), 1); } while (0)
#define GEMM_WRITE(ST) do { char* s = smem + (ST) * LDS_STAGE + st_off;                                \
    *(u32x4*)(s) = ra0; *(u32x4*)(s + 64 * LDS_ROWB) = ra1; *(u32x4*)(s + 128 * LDS_ROWB) = ra2; *(u32x4*)(s + 192 * LDS_ROWB) = ra3; \
    *(u32x4*)(s + LDS_A) = rb0; *(u32x4*)(s + LDS_A + 64 * LDS_ROWB) = rb1; } while (0)
#pragma unroll 1
  for (int kt = 0; kt < KT; kt += 2) {
    GEMM_LOAD(kt + 1);
    GEMM_COMPUTE(smem);
    GEMM_WRITE(1);
    __syncthreads();
    GEMM_LOAD(kt + 2 < KT ? kt + 2 : kt);
    GEMM_COMPUTE(smem + LDS_STAGE);
    GEMM_WRITE(0);
    __syncthreads();
  }
#undef GEMM_COMPUTE
#undef GEMM_LOAD
#undef GEMM_WRITE
}

template <class LA, class LB>
__device__ __forceinline__ void gemm2(const LA& la, const LB& lb, int KT, char* smem, f32x16 (&acc)[2][4]) {
  const int tid = tid_fresh(), wid = tid >> 6, lane = tid & 63, r32 = lane & 31, hi = lane >> 5, wm = wid >> 1, wn = wid & 1;
#pragma unroll
  for (int mi = 0; mi < 2; ++mi)
#pragma unroll
    for (int nj = 0; nj < 4; ++nj)
#pragma unroll
      for (int r = 0; r < 16; ++r) acc[mi][nj][r] = 0.f;
  const int st_off = (tid >> 3) * LDS_ROWB + (tid & 7) * 16;
  const int a_rd = (wm * 64 + r32) * LDS_ROWB + hi * 16;
  const int b_rd = L2_A + (wn * 128 + r32) * LDS_ROWB + hi * 16;
  u32x4 xa0, xa1, xa2, xa3, xb0, xb1, xb2, xb3, ya0, ya1, ya2, ya3, yb0, yb1, yb2, yb3;
#define G2_LOADX(KT_) do { xa0 = la.ld((KT_), 0); xa1 = la.ld((KT_), 1); xa2 = la.ld((KT_), 2); xa3 = la.ld((KT_), 3); xb0 = lb.ld((KT_), 0); xb1 = lb.ld((KT_), 1); xb2 = lb.ld((KT_), 2); xb3 = lb.ld((KT_), 3); } while (0)
#define G2_LOADY(KT_) do { ya0 = la.ld((KT_), 0); ya1 = la.ld((KT_), 1); ya2 = la.ld((KT_), 2); ya3 = la.ld((KT_), 3); yb0 = lb.ld((KT_), 0); yb1 = lb.ld((KT_), 1); yb2 = lb.ld((KT_), 2); yb3 = lb.ld((KT_), 3); } while (0)
#define G2_W2(ST, P, R0, R1, O0, O1) do { char* s_ = smem + (ST) * L2_STAGE + st_off; *(u32x4*)(s_ + (O0)) = P##R0; *(u32x4*)(s_ + (O1)) = P##R1; } while (0)
#define G2_WRITE(ST, P) do { G2_W2(ST, P, a0, a1, 0, 64 * LDS_ROWB); G2_W2(ST, P, a2, a3, 128 * LDS_ROWB, 192 * LDS_ROWB); \
    G2_W2(ST, P, b0, b1, L2_A, L2_A + 64 * LDS_ROWB); G2_W2(ST, P, b2, b3, L2_A + 128 * LDS_ROWB, L2_A + 192 * LDS_ROWB); } while (0)
#define G2_LDA(SB, kk, A0, A1) do { A0 = *(const bf16x8*)((SB) + a_rd + (kk) * 32); A1 = *(const bf16x8*)((SB) + a_rd + 32 * LDS_ROWB + (kk) * 32); } while (0)
#define G2_STEPP(SB, kk, A0, A1, N0, N1, HASNEXT) do {                                                \
    if (HASNEXT) G2_LDA(SB, (kk) + 1, N0, N1);                                                        \
    _Pragma("unroll") for (int nj = 0; nj < 4; ++nj) {                                                \
      const bf16x8 b_ = *(const bf16x8*)((SB) + b_rd + nj * 32 * LDS_ROWB + (kk) * 32);               \
      acc[0][nj] = __builtin_amdgcn_mfma_f32_32x32x16_bf16(b_, A0, acc[0][nj], 0, 0, 0);              \
      acc[1][nj] = __builtin_amdgcn_mfma_f32_32x32x16_bf16(b_, A1, acc[1][nj], 0, 0, 0);              \
    } } while (0)
#define G2_COMPUTE_W(SB, ST, P) do { bf16x8 p0_, p1_, q0_, q1_;                                        \
    G2_LDA(SB, 0, p0_, p1_);                                                                          \
    G2_STEPP(SB, 0, p0_, p1_, q0_, q1_, 1); G2_W2(ST, P, a0, a1, 0, 64 * LDS_ROWB);                   \
    G2_STEPP(SB, 1, q0_, q1_, p0_, p1_, 1); G2_W2(ST, P, a2, a3, 128 * LDS_ROWB, 192 * LDS_ROWB);     \
    G2_STEPP(SB, 2, p0_, p1_, q0_, q1_, 1); G2_W2(ST, P, b0, b1, L2_A, L2_A + 64 * LDS_ROWB);         \
    G2_STEPP(SB, 3, q0_, q1_, p0_, p1_, 0); G2_W2(ST, P, b2, b3, L2_A + 128 * LDS_ROWB, L2_A + 192 * LDS_ROWB); } while (0)
  G2_LOADX(0); G2_LOADY(1);
  G2_WRITE(0, x);
  __syncthreads();
  G2_LOADX(2 < KT ? 2 : 0);
#pragma unroll 1
  for (int kt = 0; kt < KT; kt += 2) {
    G2_COMPUTE_W(smem, 1, y);
    __syncthreads();
    G2_LOADY(kt + 3 < KT ? kt + 3 : KT - 1);
    G2_COMPUTE_W(smem + L2_STAGE, 0, x);
    __syncthreads();
    G2_LOADX(kt + 4 < KT ? kt + 4 : KT - 2);
  }
#undef G2_LOADX
#undef G2_LOADY
#undef G2_WRITE
#undef G2_W2
#undef G2_STEPP
#undef G2_LDA
#undef G2_COMPUTE_W
}
template <class F>
__device__ __forceinline__ void epi2_foreach(const f32x16 (&acc)[2][4], F&& f) {
  const int tid = tid_fresh(), wid = tid >> 6, lane = tid & 63, r32 = lane & 31, hi = lane >> 5, wm = wid >> 1, wn = wid & 1;
#pragma unroll
  for (int mi = 0; mi < 2; ++mi)
#pragma unroll
    for (int nj = 0; nj < 4; ++nj)
#pragma unroll
      for (int q = 0; q < 4; ++q)
        f(wm * 64 + mi * 32 + r32, wn * 128 + nj * 32 + q * 8 + hi * 4, acc[mi][nj][4 * q + 0], acc[mi][nj][4 * q + 1],
          acc[mi][nj][4 * q + 2], acc[mi][nj][4 * q + 3]);
}

constexpr int ET_S = 528;
__device__ __forceinline__ void tile_flush_bf16(char* smem, bf16_t* dst, size_t ld) {
  const int tid = tid_fresh();
  __syncthreads();
#pragma unroll
  for (int i = 0; i < 16; ++i) {
    const int id = tid + 512 * i, row = id >> 5, ck = id & 31;
    *(u32x4*)(dst + (size_t)row * ld + ck * 8) = *(const u32x4*)(smem + row * ET_S + ck * 16);
  }
  __syncthreads();
}
template <class F>
__device__ __forceinline__ void epi2_store_lds(const f32x16 (&acc)[2][4], char* smem, F&& xf, bf16_t* dst, size_t ld) {
  epi2_foreach(acc, [&](int row, int col, float a, float b, float c, float d) {
    xf(row, col, a, b, c, d);
    u32x2 w = {cvtpk(a, b), cvtpk(c, d)};
    *(u32x2*)(smem + row * ET_S + col * 2) = w;
  });
  tile_flush_bf16(smem, dst, ld);
}

template <class F>
__device__ __forceinline__ void epi_foreach(const f32x16 (&acc)[2][2], F&& f) {
  const int tid = tid_fresh(), wid = tid >> 6, lane = tid & 63, r32 = lane & 31, hi = lane >> 5, wm = wid >> 1, wn = wid & 1;
#pragma unroll
  for (int mi = 0; mi < 2; ++mi)
#pragma unroll
    for (int nj = 0; nj < 2; ++nj)
#pragma unroll
      for (int q = 0; q < 4; ++q)
        f(wm * 64 + mi * 32 + r32, nj * 64 + wn * 32 + q * 8 + hi * 4, acc[mi][nj][4 * q + 0], acc[mi][nj][4 * q + 1],
          acc[mi][nj][4 * q + 2], acc[mi][nj][4 * q + 3]);
}
__device__ __forceinline__ void st_bf4(bf16_t* p, float a, float b, float c, float d) {
  u32x2 w = {cvtpk(a, b), cvtpk(c, d)}; *(u32x2*)p = w;
}

__device__ __forceinline__ void tr_tile(const float* src, bf16_t* dst, int K, int N, int kt, int nt, float* tile) {
  const int tid = tid_fresh(), k0 = kt * 64, n0 = nt * 64;
#pragma unroll
  for (int j = 0; j < 8; ++j) { const int e = j * 512 + tid, r = e >> 6, c = e & 63; tile[r * 65 + c] = src[(size_t)(k0 + r) * N + n0 + c]; }
  __syncthreads();
  const int rn = tid >> 3, ck = (tid & 7) * 8;
  const float v0 = tile[(ck + 0) * 65 + rn], v1 = tile[(ck + 1) * 65 + rn], v2 = tile[(ck + 2) * 65 + rn], v3 = tile[(ck + 3) * 65 + rn];
  const float v4 = tile[(ck + 4) * 65 + rn], v5 = tile[(ck + 5) * 65 + rn], v6 = tile[(ck + 6) * 65 + rn], v7 = tile[(ck + 7) * 65 + rn];
  u32x4 w = {cvtpk(v0, v1), cvtpk(v2, v3), cvtpk(v4, v5), cvtpk(v6, v7)};
  *(u32x4*)(dst + (size_t)(n0 + rn) * K + k0 + ck) = w;
  __syncthreads();
}

__device__ __forceinline__ void phase0(const Params& p, char* smem) {
  const int tid = tid_fresh(), G = gridDim.x, bid = blockIdx.x;
  char* ws = p.ws;
  {
    float* s = (float*)smem;
    float* part = (float*)(smem + 17 * 1024 * 4);
    float* MOD = (float*)(ws + OFF_MOD);
    for (int u = bid; u < 96; u += G) {
      const int l = u / 48, j0 = (u % 48) * 64;
      for (int e = tid; e < 17 * 1024; e += 512) { const int r = e >> 10, k = e & 1023; const float cv = (r < 16) ? p.c[r * 1024 + k] : p.c_ctx[k]; s[e] = silu_f(cv); }
      __syncthreads();
      const int col = tid & 63, ks = tid >> 6;
      float a0 = 0, a1 = 0, a2 = 0, a3 = 0, a4 = 0, a5 = 0, a6 = 0, a7 = 0, a8 = 0, a9 = 0, a10 = 0, a11 = 0, a12 = 0, a13 = 0, a14 = 0, a15 = 0, a16 = 0;
      const float* w = p.w_mod + (size_t)l * 1024 * 3072 + j0 + col;
#pragma unroll 4
      for (int k = ks * 128; k < ks * 128 + 128; ++k) {
        const float wv = w[(size_t)k * 3072];
        a0 += s[0 * 1024 + k] * wv; a1 += s[1 * 1024 + k] * wv; a2 += s[2 * 1024 + k] * wv; a3 += s[3 * 1024 + k] * wv;
        a4 += s[4 * 1024 + k] * wv; a5 += s[5 * 1024 + k] * wv; a6 += s[6 * 1024 + k] * wv; a7 += s[7 * 1024 + k] * wv;
        a8 += s[8 * 1024 + k] * wv; a9 += s[9 * 1024 + k] * wv; a10 += s[10 * 1024 + k] * wv; a11 += s[11 * 1024 + k] * wv;
        a12 += s[12 * 1024 + k] * wv; a13 += s[13 * 1024 + k] * wv; a14 += s[14 * 1024 + k] * wv; a15 += s[15 * 1024 + k] * wv;
        a16 += s[16 * 1024 + k] * wv;
      }
      float* pp = part + ks * 17 * 64 + col;
      pp[0 * 64] = a0; pp[1 * 64] = a1; pp[2 * 64] = a2; pp[3 * 64] = a3; pp[4 * 64] = a4; pp[5 * 64] = a5; pp[6 * 64] = a6; pp[7 * 64] = a7;
      pp[8 * 64] = a8; pp[9 * 64] = a9; pp[10 * 64] = a10; pp[11 * 64] = a11; pp[12 * 64] = a12; pp[13 * 64] = a13; pp[14 * 64] = a14; pp[15 * 64] = a15;
      pp[16 * 64] = a16;
      __syncthreads();
      for (int e = tid; e < 17 * 64; e += 512) {
        const int r = e >> 6, cc = e & 63;
        float t = p.b_mod[l * 3072 + j0 + cc];
#pragma unroll
        for (int q = 0; q < 8; ++q) t += part[q * 17 * 64 + r * 64 + cc];
        MOD[(size_t)(l * 17 + r) * 3072 + j0 + cc] = t;
      }
      __syncthreads();
    }
  }
  {
    float* tile = (float*)smem;
    constexpr int T0 = 16 * 88, T1 = 32 * 16, T2 = 16 * 64, T3 = 32 * 16;
    for (int u = bid; u < T0 + T1 + T2 + T3; u += G) {
      if (u < T0) tr_tile(p.e_w_in, (bf16_t*)(ws + OFF_WT_EIN), 1024, EVEN_IN, u / 88, u % 88, tile);
      else if (u < T0 + T1) { const int v = u - T0; tr_tile(p.e_w_out, (bf16_t*)(ws + OFF_WT_EOUT), 2048, 1024, v / 16, v % 16, tile); }
      else if (u < T0 + T1 + T2) { const int v = u - T0 - T1; tr_tile(p.o_w_in, (bf16_t*)(ws + OFF_WT_OIN), 1024, ODD_IN, v / 64, v % 64, tile); }
      else { const int v = u - T0 - T1 - T2; tr_tile(p.o_w_out, (bf16_t*)(ws + OFF_WT_OOUT), 2048, 1024, v / 16, v % 16, tile); }
    }
  }
  {
    const long gt = (long)bid * 512 + tid, gn = (long)G * 512;
    bf16_t* TC = (bf16_t*)(ws + OFF_TAB_C); bf16_t* TS = (bf16_t*)(ws + OFF_TAB_S);
    (void)TS;
    for (long e = gt; e < 4L * 512 * 512; e += gn) {
      const int ty = (int)(e >> 18), sidx = (int)((e >> 9) & 511), t = (int)(e & 511);
      float v;
      if (ty == 0) v = cospif((float)((sidx * t) & 1023) * (1.f / 512.f));
      else if (ty == 1) v = cospif((float)(((2 * sidx + 1) * t) & 2047) * (1.f / 1024.f));
      else if (ty == 2) v = sinpif((float)((sidx * t) & 1023) * (1.f / 512.f));
      else v = sinpif((float)(((2 * sidx + 1) * t) & 2047) * (1.f / 1024.f));
      TC[e] = f2bf(v);
    }
    bf16_t* CDM = (bf16_t*)(ws + OFF_CDM); bf16_t* CDP = (bf16_t*)(ws + OFF_CDP);
    for (long e = gt; e < 128L * 256; e += gn) {
      const int cp = (int)(e >> 8), k = (int)(e & 255);
      const int m = (cp * (k & 127)) & 127;
      const float x = (float)m * (1.f / 64.f);
      float vm, vp;
      if (k < 128) { vm = cospif(x); vp = vm; } else { vp = sinpif(x); vm = -vp; }
      CDM[e] = f2bf(vm); CDP[e] = f2bf(vp);
    }
    bf16_t* WSB = (bf16_t*)(ws + OFF_WSB);
    for (long e = gt; e < 8L * 128 * 128; e += gn) WSB[e] = f2bf(p.e_ws[e]);
    float2* ROPE = (float2*)(ws + OFF_ROPE);
    for (long e = gt; e < 64L * 32; e += gn) {
      const int pos = (int)(e >> 5), i = (int)(e & 31);
      const float inv = powf(10000.f, -(float)i / 32.f);
      const float ang = (float)pos * inv;
      ROPE[e] = make_float2(cosf(ang), sinf(ang));
    }
  }
}

__device__ __forceinline__ void ln_rows_modulate(const float* src, bf16_t* dst, int nrows, int rows_per_b, const float* mod17, int fixed_row) {
  const int tid = tid_fresh(), wid = tid >> 6, lane = tid & 63;
  const int gw = blockIdx.x * 8 + wid, nw = gridDim.x * 8;
  float4 n0, n1, n2, n3;
  { const int r0 = gw < nrows ? gw : 0; const float4* ps = (const float4*)(src + (size_t)r0 * 1024); n0 = ps[lane]; n1 = ps[lane + 64]; n2 = ps[lane + 128]; n3 = ps[lane + 192]; }
  for (int row = gw; row < nrows; row += nw) {
    float4 v0 = n0, v1 = n1, v2 = n2, v3 = n3;
    { const int nr = (row + nw < nrows) ? row + nw : row;
      const float4* ps = (const float4*)(src + (size_t)nr * 1024); n0 = ps[lane]; n1 = ps[lane + 64]; n2 = ps[lane + 128]; n3 = ps[lane + 192]; }
    float s = v0.x + v0.y + v0.z + v0.w + v1.x + v1.y + v1.z + v1.w + v2.x + v2.y + v2.z + v2.w + v3.x + v3.y + v3.z + v3.w;
    const float mu = wave_sum(s) * (1.f / 1024.f);
    v0.x -= mu; v0.y -= mu; v0.z -= mu; v0.w -= mu; v1.x -= mu; v1.y -= mu; v1.z -= mu; v1.w -= mu;
    v2.x -= mu; v2.y -= mu; v2.z -= mu; v2.w -= mu; v3.x -= mu; v3.y -= mu; v3.z -= mu; v3.w -= mu;
    float q = v0.x * v0.x + v0.y * v0.y + v0.z * v0.z + v0.w * v0.w + v1.x * v1.x + v1.y * v1.y + v1.z * v1.z + v1.w * v1.w +
              v2.x * v2.x + v2.y * v2.y + v2.z * v2.z + v2.w * v2.w + v3.x * v3.x + v3.y * v3.y + v3.z * v3.z + v3.w * v3.w;
    const float rstd = rsqrtf(wave_sum(q) * (1.f / 1024.f) + EPS);
    const int mr = (fixed_row >= 0) ? fixed_row : (row / rows_per_b);
    const float* md = mod17 + (size_t)mr * 3072;
    bf16_t* pd = dst + (size_t)row * 1024;
#define MODST(V, J) { const int col = (lane + 64 * J) * 4; const float4 sh = *(const float4*)(md + col); const float4 sc = *(const float4*)(md + 1024 + col); \
      st_bf4(pd + col, V.x * rstd * (1.f + sc.x) + sh.x, V.y * rstd * (1.f + sc.y) + sh.y, V.z * rstd * (1.f + sc.z) + sh.z, V.w * rstd * (1.f + sc.w) + sh.w); }
    MODST(v0, 0) MODST(v1, 1) MODST(v2, 2) MODST(v3, 3)
#undef MODST
  }
}

__device__ __forceinline__ void phase2(const Params& p, char* smem) {
  char* ws = p.ws;
  const bf16_t* M0 = (const bf16_t*)(ws + OFF_M0); const bf16_t* MC = (const bf16_t*)(ws + OFF_MC);
  const bf16_t* WT = (const bf16_t*)(ws + OFF_WT_EIN);
  bf16_t* Q = (bf16_t*)(ws + OFF_Q); bf16_t* KA = (bf16_t*)(ws + OFF_KALL); bf16_t* VA = (bf16_t*)(ws + OFF_VALL);
  bf16_t* BU = (bf16_t*)(ws + OFF_BU); bf16_t* BV = (bf16_t*)(ws + OFF_BV); bf16_t* SG = (bf16_t*)(ws + OFF_SG);
  const float2* ROPE = (const float2*)(ws + OFF_ROPE);
  const int tid = tid_fresh(), wid = tid >> 6, lane = tid & 63, r32 = lane & 31, hi = lane >> 5, wm = wid >> 1, wn = wid & 1;
  const int lb = logical_block();
  for (int u = lb; u < 2816 + 32; u += gridDim.x) {
    const bool isctx = (u >= 2816);
    int mt, nt;
    if (!isctx) { mt = u / 22; nt = u % 22; } else { const int v = u - 2816; mt = v >> 1; nt = 4 + (v & 1); }
    const bf16_t* A = (isctx ? MC : M0) + (size_t)mt * 256 * 1024;
    f32x16 acc[2][4];
    gemm2(mkPlain(A, 1024), mkPlain(WT + (size_t)nt * 256 * 1024, 1024), 16, smem, acc);
    if (nt < 5) {
      const bool isq = nt < 4;
      const int head = isq ? (nt * 2 + wn) : wn;
      const float* gv = isq ? p.e_qn : p.e_kn;
#pragma unroll
      for (int mi = 0; mi < 2; ++mi) {
        float ss = 0.f;
#pragma unroll
        for (int nj = 0; nj < 4; ++nj)
#pragma unroll
          for (int r = 0; r < 16; ++r) ss += acc[mi][nj][r] * acc[mi][nj][r];
        ss += __shfl_xor(ss, 32);
        const float rstd = rsqrtf(ss * (1.f / 128.f) + EPS);
        const int row = wm * 64 + mi * 32 + r32;
        int t = 0;
        if (!isctx) t = (mt & 7) * 256 + row;
#pragma unroll
        for (int nj = 0; nj < 2; ++nj) {
          const int pos = (nj == 0) ? (t >> 6) : (t & 63);
#pragma unroll
          for (int q = 0; q < 4; ++q) {
            float o1[4], o2[4];
#pragma unroll
            for (int e = 0; e < 4; ++e) {
              const int r = 4 * q + e;
              const int i = 8 * q + 4 * hi + e;
              const int d = nj * 32 + i;
              const float x1 = acc[mi][nj][r] * rstd * gv[d];
              const float x2 = acc[mi][nj + 2][r] * rstd * gv[64 + d];
              if (!isctx) {
                const float2 cs = ROPE[pos * 32 + i];
                o1[e] = x1 * cs.x - x2 * cs.y; o2[e] = x2 * cs.x + x1 * cs.y;
              } else { o1[e] = x1; o2[e] = x2; }
            }
            const int d0 = nj * 32 + 8 * q + 4 * hi;
            { char* lp = smem + row * ET_S + (wn * 128 + d0) * 2;
              u32x2 w1 = {cvtpk(o1[0], o1[1]), cvtpk(o1[2], o1[3])}, w2 = {cvtpk(o2[0], o2[1]), cvtpk(o2[2], o2[3])};
              *(u32x2*)lp = w1; *(u32x2*)(lp + 128) = w2; }
          }
        }
      }
      {
        const int bb = mt >> 3, t0 = (mt & 7) * 256;
        bf16_t* tb; size_t tl;
        if (isq) { tb = Q + ((size_t)(bb * SEQ + t0) * 8 + nt * 2) * 128; tl = 1024; }
        else if (!isctx) { tb = KA + (size_t)(bb * SKV + CTXL + t0) * 256; tl = 256; }
        else { tb = KA + (size_t)mt * SKV * 256; tl = 256; }
        tile_flush_bf16(smem, tb, tl);
      }
    } else if (nt == 5) {
      const int bb = mt >> 3, t0 = (mt & 7) * 256;
      bf16_t* tb = isctx ? (VA + (size_t)mt * SKV * 256) : (VA + (size_t)(bb * SKV + CTXL + t0) * 256);
      epi2_store_lds(acc, smem, [&](int, int, float&, float&, float&, float&) {}, tb, 256);
    } else if (nt < 14) {
      bf16_t* dst = (nt < 10) ? (BU + (size_t)(nt - 6) * 256) : (BV + (size_t)(nt - 10) * 256);
      epi2_store_lds(acc, smem, [&](int, int, float& a, float& b, float& c, float& d) { a = gelu_tanh_f(a); b = gelu_tanh_f(b); c = gelu_tanh_f(c); d = gelu_tanh_f(d); },
                     dst + (size_t)mt * 256 * 1024, 1024);
    } else {
      bf16_t* dst = SG + (size_t)(nt - 14) * 256;
      epi2_store_lds(acc, smem, [&](int, int, float& a, float& b, float& c, float& d) { a = silu_f(a); b = silu_f(b); c = silu_f(c); d = silu_f(d); },
                     dst + (size_t)mt * 256 * 2048, 2048);
    }
  }
}

namespace att {
constexpr int D = 128, NW = 8, QBLK = 32, KVBLK = 64;
constexpr float SCALE = 0.088388347648318440f;
constexpr float THR = 8.f;
constexpr int LDQ = 1024, LDK = 256;
constexpr int SHM_V = KVBLK * D * 2, SHM_K = KVBLK * D * 2;
#define KSWZ(row, colB) ((row) * 256 + ((colB) ^ (((row) & 7) << 4)))
#define SBAR() __builtin_amdgcn_sched_barrier(0)
__device__ __forceinline__ void partialSM(f32x16& p0, f32x16& p1, float& m_reg, float& mn, float& alpha) {
  constexpr float C = SCALE * 1.4426950408889634f;
  float pmax = p0[0];
#pragma unroll
  for (int r = 1; r < 16; ++r) pmax = fmaxf(pmax, p0[r]);
#pragma unroll
  for (int r = 0; r < 16; ++r) pmax = fmaxf(pmax, p1[r]);
  { auto rr = __builtin_amdgcn_permlane32_swap(__float_as_uint(pmax), __float_as_uint(pmax), false, false);
    pmax = fmaxf(__uint_as_float(rr[0]), __uint_as_float(rr[1])); }
  if (__builtin_expect(__all(pmax - m_reg <= THR / SCALE), 1)) { mn = m_reg; alpha = 1.f; }
  else { mn = fmaxf(m_reg, pmax); alpha = __builtin_amdgcn_exp2f((m_reg - mn) * C); m_reg = mn; }
  const float mnC = -mn * C;
#pragma unroll
  for (int r = 0; r < 16; ++r) p0[r] = fmaf(p0[r], C, mnC);
#pragma unroll
  for (int r = 0; r < 16; ++r) p1[r] = fmaf(p1[r], C, mnC);
#pragma unroll
  for (int r = 0; r < 16; ++r) p0[r] = __builtin_amdgcn_exp2f(p0[r]);
}
__device__ __forceinline__ void finishSM(f32x16& p0, f32x16& p1, float alpha, float& l_reg, bf16x8& pa0, bf16x8& pa1, bf16x8& pa2, bf16x8& pa3) {
#pragma unroll
  for (int r = 0; r < 16; ++r) p1[r] = __builtin_amdgcn_exp2f(p1[r]);
  float ps = 0;
#pragma unroll
  for (int r = 0; r < 16; ++r) ps += p0[r];
#pragma unroll
  for (int r = 0; r < 16; ++r) ps += p1[r];
  { auto rr = __builtin_amdgcn_permlane32_swap(__float_as_uint(ps), __float_as_uint(ps), false, false);
    ps = __uint_as_float(rr[0]) + __uint_as_float(rr[1]); }
  l_reg = l_reg * alpha + ps;
#define PK4(P, BASE, OUT) do { unsigned a0 = cvtpk(P[BASE + 0], P[BASE + 1]), a1 = cvtpk(P[BASE + 2], P[BASE + 3]);   \
    unsigned b0 = cvtpk(P[BASE + 4], P[BASE + 5]), b1 = cvtpk(P[BASE + 6], P[BASE + 7]);                              \
    auto r0 = __builtin_amdgcn_permlane32_swap(a0, b0, false, false); auto r1 = __builtin_amdgcn_permlane32_swap(a1, b1, false, false); \
    u32x4 w = {r0[0], r1[0], r0[1], r1[1]}; OUT = *reinterpret_cast<bf16x8*>(&w); } while (0)
  PK4(p0, 0, pa0); PK4(p0, 8, pa1); PK4(p1, 0, pa2); PK4(p1, 8, pa3);
#undef PK4
}
__device__ __forceinline__ void qkt(f32x16& p0, f32x16& p1, const bf16_t* Ks, const bf16x8* qr, int r32, int hi) {
#pragma unroll
  for (int r = 0; r < 16; ++r) { p0[r] = 0.f; p1[r] = 0.f; }
#pragma unroll
  for (int d0 = 0; d0 < 8; ++d0) { const int cb = (d0 * 16 + hi * 8) * 2;
    bf16x8 b0 = *reinterpret_cast<const bf16x8*>((const char*)Ks + KSWZ(r32, cb));
    bf16x8 b1 = *reinterpret_cast<const bf16x8*>((const char*)Ks + KSWZ(32 + r32, cb));
    p0 = __builtin_amdgcn_mfma_f32_32x32x16_bf16(b0, qr[d0], p0, 0, 0, 0);
    p1 = __builtin_amdgcn_mfma_f32_32x32x16_bf16(b1, qr[d0], p1, 0, 0, 0); }
}
__device__ __forceinline__ int v_st(int k, int c) { const int kk = (k & ~0xC) | ((k & 4) << 1) | ((k & 8) >> 1); return ((kk >> 3) * 4 + (c >> 5)) * 512 + ((kk & 7) * 32 + (c & 31)) * 2; }
__device__ __forceinline__ int v_rd_base(int lane) { return ((lane & 3) << 3) | (((lane >> 2) & 3) << 6) | (((lane >> 4) & 1) << 5) | (((lane >> 5) & 1) << 8); }
constexpr int v_rd_off(int d0, int ks, int half) { return d0 * 512 + ks * 4096 + half * 2048; }
template <int OFF> __device__ __forceinline__ s16x4 tr_read(int vb) {
  s16x4 r; asm volatile("ds_read_b64_tr_b16 %0, %1 offset:%2" : "=&v"(r) : "v"(vb), "i"(OFF) : "memory"); return r;
}
template <int D0> __device__ __forceinline__ void pv_one(f32x16& od, int vb, bf16x8 pa0, bf16x8 pa1, bf16x8 pa2, bf16x8 pa3) {
  const s16x4 l0 = tr_read<v_rd_off(D0, 0, 0)>(vb), h0 = tr_read<v_rd_off(D0, 0, 1)>(vb), l1 = tr_read<v_rd_off(D0, 1, 0)>(vb), h1 = tr_read<v_rd_off(D0, 1, 1)>(vb);
  const s16x4 l2 = tr_read<v_rd_off(D0, 2, 0)>(vb), h2 = tr_read<v_rd_off(D0, 2, 1)>(vb), l3 = tr_read<v_rd_off(D0, 3, 0)>(vb), h3 = tr_read<v_rd_off(D0, 3, 1)>(vb);
  asm volatile("s_waitcnt lgkmcnt(0)" ::: "memory"); SBAR();
#define PK(L, H) (bf16x8){L[0], L[1], L[2], L[3], H[0], H[1], H[2], H[3]}
  od = __builtin_amdgcn_mfma_f32_32x32x16_bf16(pa0, PK(l0, h0), od, 0, 0, 0);
  od = __builtin_amdgcn_mfma_f32_32x32x16_bf16(pa1, PK(l1, h1), od, 0, 0, 0);
  od = __builtin_amdgcn_mfma_f32_32x32x16_bf16(pa2, PK(l2, h2), od, 0, 0, 0);
  od = __builtin_amdgcn_mfma_f32_32x32x16_bf16(pa3, PK(l3, h3), od, 0, 0, 0);
#undef PK
}
__device__ __forceinline__ void pv_d0(f32x16* o, int vb, bf16x8 pa0, bf16x8 pa1, bf16x8 pa2, bf16x8 pa3) {
  pv_one<0>(o[0], vb, pa0, pa1, pa2, pa3); pv_one<1>(o[1], vb, pa0, pa1, pa2, pa3); pv_one<2>(o[2], vb, pa0, pa1, pa2, pa3); pv_one<3>(o[3], vb, pa0, pa1, pa2, pa3);
}
__device__ __forceinline__ void attn_body(const bf16_t* __restrict__ Qb, const bf16_t* __restrict__ Kh, const bf16_t* __restrict__ Vh,
                                          bf16_t* GO, int seq, char* lds) {
  const int tid = tid_fresh(), wid = tid >> 6, lane = tid & 63, r32 = lane & 31, hi = lane >> 5;
  bf16_t* V_lds = (bf16_t*)lds; bf16_t* K_lds = (bf16_t*)(lds + 2 * SHM_V);
  float* wsx = (float*)(lds + 2 * SHM_V + 2 * SHM_K) + wid * 64; float* li_l = wsx; float* al_l = wsx + 32;
  float m_reg = -1e30f, l_reg = 0; f32x16 o[4]; bf16x8 qr[8];
#pragma unroll
  for (int d = 0; d < 4; ++d)
#pragma unroll
    for (int r = 0; r < 16; ++r) o[d][r] = 0.f;
  const bf16_t* Qw = Qb + (long)(wid * QBLK + r32) * LDQ + hi * 8;
#pragma unroll
  for (int d0 = 0; d0 < 8; ++d0) qr[d0] = *reinterpret_cast<const bf16x8*>(Qw + d0 * 16);
  const int sr = tid >> 4, sc = (tid & 15) * 8, vst0 = v_st(sr, sc), vst1 = v_st(32 + sr, sc);
  const int vb0 = (int)(uintptr_t)V_lds + v_rd_base(lane);
  constexpr int SDEPTH = 1;
  bf16x8 sv0[SDEPTH], sv1[SDEPTH], sk0[SDEPTH], sk1[SDEPTH];
#define SLOAD(i, k0) do { sv0[i] = *reinterpret_cast<const bf16x8*>(&Vh[(long)((k0) + sr) * LDK + sc]); sv1[i] = *reinterpret_cast<const bf16x8*>(&Vh[(long)((k0) + 32 + sr) * LDK + sc]); \
    sk0[i] = *reinterpret_cast<const bf16x8*>(&Kh[(long)((k0) + sr) * LDK + sc]); sk1[i] = *reinterpret_cast<const bf16x8*>(&Kh[(long)((k0) + 32 + sr) * LDK + sc]); } while (0)
#define SWRITE(b, i) do { *(bf16x8*)((char*)V_lds + (b) * SHM_V + vst0) = sv0[i];          \
    *(bf16x8*)((char*)V_lds + (b) * SHM_V + vst1) = sv1[i]; const int kc = sc * 2;               \
    *(bf16x8*)((char*)K_lds + (b) * SHM_K + KSWZ(sr, kc)) = sk0[i];                       \
    *(bf16x8*)((char*)K_lds + (b) * SHM_K + KSWZ(32 + sr, kc)) = sk1[i]; } while (0)
#define SWAIT() do { if (SDEPTH == 2) asm volatile("s_waitcnt vmcnt(4)" ::: "memory"); else asm volatile("s_waitcnt vmcnt(0)" ::: "memory"); } while (0)
#define RESC(a) do { if (__any((a) < 1.f)) { if (hi == 0) al_l[r32] = (a); asm volatile("s_waitcnt lgkmcnt(0)" ::: "memory"); \
    _Pragma("unroll") for (int d = 0; d < 4; ++d) _Pragma("unroll") for (int r = 0; r < 16; ++r) o[d][r] *= al_l[crow(r, hi)]; } } while (0)
  f32x16 pA0, pA1, pB0, pB1; float mnA, mnB, alA, alB; bf16x8 pa0, pa1, pa2, pa3; const int NT = seq / KVBLK;
  constexpr int SE = 0, SO = SDEPTH - 1;
  SLOAD(SE, 0); asm volatile("s_waitcnt vmcnt(0)" ::: "memory"); SWRITE(0, SE); __syncthreads();
  qkt(pA0, pA1, K_lds, qr, r32, hi); partialSM(pA0, pA1, m_reg, mnA, alA);
  SLOAD(SO, KVBLK); if (SDEPTH == 2) { if (2 < NT) SLOAD(SE, 2 * KVBLK); }
  SWAIT(); SWRITE(1, SO); __syncthreads();
  for (int j = 1; j + 1 < NT; j += 2) {
    SBAR(); qkt(pB0, pB1, (bf16_t*)((char*)K_lds + SHM_K), qr, r32, hi);
    finishSM(pA0, pA1, alA, l_reg, pa0, pa1, pa2, pa3); SBAR();
    SLOAD(SO, (j + SDEPTH) * KVBLK); SBAR();
    pv_d0(o, vb0, pa0, pa1, pa2, pa3); partialSM(pB0, pB1, m_reg, mnB, alB);
    __syncthreads(); SWAIT(); SWRITE(0, SE);
    RESC(alB); __syncthreads();
    SBAR(); qkt(pA0, pA1, K_lds, qr, r32, hi);
    finishSM(pB0, pB1, alB, l_reg, pa0, pa1, pa2, pa3); SBAR();
    if (SDEPTH == 1 || j + 3 < NT) SLOAD(SE, (j + 1 + SDEPTH) * KVBLK); SBAR();
    pv_d0(o, vb0 + (int)SHM_V, pa0, pa1, pa2, pa3); partialSM(pA0, pA1, m_reg, mnA, alA);
    __syncthreads(); SWAIT(); SWRITE(1, SO);
    RESC(alA); __syncthreads();
  }
  SBAR(); qkt(pB0, pB1, (bf16_t*)((char*)K_lds + SHM_K), qr, r32, hi);
  finishSM(pA0, pA1, alA, l_reg, pa0, pa1, pa2, pa3); SBAR();
  pv_d0(o, vb0, pa0, pa1, pa2, pa3); partialSM(pB0, pB1, m_reg, mnB, alB);
  __syncthreads(); RESC(alB);
  finishSM(pB0, pB1, alB, l_reg, pa0, pa1, pa2, pa3); SBAR();
  pv_d0(o, vb0 + (int)SHM_V, pa0, pa1, pa2, pa3);
  if (hi == 0) li_l[r32] = l_reg; asm volatile("s_waitcnt lgkmcnt(0)" ::: "memory");
  float rli[16];
#pragma unroll
  for (int r = 0; r < 16; ++r) rli[r] = __builtin_amdgcn_rcpf(li_l[crow(r, hi)]);
  bf16_t* Ow = GO + (long)(wid * QBLK) * 2048;
#pragma unroll
  for (int r = 0; r < 16; ++r) { const int orow = crow(r, hi);
#pragma unroll
    for (int d0 = 0; d0 < 4; ++d0) { bf16_t* q = Ow + (long)orow * 2048 + d0 * 32 + r32; *q = f2bf(o[d0][r] * rli[r] * bf2f(*q)); }
    SBAR(); }
  __syncthreads();
#undef SLOAD
#undef SWRITE
#undef SWAIT
#undef RESC
}
}

__device__ __forceinline__ void chunk_gate_unit(const Params& p, int b, int n, char* smem) {
  char* ws = p.ws;
  const bf16_t* BU = (const bf16_t*)(ws + OFF_BU); const bf16_t* BV = (const bf16_t*)(ws + OFF_BV);
  bf16_t* SG = (bf16_t*)(ws + OFF_SG); const bf16_t* WSB = (const bf16_t*)(ws + OFF_WSB);
  const int tid = tid_fresh(), wid = tid >> 6, lane = tid & 63, r32 = lane & 31, hi = lane >> 5;
  constexpr int RS = 272;
  char* sW = smem; char* sV = smem + 128 * RS;
  float* smu = (float*)(smem + 2 * 128 * RS); float* srs = smu + 128;
  const size_t tok0 = (size_t)b * SEQ + (size_t)n * 128;
  {
    const int q = tid >> 2, part = tid & 3;
    const u32x4* src = (const u32x4*)(BV + (tok0 + q) * 1024 + part * 256);
    float s = 0.f, s2 = 0.f;
#pragma unroll 4
    for (int i = 0; i < 32; ++i) {
      const u32x4 w = src[i];
#pragma unroll
      for (int e = 0; e < 4; ++e) { const float a = bf_lo(w[e]), c = bf_hi(w[e]); s += a + c; s2 += a * a + c * c; }
    }
    s += __shfl_xor(s, 1); s2 += __shfl_xor(s2, 1); s += __shfl_xor(s, 2); s2 += __shfl_xor(s2, 2);
    const float mu = s * (1.f / 1024.f);
    const float var = fmaxf(s2 * (1.f / 1024.f) - mu * mu, 0.f);
    if (part == 0) { smu[q] = mu; srs[q] = rsqrtf(var + EPS); }
  }
  __syncthreads();
  const int wp = wid >> 1, wc = wid & 1;
  for (int g = 0; g < 8; ++g) {
#pragma unroll
    for (int i = 0; i < 4; ++i) {
      const int id = tid + 512 * i, row = id >> 4, ck = (id & 15) * 8;
      *(u32x4*)(sW + row * RS + ck * 2) = *(const u32x4*)(WSB + (size_t)g * 16384 + row * 128 + ck);
    }
#pragma unroll
    for (int i = 0; i < 4; ++i) {
      const int id = tid + 512 * i, q = id & 127, cc = (id >> 7) * 8;
      const u32x4 w = *(const u32x4*)(BV + (tok0 + q) * 1024 + g * 128 + cc);
      const float mu = smu[q], rs = srs[q];
      const float* lg = p.e_vg + g * 128 + cc; const float* lbp = p.e_vb + g * 128 + cc;
#pragma unroll
      for (int e = 0; e < 4; ++e) {
        const float a = (bf_lo(w[e]) - mu) * rs * lg[2 * e] + lbp[2 * e];
        const float c = (bf_hi(w[e]) - mu) * rs * lg[2 * e + 1] + lbp[2 * e + 1];
        *(bf16_t*)(sV + (cc + 2 * e) * RS + q * 2) = f2bf(a);
        *(bf16_t*)(sV + (cc + 2 * e + 1) * RS + q * 2) = f2bf(c);
      }
    }
    __syncthreads();
    f32x16 acc0, acc1;
#pragma unroll
    for (int r = 0; r < 16; ++r) { acc0[r] = 0.f; acc1[r] = 0.f; }
#pragma unroll
    for (int kk = 0; kk < 8; ++kk) {
      const bf16x8 af = *(const bf16x8*)(sW + (wp * 32 + r32) * RS + kk * 32 + hi * 16);
      const bf16x8 b0 = *(const bf16x8*)(sV + (wc * 64 + r32) * RS + kk * 32 + hi * 16);
      const bf16x8 b1 = *(const bf16x8*)(sV + (wc * 64 + 32 + r32) * RS + kk * 32 + hi * 16);
      acc0 = __builtin_amdgcn_mfma_f32_32x32x16_bf16(b0, af, acc0, 0, 0, 0);
      acc1 = __builtin_amdgcn_mfma_f32_32x32x16_bf16(b1, af, acc1, 0, 0, 0);
    }
    const int pr = wp * 32 + r32;
    const float bias = p.e_bs[g * 128 + pr];
    const size_t tok = tok0 + pr;
#pragma unroll
    for (int nj = 0; nj < 2; ++nj)
#pragma unroll
      for (int q = 0; q < 4; ++q) {
        const int col = g * 128 + wc * 64 + nj * 32 + q * 8 + hi * 4;
        const u32x2 bu = *(const u32x2*)(BU + tok * 1024 + col);
        bf16_t* gp = SG + tok * 2048 + 1024 + col;
        const u32x2 sg = *(const u32x2*)gp;
        const float m0 = (nj ? acc1[4 * q + 0] : acc0[4 * q + 0]) + bias, m1 = (nj ? acc1[4 * q + 1] : acc0[4 * q + 1]) + bias;
        const float m2 = (nj ? acc1[4 * q + 2] : acc0[4 * q + 2]) + bias, m3 = (nj ? acc1[4 * q + 3] : acc0[4 * q + 3]) + bias;
        st_bf4(gp, bf_lo(bu[0]) * m0 * bf_lo(sg[0]), bf_hi(bu[0]) * m1 * bf_hi(sg[0]), bf_lo(bu[1]) * m2 * bf_lo(sg[1]), bf_hi(bu[1]) * m3 * bf_hi(sg[1]));
      }
    __syncthreads();
  }
}

__device__ __forceinline__ void post_ln_rows(const float* resid, const bf16_t* yg, float* dst, const float* pg, const float* pb, bf16_t* m1, const float* mod17) {
  const int tid = tid_fresh(), wid = tid >> 6, lane = tid & 63;
  const int gw = blockIdx.x * 8 + wid, nw = gridDim.x * 8;
  float4 nx[4]; u32x2 ny[4];
  { const float4* ps = (const float4*)(resid + (size_t)gw * 1024); const u32x2* py = (const u32x2*)(yg + (size_t)gw * 1024);
#pragma unroll
    for (int j = 0; j < 4; ++j) { nx[j] = ps[lane + 64 * j]; ny[j] = py[lane + 64 * j]; } }
  for (int row = gw; row < NTOK; row += nw) {
    float4 v[4];
#pragma unroll
    for (int j = 0; j < 4; ++j) {
      v[j].x = ALPHA * nx[j].x + bf_lo(ny[j][0]); v[j].y = ALPHA * nx[j].y + bf_hi(ny[j][0]);
      v[j].z = ALPHA * nx[j].z + bf_lo(ny[j][1]); v[j].w = ALPHA * nx[j].w + bf_hi(ny[j][1]);
    }
    { const int nr = (row + nw < NTOK) ? row + nw : row;
      const float4* ps = (const float4*)(resid + (size_t)nr * 1024); const u32x2* py = (const u32x2*)(yg + (size_t)nr * 1024);
#pragma unroll
      for (int j = 0; j < 4; ++j) { nx[j] = ps[lane + 64 * j]; ny[j] = py[lane + 64 * j]; } }
    float s = 0.f;
#pragma unroll
    for (int j = 0; j < 4; ++j) s += v[j].x + v[j].y + v[j].z + v[j].w;
    float mu = wave_sum(s) * (1.f / 1024.f);
    float q = 0.f;
#pragma unroll
    for (int j = 0; j < 4; ++j) { v[j].x -= mu; v[j].y -= mu; v[j].z -= mu; v[j].w -= mu; q += v[j].x * v[j].x + v[j].y * v[j].y + v[j].z * v[j].z + v[j].w * v[j].w; }
    float rstd = rsqrtf(wave_sum(q) * (1.f / 1024.f) + EPS);
    float4* pd = (float4*)(dst + (size_t)row * 1024);
    s = 0.f;
#pragma unroll
    for (int j = 0; j < 4; ++j) {
      const int col = (lane + 64 * j) * 4;
      const float4 g4 = *(const float4*)(pg + col), b4 = *(const float4*)(pb + col);
      v[j].x = v[j].x * rstd * g4.x + b4.x; v[j].y = v[j].y * rstd * g4.y + b4.y; v[j].z = v[j].z * rstd * g4.z + b4.z; v[j].w = v[j].w * rstd * g4.w + b4.w;
      pd[lane + 64 * j] = v[j];
      s += v[j].x + v[j].y + v[j].z + v[j].w;
    }
    if (m1) {
      mu = wave_sum(s) * (1.f / 1024.f);
      q = 0.f;
#pragma unroll
      for (int j = 0; j < 4; ++j) { v[j].x -= mu; v[j].y -= mu; v[j].z -= mu; v[j].w -= mu; q += v[j].x * v[j].x + v[j].y * v[j].y + v[j].z * v[j].z + v[j].w * v[j].w; }
      rstd = rsqrtf(wave_sum(q) * (1.f / 1024.f) + EPS);
      const float* md = mod17 + (size_t)(row >> 11) * 3072;
      bf16_t* pm = m1 + (size_t)row * 1024;
#pragma unroll
      for (int j = 0; j < 4; ++j) {
        const int col = (lane + 64 * j) * 4;
        const float4 sh = *(const float4*)(md + col), sc = *(const float4*)(md + 1024 + col);
        st_bf4(pm + col, v[j].x * rstd * (1.f + sc.x) + sh.x, v[j].y * rstd * (1.f + sc.y) + sh.y, v[j].z * rstd * (1.f + sc.z) + sh.z, v[j].w * rstd * (1.f + sc.w) + sh.w);
      }
    }
  }
}

__device__ __forceinline__ void out_proj(const bf16_t* A, const bf16_t* WT, const float* gate17, bf16_t* dst, char* smem) {
  const int lb = logical_block();
  for (int u = lb; u < 512; u += gridDim.x) {
    const int mt = u >> 2, nt = u & 3;
    f32x16 acc[2][4];
    gemm2(mkPlain(A + (size_t)mt * 256 * 2048, 2048), mkPlain(WT + (size_t)nt * 256 * 2048, 2048), 32, smem, acc);
    const float* gt = gate17 + (size_t)(mt >> 3) * 3072 + 2048 + nt * 256;
    epi2_store_lds(acc, smem, [&](int, int col, float& a, float& b, float& c, float& d) {
      const float4 g4 = *(const float4*)(gt + col);
      a *= g4.x; b *= g4.y; c *= g4.z; d *= g4.w;
    }, dst + (size_t)mt * 256 * 1024 + nt * 256, 1024);
  }
}

#define XB_TMO      128
#define XB_XCNT(j)  (256  + 64 * (j))
#define XB_XSUB(j)  (1280 + 64 * (j))
#define XB_XGEN(j)  (2304 + 64 * (j))
#define XB_TOP      3328
#define XB_TOPGEN   3392
#define XCD_BAR_WORDS 3456
#define XB_SPIN_CAP (1u << 18)
#define LAS __attribute__((address_space(3)))

__device__ __forceinline__ unsigned xb_ld(unsigned* p)              { return __hip_atomic_load(p, __ATOMIC_RELAXED, __HIP_MEMORY_SCOPE_AGENT); }
__device__ __forceinline__ unsigned xb_add(unsigned* p, unsigned v) { return __hip_atomic_fetch_add(p, v, __ATOMIC_RELAXED, __HIP_MEMORY_SCOPE_AGENT); }
__device__ __forceinline__ unsigned xb_xcc_id() { return (unsigned)__builtin_amdgcn_s_getreg((3 << 11) | 20) & 0xFu; }
#define XB_SPIN(cond, bar) do { unsigned _sp = 0; while (cond) { __builtin_amdgcn_s_sleep(1); \
    if ((++_sp & 255u) == 0u) { if (xb_ld(&(bar)[XB_TMO])) break; if (_sp > XB_SPIN_CAP) { atomicAdd(&(bar)[XB_TMO], 1u); break; } } } } while (0)

struct XcdBarrier {
    unsigned* bar; unsigned x;
    volatile LAS unsigned* st;
};

__device__ __forceinline__ XcdBarrier xcd_barrier_post(unsigned* bar, volatile LAS unsigned* st) {
    XcdBarrier b; b.bar = bar; b.x = xb_xcc_id(); b.st = st;
    if (threadIdx.x == 0) (void)xb_add(&bar[XB_XCNT(b.x)], 1u);
    return b;
}
__device__ __forceinline__ void xcd_barrier_complete(unsigned* bar, unsigned x, unsigned& nloc, unsigned& nx) {
    const unsigned G = gridDim.x * gridDim.y * gridDim.z;
    unsigned sum, cnt, mine, sp = 0u;
    for (;;) {
        sum = 0u; cnt = 0u; mine = 0u;
#pragma unroll
        for (unsigned j = 0; j < 16; ++j) { const unsigned c = xb_ld(&bar[XB_XCNT(j)]); sum += c; cnt += (c > 0u) ? 1u : 0u; mine = (j == x) ? c : mine; }
        if (sum == G) break;
        __builtin_amdgcn_s_sleep(1);
        if ((++sp & 255u) == 0u) { if (xb_ld(&bar[XB_TMO])) break; if (sp > XB_SPIN_CAP) { atomicAdd(&bar[XB_TMO], 1u); break; } }
    }
    nloc = mine > 0u ? mine : 1u; nx = cnt > 0u ? cnt : 1u;
}

__device__ __forceinline__ void xcd_barrier(const XcdBarrier& b) {
    asm volatile("s_waitcnt vmcnt(0)" ::: "memory");
    __syncthreads();
    if (threadIdx.x == 0) {
        unsigned* bar = b.bar;
        __builtin_amdgcn_s_waitcnt(0);
        unsigned nloc = b.st[0], nx = b.st[1];
        if (nloc == 0u) { xcd_barrier_complete(bar, b.x, nloc, nx); b.st[0] = nloc; b.st[1] = nx; }
        const unsigned old = xb_add(&bar[XB_XSUB(b.x)], 1u);
        const unsigned gen = old / nloc;
        if (old + 1u == (gen + 1u) * nloc) {
            __builtin_amdgcn_fence(__ATOMIC_RELEASE, "agent");
            asm volatile("s_waitcnt vmcnt(0)" ::: "memory");
            const unsigned og = xb_add(&bar[XB_TOP], 1u);
            const unsigned tg = og / nx;
            if (og + 1u == (tg + 1u) * nx) xb_add(&bar[XB_TOPGEN], 1u);
            else XB_SPIN(xb_ld(&bar[XB_TOPGEN]) == tg, bar);
            __builtin_amdgcn_fence(__ATOMIC_ACQUIRE, "agent");
            xb_add(&bar[XB_XGEN(b.x)], 1u);
            asm volatile("s_waitcnt vmcnt(0)" ::: "memory");
        } else {
            XB_SPIN(xb_ld(&bar[XB_XGEN(b.x)]) == gen, bar);
            __builtin_amdgcn_fence(__ATOMIC_ACQUIRE, "agent");
            asm volatile("s_waitcnt vmcnt(0)" ::: "memory");
        }
    }
    __syncthreads();
}


constexpr size_t OFF_XBAR = OFF_SMALL + 1536 * 1024;
constexpr size_t OFF_PX = OFF_SMALL + 1152 * 1024;
#define GSYNC_CG() do { __threadfence(); grid.sync(); __threadfence(); } while (0)
#define GSYNC() xcd_barrier(xbar)
#ifndef LAUNCH_SPLITS
#define LAUNCH_SPLITS {{0,0},{1,1},{2,2},{3,3},{4,4},{5,5},{6,6},{7,7},{8,8},{9,9},{10,10}}
#endif
template <int PLO, int PHI>
__global__ void __launch_bounds__(512) mega(Params p) {
  cg::grid_group grid = cg::this_grid();
  __shared__ __attribute__((aligned(16))) char smem[SMEM_BYTES];
  char* ws = p.ws;
  float* MOD = (float*)(ws + OFF_MOD);
  const int lb = logical_block();
  volatile LAS unsigned* xst = (volatile LAS unsigned*)(smem + LDS_RED + 2048);
  if (tid_fresh() < 4) xst[tid_fresh()] = 0u;
  __syncthreads();
  XcdBarrier xbar = xcd_barrier_post((unsigned*)(ws + OFF_XBAR), xst);
  if (PLO < PHI) grid.sync();

  if (PLO <= 0 && 0 <= PHI) {
  phase0(p, smem);
  }
  if (PLO <= 0 && 0 < PHI) { GSYNC(); }
  if (PLO <= 1 && 1 <= PHI) {

  ln_rows_modulate(p.x, (bf16_t*)(ws + OFF_M0), NTOK, SEQ, MOD, -1);
  ln_rows_modulate(p.ctx, (bf16_t*)(ws + OFF_MC), NCTX, CTXL, MOD, 16);
  }
  if (PLO <= 1 && 1 < PHI) { GSYNC(); }
  if (PLO <= 2 && 2 <= PHI) {

  phase2(p, smem);
  }
  if (PLO <= 2 && 2 < PHI) { GSYNC(); }
  if (PLO <= 3 && 3 <= PHI) {

  for (int u = lb; u < 1024; u += gridDim.x) {
      const int grp = u >> 5, j = u & 31, b = grp >> 1, kvh = grp & 1, hq = kvh * 4 + (j >> 3), qb = j & 7;
      const bf16_t* Qb = (const bf16_t*)(ws + OFF_Q) + ((size_t)(b * SEQ + qb * 256) * 8 + hq) * 128;
      const bf16_t* Kh = (const bf16_t*)(ws + OFF_KALL) + ((size_t)b * SKV * 2 + kvh) * 128;
      const bf16_t* Vh = (const bf16_t*)(ws + OFF_VALL) + ((size_t)b * SKV * 2 + kvh) * 128;
      bf16_t* GO = (bf16_t*)(ws + OFF_SG) + (size_t)(b * SEQ + qb * 256) * 2048 + hq * 128;
      att::attn_body(Qb, Kh, Vh, GO, SKV, smem);
  }
  for (int v = lb; v < 256; v += gridDim.x) chunk_gate_unit(p, v >> 4, v & 15, smem);
  }
  if (PLO <= 3 && 3 < PHI) { GSYNC(); }
  if (PLO <= 4 && 4 <= PHI) {

  out_proj((const bf16_t*)(ws + OFF_SG), (const bf16_t*)(ws + OFF_WT_EOUT), MOD, (bf16_t*)(ws + OFF_YG), smem);
  }
  if (PLO <= 4 && 4 < PHI) { GSYNC(); }
  if (PLO <= 5 && 5 <= PHI) {

  post_ln_rows(p.x, (const bf16_t*)(ws + OFF_YG), (float*)(ws + OFF_Q), p.post_g, p.post_b, (bf16_t*)(ws + OFF_M0), MOD + 17 * 3072);
  }
  if (PLO <= 5 && 5 < PHI) { GSYNC(); }
  if (PLO <= 6 && 6 <= PHI) {

  {
    const bf16_t* M1 = (const bf16_t*)(ws + OFF_M0); const bf16_t* WT = (const bf16_t*)(ws + OFF_WT_OIN);
    bf16_t* F = (bf16_t*)(ws + OFF_F); bf16_t* RV = (bf16_t*)(ws + OFF_RV); bf16_t* XM = (bf16_t*)(ws + OFF_XM);
    bf16_t* SG1 = (bf16_t*)(ws + OFF_SG);
    for (int u = lb; u < 2048; u += gridDim.x) {
      f32x16 acc[2][4];
      if (u < 1024) {
        const int tt = u >> 3, ct = u & 7, b = tt >> 3, t0 = (tt & 7) * 256;
        gemm2(mkPlain(WT + (size_t)ct * 256 * 1024, 1024), mkPlain(M1 + (size_t)tt * 256 * 1024, 1024), 16, smem, acc);
        epi2_foreach(acc, [&](int row, int col, float a, float bq, float c, float d) {
          const int ch = ct * 256 + row, t = t0 + col;
          const size_t base = ((size_t)b * 2048 + ch) * 1024;
          if (t < 1024) {
            st_bf4(F + base + t, a, bq, c, d);
            if (t == 0) RV[base] = 0;
          } else if (t == 1024) {
            XM[(size_t)b * 2048 + ch] = f2bf(a);
            RV[base + 1023] = f2bf(bq); RV[base + 1022] = f2bf(c); RV[base + 1021] = f2bf(d);
          } else {
            RV[base + 2048 - t] = f2bf(a); RV[base + 2047 - t] = f2bf(bq); RV[base + 2046 - t] = f2bf(c); RV[base + 2045 - t] = f2bf(d);
          }
        });
      } else {
        const int v = u - 1024, mt = v >> 3, nt = v & 7;
        gemm2(mkPlain(M1 + (size_t)mt * 256 * 1024, 1024), mkPlain(WT + (size_t)(2048 + nt * 256) * 1024, 1024), 16, smem, acc);
        epi2_store_lds(acc, smem, [&](int, int, float& a, float& bq, float& c, float& d) { a = silu_f(a); bq = silu_f(bq); c = silu_f(c); d = silu_f(d); },
                       SG1 + (size_t)mt * 256 * 2048 + nt * 256, 2048);
      }
    }
  }
  }
  if (PLO <= 6 && 6 < PHI) { GSYNC(); }
  if (PLO <= 7 && 7 <= PHI) {

  {
    bf16_t* EE = (bf16_t*)p.out + (size_t)32 * MiB;
    bf16_t* EO = EE + (size_t)16 * MiB;
    bf16_t* OE = (bf16_t*)(ws + OFF_M0); bf16_t* OO = OE + (size_t)16 * MiB;
    float* PX = (float*)(ws + OFF_PX); float* E512 = PX + 32768; float* O512 = PX + 65536;
    {
      const int tid = tid_fresh(), wid = tid >> 6, lane = tid & 63;
      const int gw = blockIdx.x * 8 + wid, nw = gridDim.x * 8;
      const bf16_t* XMr = (const bf16_t*)(ws + OFF_XM);
      u32x4 na0, na1, nb0, nb1;
      { const size_t ro = (size_t)gw * 128; const u32x4* Fr = (const u32x4*)(ws + OFF_F) + ro; const u32x4* Rr = (const u32x4*)(ws + OFF_RV) + ro;
        na0 = Fr[lane]; na1 = Fr[lane + 64]; nb0 = Rr[lane]; nb1 = Rr[lane + 64]; }
      const int src1 = 63 - lane, src0 = (64 - lane) & 63;
      for (int row = gw; row < 16 * 2048; row += nw) {
        const u32x4 a0 = na0, a1 = na1, b0 = nb0, b1 = nb1;
        { const int nr = (row + nw < 16 * 2048) ? row + nw : row; const size_t ro = (size_t)nr * 128;
          const u32x4* Fr = (const u32x4*)(ws + OFF_F) + ro; const u32x4* Rr = (const u32x4*)(ws + OFF_RV) + ro;
          na0 = Fr[lane]; na1 = Fr[lane + 64]; nb0 = Rr[lane]; nb1 = Rr[lane + 64]; }
        float e1[8], o1[8], e2[8], o2[8];
#pragma unroll
        for (int k = 0; k < 4; ++k) {
          { const float al = bf_lo(a0[k]), ah = bf_hi(a0[k]), bl = bf_lo(b0[k]), bh = bf_hi(b0[k]);
            e1[2 * k] = al + bl; e1[2 * k + 1] = ah + bh; o1[2 * k] = al - bl; o1[2 * k + 1] = ah - bh; }
          { const float al = bf_lo(a1[k]), ah = bf_hi(a1[k]), bl = bf_lo(b1[k]), bh = bf_hi(b1[k]);
            e2[2 * k] = al + bl; e2[2 * k + 1] = ah + bh; o2[2 * k] = al - bl; o2[2 * k + 1] = ah - bh; }
        }
        float alt = 0.f;
#pragma unroll
        for (int j = 0; j < 8; j += 2) alt += (e1[j] - e1[j + 1]) + (e2[j] - e2[j + 1]);
        float me[8], mo[8];
        me[0] = __shfl(e2[0], src0); mo[0] = __shfl(o2[0], src0);
        if (lane == 0) { me[0] = 0.f; mo[0] = 0.f; }
#pragma unroll
        for (int j = 1; j < 8; ++j) { me[j] = __shfl(e2[8 - j], src1); mo[j] = __shfl(o2[8 - j], src1); }
        u32x4 wee, weo, woe, woo;
#pragma unroll
        for (int k = 0; k < 4; ++k) {
          wee[k] = cvtpk(e1[2 * k] + me[2 * k], e1[2 * k + 1] + me[2 * k + 1]);
          weo[k] = cvtpk(e1[2 * k] - me[2 * k], e1[2 * k + 1] - me[2 * k + 1]);
          woe[k] = cvtpk(o1[2 * k] - mo[2 * k], o1[2 * k + 1] - mo[2 * k + 1]);
          woo[k] = cvtpk(o1[2 * k] + mo[2 * k], o1[2 * k + 1] + mo[2 * k + 1]);
        }
        const size_t wo = (size_t)row * 64 + lane;
        ((u32x4*)EE)[wo] = wee; ((u32x4*)EO)[wo] = weo; ((u32x4*)OE)[wo] = woe; ((u32x4*)OO)[wo] = woo;
        alt = wave_sum(alt);
        if (lane == 0) { PX[row] = alt + bf2f(XMr[row]); E512[row] = e2[0]; O512[row] = o2[0]; }
      }
    }
    if (PLO < PHI) { GSYNC(); }
    const bf16_t* XM = (const bf16_t*)(ws + OFF_XM);
    const bf16_t* TAB = (const bf16_t*)(ws + OFF_TAB_C);
    bf16_t* PC = (bf16_t*)p.out; bf16_t* PS = (bf16_t*)(ws + OFF_F);
    for (int u = lb; u < 1024; u += gridDim.x) {
      f32x16 acc[2][4];
      const int ty = u >> 8, v = u & 255, b = v >> 4, mt = (v >> 3) & 1, nt = v & 7;
      const bf16_t* Bsrc = (ty == 0) ? EE : (ty == 1) ? EO : (ty == 2) ? OE : OO;
      gemm2(mkPlain(TAB + (size_t)ty * 512 * 512 + (size_t)mt * 256 * 512, 512), mkPlain(Bsrc + ((size_t)b * 2048 + nt * 256) * 512, 512), 8, smem, acc);
      bf16_t* dstP = (ty < 2) ? PC : PS;
      const int par = ty & 1;
      epi2_store_lds(acc, smem, [&](int row, int col, float& a, float& bq, float& c, float& d) {
        const int sidx = mt * 256 + row, ch = nt * 256 + col;
        const size_t vi = (size_t)b * 2048 + ch;
        const float sg = (sidx & 1) ? -1.f : 1.f;
        if (ty == 0) {
          const u32x2 xm = *(const u32x2*)(XM + vi); const float4 em = *(const float4*)(E512 + vi);
          a += sg * em.x + bf_lo(xm[0]); bq += sg * em.y + bf_hi(xm[0]); c += sg * em.z + bf_lo(xm[1]); d += sg * em.w + bf_hi(xm[1]);
        } else if (ty == 1) {
          const u32x2 xm = *(const u32x2*)(XM + vi);
          a -= bf_lo(xm[0]); bq -= bf_hi(xm[0]); c -= bf_lo(xm[1]); d -= bf_hi(xm[1]);
        } else if (ty == 3) {
          const float4 om = *(const float4*)(O512 + vi);
          a += sg * om.x; bq += sg * om.y; c += sg * om.z; d += sg * om.w;
        }
      }, dstP + ((size_t)b * 1024 + 2 * (mt * 256) + par) * 2048 + nt * 256, 4096);
    }
  }
  }
  if (PLO <= 7 && 7 < PHI) { GSYNC(); }
  if (PLO <= 8 && 8 <= PHI) {

  {
    const bf16_t* PC = (const bf16_t*)p.out; const bf16_t* PS = (const bf16_t*)(ws + OFF_F);
    const bf16_t* CDP = (const bf16_t*)(ws + OFF_CDP);
    bf16_t* SG1 = (bf16_t*)(ws + OFF_SG);
    const int tid = tid_fresh(), wid = tid >> 6, lane = tid & 63, r32 = lane & 31, hi = lane >> 5, wm = wid >> 1, wn = wid & 1;
    constexpr int TBS = 528;
    constexpr int TB_BYTES = 128 * TBS;
    char* sT = smem; char* sA = smem + TB_BYTES;
#pragma unroll
    for (int i = 0; i < 8; ++i) {
      const int id = tid + 512 * i, row = id >> 5, ck = id & 31;
      *(u32x4*)(sT + row * TBS + ck * 16) = *(const u32x4*)(CDP + row * 256 + ck * 8);
    }
    const int st_off = (tid >> 3) * LDS_ROWB + (tid & 7) * 16;
    const int a_rd = (wm * 64 + r32) * LDS_ROWB + hi * 16;
    const int b_rd = (wn * 32 + r32) * TBS + hi * 16;
    const size_t rowoff = (size_t)(tid >> 3) * 2048 + (tid & 7) * 8;
    u32x4 r00, r01, r02, r03, r10, r11, r12, r13, r20, r21, r22, r23, r30, r31, r32_, r33;
    auto a_base = [&](int u_, int s_) -> const bf16_t* {
      const int b_ = u_ >> 6, j_ = (u_ >> 4) & 3, G_ = u_ & 15;
      return ((s_ < 2) ? PC : PS) + ((size_t)b_ * 1024 + j_ * 256) * 2048 + G_ * 128 + (s_ & 1) * 64 + rowoff;
    };
#define P8_LOAD(S, U, A, B, C, D) do { const bf16_t* q_ = a_base((U), (S)); A = *(const u32x4*)(q_); B = *(const u32x4*)(q_ + (size_t)64 * 2048); \
      C = *(const u32x4*)(q_ + (size_t)128 * 2048); D = *(const u32x4*)(q_ + (size_t)192 * 2048); } while (0)
#define P8_WRITE(ST, A, B, C, D) do { char* s_ = sA + (ST) * L2_A + st_off; *(u32x4*)(s_) = A; *(u32x4*)(s_ + 64 * LDS_ROWB) = B; \
      *(u32x4*)(s_ + 128 * LDS_ROWB) = C; *(u32x4*)(s_ + 192 * LDS_ROWB) = D; } while (0)
#define P8_COMPUTE(ST, S, ACC) do { const char* sb_ = sA + (ST) * L2_A;                                              \
      _Pragma("unroll") for (int kk = 0; kk < 4; ++kk) {                                                               \
        const bf16x8 fa0 = *(const bf16x8*)(sb_ + a_rd + kk * 32);                                                      \
        const bf16x8 fa1 = *(const bf16x8*)(sb_ + a_rd + 32 * LDS_ROWB + kk * 32);                                      \
        const bf16x8 fb0 = *(const bf16x8*)(sT + b_rd + ((S) * 64 + kk * 16) * 2);                                      \
        const bf16x8 fb1 = *(const bf16x8*)(sT + b_rd + 64 * TBS + ((S) * 64 + kk * 16) * 2);                           \
        ACC[0][0] = __builtin_amdgcn_mfma_f32_32x32x16_bf16(fb0, fa0, ACC[0][0], 0, 0, 0);                              \
        ACC[0][1] = __builtin_amdgcn_mfma_f32_32x32x16_bf16(fb1, fa0, ACC[0][1], 0, 0, 0);                              \
        ACC[1][0] = __builtin_amdgcn_mfma_f32_32x32x16_bf16(fb0, fa1, ACC[1][0], 0, 0, 0);                              \
        ACC[1][1] = __builtin_amdgcn_mfma_f32_32x32x16_bf16(fb1, fa1, ACC[1][1], 0, 0, 0);                              \
      } } while (0)
    P8_LOAD(0, lb, r00, r01, r02, r03); P8_LOAD(1, lb, r10, r11, r12, r13); P8_LOAD(2, lb, r20, r21, r22, r23); P8_LOAD(3, lb, r30, r31, r32_, r33);
    for (int u = lb; u < 1024; u += gridDim.x) {
      const int un = (u + (int)gridDim.x < 1024) ? u + (int)gridDim.x : u;
      f32x16 acc1[2][2], acc2[2][2];
#pragma unroll
      for (int mi = 0; mi < 2; ++mi)
#pragma unroll
        for (int nj = 0; nj < 2; ++nj)
#pragma unroll
          for (int r = 0; r < 16; ++r) { acc1[mi][nj][r] = 0.f; acc2[mi][nj][r] = 0.f; }
      P8_WRITE(0, r00, r01, r02, r03); __syncthreads(); P8_LOAD(0, un, r00, r01, r02, r03); P8_COMPUTE(0, 0, acc1);
      P8_WRITE(1, r10, r11, r12, r13); __syncthreads(); P8_LOAD(1, un, r10, r11, r12, r13); P8_COMPUTE(1, 1, acc1);
      P8_WRITE(0, r20, r21, r22, r23); __syncthreads(); P8_LOAD(2, un, r20, r21, r22, r23); P8_COMPUTE(0, 2, acc2);
      P8_WRITE(1, r30, r31, r32_, r33); __syncthreads(); P8_LOAD(3, un, r30, r31, r32_, r33); P8_COMPUTE(1, 3, acc2);
      const int b = u >> 6, j = (u >> 4) & 3, G = u & 15;
      const float sc = 1.f / 512.f;
      char* sE = sA;
      constexpr int ES = 272;
      __syncthreads();
#pragma unroll 1
      for (int pass = 0; pass < 2; ++pass) {
#pragma unroll
        for (int i = 0; i < 8; ++i) {
          const int id = tid + 512 * i, row = id >> 4, ck = id & 15, tp = j * 256 + row;
          const int tok = pass ? ((tp >= 1) ? 2048 - tp : 0) : tp;
          *(u32x4*)(sE + row * ES + ck * 16) = *(const u32x4*)(SG1 + ((size_t)b * 2048 + tok) * 2048 + G * 128 + ck * 8);
        }
        __syncthreads();
        const float sgn = pass ? 1.f : -1.f;
#pragma unroll
        for (int mi = 0; mi < 2; ++mi)
#pragma unroll
          for (int nj = 0; nj < 2; ++nj)
#pragma unroll
            for (int q = 0; q < 4; ++q) {
              char* ad = sE + (wm * 64 + mi * 32 + r32) * ES + (nj * 64 + wn * 32 + q * 8 + hi * 4) * 2;
              const u32x2 sg = *(const u32x2*)ad;
              const float y0 = (acc1[mi][nj][4 * q + 0] + sgn * acc2[mi][nj][4 * q + 0]) * sc, y1 = (acc1[mi][nj][4 * q + 1] + sgn * acc2[mi][nj][4 * q + 1]) * sc;
              const float y2 = (acc1[mi][nj][4 * q + 2] + sgn * acc2[mi][nj][4 * q + 2]) * sc, y3 = (acc1[mi][nj][4 * q + 3] + sgn * acc2[mi][nj][4 * q + 3]) * sc;
              u32x2 w = {cvtpk(y0 * bf_lo(sg[0]), y1 * bf_hi(sg[0])), cvtpk(y2 * bf_lo(sg[1]), y3 * bf_hi(sg[1]))};
              *(u32x2*)ad = w;
            }
        __syncthreads();
#pragma unroll
        for (int i = 0; i < 8; ++i) {
          const int id = tid + 512 * i, row = id >> 4, ck = id & 15, tp = j * 256 + row;
          if (!pass || tp >= 1) {
            const int tok = pass ? 2048 - tp : tp;
            *(u32x4*)(SG1 + ((size_t)b * 2048 + tok) * 2048 + G * 128 + ck * 8) = *(const u32x4*)(sE + row * ES + ck * 16);
          }
        }
        __syncthreads();
      }
    }
#undef P8_LOAD
#undef P8_WRITE
#undef P8_COMPUTE
    {
      const float* PX = (const float*)(ws + OFF_PX);
      for (int i = blockIdx.x; i < 256; i += gridDim.x) {
        if (tid < 128) {
          const int b = i >> 4, G = i & 15;
          const float* px = PX + (size_t)b * 2048 + G * 128;
          float y = 0.f;
          for (int c = 0; c < 128; ++c) y += px[c] * bf2f(*(const bf16_t*)(sT + tid * TBS + c * 2));
          bf16_t* gp = SG1 + ((size_t)b * 2048 + 1024) * 2048 + G * 128 + tid;
          *gp = f2bf(y * (1.f / 512.f) * bf2f(*gp));
        }
      }
    }
  }
  }
  if (PLO <= 8 && 8 < PHI) { GSYNC(); }
  if (PLO <= 9 && 9 <= PHI) {

  out_proj((const bf16_t*)(ws + OFF_SG), (const bf16_t*)(ws + OFF_WT_OOUT), MOD + 17 * 3072, (bf16_t*)(ws + OFF_YG), smem);
  }
  if (PLO <= 9 && 9 < PHI) { GSYNC(); }
  if (PLO <= 10 && 10 <= PHI) {

  post_ln_rows((const float*)(ws + OFF_Q), (const bf16_t*)(ws + OFF_YG), p.out, p.post_g + 1024, p.post_b + 1024, nullptr, nullptr);
  }
}

extern "C" void kernel_launch(void* const* d_in, const int* in_sizes, int n_in, void* d_out, int out_size, void* d_ws, size_t ws_size,
                              hipStream_t stream) {
  static int grid_blocks = 0;
  if (!grid_blocks) {
    int dev = 0, cus = 0, per_cu = 0;
    hipGetDevice(&dev);
    hipDeviceGetAttribute(&cus, hipDeviceAttributeMultiprocessorCount, dev);
    hipOccupancyMaxActiveBlocksPerMultiprocessor(&per_cu, mega<0, 10>, 512, 0);
    if (per_cu > 1) per_cu = 1;
    grid_blocks = cus * per_cu;
    if (n_in != 18 || ws_size < WS_NEED) fprintf(stderr, "kernel_launch: unexpected n_in %d or ws_size %zu (need %zu)\n", n_in, ws_size, (size_t)WS_NEED);
  }
  Params p{};
  p.x = (const float*)d_in[0]; p.c = (const float*)d_in[1]; p.ctx = (const float*)d_in[2]; p.c_ctx = (const float*)d_in[3];
  p.w_mod = (const float*)d_in[4]; p.b_mod = (const float*)d_in[5]; p.post_g = (const float*)d_in[6]; p.post_b = (const float*)d_in[7];
  p.e_w_in = (const float*)d_in[8]; p.e_qn = (const float*)d_in[9]; p.e_kn = (const float*)d_in[10]; p.e_vg = (const float*)d_in[11];
  p.e_vb = (const float*)d_in[12]; p.e_ws = (const float*)d_in[13]; p.e_bs = (const float*)d_in[14]; p.e_w_out = (const float*)d_in[15];
  p.o_w_in = (const float*)d_in[16]; p.o_w_out = (const float*)d_in[17];
  p.out = (float*)d_out; p.ws = (char*)d_ws;
#define ONE_LAUNCH 1
#ifdef ONE_LAUNCH
  hipMemsetAsync((char*)d_ws + OFF_XBAR, 0, XCD_BAR_WORDS * 4, stream);
  { void* args[] = {&p};
    hipError_t e = hipLaunchCooperativeKernel((void*)mega<0, 10>, dim3(grid_blocks), dim3(512), args, 0, stream);
    if (e != hipSuccess) fprintf(stderr, "cooperative launch failed: %s (grid %d)\n", hipGetErrorString(e), grid_blocks); }
#else
  hipLaunchKernelGGL((mega<0, 0>), dim3(grid_blocks), dim3(512), 0, stream, p);
  hipLaunchKernelGGL((mega<1, 1>), dim3(grid_blocks), dim3(512), 0, stream, p);
  hipLaunchKernelGGL((mega<2, 2>), dim3(grid_blocks), dim3(512), 0, stream, p);
  hipLaunchKernelGGL((mega<3, 3>), dim3(grid_blocks), dim3(512), 0, stream, p);
  hipLaunchKernelGGL((mega<4, 4>), dim3(grid_blocks), dim3(512), 0, stream, p);
  hipLaunchKernelGGL((mega<5, 5>), dim3(grid_blocks), dim3(512), 0, stream, p);
  hipLaunchKernelGGL((mega<6, 6>), dim3(grid_blocks), dim3(512), 0, stream, p);
  hipLaunchKernelGGL((mega<7, 7>), dim3(grid_blocks), dim3(512), 0, stream, p);
  hipLaunchKernelGGL((mega<8, 8>), dim3(grid_blocks), dim3(512), 0, stream, p);
  hipLaunchKernelGGL((mega<9, 9>), dim3(grid_blocks), dim3(512), 0, stream, p);
  hipLaunchKernelGGL((mega<10, 10>), dim3(grid_blocks), dim3(512), 0, stream, p);
#endif
}
```

```cpp
#include <hip/hip_runtime.h>
#include <hip/hip_cooperative_groups.h>
#include <cstdio>
#include <cstdint>
namespace cg = cooperative_groups;

typedef unsigned short bf16_t;
using bf16x8 = __attribute__((ext_vector_type(8))) short;
using s16x4  = __attribute__((ext_vector_type(4))) short;
using f32x16 = __attribute__((ext_vector_type(16))) float;
using u32x4  = __attribute__((ext_vector_type(4))) unsigned;
using u32x2  = __attribute__((ext_vector_type(2))) unsigned;

constexpr int DM = 1024, NB = 16, SEQ = 2048, CTXL = 256, SKV = SEQ + CTXL;
constexpr int NTOK = NB * SEQ;
constexpr int NCTX = NB * CTXL;
constexpr int EVEN_IN = 5632, ODD_IN = 4096, DIN = 2048;
constexpr float ALPHA = 1.4142135623730951f;
constexpr float EPS = 1e-6f;

constexpr size_t MiB = 1ull << 20;
constexpr size_t OFF_WT_EIN = 0, OFF_WT_EOUT = 11 * MiB, OFF_WT_OIN = 15 * MiB, OFF_WT_OOUT = 23 * MiB;
constexpr size_t OFF_TAB_C = 27 * MiB, OFF_TAB_S = 30 * MiB, OFF_SMALL = 33 * MiB;
constexpr size_t OFF_CDM = OFF_SMALL, OFF_CDP = OFF_SMALL + 64 * 1024, OFF_WSB = OFF_SMALL + 128 * 1024;
constexpr size_t OFF_ROPE = OFF_SMALL + 384 * 1024, OFF_MOD = OFF_SMALL + 512 * 1024, OFF_XM = OFF_SMALL + 1024 * 1024;
constexpr size_t OFF_M0 = 36 * MiB, OFF_MC = 100 * MiB;
constexpr size_t OFF_SG = 108 * MiB;
constexpr size_t OFF_Q = 236 * MiB, OFF_BU = 300 * MiB;
constexpr size_t OFF_KALL = 364 * MiB, OFF_VALL = 382 * MiB, OFF_BV = 400 * MiB;
constexpr size_t OFF_F = 364 * MiB, OFF_RV = 428 * MiB;
constexpr size_t OFF_YG = 364 * MiB;
constexpr size_t WS_NEED = 492 * MiB;

struct Params {
  const float *x, *c, *ctx, *c_ctx, *w_mod, *b_mod, *post_g, *post_b, *e_w_in, *e_qn, *e_kn, *e_vg, *e_vb, *e_ws, *e_bs,
      *e_w_out, *o_w_in, *o_w_out;
  float* out;
  char* ws;
  long pad_;
};

typedef float f32x2_t __attribute__((ext_vector_type(2)));
typedef __bf16 bf16x2_t __attribute__((ext_vector_type(2)));
__device__ __forceinline__ unsigned cvtpk(float lo, float hi) {
  f32x2_t v = {lo, hi}; bf16x2_t h = __builtin_convertvector(v, bf16x2_t); return __builtin_bit_cast(unsigned, h);
}
__device__ __forceinline__ int tid_fresh() { int t = (int)__builtin_amdgcn_workitem_id_x(); asm volatile("" : "+v"(t)); return t; }
__device__ __forceinline__ float bf_lo(unsigned w) { return __uint_as_float(w << 16); }
__device__ __forceinline__ float bf_hi(unsigned w) { return __uint_as_float(w & 0xffff0000u); }
__device__ __forceinline__ bf16_t f2bf(float x) { return (bf16_t)(cvtpk(x, 0.f) & 0xffffu); }
__device__ __forceinline__ float bf2f(bf16_t h) { return __uint_as_float(((unsigned)h) << 16); }
__device__ __forceinline__ int crow(int r, int hi) { return (r & 3) + 8 * (r >> 2) + 4 * hi; }
__device__ __forceinline__ float wave_sum(float v) {
#pragma unroll
  for (int o = 32; o >= 1; o >>= 1) v += __shfl_xor(v, o);
  return v;
}
__device__ __forceinline__ float silu_f(float x) { return x * __builtin_amdgcn_rcpf(1.f + __expf(-x)); }
__device__ __forceinline__ float gelu_tanh_f(float x) {
  const float u = 0.7978845608028654f * (x + 0.044715f * x * x * x);
  const float t = 1.f - 2.f * __builtin_amdgcn_rcpf(__expf(2.f * u) + 1.f);
  return 0.5f * x * (1.f + t);
}
__device__ __forceinline__ int logical_block() {
  const int g = gridDim.x, b = blockIdx.x;
  return (g & 7) ? b : (b & 7) * (g >> 3) + (b >> 3);
}

constexpr int LDS_ROWB = 144;
constexpr int LDS_A = 256 * LDS_ROWB;
constexpr int LDS_B = 128 * LDS_ROWB;
constexpr int LDS_STAGE = LDS_A + LDS_B;
constexpr int L2_A = 256 * LDS_ROWB;
constexpr int L2_STAGE = 2 * L2_A;
constexpr int LDS_RED = 2 * L2_STAGE;
constexpr int SMEM_BYTES = LDS_RED + 2048 + 2048;

struct LdPlain {
  const bf16_t* p; size_t rs;
  __device__ __forceinline__ u32x4 ld(int kt, int i) const { return *(const u32x4*)(p + (size_t)i * rs + kt * 64); }
};
__device__ __forceinline__ LdPlain mkPlain(const bf16_t* base, int ld) {
  const int tid = tid_fresh();
  LdPlain l; l.p = base + (size_t)(tid >> 3) * ld + (tid & 7) * 8; l.rs = (size_t)64 * ld; return l;
}
struct LdSplit {
  const bf16_t* p0; const bf16_t* p1; size_t rs; int kts;
  __device__ __forceinline__ u32x4 ld(int kt, int i) const {
    const bf16_t* q = (kt < kts) ? (p0 + kt * 64) : (p1 + (kt - kts) * 64);
    return *(const u32x4*)(q + (size_t)i * rs);
  }
};
__device__ __forceinline__ LdSplit mkSplit(const bf16_t* b0, const bf16_t* b1, int ld, int kts) {
  const int tid = tid_fresh(); const size_t o = (size_t)(tid >> 3) * ld + (tid & 7) * 8;
  LdSplit l; l.p0 = b0 + o; l.p1 = b1 + o; l.rs = (size_t)64 * ld; l.kts = kts; return l;
}
struct LdFold {
  const bf16_t* f; const bf16_t* r; size_t rs; float sg;
  __device__ __forceinline__ u32x4 ld(int kt, int i) const {
    const u32x4 a = *(const u32x4*)(f + (size_t)i * rs + kt * 64);
    const u32x4 b = *(const u32x4*)(r + (size_t)i * rs + kt * 64);
    u32x4 o;
    o[0] = cvtpk(bf_lo(a[0]) + sg * bf_lo(b[0]), bf_hi(a[0]) + sg * bf_hi(b[0]));
    o[1] = cvtpk(bf_lo(a[1]) + sg * bf_lo(b[1]), bf_hi(a[1]) + sg * bf_hi(b[1]));
    o[2] = cvtpk(bf_lo(a[2]) + sg * bf_lo(b[2]), bf_hi(a[2]) + sg * bf_hi(b[2]));
    o[3] = cvtpk(bf_lo(a[3]) + sg * bf_lo(b[3]), bf_hi(a[3]) + sg * bf_hi(b[3]));
    return o;
  }
};
__device__ __forceinline__ LdFold mkFold(const bf16_t* f, const bf16_t* r, int ld, float sg) {
  const int tid = tid_fresh(); const size_t o = (size_t)(tid >> 3) * ld + (tid & 7) * 8;
  LdFold l; l.f = f + o; l.r = r + o; l.rs = (size_t)64 * ld; l.sg = sg; return l;
}

template <class LA, class LB>
__device__ __forceinline__ void gemm_mainloop(const LA& la, const LB& lb, int KT, char* smem, f32x16 (&acc)[2][2]) {
  const int tid = tid_fresh(), wid = tid >> 6, lane = tid & 63, r32 = lane & 31, hi = lane >> 5, wm = wid >> 1, wn = wid & 1;
#pragma unroll
  for (int mi = 0; mi < 2; ++mi)
#pragma unroll
    for (int nj = 0; nj < 2; ++nj)
#pragma unroll
      for (int r = 0; r < 16; ++r) acc[mi][nj][r] = 0.f;
  const int st_off = (tid >> 3) * LDS_ROWB + (tid & 7) * 16;
  const int a_rd = (wm * 64 + r32) * LDS_ROWB + hi * 16;
  const int b_rd = LDS_A + (wn * 32 + r32) * LDS_ROWB + hi * 16;
  u32x4 ra0, ra1, ra2, ra3, rb0, rb1;
  ra0 = la.ld(0, 0); ra1 = la.ld(0, 1); ra2 = la.ld(0, 2); ra3 = la.ld(0, 3); rb0 = lb.ld(0, 0); rb1 = lb.ld(0, 1);
  {
    char* s = smem + st_off;
    *(u32x4*)(s) = ra0; *(u32x4*)(s + 64 * LDS_ROWB) = ra1; *(u32x4*)(s + 128 * LDS_ROWB) = ra2; *(u32x4*)(s + 192 * LDS_ROWB) = ra3;
    *(u32x4*)(s + LDS_A) = rb0; *(u32x4*)(s + LDS_A + 64 * LDS_ROWB) = rb1;
  }
  __syncthreads();
#define GEMM_COMPUTE(SB)                                                                              \
  _Pragma("unroll") for (int kk = 0; kk < 4; ++kk) {                                                  \
    const bf16x8 a0 = *(const bf16x8*)((SB) + a_rd + kk * 32);                                        \
    const bf16x8 a1 = *(const bf16x8*)((SB) + a_rd + 32 * LDS_ROWB + kk * 32);                        \
    const bf16x8 b0 = *(const bf16x8*)((SB) + b_rd + kk * 32);                                        \
    const bf16x8 b1 = *(const bf16x8*)((SB) + b_rd + 64 * LDS_ROWB + kk * 32);                        \
    acc[0][0] = __builtin_amdgcn_mfma_f32_32x32x16_bf16(b0, a0, acc[0][0], 0, 0, 0);                  \
    acc[0][1] = __builtin_amdgcn_mfma_f32_32x32x16_bf16(b1, a0, acc[0][1], 0, 0, 0);                  \
    acc[1][0] = __builtin_amdgcn_mfma_f32_32x32x16_bf16(b0, a1, acc[1][0], 0, 0, 0);                  \
    acc[1][1] = __builtin_amdgcn_mfma_f32_32x32x16_bf16(b1, a1, acc[1][1], 0, 0, 0);                  \
  }
#define GEMM_LOAD(KT_) do { ra0 = la.ld((KT_), 0); ra1 = la.ld((KT_), 1); ra2 = la.ld((KT_), 2); ra3 = la.ld((KT_), 3); rb0 = lb.ld((KT_), 0); rb1 = lb.ld((KT_), 1); } while (0)
#define GEMM_WRITE(ST) do { char* s = smem + (ST) * LDS_STAGE + st_off;                                \
    *(u32x4*)(s) = ra0; *(u32x4*)(s + 64 * LDS_ROWB) = ra1; *(u32x4*)(s + 128 * LDS_ROWB) = ra2; *(u32x4*)(s + 192 * LDS_ROWB) = ra3; \
    *(u32x4*)(s + LDS_A) = rb0; *(u32x4*)(s + LDS_A + 64 * LDS_ROWB) = rb1; } while (0)
#pragma unroll 1
  for (int kt = 0; kt < KT; kt += 2) {
    GEMM_LOAD(kt + 1);
    GEMM_COMPUTE(smem);
    GEMM_WRITE(1);
    __syncthreads();
    GEMM_LOAD(kt + 2 < KT ? kt + 2 : kt);
    GEMM_COMPUTE(smem + LDS_STAGE);
    GEMM_WRITE(0);
    __syncthreads();
  }
#undef GEMM_COMPUTE
#undef GEMM_LOAD
#undef GEMM_WRITE
}

template <class LA, class LB>
__device__ __forceinline__ void gemm2(const LA& la, const LB& lb, int KT, char* smem, f32x16 (&acc)[2][4]) {
  const int tid = tid_fresh(), wid = tid >> 6, lane = tid & 63, r32 = lane & 31, hi = lane >> 5, wm = wid >> 1, wn = wid & 1;
#pragma unroll
  for (int mi = 0; mi < 2; ++mi)
#pragma unroll
    for (int nj = 0; nj < 4; ++nj)
#pragma unroll
      for (int r = 0; r < 16; ++r) acc[mi][nj][r] = 0.f;
  const int st_off = (tid >> 3) * LDS_ROWB + (tid & 7) * 16;
  const int a_rd = (wm * 64 + r32) * LDS_ROWB + hi * 16;
  const int b_rd = L2_A + (wn * 128 + r32) * LDS_ROWB + hi * 16;
  u32x4 xa0, xa1, xa2, xa3, xb0, xb1, xb2, xb3, ya0, ya1, ya2, ya3, yb0, yb1, yb2, yb3;
#define G2_LOADX(KT_) do { xa0 = la.ld((KT_), 0); xa1 = la.ld((KT_), 1); xa2 = la.ld((KT_), 2); xa3 = la.ld((KT_), 3); xb0 = lb.ld((KT_), 0); xb1 = lb.ld((KT_), 1); xb2 = lb.ld((KT_), 2); xb3 = lb.ld((KT_), 3); } while (0)
#define G2_LOADY(KT_) do { ya0 = la.ld((KT_), 0); ya1 = la.ld((KT_), 1); ya2 = la.ld((KT_), 2); ya3 = la.ld((KT_), 3); yb0 = lb.ld((KT_), 0); yb1 = lb.ld((KT_), 1); yb2 = lb.ld((KT_), 2); yb3 = lb.ld((KT_), 3); } while (0)
#define G2_W2(ST, P, R0, R1, O0, O1) do { char* s_ = smem + (ST) * L2_STAGE + st_off; *(u32x4*)(s_ + (O0)) = P##R0; *(u32x4*)(s_ + (O1)) = P##R1; } while (0)
#define G2_WRITE(ST, P) do { G2_W2(ST, P, a0, a1, 0, 64 * LDS_ROWB); G2_W2(ST, P, a2, a3, 128 * LDS_ROWB, 192 * LDS_ROWB); \
    G2_W2(ST, P, b0, b1, L2_A, L2_A + 64 * LDS_ROWB); G2_W2(ST, P, b2, b3, L2_A + 128 * LDS_ROWB, L2_A + 192 * LDS_ROWB); } while (0)
#define G2_LDA(SB, kk, A0, A1) do { A0 = *(const bf16x8*)((SB) + a_rd + (kk) * 32); A1 = *(const bf16x8*)((SB) + a_rd + 32 * LDS_ROWB + (kk) * 32); } while (0)
#define G2_STEPP(SB, kk, A0, A1, N0, N1, HASNEXT) do {                                                \
    if (HASNEXT) G2_LDA(SB, (kk) + 1, N0, N1);                                                        \
    _Pragma("unroll") for (int nj = 0; nj < 4; ++nj) {                                                \
      const bf16x8 b_ = *(const bf16x8*)((SB) + b_rd + nj * 32 * LDS_ROWB + (kk) * 32);               \
      acc[0][nj] = __builtin_amdgcn_mfma_f32_32x32x16_bf16(b_, A0, acc[0][nj], 0, 0, 0);              \
      acc[1][nj] = __builtin_amdgcn_mfma_f32_32x32x16_bf16(b_, A1, acc[1][nj], 0, 0, 0);              \
    } } while (0)
#define G2_COMPUTE_W(SB, ST, P) do { bf16x8 p0_, p1_, q0_, q1_;                                        \
    G2_LDA(SB, 0, p0_, p1_);                                                                          \
    G2_STEPP(SB, 0, p0_, p1_, q0_, q1_, 1); G2_W2(ST, P, a0, a1, 0, 64 * LDS_ROWB);                   \
    G2_STEPP(SB, 1, q0_, q1_, p0_, p1_, 1); G2_W2(ST, P, a2, a3, 128 * LDS_ROWB, 192 * LDS_ROWB);     \
    G2_STEPP(SB, 2, p0_, p1_, q0_, q1_, 1); G2_W2(ST, P, b0, b1, L2_A, L2_A + 64 * LDS_ROWB);         \
    G2_STEPP(SB, 3, q0_, q1_, p0_, p1_, 0); G2_W2(ST, P, b2, b3, L2_A + 128 * LDS_ROWB, L2_A + 192 * LDS_ROWB); } while (0)
  G2_LOADX(0); G2_LOADY(1);
  G2_WRITE(0, x);
  __syncthreads();
  G2_LOADX(2 < KT ? 2 : 0);
#pragma unroll 1
  for (int kt = 0; kt < KT; kt += 2) {
    G2_COMPUTE_W(smem, 1, y);
    __syncthreads();
    G2_LOADY(kt + 3 < KT ? kt + 3 : KT - 1);
    G2_COMPUTE_W(smem + L2_STAGE, 0, x);
    __syncthreads();
    G2_LOADX(kt + 4 < KT ? kt + 4 : KT - 2);
  }
#undef G2_LOADX
#undef G2_LOADY
#undef G2_WRITE
#undef G2_W2
#undef G2_STEPP
#undef G2_LDA
#undef G2_COMPUTE_W
}
template <class F>
__device__ __forceinline__ void epi2_foreach(const f32x16 (&acc)[2][4], F&& f) {
  const int tid = tid_fresh(), wid = tid >> 6, lane = tid & 63, r32 = lane & 31, hi = lane >> 5, wm = wid >> 1, wn = wid & 1;
#pragma unroll
  for (int mi = 0; mi < 2; ++mi)
#pragma unroll
    for (int nj = 0; nj < 4; ++nj)
#pragma unroll
      for (int q = 0; q < 4; ++q)
        f(wm * 64 + mi * 32 + r32, wn * 128 + nj * 32 + q * 8 + hi * 4, acc[mi][nj][4 * q + 0], acc[mi][nj][4 * q + 1],
          acc[mi][nj][4 * q + 2], acc[mi][nj][4 * q + 3]);
}

constexpr int ET_S = 528;
__device__ __forceinline__ void tile_flush_bf16(char* smem, bf16_t* dst, size_t ld) {
  const int tid = tid_fresh();
  __syncthreads();
#pragma unroll
  for (int i = 0; i < 16; ++i) {
    const int id = tid + 512 * i, row = id >> 5, ck = id & 31;
    *(u32x4*)(dst + (size_t)row * ld + ck * 8) = *(const u32x4*)(smem + row * ET_S + ck * 16);
  }
  __syncthreads();
}
template <class F>
__device__ __forceinline__ void epi2_store_lds(const f32x16 (&acc)[2][4], char* smem, F&& xf, bf16_t* dst, size_t ld) {
  epi2_foreach(acc, [&](int row, int col, float a, float b, float c, float d) {
    xf(row, col, a, b, c, d);
    u32x2 w = {cvtpk(a, b), cvtpk(c, d)};
    *(u32x2*)(smem + row * ET_S + col * 2) = w;
  });
  tile_flush_bf16(smem, dst, ld);
}

template <class F>
__device__ __forceinline__ void epi_foreach(const f32x16 (&acc)[2][2], F&& f) {
  const int tid = tid_fresh(), wid = tid >> 6, lane = tid & 63, r32 = lane & 31, hi = lane >> 5, wm = wid >> 1, wn = wid & 1;
#pragma unroll
  for (int mi = 0; mi < 2; ++mi)
#pragma unroll
    for (int nj = 0; nj < 2; ++nj)
#pragma unroll
      for (int q = 0; q < 4; ++q)
        f(wm * 64 + mi * 32 + r32, nj * 64 + wn * 32 + q * 8 + hi * 4, acc[mi][nj][4 * q + 0], acc[mi][nj][4 * q + 1],
          acc[mi][nj][4 * q + 2], acc[mi][nj][4 * q + 3]);
}
__device__ __forceinline__ void st_bf4(bf16_t* p, float a, float b, float c, float d) {
  u32x2 w = {cvtpk(a, b), cvtpk(c, d)}; *(u32x2*)p = w;
}

__device__ __forceinline__ void tr_tile(const float* src, bf16_t* dst, int K, int N, int kt, int nt, float* tile) {
  const int tid = tid_fresh(), k0 = kt * 64, n0 = nt * 64;
#pragma unroll
  for (int j = 0; j < 8; ++j) { const int e = j * 512 + tid, r = e >> 6, c = e & 63; tile[r * 65 + c] = src[(size_t)(k0 + r) * N + n0 + c]; }
  __syncthreads();
  const int rn = tid >> 3, ck = (tid & 7) * 8;
  const float v0 = tile[(ck + 0) * 65 + rn], v1 = tile[(ck + 1) * 65 + rn], v2 = tile[(ck + 2) * 65 + rn], v3 = tile[(ck + 3) * 65 + rn];
  const float v4 = tile[(ck + 4) * 65 + rn], v5 = tile[(ck + 5) * 65 + rn], v6 = tile[(ck + 6) * 65 + rn], v7 = tile[(ck + 7) * 65 + rn];
  u32x4 w = {cvtpk(v0, v1), cvtpk(v2, v3), cvtpk(v4, v5), cvtpk(v6, v7)};
  *(u32x4*)(dst + (size_t)(n0 + rn) * K + k0 + ck) = w;
  __syncthreads();
}

__device__ __forceinline__ void phase0(const Params& p, char* smem) {
  const int tid = tid_fresh(), G = gridDim.x, bid = blockIdx.x;
  char* ws = p.ws;
  {
    float* s = (float*)smem;
    float* part = (float*)(smem + 17 * 1024 * 4);
    float* MOD = (float*)(ws + OFF_MOD);
    for (int u = bid; u < 96; u += G) {
      const int l = u / 48, j0 = (u % 48) * 64;
      for (int e = tid; e < 17 * 1024; e += 512) { const int r = e >> 10, k = e & 1023; const float cv = (r < 16) ? p.c[r * 1024 + k] : p.c_ctx[k]; s[e] = silu_f(cv); }
      __syncthreads();
      const int col = tid & 63, ks = tid >> 6;
      float a0 = 0, a1 = 0, a2 = 0, a3 = 0, a4 = 0, a5 = 0, a6 = 0, a7 = 0, a8 = 0, a9 = 0, a10 = 0, a11 = 0, a12 = 0, a13 = 0, a14 = 0, a15 = 0, a16 = 0;
      const float* w = p.w_mod + (size_t)l * 1024 * 3072 + j0 + col;
#pragma unroll 4
      for (int k = ks * 128; k < ks * 128 + 128; ++k) {
        const float wv = w[(size_t)k * 3072];
        a0 += s[0 * 1024 + k] * wv; a1 += s[1 * 1024 + k] * wv; a2 += s[2 * 1024 + k] * wv; a3 += s[3 * 1024 + k] * wv;
        a4 += s[4 * 1024 + k] * wv; a5 += s[5 * 1024 + k] * wv; a6 += s[6 * 1024 + k] * wv; a7 += s[7 * 1024 + k] * wv;
        a8 += s[8 * 1024 + k] * wv; a9 += s[9 * 1024 + k] * wv; a10 += s[10 * 1024 + k] * wv; a11 += s[11 * 1024 + k] * wv;
        a12 += s[12 * 1024 + k] * wv; a13 += s[13 * 1024 + k] * wv; a14 += s[14 * 1024 + k] * wv; a15 += s[15 * 1024 + k] * wv;
        a16 += s[16 * 1024 + k] * wv;
      }
      float* pp = part + ks * 17 * 64 + col;
      pp[0 * 64] = a0; pp[1 * 64] = a1; pp[2 * 64] = a2; pp[3 * 64] = a3; pp[4 * 64] = a4; pp[5 * 64] = a5; pp[6 * 64] = a6; pp[7 * 64] = a7;
      pp[8 * 64] = a8; pp[9 * 64] = a9; pp[10 * 64] = a10; pp[11 * 64] = a11; pp[12 * 64] = a12; pp[13 * 64] = a13; pp[14 * 64] = a14; pp[15 * 64] = a15;
      pp[16 * 64] = a16;
      __syncthreads();
      for (int e = tid; e < 17 * 64; e += 512) {
        const int r = e >> 6, cc = e & 63;
        float t = p.b_mod[l * 3072 + j0 + cc];
#pragma unroll
        for (int q = 0; q < 8; ++q) t += part[q * 17 * 64 + r * 64 + cc];
        MOD[(size_t)(l * 17 + r) * 3072 + j0 + cc] = t;
      }
      __syncthreads();
    }
  }
  {
    float* tile = (float*)smem;
    constexpr int T0 = 16 * 88, T1 = 32 * 16, T2 = 16 * 64, T3 = 32 * 16;
    for (int u = bid; u < T0 + T1 + T2 + T3; u += G) {
      if (u < T0) tr_tile(p.e_w_in, (bf16_t*)(ws + OFF_WT_EIN), 1024, EVEN_IN, u / 88, u % 88, tile);
      else if (u < T0 + T1) { const int v = u - T0; tr_tile(p.e_w_out, (bf16_t*)(ws + OFF_WT_EOUT), 2048, 1024, v / 16, v % 16, tile); }
      else if (u < T0 + T1 + T2) { const int v = u - T0 - T1; tr_tile(p.o_w_in, (bf16_t*)(ws + OFF_WT_OIN), 1024, ODD_IN, v / 64, v % 64, tile); }
      else { const int v = u - T0 - T1 - T2; tr_tile(p.o_w_out, (bf16_t*)(ws + OFF_WT_OOUT), 2048, 1024, v / 16, v % 16, tile); }
    }
  }
  {
    const long gt = (long)bid * 512 + tid, gn = (long)G * 512;
    bf16_t* TC = (bf16_t*)(ws + OFF_TAB_C); bf16_t* TS = (bf16_t*)(ws + OFF_TAB_S);
    (void)TS;
    for (long e = gt; e < 4L * 512 * 512; e += gn) {
      const int ty = (int)(e >> 18), sidx = (int)((e >> 9) & 511), t = (int)(e & 511);
      float v;
      if (ty == 0) v = cospif((float)((sidx * t) & 1023) * (1.f / 512.f));
      else if (ty == 1) v = cospif((float)(((2 * sidx + 1) * t) & 2047) * (1.f / 1024.f));
      else if (ty == 2) v = sinpif((float)((sidx * t) & 1023) * (1.f / 512.f));
      else v = sinpif((float)(((2 * sidx + 1) * t) & 2047) * (1.f / 1024.f));
      TC[e] = f2bf(v);
    }
    bf16_t* CDM = (bf16_t*)(ws + OFF_CDM); bf16_t* CDP = (bf16_t*)(ws + OFF_CDP);
    for (long e = gt; e < 128L * 256; e += gn) {
      const int cp = (int)(e >> 8), k = (int)(e & 255);
      const int m = (cp * (k & 127)) & 127;
      const float x = (float)m * (1.f / 64.f);
      float vm, vp;
      if (k < 128) { vm = cospif(x); vp = vm; } else { vp = sinpif(x); vm = -vp; }
      CDM[e] = f2bf(vm); CDP[e] = f2bf(vp);
    }
    bf16_t* WSB = (bf16_t*)(ws + OFF_WSB);
    for (long e = gt; e < 8L * 128 * 128; e += gn) WSB[e] = f2bf(p.e_ws[e]);
    float2* ROPE = (float2*)(ws + OFF_ROPE);
    for (long e = gt; e < 64L * 32; e += gn) {
      const int pos = (int)(e >> 5), i = (int)(e & 31);
      const float inv = powf(10000.f, -(float)i / 32.f);
      const float ang = (float)pos * inv;
      ROPE[e] = make_float2(cosf(ang), sinf(ang));
    }
  }
}

__device__ __forceinline__ void ln_rows_modulate(const float* src, bf16_t* dst, int nrows, int rows_per_b, const float* mod17, int fixed_row) {
  const int tid = tid_fresh(), wid = tid >> 6, lane = tid & 63;
  const int gw = blockIdx.x * 8 + wid, nw = gridDim.x * 8;
  float4 n0, n1, n2, n3;
  { const int r0 = gw < nrows ? gw : 0; const float4* ps = (const float4*)(src + (size_t)r0 * 1024); n0 = ps[lane]; n1 = ps[lane + 64]; n2 = ps[lane + 128]; n3 = ps[lane + 192]; }
  for (int row = gw; row < nrows; row += nw) {
    float4 v0 = n0, v1 = n1, v2 = n2, v3 = n3;
    { const int nr = (row + nw < nrows) ? row + nw : row;
      const float4* ps = (const float4*)(src + (size_t)nr * 1024); n0 = ps[lane]; n1 = ps[lane + 64]; n2 = ps[lane + 128]; n3 = ps[lane + 192]; }
    float s = v0.x + v0.y + v0.z + v0.w + v1.x + v1.y + v1.z + v1.w + v2.x + v2.y + v2.z + v2.w + v3.x + v3.y + v3.z + v3.w;
    const float mu = wave_sum(s) * (1.f / 1024.f);
    v0.x -= mu; v0.y -= mu; v0.z -= mu; v0.w -= mu; v1.x -= mu; v1.y -= mu; v1.z -= mu; v1.w -= mu;
    v2.x -= mu; v2.y -= mu; v2.z -= mu; v2.w -= mu; v3.x -= mu; v3.y -= mu; v3.z -= mu; v3.w -= mu;
    float q = v0.x * v0.x + v0.y * v0.y + v0.z * v0.z + v0.w * v0.w + v1.x * v1.x + v1.y * v1.y + v1.z * v1.z + v1.w * v1.w +
              v2.x * v2.x + v2.y * v2.y + v2.z * v2.z + v2.w * v2.w + v3.x * v3.x + v3.y * v3.y + v3.z * v3.z + v3.w * v3.w;
    const float rstd = rsqrtf(wave_sum(q) * (1.f / 1024.f) + EPS);
    const int mr = (fixed_row >= 0) ? fixed_row : (row / rows_per_b);
    const float* md = mod17 + (size_t)mr * 3072;
    bf16_t* pd = dst + (size_t)row * 1024;
#define MODST(V, J) { const int col = (lane + 64 * J) * 4; const float4 sh = *(const float4*)(md + col); const float4 sc = *(const float4*)(md + 1024 + col); \
      st_bf4(pd + col, V.x * rstd * (1.f + sc.x) + sh.x, V.y * rstd * (1.f + sc.y) + sh.y, V.z * rstd * (1.f + sc.z) + sh.z, V.w * rstd * (1.f + sc.w) + sh.w); }
    MODST(v0, 0) MODST(v1, 1) MODST(v2, 2) MODST(v3, 3)
#undef MODST
  }
}

__device__ __forceinline__ void phase2(const Params& p, char* smem) {
  char* ws = p.ws;
  const bf16_t* M0 = (const bf16_t*)(ws + OFF_M0); const bf16_t* MC = (const bf16_t*)(ws + OFF_MC);
  const bf16_t* WT = (const bf16_t*)(ws + OFF_WT_EIN);
  bf16_t* Q = (bf16_t*)(ws + OFF_Q); bf16_t* KA = (bf16_t*)(ws + OFF_KALL); bf16_t* VA = (bf16_t*)(ws + OFF_VALL);
  bf16_t* BU = (bf16_t*)(ws + OFF_BU); bf16_t* BV = (bf16_t*)(ws + OFF_BV); bf16_t* SG = (bf16_t*)(ws + OFF_SG);
  const float2* ROPE = (const float2*)(ws + OFF_ROPE);
  const int tid = tid_fresh(), wid = tid >> 6, lane = tid & 63, r32 = lane & 31, hi = lane >> 5, wm = wid >> 1, wn = wid & 1;
  const int lb = logical_block();
  for (int u = lb; u < 2816 + 32; u += gridDim.x) {
    const bool isctx = (u >= 2816);
    int mt, nt;
    if (!isctx) { mt = u / 22; nt = u % 22; } else { const int v = u - 2816; mt = v >> 1; nt = 4 + (v & 1); }
    const bf16_t* A = (isctx ? MC : M0) + (size_t)mt * 256 * 1024;
    f32x16 acc[2][4];
    gemm2(mkPlain(A, 1024), mkPlain(WT + (size_t)nt * 256 * 1024, 1024), 16, smem, acc);
    if (nt < 5) {
      const bool isq = nt < 4;
      const int head = isq ? (nt * 2 + wn) : wn;
      const float* gv = isq ? p.e_qn : p.e_kn;
#pragma unroll
      for (int mi = 0; mi < 2; ++mi) {
        float ss = 0.f;
#pragma unroll
        for (int nj = 0; nj < 4; ++nj)
#pragma unroll
          for (int r = 0; r < 16; ++r) ss += acc[mi][nj][r] * acc[mi][nj][r];
        ss += __shfl_xor(ss, 32);
        const float rstd = rsqrtf(ss * (1.f / 128.f) + EPS);
        const int row = wm * 64 + mi * 32 + r32;
        int t = 0;
        if (!isctx) t = (mt & 7) * 256 + row;
#pragma unroll
        for (int nj = 0; nj < 2; ++nj) {
          const int pos = (nj == 0) ? (t >> 6) : (t & 63);
#pragma unroll
          for (int q = 0; q < 4; ++q) {
            float o1[4], o2[4];
#pragma unroll
            for (int e = 0; e < 4; ++e) {
              const int r = 4 * q + e;
              const int i = 8 * q + 4 * hi + e;
              const int d = nj * 32 + i;
              const float x1 = acc[mi][nj][r] * rstd * gv[d];
              const float x2 = acc[mi][nj + 2][r] * rstd * gv[64 + d];
              if (!isctx) {
                const float2 cs = ROPE[pos * 32 + i];
                o1[e] = x1 * cs.x - x2 * cs.y; o2[e] = x2 * cs.x + x1 * cs.y;
              } else { o1[e] = x1; o2[e] = x2; }
            }
            const int d0 = nj * 32 + 8 * q + 4 * hi;
            { char* lp = smem + row * ET_S + (wn * 128 + d0) * 2;
              u32x2 w1 = {cvtpk(o1[0], o1[1]), cvtpk(o1[2], o1[3])}, w2 = {cvtpk(o2[0], o2[1]), cvtpk(o2[2], o2[3])};
              *(u32x2*)lp = w1; *(u32x2*)(lp + 128) = w2; }
          }
        }
      }
      {
        const int bb = mt >> 3, t0 = (mt & 7) * 256;
        bf16_t* tb; size_t tl;
        if (isq) { tb = Q + ((size_t)(bb * SEQ + t0) * 8 + nt * 2) * 128; tl = 1024; }
        else if (!isctx) { tb = KA + (size_t)(bb * SKV + CTXL + t0) * 256; tl = 256; }
        else { tb = KA + (size_t)mt * SKV * 256; tl = 256; }
        tile_flush_bf16(smem, tb, tl);
      }
    } else if (nt == 5) {
      const int bb = mt >> 3, t0 = (mt & 7) * 256;
      bf16_t* tb = isctx ? (VA + (size_t)mt * SKV * 256) : (VA + (size_t)(bb * SKV + CTXL + t0) * 256);
      epi2_store_lds(acc, smem, [&](int, int, float&, float&, float&, float&) {}, tb, 256);
    } else if (nt < 14) {
      bf16_t* dst = (nt < 10) ? (BU + (size_t)(nt - 6) * 256) : (BV + (size_t)(nt - 10) * 256);
      epi2_store_lds(acc, smem, [&](int, int, float& a, float& b, float& c, float& d) { a = gelu_tanh_f(a); b = gelu_tanh_f(b); c = gelu_tanh_f(c); d = gelu_tanh_f(d); },
                     dst + (size_t)mt * 256 * 1024, 1024);
    } else {
      bf16_t* dst = SG + (size_t)(nt - 14) * 256;
      epi2_store_lds(acc, smem, [&](int, int, float& a, float& b, float& c, float& d) { a = silu_f(a); b = silu_f(b); c = silu_f(c); d = silu_f(d); },
                     dst + (size_t)mt * 256 * 2048, 2048);
    }
  }
}

namespace att {
constexpr int D = 128, NW = 8, QBLK = 32, KVBLK = 64;
constexpr float SCALE = 0.088388347648318440f;
constexpr float THR = 8.f;
constexpr int LDQ = 1024, LDK = 256;
constexpr int SHM_V = KVBLK * D * 2, SHM_K = KVBLK * D * 2;
#define KSWZ(row, colB) ((row) * 256 + ((colB) ^ (((row) & 7) << 4)))
#define SBAR() __builtin_amdgcn_sched_barrier(0)
__device__ __forceinline__ void partialSM(f32x16& p0, f32x16& p1, float& m_reg, float& mn, float& alpha) {
  constexpr float C = SCALE * 1.4426950408889634f;
  float pmax = p0[0];
#pragma unroll
  for (int r = 1; r < 16; ++r) pmax = fmaxf(pmax, p0[r]);
#pragma unroll
  for (int r = 0; r < 16; ++r) pmax = fmaxf(pmax, p1[r]);
  { auto rr = __builtin_amdgcn_permlane32_swap(__float_as_uint(pmax), __float_as_uint(pmax), false, false);
    pmax = fmaxf(__uint_as_float(rr[0]), __uint_as_float(rr[1])); }
  if (__builtin_expect(__all(pmax - m_reg <= THR / SCALE), 1)) { mn = m_reg; alpha = 1.f; }
  else { mn = fmaxf(m_reg, pmax); alpha = __builtin_amdgcn_exp2f((m_reg - mn) * C); m_reg = mn; }
  const float mnC = -mn * C;
#pragma unroll
  for (int r = 0; r < 16; ++r) p0[r] = fmaf(p0[r], C, mnC);
#pragma unroll
  for (int r = 0; r < 16; ++r) p1[r] = fmaf(p1[r], C, mnC);
#pragma unroll
  for (int r = 0; r < 16; ++r) p0[r] = __builtin_amdgcn_exp2f(p0[r]);
}
__device__ __forceinline__ void finishSM(f32x16& p0, f32x16& p1, float alpha, float& l_reg, bf16x8& pa0, bf16x8& pa1, bf16x8& pa2, bf16x8& pa3) {
#pragma unroll
  for (int r = 0; r < 16; ++r) p1[r] = __builtin_amdgcn_exp2f(p1[r]);
  float ps = 0;
#pragma unroll
  for (int r = 0; r < 16; ++r) ps += p0[r];
#pragma unroll
  for (int r = 0; r < 16; ++r) ps += p1[r];
  { auto rr = __builtin_amdgcn_permlane32_swap(__float_as_uint(ps), __float_as_uint(ps), false, false);
    ps = __uint_as_float(rr[0]) + __uint_as_float(rr[1]); }
  l_reg = l_reg * alpha + ps;
#define PK4(P, BASE, OUT) do { unsigned a0 = cvtpk(P[BASE + 0], P[BASE + 1]), a1 = cvtpk(P[BASE + 2], P[BASE + 3]);   \
    unsigned b0 = cvtpk(P[BASE + 4], P[BASE + 5]), b1 = cvtpk(P[BASE + 6], P[BASE + 7]);                              \
    auto r0 = __builtin_amdgcn_permlane32_swap(a0, b0, false, false); auto r1 = __builtin_amdgcn_permlane32_swap(a1, b1, false, false); \
    u32x4 w = {r0[0], r1[0], r0[1], r1[1]}; OUT = *reinterpret_cast<bf16x8*>(&w); } while (0)
  PK4(p0, 0, pa0); PK4(p0, 8, pa1); PK4(p1, 0, pa2); PK4(p1, 8, pa3);
#undef PK4
}
__device__ __forceinline__ void qkt(f32x16& p0, f32x16& p1, const bf16_t* Ks, const bf16x8* qr, int r32, int hi) {
#pragma unroll
  for (int r = 0; r < 16; ++r) { p0[r] = 0.f; p1[r] = 0.f; }
#pragma unroll
  for (int d0 = 0; d0 < 8; ++d0) { const int cb = (d0 * 16 + hi * 8) * 2;
    bf16x8 b0 = *reinterpret_cast<const bf16x8*>((const char*)Ks + KSWZ(r32, cb));
    bf16x8 b1 = *reinterpret_cast<const bf16x8*>((const char*)Ks + KSWZ(32 + r32, cb));
    p0 = __builtin_amdgcn_mfma_f32_32x32x16_bf16(b0, qr[d0], p0, 0, 0, 0);
    p1 = __builtin_amdgcn_mfma_f32_32x32x16_bf16(b1, qr[d0], p1, 0, 0, 0); }
}
__device__ __forceinline__ int v_st(int k, int c) { const int kk = (k & ~0xC) | ((k & 4) << 1) | ((k & 8) >> 1); return ((kk >> 3) * 4 + (c >> 5)) * 512 + ((kk & 7) * 32 + (c & 31)) * 2; }
__device__ __forceinline__ int v_rd_base(int lane) { return ((lane & 3) << 3) | (((lane >> 2) & 3) << 6) | (((lane >> 4) & 1) << 5) | (((lane >> 5) & 1) << 8); }
constexpr int v_rd_off(int d0, int ks, int half) { return d0 * 512 + ks * 4096 + half * 2048; }
template <int OFF> __device__ __forceinline__ s16x4 tr_read(int vb) {
  s16x4 r; asm volatile("ds_read_b64_tr_b16 %0, %1 offset:%2" : "=&v"(r) : "v"(vb), "i"(OFF) : "memory"); return r;
}
template <int D0> __device__ __forceinline__ void pv_one(f32x16& od, int vb, bf16x8 pa0, bf16x8 pa1, bf16x8 pa2, bf16x8 pa3) {
  const s16x4 l0 = tr_read<v_rd_off(D0, 0, 0)>(vb), h0 = tr_read<v_rd_off(D0, 0, 1)>(vb), l1 = tr_read<v_rd_off(D0, 1, 0)>(vb), h1 = tr_read<v_rd_off(D0, 1, 1)>(vb);
  const s16x4 l2 = tr_read<v_rd_off(D0, 2, 0)>(vb), h2 = tr_read<v_rd_off(D0, 2, 1)>(vb), l3 = tr_read<v_rd_off(D0, 3, 0)>(vb), h3 = tr_read<v_rd_off(D0, 3, 1)>(vb);
  asm volatile("s_waitcnt lgkmcnt(0)" ::: "memory"); SBAR();
#define PK(L, H) (bf16x8){L[0], L[1], L[2], L[3], H[0], H[1], H[2], H[3]}
  od = __builtin_amdgcn_mfma_f32_32x32x16_bf16(pa0, PK(l0, h0), od, 0, 0, 0);
  od = __builtin_amdgcn_mfma_f32_32x32x16_bf16(pa1, PK(l1, h1), od, 0, 0, 0);
  od = __builtin_amdgcn_mfma_f32_32x32x16_bf16(pa2, PK(l2, h2), od, 0, 0, 0);
  od = __builtin_amdgcn_mfma_f32_32x32x16_bf16(pa3, PK(l3, h3), od, 0, 0, 0);
#undef PK
}
__device__ __forceinline__ void pv_d0(f32x16* o, int vb, bf16x8 pa0, bf16x8 pa1, bf16x8 pa2, bf16x8 pa3) {
  pv_one<0>(o[0], vb, pa0, pa1, pa2, pa3); pv_one<1>(o[1], vb, pa0, pa1, pa2, pa3); pv_one<2>(o[2], vb, pa0, pa1, pa2, pa3); pv_one<3>(o[3], vb, pa0, pa1, pa2, pa3);
}
__device__ __forceinline__ void attn_body(const bf16_t* __restrict__ Qb, const bf16_t* __restrict__ Kh, const bf16_t* __restrict__ Vh,
                                          bf16_t* GO, int seq, char* lds) {
  const int tid = tid_fresh(), wid = tid >> 6, lane = tid & 63, r32 = lane & 31, hi = lane >> 5;
  bf16_t* V_lds = (bf16_t*)lds; bf16_t* K_lds = (bf16_t*)(lds + 2 * SHM_V);
  float* wsx = (float*)(lds + 2 * SHM_V + 2 * SHM_K) + wid * 64; float* li_l = wsx; float* al_l = wsx + 32;
  float m_reg = -1e30f, l_reg = 0; f32x16 o[4]; bf16x8 qr[8];
#pragma unroll
  for (int d = 0; d < 4; ++d)
#pragma unroll
    for (int r = 0; r < 16; ++r) o[d][r] = 0.f;
  const bf16_t* Qw = Qb + (long)(wid * QBLK + r32) * LDQ + hi * 8;
#pragma unroll
  for (int d0 = 0; d0 < 8; ++d0) qr[d0] = *reinterpret_cast<const bf16x8*>(Qw + d0 * 16);
  const int sr = tid >> 4, sc = (tid & 15) * 8, vst0 = v_st(sr, sc), vst1 = v_st(32 + sr, sc);
  const int vb0 = (int)(uintptr_t)V_lds + v_rd_base(lane);
  constexpr int SDEPTH = 1;
  bf16x8 sv0[SDEPTH], sv1[SDEPTH], sk0[SDEPTH], sk1[SDEPTH];
#define SLOAD(i, k0) do { sv0[i] = *reinterpret_cast<const bf16x8*>(&Vh[(long)((k0) + sr) * LDK + sc]); sv1[i] = *reinterpret_cast<const bf16x8*>(&Vh[(long)((k0) + 32 + sr) * LDK + sc]); \
    sk0[i] = *reinterpret_cast<const bf16x8*>(&Kh[(long)((k0) + sr) * LDK + sc]); sk1[i] = *reinterpret_cast<const bf16x8*>(&Kh[(long)((k0) + 32 + sr) * LDK + sc]); } while (0)
#define SWRITE(b, i) do { *(bf16x8*)((char*)V_lds + (b) * SHM_V + vst0) = sv0[i];          \
    *(bf16x8*)((char*)V_lds + (b) * SHM_V + vst1) = sv1[i]; const int kc = sc * 2;               \
    *(bf16x8*)((char*)K_lds + (b) * SHM_K + KSWZ(sr, kc)) = sk0[i];                       \
    *(bf16x8*)((char*)K_lds + (b) * SHM_K + KSWZ(32 + sr, kc)) = sk1[i]; } while (0)
#define SWAIT() do { if (SDEPTH == 2) asm volatile("s_waitcnt vmcnt(4)" ::: "memory"); else asm volatile("s_waitcnt vmcnt(0)" ::: "memory"); } while (0)
#define RESC(a) do { if (__any((a) < 1.f)) { if (hi == 0) al_l[r32] = (a); asm volatile("s_waitcnt lgkmcnt(0)" ::: "memory"); \
    _Pragma("unroll") for (int d = 0; d < 4; ++d) _Pragma("unroll") for (int r = 0; r < 16; ++r) o[d][r] *= al_l[crow(r, hi)]; } } while (0)
  f32x16 pA0, pA1, pB0, pB1; float mnA, mnB, alA, alB; bf16x8 pa0, pa1, pa2, pa3; const int NT = seq / KVBLK;
  constexpr int SE = 0, SO = SDEPTH - 1;
  SLOAD(SE, 0); asm volatile("s_waitcnt vmcnt(0)" ::: "memory"); SWRITE(0, SE); __syncthreads();
  qkt(pA0, pA1, K_lds, qr, r32, hi); partialSM(pA0, pA1, m_reg, mnA, alA);
  SLOAD(SO, KVBLK); if (SDEPTH == 2) { if (2 < NT) SLOAD(SE, 2 * KVBLK); }
  SWAIT(); SWRITE(1, SO); __syncthreads();
  for (int j = 1; j + 1 < NT; j += 2) {
    SBAR(); qkt(pB0, pB1, (bf16_t*)((char*)K_lds + SHM_K), qr, r32, hi);
    finishSM(pA0, pA1, alA, l_reg, pa0, pa1, pa2, pa3); SBAR();
    SLOAD(SO, (j + SDEPTH) * KVBLK); SBAR();
    pv_d0(o, vb0, pa0, pa1, pa2, pa3); partialSM(pB0, pB1, m_reg, mnB, alB);
    __syncthreads(); SWAIT(); SWRITE(0, SE);
    RESC(alB); __syncthreads();
    SBAR(); qkt(pA0, pA1, K_lds, qr, r32, hi);
    finishSM(pB0, pB1, alB, l_reg, pa0, pa1, pa2, pa3); SBAR();
    if (SDEPTH == 1 || j + 3 < NT) SLOAD(SE, (j + 1 + SDEPTH) * KVBLK); SBAR();
    pv_d0(o, vb0 + (int)SHM_V, pa0, pa1, pa2, pa3); partialSM(pA0, pA1, m_reg, mnA, alA);
    __syncthreads(); SWAIT(); SWRITE(1, SO);
    RESC(alA); __syncthreads();
  }
  SBAR(); qkt(pB0, pB1, (bf16_t*)((char*)K_lds + SHM_K), qr, r32, hi);
  finishSM(pA0, pA1, alA, l_reg, pa0, pa1, pa2, pa3); SBAR();
  pv_d0(o, vb0, pa0, pa1, pa2, pa3); partialSM(pB0, pB1, m_reg, mnB, alB);
  __syncthreads(); RESC(alB);
  finishSM(pB0, pB1, alB, l_reg, pa0, pa1, pa2, pa3); SBAR();
  pv_d0(o, vb0 + (int)SHM_V, pa0, pa1, pa2, pa3);
  if (hi == 0) li_l[r32] = l_reg; asm volatile("s_waitcnt lgkmcnt(0)" ::: "memory");
  float rli[16];
#pragma unroll
  for (int r = 0; r < 16; ++r) rli[r] = __builtin_amdgcn_rcpf(li_l[crow(r, hi)]);
  bf16_t* Ow = GO + (long)(wid * QBLK) * 2048;
#pragma unroll
  for (int r = 0; r < 16; ++r) { const int orow = crow(r, hi);
#pragma unroll
    for (int d0 = 0; d0 < 4; ++d0) { bf16_t* q = Ow + (long)orow * 2048 + d0 * 32 + r32; *q = f2bf(o[d0][r] * rli[r] * bf2f(*q)); }
    SBAR(); }
  __syncthreads();
#undef SLOAD
#undef SWRITE
#undef SWAIT
#undef RESC
}
}

__device__ __forceinline__ void chunk_gate_unit(const Params& p, int b, int n, char* smem) {
  char* ws = p.ws;
  const bf16_t* BU = (const bf16_t*)(ws + OFF_BU); const bf16_t* BV = (const bf16_t*)(ws + OFF_BV);
  bf16_t* SG = (bf16_t*)(ws + OFF_SG); const bf16_t* WSB = (const bf16_t*)(ws + OFF_WSB);
  const int tid = tid_fresh(), wid = tid >> 6, lane = tid & 63, r32 = lane & 31, hi = lane >> 5;
  constexpr int RS = 272;
  char* sW = smem; char* sV = smem + 128 * RS;
  float* smu = (float*)(smem + 2 * 128 * RS); float* srs = smu + 128;
  const size_t tok0 = (size_t)b * SEQ + (size_t)n * 128;
  {
    const int q = tid >> 2, part = tid & 3;
    const u32x4* src = (const u32x4*)(BV + (tok0 + q) * 1024 + part * 256);
    float s = 0.f, s2 = 0.f;
#pragma unroll 4
    for (int i = 0; i < 32; ++i) {
      const u32x4 w = src[i];
#pragma unroll
      for (int e = 0; e < 4; ++e) { const float a = bf_lo(w[e]), c = bf_hi(w[e]); s += a + c; s2 += a * a + c * c; }
    }
    s += __shfl_xor(s, 1); s2 += __shfl_xor(s2, 1); s += __shfl_xor(s, 2); s2 += __shfl_xor(s2, 2);
    const float mu = s * (1.f / 1024.f);
    const float var = fmaxf(s2 * (1.f / 1024.f) - mu * mu, 0.f);
    if (part == 0) { smu[q] = mu; srs[q] = rsqrtf(var + EPS); }
  }
  __syncthreads();
  const int wp = wid >> 1, wc = wid & 1;
  for (int g = 0; g < 8; ++g) {
#pragma unroll
    for (int i = 0; i < 4; ++i) {
      const int id = tid + 512 * i, row = id >> 4, ck = (id & 15) * 8;
      *(u32x4*)(sW + row * RS + ck * 2) = *(const u32x4*)(WSB + (size_t)g * 16384 + row * 128 + ck);
    }
#pragma unroll
    for (int i = 0; i < 4; ++i) {
      const int id = tid + 512 * i, q = id & 127, cc = (id >> 7) * 8;
      const u32x4 w = *(const u32x4*)(BV + (tok0 + q) * 1024 + g * 128 + cc);
      const float mu = smu[q], rs = srs[q];
      const float* lg = p.e_vg + g * 128 + cc; const float* lbp = p.e_vb + g * 128 + cc;
#pragma unroll
      for (int e = 0; e < 4; ++e) {
        const float a = (bf_lo(w[e]) - mu) * rs * lg[2 * e] + lbp[2 * e];
        const float c = (bf_hi(w[e]) - mu) * rs * lg[2 * e + 1] + lbp[2 * e + 1];
        *(bf16_t*)(sV + (cc + 2 * e) * RS + q * 2) = f2bf(a);
        *(bf16_t*)(sV + (cc + 2 * e + 1) * RS + q * 2) = f2bf(c);
      }
    }
    __syncthreads();
    f32x16 acc0, acc1;
#pragma unroll
    for (int r = 0; r < 16; ++r) { acc0[r] = 0.f; acc1[r] = 0.f; }
#pragma unroll
    for (int kk = 0; kk < 8; ++kk) {
      const bf16x8 af = *(const bf16x8*)(sW + (wp * 32 + r32) * RS + kk * 32 + hi * 16);
      const bf16x8 b0 = *(const bf16x8*)(sV + (wc * 64 + r32) * RS + kk * 32 + hi * 16);
      const bf16x8 b1 = *(const bf16x8*)(sV + (wc * 64 + 32 + r32) * RS + kk * 32 + hi * 16);
      acc0 = __builtin_amdgcn_mfma_f32_32x32x16_bf16(b0, af, acc0, 0, 0, 0);
      acc1 = __builtin_amdgcn_mfma_f32_32x32x16_bf16(b1, af, acc1, 0, 0, 0);
    }
    const int pr = wp * 32 + r32;
    const float bias = p.e_bs[g * 128 + pr];
    const size_t tok = tok0 + pr;
#pragma unroll
    for (int nj = 0; nj < 2; ++nj)
#pragma unroll
      for (int q = 0; q < 4; ++q) {
        const int col = g * 128 + wc * 64 + nj * 32 + q * 8 + hi * 4;
        const u32x2 bu = *(const u32x2*)(BU + tok * 1024 + col);
        bf16_t* gp = SG + tok * 2048 + 1024 + col;
        const u32x2 sg = *(const u32x2*)gp;
        const float m0 = (nj ? acc1[4 * q + 0] : acc0[4 * q + 0]) + bias, m1 = (nj ? acc1[4 * q + 1] : acc0[4 * q + 1]) + bias;
        const float m2 = (nj ? acc1[4 * q + 2] : acc0[4 * q + 2]) + bias, m3 = (nj ? acc1[4 * q + 3] : acc0[4 * q + 3]) + bias;
        st_bf4(gp, bf_lo(bu[0]) * m0 * bf_lo(sg[0]), bf_hi(bu[0]) * m1 * bf_hi(sg[0]), bf_lo(bu[1]) * m2 * bf_lo(sg[1]), bf_hi(bu[1]) * m3 * bf_hi(sg[1]));
      }
    __syncthreads();
  }
}

__device__ __forceinline__ void post_ln_rows(const float* resid, const bf16_t* yg, float* dst, const float* pg, const float* pb, bf16_t* m1, const float* mod17) {
  const int tid = tid_fresh(), wid = tid >> 6, lane = tid & 63;
  const int gw = blockIdx.x * 8 + wid, nw = gridDim.x * 8;
  float4 nx[4]; u32x2 ny[4];
  { const float4* ps = (const float4*)(resid + (size_t)gw * 1024); const u32x2* py = (const u32x2*)(yg + (size_t)gw * 1024);
#pragma unroll
    for (int j = 0; j < 4; ++j) { nx[j] = ps[lane + 64 * j]; ny[j] = py[lane + 64 * j]; } }
  for (int row = gw; row < NTOK; row += nw) {
    float4 v[4];
#pragma unroll
    for (int j = 0; j < 4; ++j) {
      v[j].x = ALPHA * nx[j].x + bf_lo(ny[j][0]); v[j].y = ALPHA * nx[j].y + bf_hi(ny[j][0]);
      v[j].z = ALPHA * nx[j].z + bf_lo(ny[j][1]); v[j].w = ALPHA * nx[j].w + bf_hi(ny[j][1]);
    }
    { const int nr = (row + nw < NTOK) ? row + nw : row;
      const float4* ps = (const float4*)(resid + (size_t)nr * 1024); const u32x2* py = (const u32x2*)(yg + (size_t)nr * 1024);
#pragma unroll
      for (int j = 0; j < 4; ++j) { nx[j] = ps[lane + 64 * j]; ny[j] = py[lane + 64 * j]; } }
    float s = 0.f;
#pragma unroll
    for (int j = 0; j < 4; ++j) s += v[j].x + v[j].y + v[j].z + v[j].w;
    float mu = wave_sum(s) * (1.f / 1024.f);
    float q = 0.f;
#pragma unroll
    for (int j = 0; j < 4; ++j) { v[j].x -= mu; v[j].y -= mu; v[j].z -= mu; v[j].w -= mu; q += v[j].x * v[j].x + v[j].y * v[j].y + v[j].z * v[j].z + v[j].w * v[j].w; }
    float rstd = rsqrtf(wave_sum(q) * (1.f / 1024.f) + EPS);
    float4* pd = (float4*)(dst + (size_t)row * 1024);
    s = 0.f;
#pragma unroll
    for (int j = 0; j < 4; ++j) {
      const int col = (lane + 64 * j) * 4;
      const float4 g4 = *(const float4*)(pg + col), b4 = *(const float4*)(pb + col);
      v[j].x = v[j].x * rstd * g4.x + b4.x; v[j].y = v[j].y * rstd * g4.y + b4.y; v[j].z = v[j].z * rstd * g4.z + b4.z; v[j].w = v[j].w * rstd * g4.w + b4.w;
      pd[lane + 64 * j] = v[j];
      s += v[j].x + v[j].y + v[j].z + v[j].w;
    }
    if (m1) {
      mu = wave_sum(s) * (1.f / 1024.f);
      q = 0.f;
#pragma unroll
      for (int j = 0; j < 4; ++j) { v[j].x -= mu; v[j].y -= mu; v[j].z -= mu; v[j].w -= mu; q += v[j].x * v[j].x + v[j].y * v[j].y + v[j].z * v[j].z + v[j].w * v[j].w; }
      rstd = rsqrtf(wave_sum(q) * (1.f / 1024.f) + EPS);
      const float* md = mod17 + (size_t)(row >> 11) * 3072;
      bf16_t* pm = m1 + (size_t)row * 1024;
#pragma unroll
      for (int j = 0; j < 4; ++j) {
        const int col = (lane + 64 * j) * 4;
        const float4 sh = *(const float4*)(md + col), sc = *(const float4*)(md + 1024 + col);
        st_bf4(pm + col, v[j].x * rstd * (1.f + sc.x) + sh.x, v[j].y * rstd * (1.f + sc.y) + sh.y, v[j].z * rstd * (1.f + sc.z) + sh.z, v[j].w * rstd * (1.f + sc.w) + sh.w);
      }
    }
  }
}

__device__ __forceinline__ void out_proj(const bf16_t* A, const bf16_t* WT, const float* gate17, bf16_t* dst, char* smem) {
  const int lb = logical_block();
  for (int u = lb; u < 512; u += gridDim.x) {
    const int mt = u >> 2, nt = u & 3;
    f32x16 acc[2][4];
    gemm2(mkPlain(A + (size_t)mt * 256 * 2048, 2048), mkPlain(WT + (size_t)nt * 256 * 2048, 2048), 32, smem, acc);
    const float* gt = gate17 + (size_t)(mt >> 3) * 3072 + 2048 + nt * 256;
    epi2_store_lds(acc, smem, [&](int, int col, float& a, float& b, float& c, float& d) {
      const float4 g4 = *(const float4*)(gt + col);
      a *= g4.x; b *= g4.y; c *= g4.z; d *= g4.w;
    }, dst + (size_t)mt * 256 * 1024 + nt * 256, 1024);
  }
}

#define XB_TMO      128
#define XB_XCNT(j)  (256  + 64 * (j))
#define XB_XSUB(j)  (1280 + 64 * (j))
#define XB_XGEN(j)  (2304 + 64 * (j))
#define XB_TOP      3328
#define XB_TOPGEN   3392
#define XCD_BAR_WORDS 3456
#define XB_SPIN_CAP (1u << 18)
#define LAS __attribute__((address_space(3)))

__device__ __forceinline__ unsigned xb_ld(unsigned* p)              { return __hip_atomic_load(p, __ATOMIC_RELAXED, __HIP_MEMORY_SCOPE_AGENT); }
__device__ __forceinline__ unsigned xb_add(unsigned* p, unsigned v) { return __hip_atomic_fetch_add(p, v, __ATOMIC_RELAXED, __HIP_MEMORY_SCOPE_AGENT); }
__device__ __forceinline__ unsigned xb_xcc_id() { return (unsigned)__builtin_amdgcn_s_getreg((3 << 11) | 20) & 0xFu; }
#define XB_SPIN(cond, bar) do { unsigned _sp = 0; while (cond) { __builtin_amdgcn_s_sleep(1); \
    if ((++_sp & 255u) == 0u) { if (xb_ld(&(bar)[XB_TMO])) break; if (_sp > XB_SPIN_CAP) { atomicAdd(&(bar)[XB_TMO], 1u); break; } } } } while (0)

struct XcdBarrier {
    unsigned* bar; unsigned x;
    volatile LAS unsigned* st;
};

__device__ __forceinline__ XcdBarrier xcd_barrier_post(unsigned* bar, volatile LAS unsigned* st) {
    XcdBarrier b; b.bar = bar; b.x = xb_xcc_id(); b.st = st;
    if (threadIdx.x == 0) (void)xb_add(&bar[XB_XCNT(b.x)], 1u);
    return b;
}
__device__ __forceinline__ void xcd_barrier_complete(unsigned* bar, unsigned x, unsigned& nloc, unsigned& nx) {
    const unsigned G = gridDim.x * gridDim.y * gridDim.z;
    unsigned sum, cnt, mine, sp = 0u;
    for (;;) {
        sum = 0u; cnt = 0u; mine = 0u;
#pragma unroll
        for (unsigned j = 0; j < 16; ++j) { const unsigned c = xb_ld(&bar[XB_XCNT(j)]); sum += c; cnt += (c > 0u) ? 1u : 0u; mine = (j == x) ? c : mine; }
        if (sum == G) break;
        __builtin_amdgcn_s_sleep(1);
        if ((++sp & 255u) == 0u) { if (xb_ld(&bar[XB_TMO])) break; if (sp > XB_SPIN_CAP) { atomicAdd(&bar[XB_TMO], 1u); break; } }
    }
    nloc = mine > 0u ? mine : 1u; nx = cnt > 0u ? cnt : 1u;
}

__device__ __forceinline__ void xcd_barrier(const XcdBarrier& b) {
    asm volatile("s_waitcnt vmcnt(0)" ::: "memory");
    __syncthreads();
    if (threadIdx.x == 0) {
        unsigned* bar = b.bar;
        __builtin_amdgcn_s_waitcnt(0);
        unsigned nloc = b.st[0], nx = b.st[1];
        if (nloc == 0u) { xcd_barrier_complete(bar, b.x, nloc, nx); b.st[0] = nloc; b.st[1] = nx; }
        const unsigned old = xb_add(&bar[XB_XSUB(b.x)], 1u);
        const unsigned gen = old / nloc;
        if (old + 1u == (gen + 1u) * nloc) {
            __builtin_amdgcn_fence(__ATOMIC_RELEASE, "agent");
            asm volatile("s_waitcnt vmcnt(0)" ::: "memory");
            const unsigned og = xb_add(&bar[XB_TOP], 1u);
            const unsigned tg = og / nx;
            if (og + 1u == (tg + 1u) * nx) xb_add(&bar[XB_TOPGEN], 1u);
            else XB_SPIN(xb_ld(&bar[XB_TOPGEN]) == tg, bar);
            __builtin_amdgcn_fence(__ATOMIC_ACQUIRE, "agent");
            xb_add(&bar[XB_XGEN(b.x)], 1u);
            asm volatile("s_waitcnt vmcnt(0)" ::: "memory");
        } else {
            XB_SPIN(xb_ld(&bar[XB_XGEN(b.x)]) == gen, bar);
            __builtin_amdgcn_fence(__ATOMIC_ACQUIRE, "agent");
            asm volatile("s_waitcnt vmcnt(0)" ::: "memory");
        }
    }
    __syncthreads();
}


constexpr size_t OFF_XBAR = OFF_SMALL + 1536 * 1024;
constexpr size_t OFF_PX = OFF_SMALL + 1152 * 1024;
#define GSYNC_CG() do { __threadfence(); grid.sync(); __threadfence(); } while (0)
#define GSYNC() xcd_barrier(xbar)
#ifndef LAUNCH_SPLITS
#define LAUNCH_SPLITS {{0,0},{1,1},{2,2},{3,3},{4,4},{5,5},{6,6},{7,7},{8,8},{9,9},{10,10}}
#endif
template <int PLO, int PHI>
__global__ void __launch_bounds__(512) mega(Params p) {
  cg::grid_group grid = cg::this_grid();
  __shared__ __attribute__((aligned(16))) char smem[SMEM_BYTES];
  char* ws = p.ws;
  float* MOD = (float*)(ws + OFF_MOD);
  const int lb = logical_block();
  volatile LAS unsigned* xst = (volatile LAS unsigned*)(smem + LDS_RED + 2048);
  if (tid_fresh() < 4) xst[tid_fresh()] = 0u;
  __syncthreads();
  XcdBarrier xbar = xcd_barrier_post((unsigned*)(ws + OFF_XBAR), xst);
  if (PLO < PHI) grid.sync();

  if (PLO <= 0 && 0 <= PHI) {
  phase0(p, smem);
  }
  if (PLO <= 0 && 0 < PHI) { GSYNC(); }
  if (PLO <= 1 && 1 <= PHI) {

  ln_rows_modulate(p.x, (bf16_t*)(ws + OFF_M0), NTOK, SEQ, MOD, -1);
  ln_rows_modulate(p.ctx, (bf16_t*)(ws + OFF_MC), NCTX, CTXL, MOD, 16);
  }
  if (PLO <= 1 && 1 < PHI) { GSYNC(); }
  if (PLO <= 2 && 2 <= PHI) {

  phase2(p, smem);
  }
  if (PLO <= 2 && 2 < PHI) { GSYNC(); }
  if (PLO <= 3 && 3 <= PHI) {

  for (int u = lb; u < 1024; u += gridDim.x) {
      const int grp = u >> 5, j = u & 31, b = grp >> 1, kvh = grp & 1, hq = kvh * 4 + (j >> 3), qb = j & 7;
      const bf16_t* Qb = (const bf16_t*)(ws + OFF_Q) + ((size_t)(b * SEQ + qb * 256) * 8 + hq) * 128;
      const bf16_t* Kh = (const bf16_t*)(ws + OFF_KALL) + ((size_t)b * SKV * 2 + kvh) * 128;
      const bf16_t* Vh = (const bf16_t*)(ws + OFF_VALL) + ((size_t)b * SKV * 2 + kvh) * 128;
      bf16_t* GO = (bf16_t*)(ws + OFF_SG) + (size_t)(b * SEQ + qb * 256) * 2048 + hq * 128;
      att::attn_body(Qb, Kh, Vh, GO, SKV, smem);
  }
  for (int v = lb; v < 256; v += gridDim.x) chunk_gate_unit(p, v >> 4, v & 15, smem);
  }
  if (PLO <= 3 && 3 < PHI) { GSYNC(); }
  if (PLO <= 4 && 4 <= PHI) {

  out_proj((const bf16_t*)(ws + OFF_SG), (const bf16_t*)(ws + OFF_WT_EOUT), MOD, (bf16_t*)(ws + OFF_YG), smem);
  }
  if (PLO <= 4 && 4 < PHI) { GSYNC(); }
  if (PLO <= 5 && 5 <= PHI) {

  post_ln_rows(p.x, (const bf16_t*)(ws + OFF_YG), (float*)(ws + OFF_Q), p.post_g, p.post_b, (bf16_t*)(ws + OFF_M0), MOD + 17 * 3072);
  }
  if (PLO <= 5 && 5 < PHI) { GSYNC(); }
  if (PLO <= 6 && 6 <= PHI) {

  {
    const bf16_t* M1 = (const bf16_t*)(ws + OFF_M0); const bf16_t* WT = (const bf16_t*)(ws + OFF_WT_OIN);
    bf16_t* F = (bf16_t*)(ws + OFF_F); bf16_t* RV = (bf16_t*)(ws + OFF_RV); bf16_t* XM = (bf16_t*)(ws + OFF_XM);
    bf16_t* SG1 = (bf16_t*)(ws + OFF_SG);
    for (int u = lb; u < 2048; u += gridDim.x) {
      f32x16 acc[2][4];
      if (u < 1024) {
        const int tt = u >> 3, ct = u & 7, b = tt >> 3, t0 = (tt & 7) * 256;
        gemm2(mkPlain(WT + (size_t)ct * 256 * 1024, 1024), mkPlain(M1 + (size_t)tt * 256 * 1024, 1024), 16, smem, acc);
        const size_t rbase = ((size_t)b * 2048 + ct * 256) * 1024;
        if (t0 < 1024) {
          epi2_store_lds(acc, smem, [&](int, int, float&, float&, float&, float&) {}, F + rbase + t0, 1024);
          if (t0 == 0 && tid_fresh() < 256) RV[rbase + (size_t)tid_fresh() * 1024] = 0;
        } else {
          const int P0 = 1792 - t0;
          epi2_foreach(acc, [&](int row, int col, float a, float bq, float c, float d) {
            char* lr = smem + row * ET_S;
            if (col == 0) {
              const bf16_t v0 = f2bf(a);
              if (t0 == 1024) XM[(size_t)b * 2048 + ct * 256 + row] = v0; else RV[rbase + (size_t)row * 1024 + P0 + 256] = v0;
            } else *(bf16_t*)(lr + (256 - col) * 2) = f2bf(a);
            *(bf16_t*)(lr + (255 - col) * 2) = f2bf(bq); *(bf16_t*)(lr + (254 - col) * 2) = f2bf(c); *(bf16_t*)(lr + (253 - col) * 2) = f2bf(d);
          });
          __syncthreads();
          {
            const int tid = tid_fresh();
#pragma unroll
            for (int i = 0; i < 16; ++i) {
              const int id = tid + 512 * i, row = id >> 5, ck = id & 31;
              bf16_t* gp = RV + rbase + (size_t)row * 1024 + P0 + ck * 8;
              const char* lp = smem + row * ET_S + ck * 16;
              if (ck) *(u32x4*)gp = *(const u32x4*)lp;
              else {
#pragma unroll
                for (int e = 1; e < 8; ++e) gp[e] = *(const bf16_t*)(lp + e * 2);
              }
            }
          }
          __syncthreads();
        }
      } else {
        const int v = u - 1024, mt = v >> 3, nt = v & 7;
        gemm2(mkPlain(M1 + (size_t)mt * 256 * 1024, 1024), mkPlain(WT + (size_t)(2048 + nt * 256) * 1024, 1024), 16, smem, acc);
        epi2_store_lds(acc, smem, [&](int, int, float& a, float& bq, float& c, float& d) { a = silu_f(a); bq = silu_f(bq); c = silu_f(c); d = silu_f(d); },
                       SG1 + (size_t)mt * 256 * 2048 + nt * 256, 2048);
      }
    }
  }
  }
  if (PLO <= 6 && 6 < PHI) { GSYNC(); }
  if (PLO <= 7 && 7 <= PHI) {

  {
    bf16_t* EE = (bf16_t*)p.out + (size_t)32 * MiB;
    bf16_t* EO = EE + (size_t)16 * MiB;
    bf16_t* OE = (bf16_t*)(ws + OFF_M0); bf16_t* OO = OE + (size_t)16 * MiB;
    float* PX = (float*)(ws + OFF_PX); float* E512 = PX + 32768; float* O512 = PX + 65536;
    {
      const int tid = tid_fresh(), wid = tid >> 6, lane = tid & 63;
      const int gw = blockIdx.x * 8 + wid, nw = gridDim.x * 8;
      const bf16_t* XMr = (const bf16_t*)(ws + OFF_XM);
      u32x4 na0, na1, nb0, nb1;
      { const size_t ro = (size_t)gw * 128; const u32x4* Fr = (const u32x4*)(ws + OFF_F) + ro; const u32x4* Rr = (const u32x4*)(ws + OFF_RV) + ro;
        na0 = Fr[lane]; na1 = Fr[lane + 64]; nb0 = Rr[lane]; nb1 = Rr[lane + 64]; }
      const int src1 = 63 - lane, src0 = (64 - lane) & 63;
      for (int row = gw; row < 16 * 2048; row += nw) {
        const u32x4 a0 = na0, a1 = na1, b0 = nb0, b1 = nb1;
        { const int nr = (row + nw < 16 * 2048) ? row + nw : row; const size_t ro = (size_t)nr * 128;
          const u32x4* Fr = (const u32x4*)(ws + OFF_F) + ro; const u32x4* Rr = (const u32x4*)(ws + OFF_RV) + ro;
          na0 = Fr[lane]; na1 = Fr[lane + 64]; nb0 = Rr[lane]; nb1 = Rr[lane + 64]; }
        float e1[8], o1[8], e2[8], o2[8];
#pragma unroll
        for (int k = 0; k < 4; ++k) {
          { const float al = bf_lo(a0[k]), ah = bf_hi(a0[k]), bl = bf_lo(b0[k]), bh = bf_hi(b0[k]);
            e1[2 * k] = al + bl; e1[2 * k + 1] = ah + bh; o1[2 * k] = al - bl; o1[2 * k + 1] = ah - bh; }
          { const float al = bf_lo(a1[k]), ah = bf_hi(a1[k]), bl = bf_lo(b1[k]), bh = bf_hi(b1[k]);
            e2[2 * k] = al + bl; e2[2 * k + 1] = ah + bh; o2[2 * k] = al - bl; o2[2 * k + 1] = ah - bh; }
        }
        float alt = 0.f;
#pragma unroll
        for (int j = 0; j < 8; j += 2) alt += (e1[j] - e1[j + 1]) + (e2[j] - e2[j + 1]);
        float me[8], mo[8];
        me[0] = __shfl(e2[0], src0); mo[0] = __shfl(o2[0], src0);
        if (lane == 0) { me[0] = 0.f; mo[0] = 0.f; }
#pragma unroll
        for (int j = 1; j < 8; ++j) { me[j] = __shfl(e2[8 - j], src1); mo[j] = __shfl(o2[8 - j], src1); }
        u32x4 wee, weo, woe, woo;
#pragma unroll
        for (int k = 0; k < 4; ++k) {
          wee[k] = cvtpk(e1[2 * k] + me[2 * k], e1[2 * k + 1] + me[2 * k + 1]);
          weo[k] = cvtpk(e1[2 * k] - me[2 * k], e1[2 * k + 1] - me[2 * k + 1]);
          woe[k] = cvtpk(o1[2 * k] - mo[2 * k], o1[2 * k + 1] - mo[2 * k + 1]);
          woo[k] = cvtpk(o1[2 * k] + mo[2 * k], o1[2 * k + 1] + mo[2 * k + 1]);
        }
        const size_t wo = (size_t)row * 64 + lane;
        ((u32x4*)EE)[wo] = wee; ((u32x4*)EO)[wo] = weo; ((u32x4*)OE)[wo] = woe; ((u32x4*)OO)[wo] = woo;
        alt = wave_sum(alt);
        if (lane == 0) { PX[row] = alt + bf2f(XMr[row]); E512[row] = e2[0]; O512[row] = o2[0]; }
      }
    }
    if (PLO < PHI) { GSYNC(); }
    const bf16_t* XM = (const bf16_t*)(ws + OFF_XM);
    const bf16_t* TAB = (const bf16_t*)(ws + OFF_TAB_C);
    bf16_t* PC = (bf16_t*)p.out; bf16_t* PS = (bf16_t*)(ws + OFF_F);
    for (int u = lb; u < 1024; u += gridDim.x) {
      f32x16 acc[2][4];
      const int ty = u >> 8, v = u & 255, b = v >> 4, mt = (v >> 3) & 1, nt = v & 7;
      const bf16_t* Bsrc = (ty == 0) ? EE : (ty == 1) ? EO : (ty == 2) ? OE : OO;
      gemm2(mkPlain(TAB + (size_t)ty * 512 * 512 + (size_t)mt * 256 * 512, 512), mkPlain(Bsrc + ((size_t)b * 2048 + nt * 256) * 512, 512), 8, smem, acc);
      bf16_t* dstP = (ty < 2) ? PC : PS;
      const int par = ty & 1;
      epi2_store_lds(acc, smem, [&](int row, int col, float& a, float& bq, float& c, float& d) {
        const int sidx = mt * 256 + row, ch = nt * 256 + col;
        const size_t vi = (size_t)b * 2048 + ch;
        const float sg = (sidx & 1) ? -1.f : 1.f;
        if (ty == 0) {
          const u32x2 xm = *(const u32x2*)(XM + vi); const float4 em = *(const float4*)(E512 + vi);
          a += sg * em.x + bf_lo(xm[0]); bq += sg * em.y + bf_hi(xm[0]); c += sg * em.z + bf_lo(xm[1]); d += sg * em.w + bf_hi(xm[1]);
        } else if (ty == 1) {
          const u32x2 xm = *(const u32x2*)(XM + vi);
          a -= bf_lo(xm[0]); bq -= bf_hi(xm[0]); c -= bf_lo(xm[1]); d -= bf_hi(xm[1]);
        } else if (ty == 3) {
          const float4 om = *(const float4*)(O512 + vi);
          a += sg * om.x; bq += sg * om.y; c += sg * om.z; d += sg * om.w;
        }
      }, dstP + ((size_t)b * 1024 + 2 * (mt * 256) + par) * 2048 + nt * 256, 4096);
    }
  }
  }
  if (PLO <= 7 && 7 < PHI) { GSYNC(); }
  if (PLO <= 8 && 8 <= PHI) {

  {
    const bf16_t* PC = (const bf16_t*)p.out; const bf16_t* PS = (const bf16_t*)(ws + OFF_F);
    const bf16_t* CDP = (const bf16_t*)(ws + OFF_CDP);
    bf16_t* SG1 = (bf16_t*)(ws + OFF_SG);
    const int tid = tid_fresh(), wid = tid >> 6, lane = tid & 63, r32 = lane & 31, hi = lane >> 5, wm = wid >> 1, wn = wid & 1;
    constexpr int TBS = 528;
    constexpr int TB_BYTES = 128 * TBS;
    char* sT = smem; char* sA = smem + TB_BYTES;
#pragma unroll
    for (int i = 0; i < 8; ++i) {
      const int id = tid + 512 * i, row = id >> 5, ck = id & 31;
      *(u32x4*)(sT + row * TBS + ck * 16) = *(const u32x4*)(CDP + row * 256 + ck * 8);
    }
    const int st_off = (tid >> 3) * LDS_ROWB + (tid & 7) * 16;
    const int a_rd = (wm * 64 + r32) * LDS_ROWB + hi * 16;
    const int b_rd = (wn * 32 + r32) * TBS + hi * 16;
    const size_t rowoff = (size_t)(tid >> 3) * 2048 + (tid & 7) * 8;
    u32x4 r00, r01, r02, r03, r10, r11, r12, r13, r20, r21, r22, r23, r30, r31, r32_, r33;
    auto a_base = [&](int u_, int s_) -> const bf16_t* {
      const int b_ = u_ >> 6, j_ = (u_ >> 4) & 3, G_ = u_ & 15;
      return ((s_ < 2) ? PC : PS) + ((size_t)b_ * 1024 + j_ * 256) * 2048 + G_ * 128 + (s_ & 1) * 64 + rowoff;
    };
#define P8_LOAD(S, U, A, B, C, D) do { const bf16_t* q_ = a_base((U), (S)); A = *(const u32x4*)(q_); B = *(const u32x4*)(q_ + (size_t)64 * 2048); \
      C = *(const u32x4*)(q_ + (size_t)128 * 2048); D = *(const u32x4*)(q_ + (size_t)192 * 2048); } while (0)
#define P8_WRITE(ST, A, B, C, D) do { char* s_ = sA + (ST) * L2_A + st_off; *(u32x4*)(s_) = A; *(u32x4*)(s_ + 64 * LDS_ROWB) = B; \
      *(u32x4*)(s_ + 128 * LDS_ROWB) = C; *(u32x4*)(s_ + 192 * LDS_ROWB) = D; } while (0)
#define P8_COMPUTE(ST, S, ACC) do { const char* sb_ = sA + (ST) * L2_A;                                              \
      _Pragma("unroll") for (int kk = 0; kk < 4; ++kk) {                                                               \
        const bf16x8 fa0 = *(const bf16x8*)(sb_ + a_rd + kk * 32);                                                      \
        const bf16x8 fa1 = *(const bf16x8*)(sb_ + a_rd + 32 * LDS_ROWB + kk * 32);                                      \
        const bf16x8 fb0 = *(const bf16x8*)(sT + b_rd + ((S) * 64 + kk * 16) * 2);                                      \
        const bf16x8 fb1 = *(const bf16x8*)(sT + b_rd + 64 * TBS + ((S) * 64 + kk * 16) * 2);                           \
        ACC[0][0] = __builtin_amdgcn_mfma_f32_32x32x16_bf16(fb0, fa0, ACC[0][0], 0, 0, 0);                              \
        ACC[0][1] = __builtin_amdgcn_mfma_f32_32x32x16_bf16(fb1, fa0, ACC[0][1], 0, 0, 0);                              \
        ACC[1][0] = __builtin_amdgcn_mfma_f32_32x32x16_bf16(fb0, fa1, ACC[1][0], 0, 0, 0);                              \
        ACC[1][1] = __builtin_amdgcn_mfma_f32_32x32x16_bf16(fb1, fa1, ACC[1][1], 0, 0, 0);                              \
      } } while (0)
    P8_LOAD(0, lb, r00, r01, r02, r03); P8_LOAD(1, lb, r10, r11, r12, r13); P8_LOAD(2, lb, r20, r21, r22, r23); P8_LOAD(3, lb, r30, r31, r32_, r33);
    for (int u = lb; u < 1024; u += gridDim.x) {
      const int un = (u + (int)gridDim.x < 1024) ? u + (int)gridDim.x : u;
      f32x16 acc1[2][2], acc2[2][2];
#pragma unroll
      for (int mi = 0; mi < 2; ++mi)
#pragma unroll
        for (int nj = 0; nj < 2; ++nj)
#pragma unroll
          for (int r = 0; r < 16; ++r) { acc1[mi][nj][r] = 0.f; acc2[mi][nj][r] = 0.f; }
      P8_WRITE(0, r00, r01, r02, r03); __syncthreads(); P8_LOAD(0, un, r00, r01, r02, r03); P8_COMPUTE(0, 0, acc1);
      P8_WRITE(1, r10, r11, r12, r13); __syncthreads(); P8_LOAD(1, un, r10, r11, r12, r13); P8_COMPUTE(1, 1, acc1);
      P8_WRITE(0, r20, r21, r22, r23); __syncthreads(); P8_LOAD(2, un, r20, r21, r22, r23); P8_COMPUTE(0, 2, acc2);
      P8_WRITE(1, r30, r31, r32_, r33); __syncthreads(); P8_LOAD(3, un, r30, r31, r32_, r33); P8_COMPUTE(1, 3, acc2);
      const int b = u >> 6, j = (u >> 4) & 3, G = u & 15;
      const float sc = 1.f / 512.f;
      char* sE = sA;
      constexpr int ES = 272;
      __syncthreads();
#pragma unroll 1
      for (int pass = 0; pass < 2; ++pass) {
#pragma unroll
        for (int i = 0; i < 8; ++i) {
          const int id = tid + 512 * i, row = id >> 4, ck = id & 15, tp = j * 256 + row;
          const int tok = pass ? ((tp >= 1) ? 2048 - tp : 0) : tp;
          *(u32x4*)(sE + row * ES + ck * 16) = *(const u32x4*)(SG1 + ((size_t)b * 2048 + tok) * 2048 + G * 128 + ck * 8);
        }
        __syncthreads();
        const float sgn = pass ? 1.f : -1.f;
#pragma unroll
        for (int mi = 0; mi < 2; ++mi)
#pragma unroll
          for (int nj = 0; nj < 2; ++nj)
#pragma unroll
            for (int q = 0; q < 4; ++q) {
              char* ad = sE + (wm * 64 + mi * 32 + r32) * ES + (nj * 64 + wn * 32 + q * 8 + hi * 4) * 2;
              const u32x2 sg = *(const u32x2*)ad;
              const float y0 = (acc1[mi][nj][4 * q + 0] + sgn * acc2[mi][nj][4 * q + 0]) * sc, y1 = (acc1[mi][nj][4 * q + 1] + sgn * acc2[mi][nj][4 * q + 1]) * sc;
              const float y2 = (acc1[mi][nj][4 * q + 2] + sgn * acc2[mi][nj][4 * q + 2]) * sc, y3 = (acc1[mi][nj][4 * q + 3] + sgn * acc2[mi][nj][4 * q + 3]) * sc;
              u32x2 w = {cvtpk(y0 * bf_lo(sg[0]), y1 * bf_hi(sg[0])), cvtpk(y2 * bf_lo(sg[1]), y3 * bf_hi(sg[1]))};
              *(u32x2*)ad = w;
            }
        __syncthreads();
#pragma unroll
        for (int i = 0; i < 8; ++i) {
          const int id = tid + 512 * i, row = id >> 4, ck = id & 15, tp = j * 256 + row;
          if (!pass || tp >= 1) {
            const int tok = pass ? 2048 - tp : tp;
            *(u32x4*)(SG1 + ((size_t)b * 2048 + tok) * 2048 + G * 128 + ck * 8) = *(const u32x4*)(sE + row * ES + ck * 16);
          }
        }
        __syncthreads();
      }
    }
#undef P8_LOAD
#undef P8_WRITE
#undef P8_COMPUTE
    {
      const float* PX = (const float*)(ws + OFF_PX);
      for (int i = blockIdx.x; i < 256; i += gridDim.x) {
        if (tid < 128) {
          const int b = i >> 4, G = i & 15;
          const float* px = PX + (size_t)b * 2048 + G * 128;
          float y = 0.f;
          for (int c = 0; c < 128; ++c) y += px[c] * bf2f(*(const bf16_t*)(sT + tid * TBS + c * 2));
          bf16_t* gp = SG1 + ((size_t)b * 2048 + 1024) * 2048 + G * 128 + tid;
          *gp = f2bf(y * (1.f / 512.f) * bf2f(*gp));
        }
      }
    }
  }
  }
  if (PLO <= 8 && 8 < PHI) { GSYNC(); }
  if (PLO <= 9 && 9 <= PHI) {

  out_proj((const bf16_t*)(ws + OFF_SG), (const bf16_t*)(ws + OFF_WT_OOUT), MOD + 17 * 3072, (bf16_t*)(ws + OFF_YG), smem);
  }
  if (PLO <= 9 && 9 < PHI) { GSYNC(); }
  if (PLO <= 10 && 10 <= PHI) {

  post_ln_rows((const float*)(ws + OFF_Q), (const bf16_t*)(ws + OFF_YG), p.out, p.post_g + 1024, p.post_b + 1024, nullptr, nullptr);
  }
}

extern "C" void kernel_launch(void* const* d_in, const int* in_sizes, int n_in, void* d_out, int out_size, void* d_ws, size_t ws_size,
                              hipStream_t stream) {
  static int grid_blocks = 0;
  if (!grid_blocks) {
    int dev = 0, cus = 0, per_cu = 0;
    hipGetDevice(&dev);
    hipDeviceGetAttribute(&cus, hipDeviceAttributeMultiprocessorCount, dev);
    hipOccupancyMaxActiveBlocksPerMultiprocessor(&per_cu, mega<0, 10>, 512, 0);
    if (per_cu > 1) per_cu = 1;
    grid_blocks = cus * per_cu;
    if (n_in != 18 || ws_size < WS_NEED) fprintf(stderr, "kernel_launch: unexpected n_in %d or ws_size %zu (need %zu)\n", n_in, ws_size, (size_t)WS_NEED);
  }
  Params p{};
  p.x = (const float*)d_in[0]; p.c = (const float*)d_in[1]; p.ctx = (const float*)d_in[2]; p.c_ctx = (const float*)d_in[3];
  p.w_mod = (const float*)d_in[4]; p.b_mod = (const float*)d_in[5]; p.post_g = (const float*)d_in[6]; p.post_b = (const float*)d_in[7];
  p.e_w_in = (const float*)d_in[8]; p.e_qn = (const float*)d_in[9]; p.e_kn = (const float*)d_in[10]; p.e_vg = (const float*)d_in[11];
  p.e_vb = (const float*)d_in[12]; p.e_ws = (const float*)d_in[13]; p.e_bs = (const float*)d_in[14]; p.e_w_out = (const float*)d_in[15];
  p.o_w_in = (const float*)d_in[16]; p.o_w_out = (const float*)d_in[17];
  p.out = (float*)d_out; p.ws = (char*)d_ws;
#define ONE_LAUNCH 1
#ifdef ONE_LAUNCH
  hipMemsetAsync((char*)d_ws + OFF_XBAR, 0, XCD_BAR_WORDS * 4, stream);
  { void* args[] = {&p};
    hipError_t e = hipLaunchCooperativeKernel((void*)mega<0, 10>, dim3(grid_blocks), dim3(512), args, 0, stream);
    if (e != hipSuccess) fprintf(stderr, "cooperative launch failed: %s (grid %d)\n", hipGetErrorString(e), grid_blocks); }
#else
  hipLaunchKernelGGL((mega<0, 0>), dim3(grid_blocks), dim3(512), 0, stream, p);
  hipLaunchKernelGGL((mega<1, 1>), dim3(grid_blocks), dim3(512), 0, stream, p);
  hipLaunchKernelGGL((mega<2, 2>), dim3(grid_blocks), dim3(512), 0, stream, p);
  hipLaunchKernelGGL((mega<3, 3>), dim3(grid_blocks), dim3(512), 0, stream, p);
  hipLaunchKernelGGL((mega<4, 4>), dim3(grid_blocks), dim3(512), 0, stream, p);
  hipLaunchKernelGGL((mega<5, 5>), dim3(grid_blocks), dim3(512), 0, stream, p);
  hipLaunchKernelGGL((mega<6, 6>), dim3(grid_blocks), dim3(512), 0, stream, p);
  hipLaunchKernelGGL((mega<7, 7>), dim3(grid_blocks), dim3(512), 0, stream, p);
  hipLaunchKernelGGL((mega<8, 8>), dim3(grid_blocks), dim3(512), 0, stream, p);
  hipLaunchKernelGGL((mega<9, 9>), dim3(grid_blocks), dim3(512), 0, stream, p);
  hipLaunchKernelGGL((mega<10, 10>), dim3(grid_blocks), dim3(512), 0, stream, p);
#endif
}
```

```cpp
#include <hip/hip_runtime.h>
#include <hip/hip_cooperative_groups.h>
#include <cstdio>
#include <cstdint>
namespace cg = cooperative_groups;

typedef unsigned short bf16_t;
using bf16x8 = __attribute__((ext_vector_type(8))) short;
using s16x4  = __attribute__((ext_vector_type(4))) short;
using f32x16 = __attribute__((ext_vector_type(16))) float;
using u32x4  = __attribute__((ext_vector_type(4))) unsigned;
using u32x2  = __attribute__((ext_vector_type(2))) unsigned;

constexpr int DM = 1024, NB = 16, SEQ = 2048, CTXL = 256, SKV = SEQ + CTXL;
constexpr int NTOK = NB * SEQ;
constexpr int NCTX = NB * CTXL;
constexpr int EVEN_IN = 5632, ODD_IN = 4096, DIN = 2048;
constexpr float ALPHA = 1.4142135623730951f;
constexpr float EPS = 1e-6f;

constexpr size_t MiB = 1ull << 20;
constexpr size_t OFF_WT_EIN = 0, OFF_WT_EOUT = 11 * MiB, OFF_WT_OIN = 15 * MiB, OFF_WT_OOUT = 23 * MiB;
constexpr size_t OFF_TAB_C = 27 * MiB, OFF_TAB_S = 30 * MiB, OFF_SMALL = 33 * MiB;
constexpr size_t OFF_CDM = OFF_SMALL, OFF_CDP = OFF_SMALL + 64 * 1024, OFF_WSB = OFF_SMALL + 128 * 1024;
constexpr size_t OFF_ROPE = OFF_SMALL + 384 * 1024, OFF_MOD = OFF_SMALL + 512 * 1024, OFF_XM = OFF_SMALL + 1024 * 1024;
constexpr size_t OFF_M0 = 36 * MiB, OFF_MC = 100 * MiB;
constexpr size_t OFF_SG = 108 * MiB;
constexpr size_t OFF_Q = 236 * MiB, OFF_BU = 300 * MiB;
constexpr size_t OFF_KALL = 364 * MiB, OFF_VALL = 382 * MiB, OFF_BV = 400 * MiB;
constexpr size_t OFF_F = 364 * MiB, OFF_RV = 428 * MiB;
constexpr size_t OFF_YG = 364 * MiB;
constexpr size_t WS_NEED = 492 * MiB;

struct Params {
  const float *x, *c, *ctx, *c_ctx, *w_mod, *b_mod, *post_g, *post_b, *e_w_in, *e_qn, *e_kn, *e_vg, *e_vb, *e_ws, *e_bs,
      *e_w_out, *o_w_in, *o_w_out;
  float* out;
  char* ws;
  long pad_;
};

typedef float f32x2_t __attribute__((ext_vector_type(2)));
typedef __bf16 bf16x2_t __attribute__((ext_vector_type(2)));
__device__ __forceinline__ unsigned cvtpk(float lo, float hi) {
  f32x2_t v = {lo, hi}; bf16x2_t h = __builtin_convertvector(v, bf16x2_t); return __builtin_bit_cast(unsigned, h);
}
__device__ __forceinline__ int tid_fresh() { int t = (int)__builtin_amdgcn_workitem_id_x(); asm volatile("" : "+v"(t)); return t; }
__device__ __forceinline__ float bf_lo(unsigned w) { return __uint_as_float(w << 16); }
__device__ __forceinline__ float bf_hi(unsigned w) { return __uint_as_float(w & 0xffff0000u); }
__device__ __forceinline__ bf16_t f2bf(float x) { return (bf16_t)(cvtpk(x, 0.f) & 0xffffu); }
__device__ __forceinline__ float bf2f(bf16_t h) { return __uint_as_float(((unsigned)h) << 16); }
__device__ __forceinline__ int crow(int r, int hi) { return (r & 3) + 8 * (r >> 2) + 4 * hi; }
__device__ __forceinline__ float wave_sum(float v) {
#pragma unroll
  for (int o = 32; o >= 1; o >>= 1) v += __shfl_xor(v, o);
  return v;
}
__device__ __forceinline__ float silu_f(float x) { return x * __builtin_amdgcn_rcpf(1.f + __expf(-x)); }
__device__ __forceinline__ float gelu_tanh_f(float x) {
  const float u = 0.7978845608028654f * (x + 0.044715f * x * x * x);
  const float t = 1.f - 2.f * __builtin_amdgcn_rcpf(__expf(2.f * u) + 1.f);
  return 0.5f * x * (1.f + t);
}
__device__ __forceinline__ int logical_block() {
  const int g = gridDim.x, b = blockIdx.x;
  return (g & 7) ? b : (b & 7) * (g >> 3) + (b >> 3);
}

constexpr int LDS_ROWB = 144;
constexpr int LDS_A = 256 * LDS_ROWB;
constexpr int LDS_B = 128 * LDS_ROWB;
constexpr int LDS_STAGE = LDS_A + LDS_B;
constexpr int L2_A = 256 * LDS_ROWB;
constexpr int L2_STAGE = 2 * L2_A;
constexpr int LDS_RED = 2 * L2_STAGE;
constexpr int SMEM_BYTES = LDS_RED + 2048 + 2048;

struct LdPlain {
  const bf16_t* p; size_t rs;
  __device__ __forceinline__ u32x4 ld(int kt, int i) const { return *(const u32x4*)(p + (size_t)i * rs + kt * 64); }
};
__device__ __forceinline__ LdPlain mkPlain(const bf16_t* base, int ld) {
  const int tid = tid_fresh();
  LdPlain l; l.p = base + (size_t)(tid >> 3) * ld + (tid & 7) * 8; l.rs = (size_t)64 * ld; return l;
}
struct LdSplit {
  const bf16_t* p0; const bf16_t* p1; size_t rs; int kts;
  __device__ __forceinline__ u32x4 ld(int kt, int i) const {
    const bf16_t* q = (kt < kts) ? (p0 + kt * 64) : (p1 + (kt - kts) * 64);
    return *(const u32x4*)(q + (size_t)i * rs);
  }
};
__device__ __forceinline__ LdSplit mkSplit(const bf16_t* b0, const bf16_t* b1, int ld, int kts) {
  const int tid = tid_fresh(); const size_t o = (size_t)(tid >> 3) * ld + (tid & 7) * 8;
  LdSplit l; l.p0 = b0 + o; l.p1 = b1 + o; l.rs = (size_t)64 * ld; l.kts = kts; return l;
}
struct LdFold {
  const bf16_t* f; const bf16_t* r; size_t rs; float sg;
  __device__ __forceinline__ u32x4 ld(int kt, int i) const {
    const u32x4 a = *(const u32x4*)(f + (size_t)i * rs + kt * 64);
    const u32x4 b = *(const u32x4*)(r + (size_t)i * rs + kt * 64);
    u32x4 o;
    o[0] = cvtpk(bf_lo(a[0]) + sg * bf_lo(b[0]), bf_hi(a[0]) + sg * bf_hi(b[0]));
    o[1] = cvtpk(bf_lo(a[1]) + sg * bf_lo(b[1]), bf_hi(a[1]) + sg * bf_hi(b[1]));
    o[2] = cvtpk(bf_lo(a[2]) + sg * bf_lo(b[2]), bf_hi(a[2]) + sg * bf_hi(b[2]));
    o[3] = cvtpk(bf_lo(a[3]) + sg * bf_lo(b[3]), bf_hi(a[3]) + sg * bf_hi(b[3]));
    return o;
  }
};
__device__ __forceinline__ LdFold mkFold(const bf16_t* f, const bf16_t* r, int ld, float sg) {
  const int tid = tid_fresh(); const size_t o = (size_t)(tid >> 3) * ld + (tid & 7) * 8;
  LdFold l; l.f = f + o; l.r = r + o; l.rs = (size_t)64 * ld; l.sg = sg; return l;
}

template <class LA, class LB>
__device__ __forceinline__ void gemm_mainloop(const LA& la, const LB& lb, int KT, char* smem, f32x16 (&acc)[2][2]) {
  const int tid = tid_fresh(), wid = tid >> 6, lane = tid & 63, r32 = lane & 31, hi = lane >> 5, wm = wid >> 1, wn = wid & 1;
#pragma unroll
  for (int mi = 0; mi < 2; ++mi)
#pragma unroll
    for (int nj = 0; nj < 2; ++nj)
#pragma unroll
      for (int r = 0; r < 16; ++r) acc[mi][nj][r] = 0.f;
  const int st_off = (tid >> 3) * LDS_ROWB + (tid & 7) * 16;
  const int a_rd = (wm * 64 + r32) * LDS_ROWB + hi * 16;
  const int b_rd = LDS_A + (wn * 32 + r32) * LDS_ROWB + hi * 16;
  u32x4 ra0, ra1, ra2, ra3, rb0, rb1;
  ra0 = la.ld(0, 0); ra1 = la.ld(0, 1); ra2 = la.ld(0, 2); ra3 = la.ld(0, 3); rb0 = lb.ld(0, 0); rb1 = lb.ld(0, 1);
  {
    char* s = smem + st_off;
    *(u32x4*)(s) = ra0; *(u32x4*)(s + 64 * LDS_ROWB) = ra1; *(u32x4*)(s + 128 * LDS_ROWB) = ra2; *(u32x4*)(s + 192 * LDS_ROWB) = ra3;
    *(u32x4*)(s + LDS_A) = rb0; *(u32x4*)(s + LDS_A + 64 * LDS_ROWB) = rb1;
  }
  __syncthreads();
#define GEMM_COMPUTE(SB)                                                                              \
  _Pragma("unroll") for (int kk = 0; kk < 4; ++kk) {                                                  \
    const bf16x8 a0 = *(const bf16x8*)((SB) + a_rd + kk * 32);                                        \
    const bf16x8 a1 = *(const bf16x8*)((SB) + a_rd + 32 * LDS_ROWB + kk * 32);                        \
    const bf16x8 b0 = *(const bf16x8*)((SB) + b_rd + kk * 32);                                        \
    const bf16x8 b1 = *(const bf16x8*)((SB) + b_rd + 64 * LDS_ROWB + kk * 32);                        \
    acc[0][0] = __builtin_amdgcn_mfma_f32_32x32x16_bf16(b0, a0, acc[0][0], 0, 0, 0);                  \
    acc[0][1] = __builtin_amdgcn_mfma_f32_32x32x16_bf16(b1, a0, acc[0][1], 0, 0, 0);                  \
    acc[1][0] = __builtin_amdgcn_mfma_f32_32x32x16_bf16(b0, a1, acc[1][0], 0, 0, 0);                  \
    acc[1][1] = __builtin_amdgcn_mfma_f32_32x32x16_bf16(b1, a1, acc[1][1], 0, 0, 0);                  \
  }
#define GEMM_LOAD(KT_) do { ra0 = la.ld((KT_), 0); ra1 = la.ld((KT_), 1); ra2 = la.ld((KT_), 2); ra3 = la.ld((KT_), 3); rb0 = lb.ld((KT_), 0); rb1 = lb.ld((KT_), 1); } while (0)
#define GEMM_WRITE(ST) do { char* s = smem + (ST) * LDS_STAGE + st_off;                                \
    *(u32x4*)(s) = ra0; *(u32x4*)(s + 64 * LDS_ROWB) = ra1; *(u32x4*)(s + 128 * LDS_ROWB) = ra2; *(u32x4*)(s + 192 * LDS_ROWB) = ra3; \
    *(u32x4*)(s + LDS_A) = rb0; *(u32x4*)(s + LDS_A + 64 * LDS_ROWB) = rb1; } while (0)
#pragma unroll 1
  for (int kt = 0; kt < KT; kt += 2) {
    GEMM_LOAD(kt + 1);
    GEMM_COMPUTE(smem);
    GEMM_WRITE(1);
    __syncthreads();
    GEMM_LOAD(kt + 2 < KT ? kt + 2 : kt);
    GEMM_COMPUTE(smem + LDS_STAGE);
    GEMM_WRITE(0);
    __syncthreads();
  }
#undef GEMM_COMPUTE
#undef GEMM_LOAD
#undef GEMM_WRITE
}

template <class LA, class LB>
__device__ __forceinline__ void gemm2(const LA& la, const LB& lb, int KT, char* smem, f32x16 (&acc)[2][4]) {
  const int tid = tid_fresh(), wid = tid >> 6, lane = tid & 63, r32 = lane & 31, hi = lane >> 5, wm = wid >> 1, wn = wid & 1;
#pragma unroll
  for (int mi = 0; mi < 2; ++mi)
#pragma unroll
    for (int nj = 0; nj < 4; ++nj)
#pragma unroll
      for (int r = 0; r < 16; ++r) acc[mi][nj][r] = 0.f;
  const int st_off = (tid >> 3) * LDS_ROWB + (tid & 7) * 16;
  const int a_rd = (wm * 64 + r32) * LDS_ROWB + hi * 16;
  const int b_rd = L2_A + (wn * 128 + r32) * LDS_ROWB + hi * 16;
  u32x4 xa0, xa1, xa2, xa3, xb0, xb1, xb2, xb3, ya0, ya1, ya2, ya3, yb0, yb1, yb2, yb3;
#define G2_LOADX(KT_) do { xa0 = la.ld((KT_), 0); xa1 = la.ld((KT_), 1); xa2 = la.ld((KT_), 2); xa3 = la.ld((KT_), 3); xb0 = lb.ld((KT_), 0); xb1 = lb.ld((KT_), 1); xb2 = lb.ld((KT_), 2); xb3 = lb.ld((KT_), 3); } while (0)
#define G2_LOADY(KT_) do { ya0 = la.ld((KT_), 0); ya1 = la.ld((KT_), 1); ya2 = la.ld((KT_), 2); ya3 = la.ld((KT_), 3); yb0 = lb.ld((KT_), 0); yb1 = lb.ld((KT_), 1); yb2 = lb.ld((KT_), 2); yb3 = lb.ld((KT_), 3); } while (0)
#define G2_W2(ST, P, R0, R1, O0, O1) do { char* s_ = smem + (ST) * L2_STAGE + st_off; *(u32x4*)(s_ + (O0)) = P##R0; *(u32x4*)(s_ + (O1)) = P##R1; } while (0)
#define G2_WRITE(ST, P) do { G2_W2(ST, P, a0, a1, 0, 64 * LDS_ROWB); G2_W2(ST, P, a2, a3, 128 * LDS_ROWB, 192 * LDS_ROWB); \
    G2_W2(ST, P, b0, b1, L2_A, L2_A + 64 * LDS_ROWB); G2_W2(ST, P, b2, b3, L2_A + 128 * LDS_ROWB, L2_A + 192 * LDS_ROWB); } while (0)
#define G2_LDA(SB, kk, A0, A1) do { A0 = *(const bf16x8*)((SB) + a_rd + (kk) * 32); A1 = *(const bf16x8*)((SB) + a_rd + 32 * LDS_ROWB + (kk) * 32); } while (0)
#define G2_STEPP(SB, kk, A0, A1, N0, N1, HASNEXT) do {                                                \
    if (HASNEXT) G2_LDA(SB, (kk) + 1, N0, N1);                                                        \
    _Pragma("unroll") for (int nj = 0; nj < 4; ++nj) {                                                \
      const bf16x8 b_ = *(const bf16x8*)((SB) + b_rd + nj * 32 * LDS_ROWB + (kk) * 32);               \
      acc[0][nj] = __builtin_amdgcn_mfma_f32_32x32x16_bf16(b_, A0, acc[0][nj], 0, 0, 0);              \
      acc[1][nj] = __builtin_amdgcn_mfma_f32_32x32x16_bf16(b_, A1, acc[1][nj], 0, 0, 0);              \
    } } while (0)
#define G2_COMPUTE_W(SB, ST, P) do { bf16x8 p0_, p1_, q0_, q1_;                                        \
    G2_LDA(SB, 0, p0_, p1_);                                                                          \
    G2_STEPP(SB, 0, p0_, p1_, q0_, q1_, 1); G2_W2(ST, P, a0, a1, 0, 64 * LDS_ROWB);                   \
    G2_STEPP(SB, 1, q0_, q1_, p0_, p1_, 1); G2_W2(ST, P, a2, a3, 128 * LDS_ROWB, 192 * LDS_ROWB);     \
    G2_STEPP(SB, 2, p0_, p1_, q0_, q1_, 1); G2_W2(ST, P, b0, b1, L2_A, L2_A + 64 * LDS_ROWB);         \
    G2_STEPP(SB, 3, q0_, q1_, p0_, p1_, 0); G2_W2(ST, P, b2, b3, L2_A + 128 * LDS_ROWB, L2_A + 192 * LDS_ROWB); } while (0)
  G2_LOADX(0); G2_LOADY(1);
  G2_WRITE(0, x);
  __syncthreads();
  G2_LOADX(2 < KT ? 2 : 0);
#pragma unroll 1
  for (int kt = 0; kt < KT; kt += 2) {
    G2_COMPUTE_W(smem, 1, y);
    __syncthreads();
    G2_LOADY(kt + 3 < KT ? kt + 3 : KT - 1);
    G2_COMPUTE_W(smem + L2_STAGE, 0, x);
    __syncthreads();
    G2_LOADX(kt + 4 < KT ? kt + 4 : KT - 2);
  }
#undef G2_LOADX
#undef G2_LOADY
#undef G2_WRITE
#undef G2_W2
#undef G2_STEPP
#undef G2_LDA
#undef G2_COMPUTE_W
}
template <class F>
__device__ __forceinline__ void epi2_foreach(const f32x16 (&acc)[2][4], F&& f) {
  const int tid = tid_fresh(), wid = tid >> 6, lane = tid & 63, r32 = lane & 31, hi = lane >> 5, wm = wid >> 1, wn = wid & 1;
#pragma unroll
  for (int mi = 0; mi < 2; ++mi)
#pragma unroll
    for (int nj = 0; nj < 4; ++nj)
#pragma unroll
      for (int q = 0; q < 4; ++q)
        f(wm * 64 + mi * 32 + r32, wn * 128 + nj * 32 + q * 8 + hi * 4, acc[mi][nj][4 * q + 0], acc[mi][nj][4 * q + 1],
          acc[mi][nj][4 * q + 2], acc[mi][nj][4 * q + 3]);
}

constexpr int ET_S = 528;
__device__ __forceinline__ void tile_flush_bf16(char* smem, bf16_t* dst, size_t ld) {
  const int tid = tid_fresh();
  __syncthreads();
#pragma unroll
  for (int i = 0; i < 16; ++i) {
    const int id = tid + 512 * i, row = id >> 5, ck = id & 31;
    *(u32x4*)(dst + (size_t)row * ld + ck * 8) = *(const u32x4*)(smem + row * ET_S + ck * 16);
  }
  __syncthreads();
}
template <class F>
__device__ __forceinline__ void epi2_store_lds(const f32x16 (&acc)[2][4], char* smem, F&& xf, bf16_t* dst, size_t ld) {
  epi2_foreach(acc, [&](int row, int col, float a, float b, float c, float d) {
    xf(row, col, a, b, c, d);
    u32x2 w = {cvtpk(a, b), cvtpk(c, d)};
    *(u32x2*)(smem + row * ET_S + col * 2) = w;
  });
  tile_flush_bf16(smem, dst, ld);
}

template <class F>
__device__ __forceinline__ void epi_foreach(const f32x16 (&acc)[2][2], F&& f) {
  const int tid = tid_fresh(), wid = tid >> 6, lane = tid & 63, r32 = lane & 31, hi = lane >> 5, wm = wid >> 1, wn = wid & 1;
#pragma unroll
  for (int mi = 0; mi < 2; ++mi)
#pragma unroll
    for (int nj = 0; nj < 2; ++nj)
#pragma unroll
      for (int q = 0; q < 4; ++q)
        f(wm * 64 + mi * 32 + r32, nj * 64 + wn * 32 + q * 8 + hi * 4, acc[mi][nj][4 * q + 0], acc[mi][nj][4 * q + 1],
          acc[mi][nj][4 * q + 2], acc[mi][nj][4 * q + 3]);
}
__device__ __forceinline__ void st_bf4(bf16_t* p, float a, float b, float c, float d) {
  u32x2 w = {cvtpk(a, b), cvtpk(c, d)}; *(u32x2*)p = w;
}

__device__ __forceinline__ void tr_tile(const float* src, bf16_t* dst, int K, int N, int kt, int nt, float* tile) {
  const int tid = tid_fresh(), k0 = kt * 64, n0 = nt * 64;
#pragma unroll
  for (int j = 0; j < 8; ++j) { const int e = j * 512 + tid, r = e >> 6, c = e & 63; tile[r * 65 + c] = src[(size_t)(k0 + r) * N + n0 + c]; }
  __syncthreads();
  const int rn = tid >> 3, ck = (tid & 7) * 8;
  const float v0 = tile[(ck + 0) * 65 + rn], v1 = tile[(ck + 1) * 65 + rn], v2 = tile[(ck + 2) * 65 + rn], v3 = tile[(ck + 3) * 65 + rn];
  const float v4 = tile[(ck + 4) * 65 + rn], v5 = tile[(ck + 5) * 65 + rn], v6 = tile[(ck + 6) * 65 + rn], v7 = tile[(ck + 7) * 65 + rn];
  u32x4 w = {cvtpk(v0, v1), cvtpk(v2, v3), cvtpk(v4, v5), cvtpk(v6, v7)};
  *(u32x4*)(dst + (size_t)(n0 + rn) * K + k0 + ck) = w;
  __syncthreads();
}

__device__ __forceinline__ void phase0(const Params& p, char* smem) {
  const int tid = tid_fresh(), G = gridDim.x, bid = blockIdx.x;
  char* ws = p.ws;
  {
    float* s = (float*)smem;
    float* part = (float*)(smem + 17 * 1024 * 4);
    float* MOD = (float*)(ws + OFF_MOD);
    for (int u = bid; u < 96; u += G) {
      const int l = u / 48, j0 = (u % 48) * 64;
      for (int e = tid; e < 17 * 1024; e += 512) { const int r = e >> 10, k = e & 1023; const float cv = (r < 16) ? p.c[r * 1024 + k] : p.c_ctx[k]; s[e] = silu_f(cv); }
      __syncthreads();
      const int col = tid & 63, ks = tid >> 6;
      float a0 = 0, a1 = 0, a2 = 0, a3 = 0, a4 = 0, a5 = 0, a6 = 0, a7 = 0, a8 = 0, a9 = 0, a10 = 0, a11 = 0, a12 = 0, a13 = 0, a14 = 0, a15 = 0, a16 = 0;
      const float* w = p.w_mod + (size_t)l * 1024 * 3072 + j0 + col;
#pragma unroll 4
      for (int k = ks * 128; k < ks * 128 + 128; ++k) {
        const float wv = w[(size_t)k * 3072];
        a0 += s[0 * 1024 + k] * wv; a1 += s[1 * 1024 + k] * wv; a2 += s[2 * 1024 + k] * wv; a3 += s[3 * 1024 + k] * wv;
        a4 += s[4 * 1024 + k] * wv; a5 += s[5 * 1024 + k] * wv; a6 += s[6 * 1024 + k] * wv; a7 += s[7 * 1024 + k] * wv;
        a8 += s[8 * 1024 + k] * wv; a9 += s[9 * 1024 + k] * wv; a10 += s[10 * 1024 + k] * wv; a11 += s[11 * 1024 + k] * wv;
        a12 += s[12 * 1024 + k] * wv; a13 += s[13 * 1024 + k] * wv; a14 += s[14 * 1024 + k] * wv; a15 += s[15 * 1024 + k] * wv;
        a16 += s[16 * 1024 + k] * wv;
      }
      float* pp = part + ks * 17 * 64 + col;
      pp[0 * 64] = a0; pp[1 * 64] = a1; pp[2 * 64] = a2; pp[3 * 64] = a3; pp[4 * 64] = a4; pp[5 * 64] = a5; pp[6 * 64] = a6; pp[7 * 64] = a7;
      pp[8 * 64] = a8; pp[9 * 64] = a9; pp[10 * 64] = a10; pp[11 * 64] = a11; pp[12 * 64] = a12; pp[13 * 64] = a13; pp[14 * 64] = a14; pp[15 * 64] = a15;
      pp[16 * 64] = a16;
      __syncthreads();
      for (int e = tid; e < 17 * 64; e += 512) {
        const int r = e >> 6, cc = e & 63;
        float t = p.b_mod[l * 3072 + j0 + cc];
#pragma unroll
        for (int q = 0; q < 8; ++q) t += part[q * 17 * 64 + r * 64 + cc];
        MOD[(size_t)(l * 17 + r) * 3072 + j0 + cc] = t;
      }
      __syncthreads();
    }
  }
  {
    float* tile = (float*)smem;
    constexpr int T0 = 16 * 88, T1 = 32 * 16, T2 = 16 * 64, T3 = 32 * 16;
    for (int u = bid; u < T0 + T1 + T2 + T3; u += G) {
      if (u < T0) tr_tile(p.e_w_in, (bf16_t*)(ws + OFF_WT_EIN), 1024, EVEN_IN, u / 88, u % 88, tile);
      else if (u < T0 + T1) { const int v = u - T0; tr_tile(p.e_w_out, (bf16_t*)(ws + OFF_WT_EOUT), 2048, 1024, v / 16, v % 16, tile); }
      else if (u < T0 + T1 + T2) { const int v = u - T0 - T1; tr_tile(p.o_w_in, (bf16_t*)(ws + OFF_WT_OIN), 1024, ODD_IN, v / 64, v % 64, tile); }
      else { const int v = u - T0 - T1 - T2; tr_tile(p.o_w_out, (bf16_t*)(ws + OFF_WT_OOUT), 2048, 1024, v / 16, v % 16, tile); }
    }
  }
  {
    const long gt = (long)bid * 512 + tid, gn = (long)G * 512;
    bf16_t* TC = (bf16_t*)(ws + OFF_TAB_C); bf16_t* TS = (bf16_t*)(ws + OFF_TAB_S);
    (void)TS;
    for (long e = gt; e < 4L * 512 * 512; e += gn) {
      const int ty = (int)(e >> 18), sidx = (int)((e >> 9) & 511), t = (int)(e & 511);
      float v;
      if (ty == 0) v = cospif((float)((sidx * t) & 1023) * (1.f / 512.f));
      else if (ty == 1) v = cospif((float)(((2 * sidx + 1) * t) & 2047) * (1.f / 1024.f));
      else if (ty == 2) v = sinpif((float)((sidx * t) & 1023) * (1.f / 512.f));
      else v = sinpif((float)(((2 * sidx + 1) * t) & 2047) * (1.f / 1024.f));
      TC[e] = f2bf(v);
    }
    bf16_t* CDM = (bf16_t*)(ws + OFF_CDM); bf16_t* CDP = (bf16_t*)(ws + OFF_CDP);
    for (long e = gt; e < 128L * 256; e += gn) {
      const int cp = (int)(e >> 8), k = (int)(e & 255);
      const int m = (cp * (k & 127)) & 127;
      const float x = (float)m * (1.f / 64.f);
      float vm, vp;
      if (k < 128) { vm = cospif(x); vp = vm; } else { vp = sinpif(x); vm = -vp; }
      CDM[e] = f2bf(vm); CDP[e] = f2bf(vp);
    }
    bf16_t* WSB = (bf16_t*)(ws + OFF_WSB);
    for (long e = gt; e < 8L * 128 * 128; e += gn) WSB[e] = f2bf(p.e_ws[e]);
    float2* ROPE = (float2*)(ws + OFF_ROPE);
    for (long e = gt; e < 64L * 32; e += gn) {
      const int pos = (int)(e >> 5), i = (int)(e & 31);
      const float inv = powf(10000.f, -(float)i / 32.f);
      const float ang = (float)pos * inv;
      ROPE[e] = make_float2(cosf(ang), sinf(ang));
    }
  }
}

__device__ __forceinline__ void ln_rows_modulate(const float* src, bf16_t* dst, int nrows, int rows_per_b, const float* mod17, int fixed_row) {
  const int tid = tid_fresh(), wid = tid >> 6, lane = tid & 63;
  const int gw = blockIdx.x * 8 + wid, nw = gridDim.x * 8;
  float4 n0, n1, n2, n3;
  { const int r0 = gw < nrows ? gw : 0; const float4* ps = (const float4*)(src + (size_t)r0 * 1024); n0 = ps[lane]; n1 = ps[lane + 64]; n2 = ps[lane + 128]; n3 = ps[lane + 192]; }
  for (int row = gw; row < nrows; row += nw) {
    float4 v0 = n0, v1 = n1, v2 = n2, v3 = n3;
    { const int nr = (row + nw < nrows) ? row + nw : row;
      const float4* ps = (const float4*)(src + (size_t)nr * 1024); n0 = ps[lane]; n1 = ps[lane + 64]; n2 = ps[lane + 128]; n3 = ps[lane + 192]; }
    float s = v0.x + v0.y + v0.z + v0.w + v1.x + v1.y + v1.z + v1.w + v2.x + v2.y + v2.z + v2.w + v3.x + v3.y + v3.z + v3.w;
    const float mu = wave_sum(s) * (1.f / 1024.f);
    v0.x -= mu; v0.y -= mu; v0.z -= mu; v0.w -= mu; v1.x -= mu; v1.y -= mu; v1.z -= mu; v1.w -= mu;
    v2.x -= mu; v2.y -= mu; v2.z -= mu; v2.w -= mu; v3.x -= mu; v3.y -= mu; v3.z -= mu; v3.w -= mu;
    float q = v0.x * v0.x + v0.y * v0.y + v0.z * v0.z + v0.w * v0.w + v1.x * v1.x + v1.y * v1.y + v1.z * v1.z + v1.w * v1.w +
              v2.x * v2.x + v2.y * v2.y + v2.z * v2.z + v2.w * v2.w + v3.x * v3.x + v3.y * v3.y + v3.z * v3.z + v3.w * v3.w;
    const float rstd = rsqrtf(wave_sum(q) * (1.f / 1024.f) + EPS);
    const int mr = (fixed_row >= 0) ? fixed_row : (row / rows_per_b);
    const float* md = mod17 + (size_t)mr * 3072;
    bf16_t* pd = dst + (size_t)row * 1024;
#define MODST(V, J) { const int col = (lane + 64 * J) * 4; const float4 sh = *(const float4*)(md + col); const float4 sc = *(const float4*)(md + 1024 + col); \
      st_bf4(pd + col, V.x * rstd * (1.f + sc.x) + sh.x, V.y * rstd * (1.f + sc.y) + sh.y, V.z * rstd * (1.f + sc.z) + sh.z, V.w * rstd * (1.f + sc.w) + sh.w); }
    MODST(v0, 0) MODST(v1, 1) MODST(v2, 2) MODST(v3, 3)
#undef MODST
  }
}

__device__ __forceinline__ void phase2(const Params& p, char* smem) {
  char* ws = p.ws;
  const bf16_t* M0 = (const bf16_t*)(ws + OFF_M0); const bf16_t* MC = (const bf16_t*)(ws + OFF_MC);
  const bf16_t* WT = (const bf16_t*)(ws + OFF_WT_EIN);
  bf16_t* Q = (bf16_t*)(ws + OFF_Q); bf16_t* KA = (bf16_t*)(ws + OFF_KALL); bf16_t* VA = (bf16_t*)(ws + OFF_VALL);
  bf16_t* BU = (bf16_t*)(ws + OFF_BU); bf16_t* BV = (bf16_t*)(ws + OFF_BV); bf16_t* SG = (bf16_t*)(ws + OFF_SG);
  const float2* ROPE = (const float2*)(ws + OFF_ROPE);
  const int tid = tid_fresh(), wid = tid >> 6, lane = tid & 63, r32 = lane & 31, hi = lane >> 5, wm = wid >> 1, wn = wid & 1;
  const int lb = logical_block();
  for (int u = lb; u < 2816 + 32; u += gridDim.x) {
    const bool isctx = (u >= 2816);
    int mt, nt;
    if (!isctx) { mt = u / 22; nt = u % 22; } else { const int v = u - 2816; mt = v >> 1; nt = 4 + (v & 1); }
    const bf16_t* A = (isctx ? MC : M0) + (size_t)mt * 256 * 1024;
    f32x16 acc[2][4];
    gemm2(mkPlain(A, 1024), mkPlain(WT + (size_t)nt * 256 * 1024, 1024), 16, smem, acc);
    if (nt < 5) {
      const bool isq = nt < 4;
      const int head = isq ? (nt * 2 + wn) : wn;
      const float* gv = isq ? p.e_qn : p.e_kn;
#pragma unroll
      for (int mi = 0; mi < 2; ++mi) {
        float ss = 0.f;
#pragma unroll
        for (int nj = 0; nj < 4; ++nj)
#pragma unroll
          for (int r = 0; r < 16; ++r) ss += acc[mi][nj][r] * acc[mi][nj][r];
        ss += __shfl_xor(ss, 32);
        const float rstd = rsqrtf(ss * (1.f / 128.f) + EPS);
        const int row = wm * 64 + mi * 32 + r32;
        int t = 0;
        if (!isctx) t = (mt & 7) * 256 + row;
#pragma unroll
        for (int nj = 0; nj < 2; ++nj) {
          const int pos = (nj == 0) ? (t >> 6) : (t & 63);
#pragma unroll
          for (int q = 0; q < 4; ++q) {
            float o1[4], o2[4];
#pragma unroll
            for (int e = 0; e < 4; ++e) {
              const int r = 4 * q + e;
              const int i = 8 * q + 4 * hi + e;
              const int d = nj * 32 + i;
              const float x1 = acc[mi][nj][r] * rstd * gv[d];
              const float x2 = acc[mi][nj + 2][r] * rstd * gv[64 + d];
              if (!isctx) {
                const float2 cs = ROPE[pos * 32 + i];
                o1[e] = x1 * cs.x - x2 * cs.y; o2[e] = x2 * cs.x + x1 * cs.y;
              } else { o1[e] = x1; o2[e] = x2; }
            }
            const int d0 = nj * 32 + 8 * q + 4 * hi;
            { char* lp = smem + row * ET_S + (wn * 128 + d0) * 2;
              u32x2 w1 = {cvtpk(o1[0], o1[1]), cvtpk(o1[2], o1[3])}, w2 = {cvtpk(o2[0], o2[1]), cvtpk(o2[2], o2[3])};
              *(u32x2*)lp = w1; *(u32x2*)(lp + 128) = w2; }
          }
        }
      }
      {
        const int bb = mt >> 3, t0 = (mt & 7) * 256;
        bf16_t* tb; size_t tl;
        if (isq) { tb = Q + ((size_t)(bb * SEQ + t0) * 8 + nt * 2) * 128; tl = 1024; }
        else if (!isctx) { tb = KA + (size_t)(bb * SKV + CTXL + t0) * 256; tl = 256; }
        else { tb = KA + (size_t)mt * SKV * 256; tl = 256; }
        tile_flush_bf16(smem, tb, tl);
      }
    } else if (nt == 5) {
      const int bb = mt >> 3, t0 = (mt & 7) * 256;
      bf16_t* tb = isctx ? (VA + (size_t)mt * SKV * 256) : (VA + (size_t)(bb * SKV + CTXL + t0) * 256);
      epi2_store_lds(acc, smem, [&](int, int, float&, float&, float&, float&) {}, tb, 256);
    } else if (nt < 14) {
      bf16_t* dst = (nt < 10) ? (BU + (size_t)(nt - 6) * 256) : (BV + (size_t)(nt - 10) * 256);
      epi2_store_lds(acc, smem, [&](int, int, float& a, float& b, float& c, float& d) { a = gelu_tanh_f(a); b = gelu_tanh_f(b); c = gelu_tanh_f(c); d = gelu_tanh_f(d); },
                     dst + (size_t)mt * 256 * 1024, 1024);
    } else {
      bf16_t* dst = SG + (size_t)(nt - 14) * 256;
      epi2_store_lds(acc, smem, [&](int, int, float& a, float& b, float& c, float& d) { a = silu_f(a); b = silu_f(b); c = silu_f(c); d = silu_f(d); },
                     dst + (size_t)mt * 256 * 2048, 2048);
    }
  }
}

namespace att {
constexpr int D = 128, NW = 8, QBLK = 32, KVBLK = 64;
constexpr float SCALE = 0.088388347648318440f;
constexpr float THR = 8.f;
constexpr int LDQ = 1024, LDK = 256;
constexpr int SHM_V = KVBLK * D * 2, SHM_K = KVBLK * D * 2;
#define KSWZ(row, colB) ((row) * 256 + ((colB) ^ (((row) & 7) << 4)))
#define SBAR() __builtin_amdgcn_sched_barrier(0)
__device__ __forceinline__ void partialSM(f32x16& p0, f32x16& p1, float& m_reg, float& mn, float& alpha) {
  constexpr float C = SCALE * 1.4426950408889634f;
  float pmax = p0[0];
#pragma unroll
  for (int r = 1; r < 16; ++r) pmax = fmaxf(pmax, p0[r]);
#pragma unroll
  for (int r = 0; r < 16; ++r) pmax = fmaxf(pmax, p1[r]);
  { auto rr = __builtin_amdgcn_permlane32_swap(__float_as_uint(pmax), __float_as_uint(pmax), false, false);
    pmax = fmaxf(__uint_as_float(rr[0]), __uint_as_float(rr[1])); }
  if (__builtin_expect(__all(pmax - m_reg <= THR / SCALE), 1)) { mn = m_reg; alpha = 1.f; }
  else { mn = fmaxf(m_reg, pmax); alpha = __builtin_amdgcn_exp2f((m_reg - mn) * C); m_reg = mn; }
  const float mnC = -mn * C;
#pragma unroll
  for (int r = 0; r < 16; ++r) p0[r] = fmaf(p0[r], C, mnC);
#pragma unroll
  for (int r = 0; r < 16; ++r) p1[r] = fmaf(p1[r], C, mnC);
#pragma unroll
  for (int r = 0; r < 16; ++r) p0[r] = __builtin_amdgcn_exp2f(p0[r]);
}
__device__ __forceinline__ void finishSM(f32x16& p0, f32x16& p1, float alpha, float& l_reg, bf16x8& pa0, bf16x8& pa1, bf16x8& pa2, bf16x8& pa3) {
#pragma unroll
  for (int r = 0; r < 16; ++r) p1[r] = __builtin_amdgcn_exp2f(p1[r]);
  float ps = 0;
#pragma unroll
  for (int r = 0; r < 16; ++r) ps += p0[r];
#pragma unroll
  for (int r = 0; r < 16; ++r) ps += p1[r];
  { auto rr = __builtin_amdgcn_permlane32_swap(__float_as_uint(ps), __float_as_uint(ps), false, false);
    ps = __uint_as_float(rr[0]) + __uint_as_float(rr[1]); }
  l_reg = l_reg * alpha + ps;
#define PK4(P, BASE, OUT) do { unsigned a0 = cvtpk(P[BASE + 0], P[BASE + 1]), a1 = cvtpk(P[BASE + 2], P[BASE + 3]);   \
    unsigned b0 = cvtpk(P[BASE + 4], P[BASE + 5]), b1 = cvtpk(P[BASE + 6], P[BASE + 7]);                              \
    auto r0 = __builtin_amdgcn_permlane32_swap(a0, b0, false, false); auto r1 = __builtin_amdgcn_permlane32_swap(a1, b1, false, false); \
    u32x4 w = {r0[0], r1[0], r0[1], r1[1]}; OUT = *reinterpret_cast<bf16x8*>(&w); } while (0)
  PK4(p0, 0, pa0); PK4(p0, 8, pa1); PK4(p1, 0, pa2); PK4(p1, 8, pa3);
#undef PK4
}
__device__ __forceinline__ void qkt(f32x16& p0, f32x16& p1, const bf16_t* Ks, const bf16x8* qr, int r32, int hi) {
#pragma unroll
  for (int r = 0; r < 16; ++r) { p0[r] = 0.f; p1[r] = 0.f; }
#pragma unroll
  for (int d0 = 0; d0 < 8; ++d0) { const int cb = (d0 * 16 + hi * 8) * 2;
    bf16x8 b0 = *reinterpret_cast<const bf16x8*>((const char*)Ks + KSWZ(r32, cb));
    bf16x8 b1 = *reinterpret_cast<const bf16x8*>((const char*)Ks + KSWZ(32 + r32, cb));
    p0 = __builtin_amdgcn_mfma_f32_32x32x16_bf16(b0, qr[d0], p0, 0, 0, 0);
    p1 = __builtin_amdgcn_mfma_f32_32x32x16_bf16(b1, qr[d0], p1, 0, 0, 0); }
}
__device__ __forceinline__ int v_st(int k, int c) { const int kk = (k & ~0xC) | ((k & 4) << 1) | ((k & 8) >> 1); return ((kk >> 3) * 4 + (c >> 5)) * 512 + ((kk & 7) * 32 + (c & 31)) * 2; }
__device__ __forceinline__ int v_rd_base(int lane) { return ((lane & 3) << 3) | (((lane >> 2) & 3) << 6) | (((lane >> 4) & 1) << 5) | (((lane >> 5) & 1) << 8); }
constexpr int v_rd_off(int d0, int ks, int half) { return d0 * 512 + ks * 4096 + half * 2048; }
template <int OFF> __device__ __forceinline__ s16x4 tr_read(int vb) {
  s16x4 r; asm volatile("ds_read_b64_tr_b16 %0, %1 offset:%2" : "=&v"(r) : "v"(vb), "i"(OFF) : "memory"); return r;
}
template <int D0> __device__ __forceinline__ void pv_one(f32x16& od, int vb, bf16x8 pa0, bf16x8 pa1, bf16x8 pa2, bf16x8 pa3) {
  const s16x4 l0 = tr_read<v_rd_off(D0, 0, 0)>(vb), h0 = tr_read<v_rd_off(D0, 0, 1)>(vb), l1 = tr_read<v_rd_off(D0, 1, 0)>(vb), h1 = tr_read<v_rd_off(D0, 1, 1)>(vb);
  const s16x4 l2 = tr_read<v_rd_off(D0, 2, 0)>(vb), h2 = tr_read<v_rd_off(D0, 2, 1)>(vb), l3 = tr_read<v_rd_off(D0, 3, 0)>(vb), h3 = tr_read<v_rd_off(D0, 3, 1)>(vb);
  asm volatile("s_waitcnt lgkmcnt(0)" ::: "memory"); SBAR();
#define PK(L, H) (bf16x8){L[0], L[1], L[2], L[3], H[0], H[1], H[2], H[3]}
  od = __builtin_amdgcn_mfma_f32_32x32x16_bf16(pa0, PK(l0, h0), od, 0, 0, 0);
  od = __builtin_amdgcn_mfma_f32_32x32x16_bf16(pa1, PK(l1, h1), od, 0, 0, 0);
  od = __builtin_amdgcn_mfma_f32_32x32x16_bf16(pa2, PK(l2, h2), od, 0, 0, 0);
  od = __builtin_amdgcn_mfma_f32_32x32x16_bf16(pa3, PK(l3, h3), od, 0, 0, 0);
#undef PK
}
__device__ __forceinline__ void pv_d0(f32x16* o, int vb, bf16x8 pa0, bf16x8 pa1, bf16x8 pa2, bf16x8 pa3) {
  pv_one<0>(o[0], vb, pa0, pa1, pa2, pa3); pv_one<1>(o[1], vb, pa0, pa1, pa2, pa3); pv_one<2>(o[2], vb, pa0, pa1, pa2, pa3); pv_one<3>(o[3], vb, pa0, pa1, pa2, pa3);
}
__device__ __forceinline__ void attn_body(const bf16_t* __restrict__ Qb, const bf16_t* __restrict__ Kh, const bf16_t* __restrict__ Vh,
                                          bf16_t* GO, int seq, char* lds) {
  const int tid = tid_fresh(), wid = tid >> 6, lane = tid & 63, r32 = lane & 31, hi = lane >> 5;
  bf16_t* V_lds = (bf16_t*)lds; bf16_t* K_lds = (bf16_t*)(lds + 2 * SHM_V);
  float* wsx = (float*)(lds + 2 * SHM_V + 2 * SHM_K) + wid * 64; float* li_l = wsx; float* al_l = wsx + 32;
  float m_reg = -1e30f, l_reg = 0; f32x16 o[4]; bf16x8 qr[8];
#pragma unroll
  for (int d = 0; d < 4; ++d)
#pragma unroll
    for (int r = 0; r < 16; ++r) o[d][r] = 0.f;
  const bf16_t* Qw = Qb + (long)(wid * QBLK + r32) * LDQ + hi * 8;
#pragma unroll
  for (int d0 = 0; d0 < 8; ++d0) qr[d0] = *reinterpret_cast<const bf16x8*>(Qw + d0 * 16);
  const int sr = tid >> 4, sc = (tid & 15) * 8, vst0 = v_st(sr, sc), vst1 = v_st(32 + sr, sc);
  const int vb0 = (int)(uintptr_t)V_lds + v_rd_base(lane);
  constexpr int SDEPTH = 1;
  bf16x8 sv0[SDEPTH], sv1[SDEPTH], sk0[SDEPTH], sk1[SDEPTH];
#define SLOAD(i, k0) do { sv0[i] = *reinterpret_cast<const bf16x8*>(&Vh[(long)((k0) + sr) * LDK + sc]); sv1[i] = *reinterpret_cast<const bf16x8*>(&Vh[(long)((k0) + 32 + sr) * LDK + sc]); \
    sk0[i] = *reinterpret_cast<const bf16x8*>(&Kh[(long)((k0) + sr) * LDK + sc]); sk1[i] = *reinterpret_cast<const bf16x8*>(&Kh[(long)((k0) + 32 + sr) * LDK + sc]); } while (0)
#define SWRITE(b, i) do { *(bf16x8*)((char*)V_lds + (b) * SHM_V + vst0) = sv0[i];          \
    *(bf16x8*)((char*)V_lds + (b) * SHM_V + vst1) = sv1[i]; const int kc = sc * 2;               \
    *(bf16x8*)((char*)K_lds + (b) * SHM_K + KSWZ(sr, kc)) = sk0[i];                       \
    *(bf16x8*)((char*)K_lds + (b) * SHM_K + KSWZ(32 + sr, kc)) = sk1[i]; } while (0)
#define SWAIT() do { if (SDEPTH == 2) asm volatile("s_waitcnt vmcnt(4)" ::: "memory"); else asm volatile("s_waitcnt vmcnt(0)" ::: "memory"); } while (0)
#define RESC(a) do { if (__any((a) < 1.f)) { if (hi == 0) al_l[r32] = (a); asm volatile("s_waitcnt lgkmcnt(0)" ::: "memory"); \
    _Pragma("unroll") for (int d = 0; d < 4; ++d) _Pragma("unroll") for (int r = 0; r < 16; ++r) o[d][r] *= al_l[crow(r, hi)]; } } while (0)
  f32x16 pA0, pA1, pB0, pB1; float mnA, mnB, alA, alB; bf16x8 pa0, pa1, pa2, pa3; const int NT = seq / KVBLK;
  constexpr int SE = 0, SO = SDEPTH - 1;
  SLOAD(SE, 0); asm volatile("s_waitcnt vmcnt(0)" ::: "memory"); SWRITE(0, SE); __syncthreads();
  qkt(pA0, pA1, K_lds, qr, r32, hi); partialSM(pA0, pA1, m_reg, mnA, alA);
  SLOAD(SO, KVBLK); if (SDEPTH == 2) { if (2 < NT) SLOAD(SE, 2 * KVBLK); }
  SWAIT(); SWRITE(1, SO); __syncthreads();
  for (int j = 1; j + 1 < NT; j += 2) {
    SBAR(); qkt(pB0, pB1, (bf16_t*)((char*)K_lds + SHM_K), qr, r32, hi);
    finishSM(pA0, pA1, alA, l_reg, pa0, pa1, pa2, pa3); SBAR();
    SLOAD(SO, (j + SDEPTH) * KVBLK); SBAR();
    pv_d0(o, vb0, pa0, pa1, pa2, pa3); partialSM(pB0, pB1, m_reg, mnB, alB);
    __syncthreads(); SWAIT(); SWRITE(0, SE);
    RESC(alB); __syncthreads();
    SBAR(); qkt(pA0, pA1, K_lds, qr, r32, hi);
    finishSM(pB0, pB1, alB, l_reg, pa0, pa1, pa2, pa3); SBAR();
    if (SDEPTH == 1 || j + 3 < NT) SLOAD(SE, (j + 1 + SDEPTH) * KVBLK); SBAR();
    pv_d0(o, vb0 + (int)SHM_V, pa0, pa1, pa2, pa3); partialSM(pA0, pA1, m_reg, mnA, alA);
    __syncthreads(); SWAIT(); SWRITE(1, SO);
    RESC(alA); __syncthreads();
  }
  SBAR(); qkt(pB0, pB1, (bf16_t*)((char*)K_lds + SHM_K), qr, r32, hi);
  finishSM(pA0, pA1, alA, l_reg, pa0, pa1, pa2, pa3); SBAR();
  pv_d0(o, vb0, pa0, pa1, pa2, pa3); partialSM(pB0, pB1, m_reg, mnB, alB);
  __syncthreads(); RESC(alB);
  finishSM(pB0, pB1, alB, l_reg, pa0, pa1, pa2, pa3); SBAR();
  pv_d0(o, vb0 + (int)SHM_V, pa0, pa1, pa2, pa3);
  if (hi == 0) li_l[r32] = l_reg; asm volatile("s_waitcnt lgkmcnt(0)" ::: "memory");
  float rli[16];
#pragma unroll
  for (int r = 0; r < 16; ++r) rli[r] = __builtin_amdgcn_rcpf(li_l[crow(r, hi)]);
  {
    bf16_t* Ow = GO + (long)(wid * QBLK) * 2048;
    char* sw = lds + 73728 + wid * (32 * 272);
#pragma unroll
    for (int i = 0; i < 8; ++i) {
      const int id = lane + 64 * i, row = id >> 4, ck = id & 15;
      *(u32x4*)(sw + row * 272 + ck * 16) = *(const u32x4*)(Ow + (long)row * 2048 + ck * 8);
    }
#pragma unroll
    for (int r = 0; r < 16; ++r) { const int orow = crow(r, hi);
#pragma unroll
      for (int d0 = 0; d0 < 4; ++d0) { bf16_t* q = (bf16_t*)(sw + orow * 272 + (d0 * 32 + r32) * 2); *q = f2bf(o[d0][r] * rli[r] * bf2f(*q)); }
    }
#pragma unroll
    for (int i = 0; i < 8; ++i) {
      const int id = lane + 64 * i, row = id >> 4, ck = id & 15;
      *(u32x4*)(Ow + (long)row * 2048 + ck * 8) = *(const u32x4*)(sw + row * 272 + ck * 16);
    }
  }
  __syncthreads();
#undef SLOAD
#undef SWRITE
#undef SWAIT
#undef RESC
}
}

__device__ __forceinline__ void chunk_gate_unit(const Params& p, int b, int n, char* smem) {
  char* ws = p.ws;
  const bf16_t* BU = (const bf16_t*)(ws + OFF_BU); const bf16_t* BV = (const bf16_t*)(ws + OFF_BV);
  bf16_t* SG = (bf16_t*)(ws + OFF_SG); const bf16_t* WSB = (const bf16_t*)(ws + OFF_WSB);
  const int tid = tid_fresh(), wid = tid >> 6, lane = tid & 63, r32 = lane & 31, hi = lane >> 5;
  constexpr int RS = 272;
  char* sW = smem; char* sV = smem + 128 * RS;
  float* smu = (float*)(smem + 2 * 128 * RS); float* srs = smu + 128;
  const size_t tok0 = (size_t)b * SEQ + (size_t)n * 128;
  {
    const int q = tid >> 2, part = tid & 3;
    const u32x4* src = (const u32x4*)(BV + (tok0 + q) * 1024 + part * 256);
    float s = 0.f, s2 = 0.f;
#pragma unroll 4
    for (int i = 0; i < 32; ++i) {
      const u32x4 w = src[i];
#pragma unroll
      for (int e = 0; e < 4; ++e) { const float a = bf_lo(w[e]), c = bf_hi(w[e]); s += a + c; s2 += a * a + c * c; }
    }
    s += __shfl_xor(s, 1); s2 += __shfl_xor(s2, 1); s += __shfl_xor(s, 2); s2 += __shfl_xor(s2, 2);
    const float mu = s * (1.f / 1024.f);
    const float var = fmaxf(s2 * (1.f / 1024.f) - mu * mu, 0.f);
    if (part == 0) { smu[q] = mu; srs[q] = rsqrtf(var + EPS); }
  }
  __syncthreads();
  const int wp = wid >> 1, wc = wid & 1;
  for (int g = 0; g < 8; ++g) {
#pragma unroll
    for (int i = 0; i < 4; ++i) {
      const int id = tid + 512 * i, row = id >> 4, ck = (id & 15) * 8;
      *(u32x4*)(sW + row * RS + ck * 2) = *(const u32x4*)(WSB + (size_t)g * 16384 + row * 128 + ck);
    }
#pragma unroll
    for (int i = 0; i < 4; ++i) {
      const int id = tid + 512 * i, q = id & 127, cc = (id >> 7) * 8;
      const u32x4 w = *(const u32x4*)(BV + (tok0 + q) * 1024 + g * 128 + cc);
      const float mu = smu[q], rs = srs[q];
      const float* lg = p.e_vg + g * 128 + cc; const float* lbp = p.e_vb + g * 128 + cc;
#pragma unroll
      for (int e = 0; e < 4; ++e) {
        const float a = (bf_lo(w[e]) - mu) * rs * lg[2 * e] + lbp[2 * e];
        const float c = (bf_hi(w[e]) - mu) * rs * lg[2 * e + 1] + lbp[2 * e + 1];
        *(bf16_t*)(sV + (cc + 2 * e) * RS + q * 2) = f2bf(a);
        *(bf16_t*)(sV + (cc + 2 * e + 1) * RS + q * 2) = f2bf(c);
      }
    }
    __syncthreads();
    f32x16 acc0, acc1;
#pragma unroll
    for (int r = 0; r < 16; ++r) { acc0[r] = 0.f; acc1[r] = 0.f; }
#pragma unroll
    for (int kk = 0; kk < 8; ++kk) {
      const bf16x8 af = *(const bf16x8*)(sW + (wp * 32 + r32) * RS + kk * 32 + hi * 16);
      const bf16x8 b0 = *(const bf16x8*)(sV + (wc * 64 + r32) * RS + kk * 32 + hi * 16);
      const bf16x8 b1 = *(const bf16x8*)(sV + (wc * 64 + 32 + r32) * RS + kk * 32 + hi * 16);
      acc0 = __builtin_amdgcn_mfma_f32_32x32x16_bf16(b0, af, acc0, 0, 0, 0);
      acc1 = __builtin_amdgcn_mfma_f32_32x32x16_bf16(b1, af, acc1, 0, 0, 0);
    }
    const int pr = wp * 32 + r32;
    const float bias = p.e_bs[g * 128 + pr];
    const size_t tok = tok0 + pr;
#pragma unroll
    for (int nj = 0; nj < 2; ++nj)
#pragma unroll
      for (int q = 0; q < 4; ++q) {
        const int col = g * 128 + wc * 64 + nj * 32 + q * 8 + hi * 4;
        const u32x2 bu = *(const u32x2*)(BU + tok * 1024 + col);
        bf16_t* gp = SG + tok * 2048 + 1024 + col;
        const u32x2 sg = *(const u32x2*)gp;
        const float m0 = (nj ? acc1[4 * q + 0] : acc0[4 * q + 0]) + bias, m1 = (nj ? acc1[4 * q + 1] : acc0[4 * q + 1]) + bias;
        const float m2 = (nj ? acc1[4 * q + 2] : acc0[4 * q + 2]) + bias, m3 = (nj ? acc1[4 * q + 3] : acc0[4 * q + 3]) + bias;
        st_bf4(gp, bf_lo(bu[0]) * m0 * bf_lo(sg[0]), bf_hi(bu[0]) * m1 * bf_hi(sg[0]), bf_lo(bu[1]) * m2 * bf_lo(sg[1]), bf_hi(bu[1]) * m3 * bf_hi(sg[1]));
      }
    __syncthreads();
  }
}

__device__ __forceinline__ void post_ln_rows(const float* resid, const bf16_t* yg, float* dst, const float* pg, const float* pb, bf16_t* m1, const float* mod17) {
  const int tid = tid_fresh(), wid = tid >> 6, lane = tid & 63;
  const int gw = blockIdx.x * 8 + wid, nw = gridDim.x * 8;
  float4 nx[4]; u32x2 ny[4];
  { const float4* ps = (const float4*)(resid + (size_t)gw * 1024); const u32x2* py = (const u32x2*)(yg + (size_t)gw * 1024);
#pragma unroll
    for (int j = 0; j < 4; ++j) { nx[j] = ps[lane + 64 * j]; ny[j] = py[lane + 64 * j]; } }
  for (int row = gw; row < NTOK; row += nw) {
    float4 v[4];
#pragma unroll
    for (int j = 0; j < 4; ++j) {
      v[j].x = ALPHA * nx[j].x + bf_lo(ny[j][0]); v[j].y = ALPHA * nx[j].y + bf_hi(ny[j][0]);
      v[j].z = ALPHA * nx[j].z + bf_lo(ny[j][1]); v[j].w = ALPHA * nx[j].w + bf_hi(ny[j][1]);
    }
    { const int nr = (row + nw < NTOK) ? row + nw : row;
      const float4* ps = (const float4*)(resid + (size_t)nr * 1024); const u32x2* py = (const u32x2*)(yg + (size_t)nr * 1024);
#pragma unroll
      for (int j = 0; j < 4; ++j) { nx[j] = ps[lane + 64 * j]; ny[j] = py[lane + 64 * j]; } }
    float s = 0.f;
#pragma unroll
    for (int j = 0; j < 4; ++j) s += v[j].x + v[j].y + v[j].z + v[j].w;
    float mu = wave_sum(s) * (1.f / 1024.f);
    float q = 0.f;
#pragma unroll
    for (int j = 0; j < 4; ++j) { v[j].x -= mu; v[j].y -= mu; v[j].z -= mu; v[j].w -= mu; q += v[j].x * v[j].x + v[j].y * v[j].y + v[j].z * v[j].z + v[j].w * v[j].w; }
    float rstd = rsqrtf(wave_sum(q) * (1.f / 1024.f) + EPS);
    float4* pd = (float4*)(dst + (size_t)row * 1024);
    s = 0.f;
#pragma unroll
    for (int j = 0; j < 4; ++j) {
      const int col = (lane + 64 * j) * 4;
      const float4 g4 = *(const float4*)(pg + col), b4 = *(const float4*)(pb + col);
      v[j].x = v[j].x * rstd * g4.x + b4.x; v[j].y = v[j].y * rstd * g4.y + b4.y; v[j].z = v[j].z * rstd * g4.z + b4.z; v[j].w = v[j].w * rstd * g4.w + b4.w;
      pd[lane + 64 * j] = v[j];
      s += v[j].x + v[j].y + v[j].z + v[j].w;
    }
    if (m1) {
      mu = wave_sum(s) * (1.f / 1024.f);
      q = 0.f;
#pragma unroll
      for (int j = 0; j < 4; ++j) { v[j].x -= mu; v[j].y -= mu; v[j].z -= mu; v[j].w -= mu; q += v[j].x * v[j].x + v[j].y * v[j].y + v[j].z * v[j].z + v[j].w * v[j].w; }
      rstd = rsqrtf(wave_sum(q) * (1.f / 1024.f) + EPS);
      const float* md = mod17 + (size_t)(row >> 11) * 3072;
      bf16_t* pm = m1 + (size_t)row * 1024;
#pragma unroll
      for (int j = 0; j < 4; ++j) {
        const int col = (lane + 64 * j) * 4;
        const float4 sh = *(const float4*)(md + col), sc = *(const float4*)(md + 1024 + col);
        st_bf4(pm + col, v[j].x * rstd * (1.f + sc.x) + sh.x, v[j].y * rstd * (1.f + sc.y) + sh.y, v[j].z * rstd * (1.f + sc.z) + sh.z, v[j].w * rstd * (1.f + sc.w) + sh.w);
      }
    }
  }
}

__device__ __forceinline__ void out_proj(const bf16_t* A, const bf16_t* WT, const float* gate17, bf16_t* dst, char* smem) {
  const int lb = logical_block();
  for (int u = lb; u < 512; u += gridDim.x) {
    const int mt = u >> 2, nt = u & 3;
    f32x16 acc[2][4];
    gemm2(mkPlain(A + (size_t)mt * 256 * 2048, 2048), mkPlain(WT + (size_t)nt * 256 * 2048, 2048), 32, smem, acc);
    const float* gt = gate17 + (size_t)(mt >> 3) * 3072 + 2048 + nt * 256;
    epi2_store_lds(acc, smem, [&](int, int col, float& a, float& b, float& c, float& d) {
      const float4 g4 = *(const float4*)(gt + col);
      a *= g4.x; b *= g4.y; c *= g4.z; d *= g4.w;
    }, dst + (size_t)mt * 256 * 1024 + nt * 256, 1024);
  }
}

#define XB_TMO      128
#define XB_XCNT(j)  (256  + 64 * (j))
#define XB_XSUB(j)  (1280 + 64 * (j))
#define XB_XGEN(j)  (2304 + 64 * (j))
#define XB_TOP      3328
#define XB_TOPGEN   3392
#define XCD_BAR_WORDS 3456
#define XB_SPIN_CAP (1u << 18)
#define LAS __attribute__((address_space(3)))

__device__ __forceinline__ unsigned xb_ld(unsigned* p)              { return __hip_atomic_load(p, __ATOMIC_RELAXED, __HIP_MEMORY_SCOPE_AGENT); }
__device__ __forceinline__ unsigned xb_add(unsigned* p, unsigned v) { return __hip_atomic_fetch_add(p, v, __ATOMIC_RELAXED, __HIP_MEMORY_SCOPE_AGENT); }
__device__ __forceinline__ unsigned xb_xcc_id() { return (unsigned)__builtin_amdgcn_s_getreg((3 << 11) | 20) & 0xFu; }
#define XB_SPIN(cond, bar) do { unsigned _sp = 0; while (cond) { __builtin_amdgcn_s_sleep(1); \
    if ((++_sp & 255u) == 0u) { if (xb_ld(&(bar)[XB_TMO])) break; if (_sp > XB_SPIN_CAP) { atomicAdd(&(bar)[XB_TMO], 1u); break; } } } } while (0)

struct XcdBarrier {
    unsigned* bar; unsigned x;
    volatile LAS unsigned* st;
};

__device__ __forceinline__ XcdBarrier xcd_barrier_post(unsigned* bar, volatile LAS unsigned* st) {
    XcdBarrier b; b.bar = bar; b.x = xb_xcc_id(); b.st = st;
    if (threadIdx.x == 0) (void)xb_add(&bar[XB_XCNT(b.x)], 1u);
    return b;
}
__device__ __forceinline__ void xcd_barrier_complete(unsigned* bar, unsigned x, unsigned& nloc, unsigned& nx) {
    const unsigned G = gridDim.x * gridDim.y * gridDim.z;
    unsigned sum, cnt, mine, sp = 0u;
    for (;;) {
        sum = 0u; cnt = 0u; mine = 0u;
#pragma unroll
        for (unsigned j = 0; j < 16; ++j) { const unsigned c = xb_ld(&bar[XB_XCNT(j)]); sum += c; cnt += (c > 0u) ? 1u : 0u; mine = (j == x) ? c : mine; }
        if (sum == G) break;
        __builtin_amdgcn_s_sleep(1);
        if ((++sp & 255u) == 0u) { if (xb_ld(&bar[XB_TMO])) break; if (sp > XB_SPIN_CAP) { atomicAdd(&bar[XB_TMO], 1u); break; } }
    }
    nloc = mine > 0u ? mine : 1u; nx = cnt > 0u ? cnt : 1u;
}

__device__ __forceinline__ void xcd_barrier(const XcdBarrier& b) {
    asm volatile("s_waitcnt vmcnt(0)" ::: "memory");
    __syncthreads();
    if (threadIdx.x == 0) {
        unsigned* bar = b.bar;
        __builtin_amdgcn_s_waitcnt(0);
        unsigned nloc = b.st[0], nx = b.st[1];
        if (nloc == 0u) { xcd_barrier_complete(bar, b.x, nloc, nx); b.st[0] = nloc; b.st[1] = nx; }
        const unsigned old = xb_add(&bar[XB_XSUB(b.x)], 1u);
        const unsigned gen = old / nloc;
        if (old + 1u == (gen + 1u) * nloc) {
            __builtin_amdgcn_fence(__ATOMIC_RELEASE, "agent");
            asm volatile("s_waitcnt vmcnt(0)" ::: "memory");
            const unsigned og = xb_add(&bar[XB_TOP], 1u);
            const unsigned tg = og / nx;
            if (og + 1u == (tg + 1u) * nx) xb_add(&bar[XB_TOPGEN], 1u);
            else XB_SPIN(xb_ld(&bar[XB_TOPGEN]) == tg, bar);
            __builtin_amdgcn_fence(__ATOMIC_ACQUIRE, "agent");
            xb_add(&bar[XB_XGEN(b.x)], 1u);
            asm volatile("s_waitcnt vmcnt(0)" ::: "memory");
        } else {
            XB_SPIN(xb_ld(&bar[XB_XGEN(b.x)]) == gen, bar);
            __builtin_amdgcn_fence(__ATOMIC_ACQUIRE, "agent");
            asm volatile("s_waitcnt vmcnt(0)" ::: "memory");
        }
    }
    __syncthreads();
}


constexpr size_t OFF_XBAR = OFF_SMALL + 1536 * 1024;
constexpr size_t OFF_PX = OFF_SMALL + 1152 * 1024;
#define GSYNC_CG() do { __threadfence(); grid.sync(); __threadfence(); } while (0)
#define GSYNC() xcd_barrier(xbar)
#ifndef LAUNCH_SPLITS
#define LAUNCH_SPLITS {{0,0},{1,1},{2,2},{3,3},{4,4},{5,5},{6,6},{7,7},{8,8},{9,9},{10,10}}
#endif
template <int PLO, int PHI>
__global__ void __launch_bounds__(512) mega(Params p) {
  cg::grid_group grid = cg::this_grid();
  __shared__ __attribute__((aligned(16))) char smem[SMEM_BYTES];
  char* ws = p.ws;
  float* MOD = (float*)(ws + OFF_MOD);
  const int lb = logical_block();
  volatile LAS unsigned* xst = (volatile LAS unsigned*)(smem + LDS_RED + 2048);
  if (tid_fresh() < 4) xst[tid_fresh()] = 0u;
  __syncthreads();
  XcdBarrier xbar = xcd_barrier_post((unsigned*)(ws + OFF_XBAR), xst);
  if (PLO < PHI) grid.sync();

  if (PLO <= 0 && 0 <= PHI) {
  phase0(p, smem);
  }
  if (PLO <= 0 && 0 < PHI) { GSYNC(); }
  if (PLO <= 1 && 1 <= PHI) {

  ln_rows_modulate(p.x, (bf16_t*)(ws + OFF_M0), NTOK, SEQ, MOD, -1);
  ln_rows_modulate(p.ctx, (bf16_t*)(ws + OFF_MC), NCTX, CTXL, MOD, 16);
  }
  if (PLO <= 1 && 1 < PHI) { GSYNC(); }
  if (PLO <= 2 && 2 <= PHI) {

  phase2(p, smem);
  }
  if (PLO <= 2 && 2 < PHI) { GSYNC(); }
  if (PLO <= 3 && 3 <= PHI) {

  for (int u = lb; u < 1024; u += gridDim.x) {
      const int grp = u >> 5, j = u & 31, b = grp >> 1, kvh = grp & 1, hq = kvh * 4 + (j >> 3), qb = j & 7;
      const bf16_t* Qb = (const bf16_t*)(ws + OFF_Q) + ((size_t)(b * SEQ + qb * 256) * 8 + hq) * 128;
      const bf16_t* Kh = (const bf16_t*)(ws + OFF_KALL) + ((size_t)b * SKV * 2 + kvh) * 128;
      const bf16_t* Vh = (const bf16_t*)(ws + OFF_VALL) + ((size_t)b * SKV * 2 + kvh) * 128;
      bf16_t* GO = (bf16_t*)(ws + OFF_SG) + (size_t)(b * SEQ + qb * 256) * 2048 + hq * 128;
      att::attn_body(Qb, Kh, Vh, GO, SKV, smem);
  }
  for (int v = lb; v < 256; v += gridDim.x) chunk_gate_unit(p, v >> 4, v & 15, smem);
  }
  if (PLO <= 3 && 3 < PHI) { GSYNC(); }
  if (PLO <= 4 && 4 <= PHI) {

  out_proj((const bf16_t*)(ws + OFF_SG), (const bf16_t*)(ws + OFF_WT_EOUT), MOD, (bf16_t*)(ws + OFF_YG), smem);
  }
  if (PLO <= 4 && 4 < PHI) { GSYNC(); }
  if (PLO <= 5 && 5 <= PHI) {

  post_ln_rows(p.x, (const bf16_t*)(ws + OFF_YG), (float*)(ws + OFF_Q), p.post_g, p.post_b, (bf16_t*)(ws + OFF_M0), MOD + 17 * 3072);
  }
  if (PLO <= 5 && 5 < PHI) { GSYNC(); }
  if (PLO <= 6 && 6 <= PHI) {

  {
    const bf16_t* M1 = (const bf16_t*)(ws + OFF_M0); const bf16_t* WT = (const bf16_t*)(ws + OFF_WT_OIN);
    bf16_t* F = (bf16_t*)(ws + OFF_F); bf16_t* RV = (bf16_t*)(ws + OFF_RV); bf16_t* XM = (bf16_t*)(ws + OFF_XM);
    bf16_t* SG1 = (bf16_t*)(ws + OFF_SG);
    for (int u = lb; u < 2048; u += gridDim.x) {
      f32x16 acc[2][4];
      if (u < 1024) {
        const int tt = u >> 3, ct = u & 7, b = tt >> 3, t0 = (tt & 7) * 256;
        gemm2(mkPlain(WT + (size_t)ct * 256 * 1024, 1024), mkPlain(M1 + (size_t)tt * 256 * 1024, 1024), 16, smem, acc);
        const size_t rbase = ((size_t)b * 2048 + ct * 256) * 1024;
        if (t0 < 1024) {
          epi2_store_lds(acc, smem, [&](int, int, float&, float&, float&, float&) {}, F + rbase + t0, 1024);
          if (t0 == 0 && tid_fresh() < 256) RV[rbase + (size_t)tid_fresh() * 1024] = 0;
        } else {
          const int P0 = 1792 - t0;
          epi2_foreach(acc, [&](int row, int col, float a, float bq, float c, float d) {
            char* lr = smem + row * ET_S;
            if (col == 0) {
              const bf16_t v0 = f2bf(a);
              if (t0 == 1024) XM[(size_t)b * 2048 + ct * 256 + row] = v0; else RV[rbase + (size_t)row * 1024 + P0 + 256] = v0;
            } else *(bf16_t*)(lr + (256 - col) * 2) = f2bf(a);
            *(bf16_t*)(lr + (255 - col) * 2) = f2bf(bq); *(bf16_t*)(lr + (254 - col) * 2) = f2bf(c); *(bf16_t*)(lr + (253 - col) * 2) = f2bf(d);
          });
          __syncthreads();
          {
            const int tid = tid_fresh();
#pragma unroll
            for (int i = 0; i < 16; ++i) {
              const int id = tid + 512 * i, row = id >> 5, ck = id & 31;
              bf16_t* gp = RV + rbase + (size_t)row * 1024 + P0 + ck * 8;
              const char* lp = smem + row * ET_S + ck * 16;
              if (ck) *(u32x4*)gp = *(const u32x4*)lp;
              else {
#pragma unroll
                for (int e = 1; e < 8; ++e) gp[e] = *(const bf16_t*)(lp + e * 2);
              }
            }
          }
          __syncthreads();
        }
      } else {
        const int v = u - 1024, mt = v >> 3, nt = v & 7;
        gemm2(mkPlain(M1 + (size_t)mt * 256 * 1024, 1024), mkPlain(WT + (size_t)(2048 + nt * 256) * 1024, 1024), 16, smem, acc);
        epi2_store_lds(acc, smem, [&](int, int, float& a, float& bq, float& c, float& d) { a = silu_f(a); bq = silu_f(bq); c = silu_f(c); d = silu_f(d); },
                       SG1 + (size_t)mt * 256 * 2048 + nt * 256, 2048);
      }
    }
  }
  }
  if (PLO <= 6 && 6 < PHI) { GSYNC(); }
  if (PLO <= 7 && 7 <= PHI) {

  {
    bf16_t* EE = (bf16_t*)p.out + (size_t)32 * MiB;
    bf16_t* EO = EE + (size_t)16 * MiB;
    bf16_t* OE = (bf16_t*)(ws + OFF_M0); bf16_t* OO = OE + (size_t)16 * MiB;
    float* PX = (float*)(ws + OFF_PX); float* E512 = PX + 32768; float* O512 = PX + 65536;
    {
      const int tid = tid_fresh(), wid = tid >> 6, lane = tid & 63;
      const int gw = blockIdx.x * 8 + wid, nw = gridDim.x * 8;
      const bf16_t* XMr = (const bf16_t*)(ws + OFF_XM);
      u32x4 na0, na1, nb0, nb1;
      { const size_t ro = (size_t)gw * 128; const u32x4* Fr = (const u32x4*)(ws + OFF_F) + ro; const u32x4* Rr = (const u32x4*)(ws + OFF_RV) + ro;
        na0 = Fr[lane]; na1 = Fr[lane + 64]; nb0 = Rr[lane]; nb1 = Rr[lane + 64]; }
      const int src1 = 63 - lane, src0 = (64 - lane) & 63;
      for (int row = gw; row < 16 * 2048; row += nw) {
        const u32x4 a0 = na0, a1 = na1, b0 = nb0, b1 = nb1;
        { const int nr = (row + nw < 16 * 2048) ? row + nw : row; const size_t ro = (size_t)nr * 128;
          const u32x4* Fr = (const u32x4*)(ws + OFF_F) + ro; const u32x4* Rr = (const u32x4*)(ws + OFF_RV) + ro;
          na0 = Fr[lane]; na1 = Fr[lane + 64]; nb0 = Rr[lane]; nb1 = Rr[lane + 64]; }
        float e1[8], o1[8], e2[8], o2[8];
#pragma unroll
        for (int k = 0; k < 4; ++k) {
          { const float al = bf_lo(a0[k]), ah = bf_hi(a0[k]), bl = bf_lo(b0[k]), bh = bf_hi(b0[k]);
            e1[2 * k] = al + bl; e1[2 * k + 1] = ah + bh; o1[2 * k] = al - bl; o1[2 * k + 1] = ah - bh; }
          { const float al = bf_lo(a1[k]), ah = bf_hi(a1[k]), bl = bf_lo(b1[k]), bh = bf_hi(b1[k]);
            e2[2 * k] = al + bl; e2[2 * k + 1] = ah + bh; o2[2 * k] = al - bl; o2[2 * k + 1] = ah - bh; }
        }
        float alt = 0.f;
#pragma unroll
        for (int j = 0; j < 8; j += 2) alt += (e1[j] - e1[j + 1]) + (e2[j] - e2[j + 1]);
        float me[8], mo[8];
        me[0] = __shfl(e2[0], src0); mo[0] = __shfl(o2[0], src0);
        if (lane == 0) { me[0] = 0.f; mo[0] = 0.f; }
#pragma unroll
        for (int j = 1; j < 8; ++j) { me[j] = __shfl(e2[8 - j], src1); mo[j] = __shfl(o2[8 - j], src1); }
        u32x4 wee, weo, woe, woo;
#pragma unroll
        for (int k = 0; k < 4; ++k) {
          wee[k] = cvtpk(e1[2 * k] + me[2 * k], e1[2 * k + 1] + me[2 * k + 1]);
          weo[k] = cvtpk(e1[2 * k] - me[2 * k], e1[2 * k + 1] - me[2 * k + 1]);
          woe[k] = cvtpk(o1[2 * k] - mo[2 * k], o1[2 * k + 1] - mo[2 * k + 1]);
          woo[k] = cvtpk(o1[2 * k] + mo[2 * k], o1[2 * k + 1] + mo[2 * k + 1]);
        }
        const size_t wo = (size_t)row * 64 + lane;
        ((u32x4*)EE)[wo] = wee; ((u32x4*)EO)[wo] = weo; ((u32x4*)OE)[wo] = woe; ((u32x4*)OO)[wo] = woo;
        alt = wave_sum(alt);
        if (lane == 0) { PX[row] = alt + bf2f(XMr[row]); E512[row] = e2[0]; O512[row] = o2[0]; }
      }
    }
    if (PLO < PHI) { GSYNC(); }
    const bf16_t* XM = (const bf16_t*)(ws + OFF_XM);
    const bf16_t* TAB = (const bf16_t*)(ws + OFF_TAB_C);
    bf16_t* PC = (bf16_t*)p.out; bf16_t* PS = (bf16_t*)(ws + OFF_F);
    for (int u = lb; u < 1024; u += gridDim.x) {
      f32x16 acc[2][4];
      const int ty = u >> 8, v = u & 255, b = v >> 4, mt = (v >> 3) & 1, nt = v & 7;
      const bf16_t* Bsrc = (ty == 0) ? EE : (ty == 1) ? EO : (ty == 2) ? OE : OO;
      gemm2(mkPlain(TAB + (size_t)ty * 512 * 512 + (size_t)mt * 256 * 512, 512), mkPlain(Bsrc + ((size_t)b * 2048 + nt * 256) * 512, 512), 8, smem, acc);
      bf16_t* dstP = (ty < 2) ? PC : PS;
      const int par = ty & 1;
      epi2_store_lds(acc, smem, [&](int row, int col, float& a, float& bq, float& c, float& d) {
        const int sidx = mt * 256 + row, ch = nt * 256 + col;
        const size_t vi = (size_t)b * 2048 + ch;
        const float sg = (sidx & 1) ? -1.f : 1.f;
        if (ty == 0) {
          const u32x2 xm = *(const u32x2*)(XM + vi); const float4 em = *(const float4*)(E512 + vi);
          a += sg * em.x + bf_lo(xm[0]); bq += sg * em.y + bf_hi(xm[0]); c += sg * em.z + bf_lo(xm[1]); d += sg * em.w + bf_hi(xm[1]);
        } else if (ty == 1) {
          const u32x2 xm = *(const u32x2*)(XM + vi);
          a -= bf_lo(xm[0]); bq -= bf_hi(xm[0]); c -= bf_lo(xm[1]); d -= bf_hi(xm[1]);
        } else if (ty == 3) {
          const float4 om = *(const float4*)(O512 + vi);
          a += sg * om.x; bq += sg * om.y; c += sg * om.z; d += sg * om.w;
        }
      }, dstP + ((size_t)b * 1024 + 2 * (mt * 256) + par) * 2048 + nt * 256, 4096);
    }
  }
  }
  if (PLO <= 7 && 7 < PHI) { GSYNC(); }
  if (PLO <= 8 && 8 <= PHI) {

  {
    const bf16_t* PC = (const bf16_t*)p.out; const bf16_t* PS = (const bf16_t*)(ws + OFF_F);
    const bf16_t* CDP = (const bf16_t*)(ws + OFF_CDP);
    bf16_t* SG1 = (bf16_t*)(ws + OFF_SG);
    const int tid = tid_fresh(), wid = tid >> 6, lane = tid & 63, r32 = lane & 31, hi = lane >> 5, wm = wid >> 1, wn = wid & 1;
    constexpr int TBS = 528;
    constexpr int TB_BYTES = 128 * TBS;
    char* sT = smem; char* sA = smem + TB_BYTES;
#pragma unroll
    for (int i = 0; i < 8; ++i) {
      const int id = tid + 512 * i, row = id >> 5, ck = id & 31;
      *(u32x4*)(sT + row * TBS + ck * 16) = *(const u32x4*)(CDP + row * 256 + ck * 8);
    }
    const int st_off = (tid >> 3) * LDS_ROWB + (tid & 7) * 16;
    const int a_rd = (wm * 64 + r32) * LDS_ROWB + hi * 16;
    const int b_rd = (wn * 32 + r32) * TBS + hi * 16;
    const size_t rowoff = (size_t)(tid >> 3) * 2048 + (tid & 7) * 8;
    u32x4 r00, r01, r02, r03, r10, r11, r12, r13, r20, r21, r22, r23, r30, r31, r32_, r33;
    auto a_base = [&](int u_, int s_) -> const bf16_t* {
      const int b_ = u_ >> 6, j_ = (u_ >> 4) & 3, G_ = u_ & 15;
      return ((s_ < 2) ? PC : PS) + ((size_t)b_ * 1024 + j_ * 256) * 2048 + G_ * 128 + (s_ & 1) * 64 + rowoff;
    };
#define P8_LOAD(S, U, A, B, C, D) do { const bf16_t* q_ = a_base((U), (S)); A = *(const u32x4*)(q_); B = *(const u32x4*)(q_ + (size_t)64 * 2048); \
      C = *(const u32x4*)(q_ + (size_t)128 * 2048); D = *(const u32x4*)(q_ + (size_t)192 * 2048); } while (0)
#define P8_WRITE(ST, A, B, C, D) do { char* s_ = sA + (ST) * L2_A + st_off; *(u32x4*)(s_) = A; *(u32x4*)(s_ + 64 * LDS_ROWB) = B; \
      *(u32x4*)(s_ + 128 * LDS_ROWB) = C; *(u32x4*)(s_ + 192 * LDS_ROWB) = D; } while (0)
#define P8_COMPUTE(ST, S, ACC) do { const char* sb_ = sA + (ST) * L2_A;                                              \
      _Pragma("unroll") for (int kk = 0; kk < 4; ++kk) {                                                               \
        const bf16x8 fa0 = *(const bf16x8*)(sb_ + a_rd + kk * 32);                                                      \
        const bf16x8 fa1 = *(const bf16x8*)(sb_ + a_rd + 32 * LDS_ROWB + kk * 32);                                      \
        const bf16x8 fb0 = *(const bf16x8*)(sT + b_rd + ((S) * 64 + kk * 16) * 2);                                      \
        const bf16x8 fb1 = *(const bf16x8*)(sT + b_rd + 64 * TBS + ((S) * 64 + kk * 16) * 2);                           \
        ACC[0][0] = __builtin_amdgcn_mfma_f32_32x32x16_bf16(fb0, fa0, ACC[0][0], 0, 0, 0);                              \
        ACC[0][1] = __builtin_amdgcn_mfma_f32_32x32x16_bf16(fb1, fa0, ACC[0][1], 0, 0, 0);                              \
        ACC[1][0] = __builtin_amdgcn_mfma_f32_32x32x16_bf16(fb0, fa1, ACC[1][0], 0, 0, 0);                              \
        ACC[1][1] = __builtin_amdgcn_mfma_f32_32x32x16_bf16(fb1, fa1, ACC[1][1], 0, 0, 0);                              \
      } } while (0)
    P8_LOAD(0, lb, r00, r01, r02, r03); P8_LOAD(1, lb, r10, r11, r12, r13); P8_LOAD(2, lb, r20, r21, r22, r23); P8_LOAD(3, lb, r30, r31, r32_, r33);
    for (int u = lb; u < 1024; u += gridDim.x) {
      const int un = (u + (int)gridDim.x < 1024) ? u + (int)gridDim.x : u;
      f32x16 acc1[2][2], acc2[2][2];
#pragma unroll
      for (int mi = 0; mi < 2; ++mi)
#pragma unroll
        for (int nj = 0; nj < 2; ++nj)
#pragma unroll
          for (int r = 0; r < 16; ++r) { acc1[mi][nj][r] = 0.f; acc2[mi][nj][r] = 0.f; }
      P8_WRITE(0, r00, r01, r02, r03); __syncthreads(); P8_LOAD(0, un, r00, r01, r02, r03); P8_COMPUTE(0, 0, acc1);
      P8_WRITE(1, r10, r11, r12, r13); __syncthreads(); P8_LOAD(1, un, r10, r11, r12, r13); P8_COMPUTE(1, 1, acc1);
      P8_WRITE(0, r20, r21, r22, r23); __syncthreads(); P8_LOAD(2, un, r20, r21, r22, r23); P8_COMPUTE(0, 2, acc2);
      P8_WRITE(1, r30, r31, r32_, r33); __syncthreads(); P8_LOAD(3, un, r30, r31, r32_, r33); P8_COMPUTE(1, 3, acc2);
      const int b = u >> 6, j = (u >> 4) & 3, G = u & 15;
      const float sc = 1.f / 512.f;
      char* sE = sA;
      constexpr int ES = 272;
      __syncthreads();
#pragma unroll 1
      for (int pass = 0; pass < 2; ++pass) {
#pragma unroll
        for (int i = 0; i < 8; ++i) {
          const int id = tid + 512 * i, row = id >> 4, ck = id & 15, tp = j * 256 + row;
          const int tok = pass ? ((tp >= 1) ? 2048 - tp : 0) : tp;
          *(u32x4*)(sE + row * ES + ck * 16) = *(const u32x4*)(SG1 + ((size_t)b * 2048 + tok) * 2048 + G * 128 + ck * 8);
        }
        __syncthreads();
        const float sgn = pass ? 1.f : -1.f;
#pragma unroll
        for (int mi = 0; mi < 2; ++mi)
#pragma unroll
          for (int nj = 0; nj < 2; ++nj)
#pragma unroll
            for (int q = 0; q < 4; ++q) {
              char* ad = sE + (wm * 64 + mi * 32 + r32) * ES + (nj * 64 + wn * 32 + q * 8 + hi * 4) * 2;
              const u32x2 sg = *(const u32x2*)ad;
              const float y0 = (acc1[mi][nj][4 * q + 0] + sgn * acc2[mi][nj][4 * q + 0]) * sc, y1 = (acc1[mi][nj][4 * q + 1] + sgn * acc2[mi][nj][4 * q + 1]) * sc;
              const float y2 = (acc1[mi][nj][4 * q + 2] + sgn * acc2[mi][nj][4 * q + 2]) * sc, y3 = (acc1[mi][nj][4 * q + 3] + sgn * acc2[mi][nj][4 * q + 3]) * sc;
              u32x2 w = {cvtpk(y0 * bf_lo(sg[0]), y1 * bf_hi(sg[0])), cvtpk(y2 * bf_lo(sg[1]), y3 * bf_hi(sg[1]))};
              *(u32x2*)ad = w;
            }
        __syncthreads();
#pragma unroll
        for (int i = 0; i < 8; ++i) {
          const int id = tid + 512 * i, row = id >> 4, ck = id & 15, tp = j * 256 + row;
          if (!pass || tp >= 1) {
            const int tok = pass ? 2048 - tp : tp;
            *(u32x4*)(SG1 + ((size_t)b * 2048 + tok) * 2048 + G * 128 + ck * 8) = *(const u32x4*)(sE + row * ES + ck * 16);
          }
        }
        __syncthreads();
      }
    }
#undef P8_LOAD
#undef P8_WRITE
#undef P8_COMPUTE
    {
      const float* PX = (const float*)(ws + OFF_PX);
      for (int i = blockIdx.x; i < 256; i += gridDim.x) {
        if (tid < 128) {
          const int b = i >> 4, G = i & 15;
          const float* px = PX + (size_t)b * 2048 + G * 128;
          float y = 0.f;
          for (int c = 0; c < 128; ++c) y += px[c] * bf2f(*(const bf16_t*)(sT + tid * TBS + c * 2));
          bf16_t* gp = SG1 + ((size_t)b * 2048 + 1024) * 2048 + G * 128 + tid;
          *gp = f2bf(y * (1.f / 512.f) * bf2f(*gp));
        }
      }
    }
  }
  }
  if (PLO <= 8 && 8 < PHI) { GSYNC(); }
  if (PLO <= 9 && 9 <= PHI) {

  out_proj((const bf16_t*)(ws + OFF_SG), (const bf16_t*)(ws + OFF_WT_OOUT), MOD + 17 * 3072, (bf16_t*)(ws + OFF_YG), smem);
  }
  if (PLO <= 9 && 9 < PHI) { GSYNC(); }
  if (PLO <= 10 && 10 <= PHI) {

  post_ln_rows((const float*)(ws + OFF_Q), (const bf16_t*)(ws + OFF_YG), p.out, p.post_g + 1024, p.post_b + 1024, nullptr, nullptr);
  }
}

extern "C" void kernel_launch(void* const* d_in, const int* in_sizes, int n_in, void* d_out, int out_size, void* d_ws, size_t ws_size,
                              hipStream_t stream) {
  static int grid_blocks = 0;
  if (!grid_blocks) {
    int dev = 0, cus = 0, per_cu = 0;
    hipGetDevice(&dev);
    hipDeviceGetAttribute(&cus, hipDeviceAttributeMultiprocessorCount, dev);
    hipOccupancyMaxActiveBlocksPerMultiprocessor(&per_cu, mega<0, 10>, 512, 0);
    if (per_cu > 1) per_cu = 1;
    grid_blocks = cus * per_cu;
    if (n_in != 18 || ws_size < WS_NEED) fprintf(stderr, "kernel_launch: unexpected n_in %d or ws_size %zu (need %zu)\n", n_in, ws_size, (size_t)WS_NEED);
  }
  Params p{};
  p.x = (const float*)d_in[0]; p.c = (const float*)d_in[1]; p.ctx = (const float*)d_in[2]; p.c_ctx = (const float*)d_in[3];
  p.w_mod = (const float*)d_in[4]; p.b_mod = (const float*)d_in[5]; p.post_g = (const float*)d_in[6]; p.post_b = (const float*)d_in[7];
  p.e_w_in = (const float*)d_in[8]; p.e_qn = (const float*)d_in[9]; p.e_kn = (const float*)d_in[10]; p.e_vg = (const float*)d_in[11];
  p.e_vb = (const float*)d_in[12]; p.e_ws = (const float*)d_in[13]; p.e_bs = (const float*)d_in[14]; p.e_w_out = (const float*)d_in[15];
  p.o_w_in = (const float*)d_in[16]; p.o_w_out = (const float*)d_in[17];
  p.out = (float*)d_out; p.ws = (char*)d_ws;
#define ONE_LAUNCH 1
#ifdef ONE_LAUNCH
  hipMemsetAsync((char*)d_ws + OFF_XBAR, 0, XCD_BAR_WORDS * 4, stream);
  { void* args[] = {&p};
    hipError_t e = hipLaunchCooperativeKernel((void*)mega<0, 10>, dim3(grid_blocks), dim3(512), args, 0, stream);
    if (e != hipSuccess) fprintf(stderr, "cooperative launch failed: %s (grid %d)\n", hipGetErrorString(e), grid_blocks); }
#else
  hipLaunchKernelGGL((mega<0, 0>), dim3(grid_blocks), dim3(512), 0, stream, p);
  hipLaunchKernelGGL((mega<1, 1>), dim3(grid_blocks), dim3(512), 0, stream, p);
  hipLaunchKernelGGL((mega<2, 2>), dim3(grid_blocks), dim3(512), 0, stream, p);
  hipLaunchKernelGGL((mega<3, 3>), dim3(grid_blocks), dim3(512), 0, stream, p);
  hipLaunchKernelGGL((mega<4, 4>), dim3(grid_blocks), dim3(512), 0, stream, p);
  hipLaunchKernelGGL((mega<5, 5>), dim3(grid_blocks), dim3(512), 0, stream, p);
  hipLaunchKernelGGL((mega<6, 6>), dim3(grid_blocks), dim3(512), 0, stream, p);
  hipLaunchKernelGGL((mega<7, 7>), dim3(grid_blocks), dim3(512), 0, stream, p);
  hipLaunchKernelGGL((mega<8, 8>), dim3(grid_blocks), dim3(512), 0, stream, p);
  hipLaunchKernelGGL((mega<9, 9>), dim3(grid_blocks), dim3(512), 0, stream, p);
  hipLaunchKernelGGL((mega<10, 10>), dim3(grid_blocks), dim3(512), 0, stream, p);
#endif
}
```

```cpp
#include <hip/hip_runtime.h>
#include <hip/hip_cooperative_groups.h>
#include <cstdio>
#include <cstdint>
namespace cg = cooperative_groups;

typedef unsigned short bf16_t;
using bf16x8 = __attribute__((ext_vector_type(8))) short;
using s16x4  = __attribute__((ext_vector_type(4))) short;
using f32x16 = __attribute__((ext_vector_type(16))) float;
using u32x4  = __attribute__((ext_vector_type(4))) unsigned;
using u32x2  = __attribute__((ext_vector_type(2))) unsigned;

constexpr int DM = 1024, NB = 16, SEQ = 2048, CTXL = 256, SKV = SEQ + CTXL;
constexpr int NTOK = NB * SEQ;
constexpr int NCTX = NB * CTXL;
constexpr int EVEN_IN = 5632, ODD_IN = 4096, DIN = 2048;
constexpr float ALPHA = 1.4142135623730951f;
constexpr float EPS = 1e-6f;

constexpr size_t MiB = 1ull << 20;
constexpr size_t OFF_WT_EIN = 0, OFF_WT_EOUT = 11 * MiB, OFF_WT_OIN = 15 * MiB, OFF_WT_OOUT = 23 * MiB;
constexpr size_t OFF_TAB_C = 27 * MiB, OFF_TAB_S = 30 * MiB, OFF_SMALL = 33 * MiB;
constexpr size_t OFF_CDM = OFF_SMALL, OFF_CDP = OFF_SMALL + 64 * 1024, OFF_WSB = OFF_SMALL + 128 * 1024;
constexpr size_t OFF_ROPE = OFF_SMALL + 384 * 1024, OFF_MOD = OFF_SMALL + 512 * 1024, OFF_XM = OFF_SMALL + 1024 * 1024;
constexpr size_t OFF_M0 = 36 * MiB, OFF_MC = 100 * MiB;
constexpr size_t OFF_SG = 108 * MiB;
constexpr size_t OFF_Q = 236 * MiB, OFF_BU = 300 * MiB;
constexpr size_t OFF_KALL = 364 * MiB, OFF_VALL = 382 * MiB, OFF_BV = 400 * MiB;
constexpr size_t OFF_F = 364 * MiB, OFF_RV = 428 * MiB;
constexpr size_t OFF_YG = 364 * MiB;
constexpr size_t WS_NEED = 492 * MiB;

struct Params {
  const float *x, *c, *ctx, *c_ctx, *w_mod, *b_mod, *post_g, *post_b, *e_w_in, *e_qn, *e_kn, *e_vg, *e_vb, *e_ws, *e_bs,
      *e_w_out, *o_w_in, *o_w_out;
  float* out;
  char* ws;
  long pad_;
};

typedef float f32x2_t __attribute__((ext_vector_type(2)));
typedef __bf16 bf16x2_t __attribute__((ext_vector_type(2)));
__device__ __forceinline__ unsigned cvtpk(float lo, float hi) {
  f32x2_t v = {lo, hi}; bf16x2_t h = __builtin_convertvector(v, bf16x2_t); return __builtin_bit_cast(unsigned, h);
}
__device__ __forceinline__ int tid_fresh() { int t = (int)__builtin_amdgcn_workitem_id_x(); asm volatile("" : "+v"(t)); return t; }
__device__ __forceinline__ float bf_lo(unsigned w) { return __uint_as_float(w << 16); }
__device__ __forceinline__ float bf_hi(unsigned w) { return __uint_as_float(w & 0xffff0000u); }
__device__ __forceinline__ bf16_t f2bf(float x) { return (bf16_t)(cvtpk(x, 0.f) & 0xffffu); }
__device__ __forceinline__ float bf2f(bf16_t h) { return __uint_as_float(((unsigned)h) << 16); }
__device__ __forceinline__ int crow(int r, int hi) { return (r & 3) + 8 * (r >> 2) + 4 * hi; }
__device__ __forceinline__ float wave_sum(float v) {
#pragma unroll
  for (int o = 32; o >= 1; o >>= 1) v += __shfl_xor(v, o);
  return v;
}
__device__ __forceinline__ float silu_f(float x) { return x * __builtin_amdgcn_rcpf(1.f + __expf(-x)); }
__device__ __forceinline__ float gelu_tanh_f(float x) {
  const float u = 0.7978845608028654f * (x + 0.044715f * x * x * x);
  const float t = 1.f - 2.f * __builtin_amdgcn_rcpf(__expf(2.f * u) + 1.f);
  return 0.5f * x * (1.f + t);
}
__device__ __forceinline__ int logical_block() {
  const int g = gridDim.x, b = blockIdx.x;
  return (g & 7) ? b : (b & 7) * (g >> 3) + (b >> 3);
}

constexpr int LDS_ROWB = 144;
constexpr int LDS_A = 256 * LDS_ROWB;
constexpr int LDS_B = 128 * LDS_ROWB;
constexpr int LDS_STAGE = LDS_A + LDS_B;
constexpr int L2_A = 256 * LDS_ROWB;
constexpr int L2_STAGE = 2 * L2_A;
constexpr int LDS_RED = 2 * L2_STAGE;
constexpr int SMEM_BYTES = LDS_RED + 2048 + 2048;

struct LdPlain {
  const bf16_t* p; size_t rs;
  __device__ __forceinline__ u32x4 ld(int kt, int i) const { return *(const u32x4*)(p + (size_t)i * rs + kt * 64); }
};
__device__ __forceinline__ LdPlain mkPlain(const bf16_t* base, int ld) {
  const int tid = tid_fresh();
  LdPlain l; l.p = base + (size_t)(tid >> 3) * ld + (tid & 7) * 8; l.rs = (size_t)64 * ld; return l;
}
struct LdSplit {
  const bf16_t* p0; const bf16_t* p1; size_t rs; int kts;
  __device__ __forceinline__ u32x4 ld(int kt, int i) const {
    const bf16_t* q = (kt < kts) ? (p0 + kt * 64) : (p1 + (kt - kts) * 64);
    return *(const u32x4*)(q + (size_t)i * rs);
  }
};
__device__ __forceinline__ LdSplit mkSplit(const bf16_t* b0, const bf16_t* b1, int ld, int kts) {
  const int tid = tid_fresh(); const size_t o = (size_t)(tid >> 3) * ld + (tid & 7) * 8;
  LdSplit l; l.p0 = b0 + o; l.p1 = b1 + o; l.rs = (size_t)64 * ld; l.kts = kts; return l;
}
struct LdFold {
  const bf16_t* f; const bf16_t* r; size_t rs; float sg;
  __device__ __forceinline__ u32x4 ld(int kt, int i) const {
    const u32x4 a = *(const u32x4*)(f + (size_t)i * rs + kt * 64);
    const u32x4 b = *(const u32x4*)(r + (size_t)i * rs + kt * 64);
    u32x4 o;
    o[0] = cvtpk(bf_lo(a[0]) + sg * bf_lo(b[0]), bf_hi(a[0]) + sg * bf_hi(b[0]));
    o[1] = cvtpk(bf_lo(a[1]) + sg * bf_lo(b[1]), bf_hi(a[1]) + sg * bf_hi(b[1]));
    o[2] = cvtpk(bf_lo(a[2]) + sg * bf_lo(b[2]), bf_hi(a[2]) + sg * bf_hi(b[2]));
    o[3] = cvtpk(bf_lo(a[3]) + sg * bf_lo(b[3]), bf_hi(a[3]) + sg * bf_hi(b[3]));
    return o;
  }
};
__device__ __forceinline__ LdFold mkFold(const bf16_t* f, const bf16_t* r, int ld, float sg) {
  const int tid = tid_fresh(); const size_t o = (size_t)(tid >> 3) * ld + (tid & 7) * 8;
  LdFold l; l.f = f + o; l.r = r + o; l.rs = (size_t)64 * ld; l.sg = sg; return l;
}

template <class LA, class LB>
__device__ __forceinline__ void gemm_mainloop(const LA& la, const LB& lb, int KT, char* smem, f32x16 (&acc)[2][2]) {
  const int tid = tid_fresh(), wid = tid >> 6, lane = tid & 63, r32 = lane & 31, hi = lane >> 5, wm = wid >> 1, wn = wid & 1;
#pragma unroll
  for (int mi = 0; mi < 2; ++mi)
#pragma unroll
    for (int nj = 0; nj < 2; ++nj)
#pragma unroll
      for (int r = 0; r < 16; ++r) acc[mi][nj][r] = 0.f;
  const int st_off = (tid >> 3) * LDS_ROWB + (tid & 7) * 16;
  const int a_rd = (wm * 64 + r32) * LDS_ROWB + hi * 16;
  const int b_rd = LDS_A + (wn * 32 + r32) * LDS_ROWB + hi * 16;
  u32x4 ra0, ra1, ra2, ra3, rb0, rb1;
  ra0 = la.ld(0, 0); ra1 = la.ld(0, 1); ra2 = la.ld(0, 2); ra3 = la.ld(0, 3); rb0 = lb.ld(0, 0); rb1 = lb.ld(0, 1);
  {
    char* s = smem + st_off;
    *(u32x4*)(s) = ra0; *(u32x4*)(s + 64 * LDS_ROWB) = ra1; *(u32x4*)(s + 128 * LDS_ROWB) = ra2; *(u32x4*)(s + 192 * LDS_ROWB) = ra3;
    *(u32x4*)(s + LDS_A) = rb0; *(u32x4*)(s + LDS_A + 64 * LDS_ROWB) = rb1;
  }
  __syncthreads();
#define GEMM_COMPUTE(SB)                                                                              \
  _Pragma("unroll") for (int kk = 0; kk < 4; ++kk) {                                                  \
    const bf16x8 a0 = *(const bf16x8*)((SB) + a_rd + kk * 32);                                        \
    const bf16x8 a1 = *(const bf16x8*)((SB) + a_rd + 32 * LDS_ROWB + kk * 32);                        \
    const bf16x8 b0 = *(const bf16x8*)((SB) + b_rd + kk * 32);                                        \
    const bf16x8 b1 = *(const bf16x8*)((SB) + b_rd + 64 * LDS_ROWB + kk * 32);                        \
    acc[0][0] = __builtin_amdgcn_mfma_f32_32x32x16_bf16(b0, a0, acc[0][0], 0, 0, 0);                  \
    acc[0][1] = __builtin_amdgcn_mfma_f32_32x32x16_bf16(b1, a0, acc[0][1], 0, 0, 0);                  \
    acc[1][0] = __builtin_amdgcn_mfma_f32_32x32x16_bf16(b0, a1, acc[1][0], 0, 0, 0);                  \
    acc[1][1] = __builtin_amdgcn_mfma_f32_32x32x16_bf16(b1, a1, acc[1][1], 0, 0, 0);                  \
  }
#define GEMM_LOAD(KT_) do { ra0 = la.ld((KT_), 0); ra1 = la.ld((KT_), 1); ra2 = la.ld((KT_), 2); ra3 = la.ld((KT_), 3); rb0 = lb.ld((KT_), 0); rb1 = lb.ld((KT_), 1); } while (0)
#define GEMM_WRITE(ST) do { char* s = smem + (ST) * LDS_STAGE + st_off;                                \
    *(u32x4*)(s) = ra0; *(u32x4*)(s + 64 * LDS_ROWB) = ra1; *(u32x4*)(s + 128 * LDS_ROWB) = ra2; *(u32x4*)(s + 192 * LDS_ROWB) = ra3; \
    *(u32x4*)(s + LDS_A) = rb0; *(u32x4*)(s + LDS_A + 64 * LDS_ROWB) = rb1; } while (0)
#pragma unroll 1
  for (int kt = 0; kt < KT; kt += 2) {
    GEMM_LOAD(kt + 1);
    GEMM_COMPUTE(smem);
    GEMM_WRITE(1);
    __syncthreads();
    GEMM_LOAD(kt + 2 < KT ? kt + 2 : kt);
    GEMM_COMPUTE(smem + LDS_STAGE);
    GEMM_WRITE(0);
    __syncthreads();
  }
#undef GEMM_COMPUTE
#undef GEMM_LOAD
#undef GEMM_WRITE
}

template <class LA, class LB>
__device__ __forceinline__ void gemm2(const LA& la, const LB& lb, int KT, char* smem, f32x16 (&acc)[2][4]) {
  const int tid = tid_fresh(), wid = tid >> 6, lane = tid & 63, r32 = lane & 31, hi = lane >> 5, wm = wid >> 1, wn = wid & 1;
#pragma unroll
  for (int mi = 0; mi < 2; ++mi)
#pragma unroll
    for (int nj = 0; nj < 4; ++nj)
#pragma unroll
      for (int r = 0; r < 16; ++r) acc[mi][nj][r] = 0.f;
  const int st_off = (tid >> 3) * LDS_ROWB + (tid & 7) * 16;
  const int a_rd = (wm * 64 + r32) * LDS_ROWB + hi * 16;
  const int b_rd = L2_A + (wn * 128 + r32) * LDS_ROWB + hi * 16;
  u32x4 xa0, xa1, xa2, xa3, xb0, xb1, xb2, xb3, ya0, ya1, ya2, ya3, yb0, yb1, yb2, yb3;
#define G2_LOADX(KT_) do { xa0 = la.ld((KT_), 0); xa1 = la.ld((KT_), 1); xa2 = la.ld((KT_), 2); xa3 = la.ld((KT_), 3); xb0 = lb.ld((KT_), 0); xb1 = lb.ld((KT_), 1); xb2 = lb.ld((KT_), 2); xb3 = lb.ld((KT_), 3); } while (0)
#define G2_LOADY(KT_) do { ya0 = la.ld((KT_), 0); ya1 = la.ld((KT_), 1); ya2 = la.ld((KT_), 2); ya3 = la.ld((KT_), 3); yb0 = lb.ld((KT_), 0); yb1 = lb.ld((KT_), 1); yb2 = lb.ld((KT_), 2); yb3 = lb.ld((KT_), 3); } while (0)
#define G2_W2(ST, P, R0, R1, O0, O1) do { char* s_ = smem + (ST) * L2_STAGE + st_off; *(u32x4*)(s_ + (O0)) = P##R0; *(u32x4*)(s_ + (O1)) = P##R1; } while (0)
#define G2_WRITE(ST, P) do { G2_W2(ST, P, a0, a1, 0, 64 * LDS_ROWB); G2_W2(ST, P, a2, a3, 128 * LDS_ROWB, 192 * LDS_ROWB); \
    G2_W2(ST, P, b0, b1, L2_A, L2_A + 64 * LDS_ROWB); G2_W2(ST, P, b2, b3, L2_A + 128 * LDS_ROWB, L2_A + 192 * LDS_ROWB); } while (0)
#define G2_LDA(SB, kk, A0, A1) do { A0 = *(const bf16x8*)((SB) + a_rd + (kk) * 32); A1 = *(const bf16x8*)((SB) + a_rd + 32 * LDS_ROWB + (kk) * 32); } while (0)
#define G2_STEPP(SB, kk, A0, A1, N0, N1, HASNEXT) do {                                                \
    if (HASNEXT) G2_LDA(SB, (kk) + 1, N0, N1);                                                        \
    _Pragma("unroll") for (int nj = 0; nj < 4; ++nj) {                                                \
      const bf16x8 b_ = *(const bf16x8*)((SB) + b_rd + nj * 32 * LDS_ROWB + (kk) * 32);               \
      acc[0][nj] = __builtin_amdgcn_mfma_f32_32x32x16_bf16(b_, A0, acc[0][nj], 0, 0, 0);              \
      acc[1][nj] = __builtin_amdgcn_mfma_f32_32x32x16_bf16(b_, A1, acc[1][nj], 0, 0, 0);              \
    } } while (0)
#define G2_COMPUTE_W(SB, ST, P) do { bf16x8 p0_, p1_, q0_, q1_;                                        \
    G2_LDA(SB, 0, p0_, p1_);                                                                          \
    G2_STEPP(SB, 0, p0_, p1_, q0_, q1_, 1); G2_W2(ST, P, a0, a1, 0, 64 * LDS_ROWB);                   \
    G2_STEPP(SB, 1, q0_, q1_, p0_, p1_, 1); G2_W2(ST, P, a2, a3, 128 * LDS_ROWB, 192 * LDS_ROWB);     \
    G2_STEPP(SB, 2, p0_, p1_, q0_, q1_, 1); G2_W2(ST, P, b0, b1, L2_A, L2_A + 64 * LDS_ROWB);         \
    G2_STEPP(SB, 3, q0_, q1_, p0_, p1_, 0); G2_W2(ST, P, b2, b3, L2_A + 128 * LDS_ROWB, L2_A + 192 * LDS_ROWB); } while (0)
  G2_LOADX(0); G2_LOADY(1);
  G2_WRITE(0, x);
  __syncthreads();
  G2_LOADX(2 < KT ? 2 : 0);
#pragma unroll 1
  for (int kt = 0; kt < KT; kt += 2) {
    G2_COMPUTE_W(smem, 1, y);
    __syncthreads();
    G2_LOADY(kt + 3 < KT ? kt + 3 : KT - 1);
    G2_COMPUTE_W(smem + L2_STAGE, 0, x);
    __syncthreads();
    G2_LOADX(kt + 4 < KT ? kt + 4 : KT - 2);
  }
#undef G2_LOADX
#undef G2_LOADY
#undef G2_WRITE
#undef G2_W2
#undef G2_STEPP
#undef G2_LDA
#undef G2_COMPUTE_W
}
template <class F>
__device__ __forceinline__ void epi2_foreach(const f32x16 (&acc)[2][4], F&& f) {
  const int tid = tid_fresh(), wid = tid >> 6, lane = tid & 63, r32 = lane & 31, hi = lane >> 5, wm = wid >> 1, wn = wid & 1;
#pragma unroll
  for (int mi = 0; mi < 2; ++mi)
#pragma unroll
    for (int nj = 0; nj < 4; ++nj)
#pragma unroll
      for (int q = 0; q < 4; ++q)
        f(wm * 64 + mi * 32 + r32, wn * 128 + nj * 32 + q * 8 + hi * 4, acc[mi][nj][4 * q + 0], acc[mi][nj][4 * q + 1],
          acc[mi][nj][4 * q + 2], acc[mi][nj][4 * q + 3]);
}

constexpr int ET_S = 528;
__device__ __forceinline__ void tile_flush_bf16(char* smem, bf16_t* dst, size_t ld) {
  const int tid = tid_fresh();
  __syncthreads();
#pragma unroll
  for (int i = 0; i < 16; ++i) {
    const int id = tid + 512 * i, row = id >> 5, ck = id & 31;
    *(u32x4*)(dst + (size_t)row * ld + ck * 8) = *(const u32x4*)(smem + row * ET_S + ck * 16);
  }
  __syncthreads();
}
template <class F>
__device__ __forceinline__ void epi2_store_lds(const f32x16 (&acc)[2][4], char* smem, F&& xf, bf16_t* dst, size_t ld) {
  epi2_foreach(acc, [&](int row, int col, float a, float b, float c, float d) {
    xf(row, col, a, b, c, d);
    u32x2 w = {cvtpk(a, b), cvtpk(c, d)};
    *(u32x2*)(smem + row * ET_S + col * 2) = w;
  });
  tile_flush_bf16(smem, dst, ld);
}

template <class F>
__device__ __forceinline__ void epi_foreach(const f32x16 (&acc)[2][2], F&& f) {
  const int tid = tid_fresh(), wid = tid >> 6, lane = tid & 63, r32 = lane & 31, hi = lane >> 5, wm = wid >> 1, wn = wid & 1;
#pragma unroll
  for (int mi = 0; mi < 2; ++mi)
#pragma unroll
    for (int nj = 0; nj < 2; ++nj)
#pragma unroll
      for (int q = 0; q < 4; ++q)
        f(wm * 64 + mi * 32 + r32, nj * 64 + wn * 32 + q * 8 + hi * 4, acc[mi][nj][4 * q + 0], acc[mi][nj][4 * q + 1],
          acc[mi][nj][4 * q + 2], acc[mi][nj][4 * q + 3]);
}
__device__ __forceinline__ void st_bf4(bf16_t* p, float a, float b, float c, float d) {
  u32x2 w = {cvtpk(a, b), cvtpk(c, d)}; *(u32x2*)p = w;
}

__device__ __forceinline__ void tr_tile(const float* src, bf16_t* dst, int K, int N, int kt, int nt, float* tile) {
  const int tid = tid_fresh(), k0 = kt * 64, n0 = nt * 64;
#pragma unroll
  for (int j = 0; j < 8; ++j) { const int e = j * 512 + tid, r = e >> 6, c = e & 63; tile[r * 65 + c] = src[(size_t)(k0 + r) * N + n0 + c]; }
  __syncthreads();
  const int rn = tid >> 3, ck = (tid & 7) * 8;
  const float v0 = tile[(ck + 0) * 65 + rn], v1 = tile[(ck + 1) * 65 + rn], v2 = tile[(ck + 2) * 65 + rn], v3 = tile[(ck + 3) * 65 + rn];
  const float v4 = tile[(ck + 4) * 65 + rn], v5 = tile[(ck + 5) * 65 + rn], v6 = tile[(ck + 6) * 65 + rn], v7 = tile[(ck + 7) * 65 + rn];
  u32x4 w = {cvtpk(v0, v1), cvtpk(v2, v3), cvtpk(v4, v5), cvtpk(v6, v7)};
  *(u32x4*)(dst + (size_t)(n0 + rn) * K + k0 + ck) = w;
  __syncthreads();
}

__device__ __forceinline__ void phase0(const Params& p, char* smem) {
  const int tid = tid_fresh(), G = gridDim.x, bid = blockIdx.x;
  char* ws = p.ws;
  {
    float* s = (float*)smem;
    float* part = (float*)(smem + 17 * 1024 * 4);
    float* MOD = (float*)(ws + OFF_MOD);
    for (int u = bid; u < 96; u += G) {
      const int l = u / 48, j0 = (u % 48) * 64;
      for (int e = tid; e < 17 * 1024; e += 512) { const int r = e >> 10, k = e & 1023; const float cv = (r < 16) ? p.c[r * 1024 + k] : p.c_ctx[k]; s[e] = silu_f(cv); }
      __syncthreads();
      const int col = tid & 63, ks = tid >> 6;
      float a0 = 0, a1 = 0, a2 = 0, a3 = 0, a4 = 0, a5 = 0, a6 = 0, a7 = 0, a8 = 0, a9 = 0, a10 = 0, a11 = 0, a12 = 0, a13 = 0, a14 = 0, a15 = 0, a16 = 0;
      const float* w = p.w_mod + (size_t)l * 1024 * 3072 + j0 + col;
#pragma unroll 4
      for (int k = ks * 128; k < ks * 128 + 128; ++k) {
        const float wv = w[(size_t)k * 3072];
        a0 += s[0 * 1024 + k] * wv; a1 += s[1 * 1024 + k] * wv; a2 += s[2 * 1024 + k] * wv; a3 += s[3 * 1024 + k] * wv;
        a4 += s[4 * 1024 + k] * wv; a5 += s[5 * 1024 + k] * wv; a6 += s[6 * 1024 + k] * wv; a7 += s[7 * 1024 + k] * wv;
        a8 += s[8 * 1024 + k] * wv; a9 += s[9 * 1024 + k] * wv; a10 += s[10 * 1024 + k] * wv; a11 += s[11 * 1024 + k] * wv;
        a12 += s[12 * 1024 + k] * wv; a13 += s[13 * 1024 + k] * wv; a14 += s[14 * 1024 + k] * wv; a15 += s[15 * 1024 + k] * wv;
        a16 += s[16 * 1024 + k] * wv;
      }
      float* pp = part + ks * 17 * 64 + col;
      pp[0 * 64] = a0; pp[1 * 64] = a1; pp[2 * 64] = a2; pp[3 * 64] = a3; pp[4 * 64] = a4; pp[5 * 64] = a5; pp[6 * 64] = a6; pp[7 * 64] = a7;
      pp[8 * 64] = a8; pp[9 * 64] = a9; pp[10 * 64] = a10; pp[11 * 64] = a11; pp[12 * 64] = a12; pp[13 * 64] = a13; pp[14 * 64] = a14; pp[15 * 64] = a15;
      pp[16 * 64] = a16;
      __syncthreads();
      for (int e = tid; e < 17 * 64; e += 512) {
        const int r = e >> 6, cc = e & 63;
        float t = p.b_mod[l * 3072 + j0 + cc];
#pragma unroll
        for (int q = 0; q < 8; ++q) t += part[q * 17 * 64 + r * 64 + cc];
        MOD[(size_t)(l * 17 + r) * 3072 + j0 + cc] = t;
      }
      __syncthreads();
    }
  }
  {
    float* tile = (float*)smem;
    constexpr int T0 = 16 * 88, T1 = 32 * 16, T2 = 16 * 64, T3 = 32 * 16;
    for (int u = bid; u < T0 + T1 + T2 + T3; u += G) {
      if (u < T0) tr_tile(p.e_w_in, (bf16_t*)(ws + OFF_WT_EIN), 1024, EVEN_IN, u / 88, u % 88, tile);
      else if (u < T0 + T1) { const int v = u - T0; tr_tile(p.e_w_out, (bf16_t*)(ws + OFF_WT_EOUT), 2048, 1024, v / 16, v % 16, tile); }
      else if (u < T0 + T1 + T2) { const int v = u - T0 - T1; tr_tile(p.o_w_in, (bf16_t*)(ws + OFF_WT_OIN), 1024, ODD_IN, v / 64, v % 64, tile); }
      else { const int v = u - T0 - T1 - T2; tr_tile(p.o_w_out, (bf16_t*)(ws + OFF_WT_OOUT), 2048, 1024, v / 16, v % 16, tile); }
    }
  }
  {
    const long gt = (long)bid * 512 + tid, gn = (long)G * 512;
    bf16_t* TC = (bf16_t*)(ws + OFF_TAB_C); bf16_t* TS = (bf16_t*)(ws + OFF_TAB_S);
    (void)TS;
    for (long e = gt; e < 4L * 512 * 512; e += gn) {
      const int ty = (int)(e >> 18), sidx = (int)((e >> 9) & 511), t = (int)(e & 511);
      float v;
      if (ty == 0) v = cospif((float)((sidx * t) & 1023) * (1.f / 512.f));
      else if (ty == 1) v = cospif((float)(((2 * sidx + 1) * t) & 2047) * (1.f / 1024.f));
      else if (ty == 2) v = sinpif((float)((sidx * t) & 1023) * (1.f / 512.f));
      else v = sinpif((float)(((2 * sidx + 1) * t) & 2047) * (1.f / 1024.f));
      TC[e] = f2bf(v);
    }
    bf16_t* CDM = (bf16_t*)(ws + OFF_CDM); bf16_t* CDP = (bf16_t*)(ws + OFF_CDP);
    for (long e = gt; e < 128L * 256; e += gn) {
      const int cp = (int)(e >> 8), k = (int)(e & 255);
      const int m = (cp * (k & 127)) & 127;
      const float x = (float)m * (1.f / 64.f);
      float vm, vp;
      if (k < 128) { vm = cospif(x); vp = vm; } else { vp = sinpif(x); vm = -vp; }
      CDM[e] = f2bf(vm); CDP[e] = f2bf(vp);
    }
    bf16_t* WSB = (bf16_t*)(ws + OFF_WSB);
    for (long e = gt; e < 8L * 128 * 128; e += gn) WSB[e] = f2bf(p.e_ws[e]);
    float2* ROPE = (float2*)(ws + OFF_ROPE);
    for (long e = gt; e < 64L * 32; e += gn) {
      const int pos = (int)(e >> 5), i = (int)(e & 31);
      const float inv = powf(10000.f, -(float)i / 32.f);
      const float ang = (float)pos * inv;
      ROPE[e] = make_float2(cosf(ang), sinf(ang));
    }
  }
}

__device__ __forceinline__ void ln_rows_modulate(const float* src, bf16_t* dst, int nrows, int rows_per_b, const float* mod17, int fixed_row) {
  const int tid = tid_fresh(), wid = tid >> 6, lane = tid & 63;
  const int gw = blockIdx.x * 8 + wid, nw = gridDim.x * 8;
  float4 n0, n1, n2, n3;
  { const int r0 = gw < nrows ? gw : 0; const float4* ps = (const float4*)(src + (size_t)r0 * 1024); n0 = ps[lane]; n1 = ps[lane + 64]; n2 = ps[lane + 128]; n3 = ps[lane + 192]; }
  for (int row = gw; row < nrows; row += nw) {
    float4 v0 = n0, v1 = n1, v2 = n2, v3 = n3;
    { const int nr = (row + nw < nrows) ? row + nw : row;
      const float4* ps = (const float4*)(src + (size_t)nr * 1024); n0 = ps[lane]; n1 = ps[lane + 64]; n2 = ps[lane + 128]; n3 = ps[lane + 192]; }
    float s = v0.x + v0.y + v0.z + v0.w + v1.x + v1.y + v1.z + v1.w + v2.x + v2.y + v2.z + v2.w + v3.x + v3.y + v3.z + v3.w;
    const float mu = wave_sum(s) * (1.f / 1024.f);
    v0.x -= mu; v0.y -= mu; v0.z -= mu; v0.w -= mu; v1.x -= mu; v1.y -= mu; v1.z -= mu; v1.w -= mu;
    v2.x -= mu; v2.y -= mu; v2.z -= mu; v2.w -= mu; v3.x -= mu; v3.y -= mu; v3.z -= mu; v3.w -= mu;
    float q = v0.x * v0.x + v0.y * v0.y + v0.z * v0.z + v0.w * v0.w + v1.x * v1.x + v1.y * v1.y + v1.z * v1.z + v1.w * v1.w +
              v2.x * v2.x + v2.y * v2.y + v2.z * v2.z + v2.w * v2.w + v3.x * v3.x + v3.y * v3.y + v3.z * v3.z + v3.w * v3.w;
    const float rstd = rsqrtf(wave_sum(q) * (1.f / 1024.f) + EPS);
    const int mr = (fixed_row >= 0) ? fixed_row : (row / rows_per_b);
    const float* md = mod17 + (size_t)mr * 3072;
    bf16_t* pd = dst + (size_t)row * 1024;
#define MODST(V, J) { const int col = (lane + 64 * J) * 4; const float4 sh = *(const float4*)(md + col); const float4 sc = *(const float4*)(md + 1024 + col); \
      st_bf4(pd + col, V.x * rstd * (1.f + sc.x) + sh.x, V.y * rstd * (1.f + sc.y) + sh.y, V.z * rstd * (1.f + sc.z) + sh.z, V.w * rstd * (1.f + sc.w) + sh.w); }
    MODST(v0, 0) MODST(v1, 1) MODST(v2, 2) MODST(v3, 3)
#undef MODST
  }
}

__device__ __forceinline__ void phase2(const Params& p, char* smem) {
  char* ws = p.ws;
  const bf16_t* M0 = (const bf16_t*)(ws + OFF_M0); const bf16_t* MC = (const bf16_t*)(ws + OFF_MC);
  const bf16_t* WT = (const bf16_t*)(ws + OFF_WT_EIN);
  bf16_t* Q = (bf16_t*)(ws + OFF_Q); bf16_t* KA = (bf16_t*)(ws + OFF_KALL); bf16_t* VA = (bf16_t*)(ws + OFF_VALL);
  bf16_t* BU = (bf16_t*)(ws + OFF_BU); bf16_t* BV = (bf16_t*)(ws + OFF_BV); bf16_t* SG = (bf16_t*)(ws + OFF_SG);
  const float2* ROPE = (const float2*)(ws + OFF_ROPE);
  const int tid = tid_fresh(), wid = tid >> 6, lane = tid & 63, r32 = lane & 31, hi = lane >> 5, wm = wid >> 1, wn = wid & 1;
  const int lb = logical_block();
  for (int u = lb; u < 2816 + 32; u += gridDim.x) {
    const bool isctx = (u >= 2816);
    int mt, nt;
    if (!isctx) { mt = u / 22; nt = u % 22; } else { const int v = u - 2816; mt = v >> 1; nt = 4 + (v & 1); }
    const bf16_t* A = (isctx ? MC : M0) + (size_t)mt * 256 * 1024;
    f32x16 acc[2][4];
    gemm2(mkPlain(A, 1024), mkPlain(WT + (size_t)nt * 256 * 1024, 1024), 16, smem, acc);
    if (nt < 5) {
      const bool isq = nt < 4;
      const int head = isq ? (nt * 2 + wn) : wn;
      const float* gv = isq ? p.e_qn : p.e_kn;
#pragma unroll
      for (int mi = 0; mi < 2; ++mi) {
        float ss = 0.f;
#pragma unroll
        for (int nj = 0; nj < 4; ++nj)
#pragma unroll
          for (int r = 0; r < 16; ++r) ss += acc[mi][nj][r] * acc[mi][nj][r];
        ss += __shfl_xor(ss, 32);
        const float rstd = rsqrtf(ss * (1.f / 128.f) + EPS);
        const int row = wm * 64 + mi * 32 + r32;
        int t = 0;
        if (!isctx) t = (mt & 7) * 256 + row;
#pragma unroll
        for (int nj = 0; nj < 2; ++nj) {
          const int pos = (nj == 0) ? (t >> 6) : (t & 63);
#pragma unroll
          for (int q = 0; q < 4; ++q) {
            float o1[4], o2[4];
#pragma unroll
            for (int e = 0; e < 4; ++e) {
              const int r = 4 * q + e;
              const int i = 8 * q + 4 * hi + e;
              const int d = nj * 32 + i;
              const float x1 = acc[mi][nj][r] * rstd * gv[d];
              const float x2 = acc[mi][nj + 2][r] * rstd * gv[64 + d];
              if (!isctx) {
                const float2 cs = ROPE[pos * 32 + i];
                o1[e] = x1 * cs.x - x2 * cs.y; o2[e] = x2 * cs.x + x1 * cs.y;
              } else { o1[e] = x1; o2[e] = x2; }
            }
            const int d0 = nj * 32 + 8 * q + 4 * hi;
            { char* lp = smem + row * ET_S + (wn * 128 + d0) * 2;
              u32x2 w1 = {cvtpk(o1[0], o1[1]), cvtpk(o1[2], o1[3])}, w2 = {cvtpk(o2[0], o2[1]), cvtpk(o2[2], o2[3])};
              *(u32x2*)lp = w1; *(u32x2*)(lp + 128) = w2; }
          }
        }
      }
      {
        const int bb = mt >> 3, t0 = (mt & 7) * 256;
        bf16_t* tb; size_t tl;
        if (isq) { tb = Q + ((size_t)(bb * SEQ + t0) * 8 + nt * 2) * 128; tl = 1024; }
        else if (!isctx) { tb = KA + (size_t)(bb * SKV + CTXL + t0) * 256; tl = 256; }
        else { tb = KA + (size_t)mt * SKV * 256; tl = 256; }
        tile_flush_bf16(smem, tb, tl);
      }
    } else if (nt == 5) {
      const int bb = mt >> 3, t0 = (mt & 7) * 256;
      bf16_t* tb = isctx ? (VA + (size_t)mt * SKV * 256) : (VA + (size_t)(bb * SKV + CTXL + t0) * 256);
      epi2_store_lds(acc, smem, [&](int, int, float&, float&, float&, float&) {}, tb, 256);
    } else if (nt < 14) {
      bf16_t* dst = (nt < 10) ? (BU + (size_t)(nt - 6) * 256) : (BV + (size_t)(nt - 10) * 256);
      epi2_store_lds(acc, smem, [&](int, int, float& a, float& b, float& c, float& d) { a = gelu_tanh_f(a); b = gelu_tanh_f(b); c = gelu_tanh_f(c); d = gelu_tanh_f(d); },
                     dst + (size_t)mt * 256 * 1024, 1024);
    } else {
      bf16_t* dst = SG + (size_t)(nt - 14) * 256;
      epi2_store_lds(acc, smem, [&](int, int, float& a, float& b, float& c, float& d) { a = silu_f(a); b = silu_f(b); c = silu_f(c); d = silu_f(d); },
                     dst + (size_t)mt * 256 * 2048, 2048);
    }
  }
}

namespace att {
constexpr int D = 128, NW = 8, QBLK = 32, KVBLK = 64;
constexpr float SCALE = 0.088388347648318440f;
constexpr float THR = 8.f;
constexpr int LDQ = 1024, LDK = 256;
constexpr int SHM_V = KVBLK * D * 2, SHM_K = KVBLK * D * 2;
#define KSWZ(row, colB) ((row) * 256 + ((colB) ^ (((row) & 7) << 4)))
#define SBAR() __builtin_amdgcn_sched_barrier(0)
__device__ __forceinline__ void partialSM(f32x16& p0, f32x16& p1, float& m_reg, float& mn, float& alpha) {
  constexpr float C = SCALE * 1.4426950408889634f;
  float pmax = p0[0];
#pragma unroll
  for (int r = 1; r < 16; ++r) pmax = fmaxf(pmax, p0[r]);
#pragma unroll
  for (int r = 0; r < 16; ++r) pmax = fmaxf(pmax, p1[r]);
  { auto rr = __builtin_amdgcn_permlane32_swap(__float_as_uint(pmax), __float_as_uint(pmax), false, false);
    pmax = fmaxf(__uint_as_float(rr[0]), __uint_as_float(rr[1])); }
  if (__builtin_expect(__all(pmax - m_reg <= THR / SCALE), 1)) { mn = m_reg; alpha = 1.f; }
  else { mn = fmaxf(m_reg, pmax); alpha = __builtin_amdgcn_exp2f((m_reg - mn) * C); m_reg = mn; }
  const float mnC = -mn * C;
#pragma unroll
  for (int r = 0; r < 16; ++r) p0[r] = fmaf(p0[r], C, mnC);
#pragma unroll
  for (int r = 0; r < 16; ++r) p1[r] = fmaf(p1[r], C, mnC);
#pragma unroll
  for (int r = 0; r < 16; ++r) p0[r] = __builtin_amdgcn_exp2f(p0[r]);
}
__device__ __forceinline__ void finishSM(f32x16& p0, f32x16& p1, float alpha, float& l_reg, bf16x8& pa0, bf16x8& pa1, bf16x8& pa2, bf16x8& pa3) {
#pragma unroll
  for (int r = 0; r < 16; ++r) p1[r] = __builtin_amdgcn_exp2f(p1[r]);
  float ps = 0;
#pragma unroll
  for (int r = 0; r < 16; ++r) ps += p0[r];
#pragma unroll
  for (int r = 0; r < 16; ++r) ps += p1[r];
  { auto rr = __builtin_amdgcn_permlane32_swap(__float_as_uint(ps), __float_as_uint(ps), false, false);
    ps = __uint_as_float(rr[0]) + __uint_as_float(rr[1]); }
  l_reg = l_reg * alpha + ps;
#define PK4(P, BASE, OUT) do { unsigned a0 = cvtpk(P[BASE + 0], P[BASE + 1]), a1 = cvtpk(P[BASE + 2], P[BASE + 3]);   \
    unsigned b0 = cvtpk(P[BASE + 4], P[BASE + 5]), b1 = cvtpk(P[BASE + 6], P[BASE + 7]);                              \
    auto r0 = __builtin_amdgcn_permlane32_swap(a0, b0, false, false); auto r1 = __builtin_amdgcn_permlane32_swap(a1, b1, false, false); \
    u32x4 w = {r0[0], r1[0], r0[1], r1[1]}; OUT = *reinterpret_cast<bf16x8*>(&w); } while (0)
  PK4(p0, 0, pa0); PK4(p0, 8, pa1); PK4(p1, 0, pa2); PK4(p1, 8, pa3);
#undef PK4
}
__device__ __forceinline__ void qkt(f32x16& p0, f32x16& p1, const bf16_t* Ks, const bf16x8* qr, int r32, int hi) {
#pragma unroll
  for (int r = 0; r < 16; ++r) { p0[r] = 0.f; p1[r] = 0.f; }
#pragma unroll
  for (int d0 = 0; d0 < 8; ++d0) { const int cb = (d0 * 16 + hi * 8) * 2;
    bf16x8 b0 = *reinterpret_cast<const bf16x8*>((const char*)Ks + KSWZ(r32, cb));
    bf16x8 b1 = *reinterpret_cast<const bf16x8*>((const char*)Ks + KSWZ(32 + r32, cb));
    p0 = __builtin_amdgcn_mfma_f32_32x32x16_bf16(b0, qr[d0], p0, 0, 0, 0);
    p1 = __builtin_amdgcn_mfma_f32_32x32x16_bf16(b1, qr[d0], p1, 0, 0, 0); }
}
__device__ __forceinline__ int v_st(int k, int c) { const int kk = (k & ~0xC) | ((k & 4) << 1) | ((k & 8) >> 1); return ((kk >> 3) * 4 + (c >> 5)) * 512 + ((kk & 7) * 32 + (c & 31)) * 2; }
__device__ __forceinline__ int v_rd_base(int lane) { return ((lane & 3) << 3) | (((lane >> 2) & 3) << 6) | (((lane >> 4) & 1) << 5) | (((lane >> 5) & 1) << 8); }
constexpr int v_rd_off(int d0, int ks, int half) { return d0 * 512 + ks * 4096 + half * 2048; }
template <int OFF> __device__ __forceinline__ s16x4 tr_read(int vb) {
  s16x4 r; asm volatile("ds_read_b64_tr_b16 %0, %1 offset:%2" : "=&v"(r) : "v"(vb), "i"(OFF) : "memory"); return r;
}
template <int D0> __device__ __forceinline__ void pv_one(f32x16& od, int vb, bf16x8 pa0, bf16x8 pa1, bf16x8 pa2, bf16x8 pa3) {
  const s16x4 l0 = tr_read<v_rd_off(D0, 0, 0)>(vb), h0 = tr_read<v_rd_off(D0, 0, 1)>(vb), l1 = tr_read<v_rd_off(D0, 1, 0)>(vb), h1 = tr_read<v_rd_off(D0, 1, 1)>(vb);
  const s16x4 l2 = tr_read<v_rd_off(D0, 2, 0)>(vb), h2 = tr_read<v_rd_off(D0, 2, 1)>(vb), l3 = tr_read<v_rd_off(D0, 3, 0)>(vb), h3 = tr_read<v_rd_off(D0, 3, 1)>(vb);
  asm volatile("s_waitcnt lgkmcnt(0)" ::: "memory"); SBAR();
#define PK(L, H) (bf16x8){L[0], L[1], L[2], L[3], H[0], H[1], H[2], H[3]}
  od = __builtin_amdgcn_mfma_f32_32x32x16_bf16(pa0, PK(l0, h0), od, 0, 0, 0);
  od = __builtin_amdgcn_mfma_f32_32x32x16_bf16(pa1, PK(l1, h1), od, 0, 0, 0);
  od = __builtin_amdgcn_mfma_f32_32x32x16_bf16(pa2, PK(l2, h2), od, 0, 0, 0);
  od = __builtin_amdgcn_mfma_f32_32x32x16_bf16(pa3, PK(l3, h3), od, 0, 0, 0);
#undef PK
}
__device__ __forceinline__ void pv_d0(f32x16* o, int vb, bf16x8 pa0, bf16x8 pa1, bf16x8 pa2, bf16x8 pa3) {
  pv_one<0>(o[0], vb, pa0, pa1, pa2, pa3); pv_one<1>(o[1], vb, pa0, pa1, pa2, pa3); pv_one<2>(o[2], vb, pa0, pa1, pa2, pa3); pv_one<3>(o[3], vb, pa0, pa1, pa2, pa3);
}
__device__ __forceinline__ void attn_body(const bf16_t* __restrict__ Qb, const bf16_t* __restrict__ Kh, const bf16_t* __restrict__ Vh,
                                          bf16_t* GO, int seq, char* lds) {
  const int tid = tid_fresh(), wid = tid >> 6, lane = tid & 63, r32 = lane & 31, hi = lane >> 5;
  bf16_t* V_lds = (bf16_t*)lds; bf16_t* K_lds = (bf16_t*)(lds + 2 * SHM_V);
  float* wsx = (float*)(lds + 2 * SHM_V + 2 * SHM_K) + wid * 64; float* li_l = wsx; float* al_l = wsx + 32;
  float m_reg = -1e30f, l_reg = 0; f32x16 o[4]; bf16x8 qr[8];
#pragma unroll
  for (int d = 0; d < 4; ++d)
#pragma unroll
    for (int r = 0; r < 16; ++r) o[d][r] = 0.f;
  const bf16_t* Qw = Qb + (long)(wid * QBLK + r32) * LDQ + hi * 8;
#pragma unroll
  for (int d0 = 0; d0 < 8; ++d0) qr[d0] = *reinterpret_cast<const bf16x8*>(Qw + d0 * 16);
  const int sr = tid >> 4, sc = (tid & 15) * 8, vst0 = v_st(sr, sc), vst1 = v_st(32 + sr, sc);
  const int vb0 = (int)(uintptr_t)V_lds + v_rd_base(lane);
  constexpr int SDEPTH = 1;
  bf16x8 sv0[SDEPTH], sv1[SDEPTH], sk0[SDEPTH], sk1[SDEPTH];
#define SLOAD(i, k0) do { sv0[i] = *reinterpret_cast<const bf16x8*>(&Vh[(long)((k0) + sr) * LDK + sc]); sv1[i] = *reinterpret_cast<const bf16x8*>(&Vh[(long)((k0) + 32 + sr) * LDK + sc]); \
    sk0[i] = *reinterpret_cast<const bf16x8*>(&Kh[(long)((k0) + sr) * LDK + sc]); sk1[i] = *reinterpret_cast<const bf16x8*>(&Kh[(long)((k0) + 32 + sr) * LDK + sc]); } while (0)
#define SWRITE(b, i) do { *(bf16x8*)((char*)V_lds + (b) * SHM_V + vst0) = sv0[i];          \
    *(bf16x8*)((char*)V_lds + (b) * SHM_V + vst1) = sv1[i]; const int kc = sc * 2;               \
    *(bf16x8*)((char*)K_lds + (b) * SHM_K + KSWZ(sr, kc)) = sk0[i];                       \
    *(bf16x8*)((char*)K_lds + (b) * SHM_K + KSWZ(32 + sr, kc)) = sk1[i]; } while (0)
#define SWAIT() do { if (SDEPTH == 2) asm volatile("s_waitcnt vmcnt(4)" ::: "memory"); else asm volatile("s_waitcnt vmcnt(0)" ::: "memory"); } while (0)
#define RESC(a) do { if (__any((a) < 1.f)) { if (hi == 0) al_l[r32] = (a); asm volatile("s_waitcnt lgkmcnt(0)" ::: "memory"); \
    _Pragma("unroll") for (int d = 0; d < 4; ++d) _Pragma("unroll") for (int r = 0; r < 16; ++r) o[d][r] *= al_l[crow(r, hi)]; } } while (0)
  f32x16 pA0, pA1, pB0, pB1; float mnA, mnB, alA, alB; bf16x8 pa0, pa1, pa2, pa3; const int NT = seq / KVBLK;
  constexpr int SE = 0, SO = SDEPTH - 1;
  SLOAD(SE, 0); asm volatile("s_waitcnt vmcnt(0)" ::: "memory"); SWRITE(0, SE); __syncthreads();
  qkt(pA0, pA1, K_lds, qr, r32, hi); partialSM(pA0, pA1, m_reg, mnA, alA);
  SLOAD(SO, KVBLK); if (SDEPTH == 2) { if (2 < NT) SLOAD(SE, 2 * KVBLK); }
  SWAIT(); SWRITE(1, SO); __syncthreads();
  for (int j = 1; j + 1 < NT; j += 2) {
    SBAR(); qkt(pB0, pB1, (bf16_t*)((char*)K_lds + SHM_K), qr, r32, hi);
    finishSM(pA0, pA1, alA, l_reg, pa0, pa1, pa2, pa3); SBAR();
    SLOAD(SO, (j + SDEPTH) * KVBLK); SBAR();
    pv_d0(o, vb0, pa0, pa1, pa2, pa3); partialSM(pB0, pB1, m_reg, mnB, alB);
    __syncthreads(); SWAIT(); SWRITE(0, SE);
    RESC(alB); __syncthreads();
    SBAR(); qkt(pA0, pA1, K_lds, qr, r32, hi);
    finishSM(pB0, pB1, alB, l_reg, pa0, pa1, pa2, pa3); SBAR();
    if (SDEPTH == 1 || j + 3 < NT) SLOAD(SE, (j + 1 + SDEPTH) * KVBLK); SBAR();
    pv_d0(o, vb0 + (int)SHM_V, pa0, pa1, pa2, pa3); partialSM(pA0, pA1, m_reg, mnA, alA);
    __syncthreads(); SWAIT(); SWRITE(1, SO);
    RESC(alA); __syncthreads();
  }
  SBAR(); qkt(pB0, pB1, (bf16_t*)((char*)K_lds + SHM_K), qr, r32, hi);
  finishSM(pA0, pA1, alA, l_reg, pa0, pa1, pa2, pa3); SBAR();
  pv_d0(o, vb0, pa0, pa1, pa2, pa3); partialSM(pB0, pB1, m_reg, mnB, alB);
  __syncthreads(); RESC(alB);
  finishSM(pB0, pB1, alB, l_reg, pa0, pa1, pa2, pa3); SBAR();
  pv_d0(o, vb0 + (int)SHM_V, pa0, pa1, pa2, pa3);
  if (hi == 0) li_l[r32] = l_reg; asm volatile("s_waitcnt lgkmcnt(0)" ::: "memory");
  float rli[16];
#pragma unroll
  for (int r = 0; r < 16; ++r) rli[r] = __builtin_amdgcn_rcpf(li_l[crow(r, hi)]);
  {
    bf16_t* Ow = GO + (long)(wid * QBLK) * 2048;
    char* sw = lds + 73728 + wid * (32 * 272);
#pragma unroll
    for (int i = 0; i < 8; ++i) {
      const int id = lane + 64 * i, row = id >> 4, ck = id & 15;
      *(u32x4*)(sw + row * 272 + ck * 16) = *(const u32x4*)(Ow + (long)row * 2048 + ck * 8);
    }
#pragma unroll
    for (int r = 0; r < 16; ++r) { const int orow = crow(r, hi);
#pragma unroll
      for (int d0 = 0; d0 < 4; ++d0) { bf16_t* q = (bf16_t*)(sw + orow * 272 + (d0 * 32 + r32) * 2); *q = f2bf(o[d0][r] * rli[r] * bf2f(*q)); }
    }
#pragma unroll
    for (int i = 0; i < 8; ++i) {
      const int id = lane + 64 * i, row = id >> 4, ck = id & 15;
      *(u32x4*)(Ow + (long)row * 2048 + ck * 8) = *(const u32x4*)(sw + row * 272 + ck * 16);
    }
  }
  __syncthreads();
#undef SLOAD
#undef SWRITE
#undef SWAIT
#undef RESC
}
}

__device__ __forceinline__ void chunk_gate_unit(const Params& p, int b, int n, char* smem) {
  char* ws = p.ws;
  const bf16_t* BU = (const bf16_t*)(ws + OFF_BU); const bf16_t* BV = (const bf16_t*)(ws + OFF_BV);
  bf16_t* SG = (bf16_t*)(ws + OFF_SG); const bf16_t* WSB = (const bf16_t*)(ws + OFF_WSB);
  const int tid = tid_fresh(), wid = tid >> 6, lane = tid & 63, r32 = lane & 31, hi = lane >> 5;
  constexpr int RS = 272;
  char* sW = smem; char* sV = smem + 128 * RS;
  float* smu = (float*)(smem + 2 * 128 * RS); float* srs = smu + 128;
  const size_t tok0 = (size_t)b * SEQ + (size_t)n * 128;
  {
    const int q = tid >> 2, part = tid & 3;
    const u32x4* src = (const u32x4*)(BV + (tok0 + q) * 1024 + part * 256);
    float s = 0.f, s2 = 0.f;
#pragma unroll 4
    for (int i = 0; i < 32; ++i) {
      const u32x4 w = src[i];
#pragma unroll
      for (int e = 0; e < 4; ++e) { const float a = bf_lo(w[e]), c = bf_hi(w[e]); s += a + c; s2 += a * a + c * c; }
    }
    s += __shfl_xor(s, 1); s2 += __shfl_xor(s2, 1); s += __shfl_xor(s, 2); s2 += __shfl_xor(s2, 2);
    const float mu = s * (1.f / 1024.f);
    const float var = fmaxf(s2 * (1.f / 1024.f) - mu * mu, 0.f);
    if (part == 0) { smu[q] = mu; srs[q] = rsqrtf(var + EPS); }
  }
  __syncthreads();
  const int wp = wid >> 1, wc = wid & 1;
  for (int g = 0; g < 8; ++g) {
#pragma unroll
    for (int i = 0; i < 4; ++i) {
      const int id = tid + 512 * i, row = id >> 4, ck = (id & 15) * 8;
      *(u32x4*)(sW + row * RS + ck * 2) = *(const u32x4*)(WSB + (size_t)g * 16384 + row * 128 + ck);
    }
#pragma unroll
    for (int i = 0; i < 4; ++i) {
      const int id = tid + 512 * i, q = id & 127, cc = (id >> 7) * 8;
      const u32x4 w = *(const u32x4*)(BV + (tok0 + q) * 1024 + g * 128 + cc);
      const float mu = smu[q], rs = srs[q];
      const float* lg = p.e_vg + g * 128 + cc; const float* lbp = p.e_vb + g * 128 + cc;
#pragma unroll
      for (int e = 0; e < 4; ++e) {
        const float a = (bf_lo(w[e]) - mu) * rs * lg[2 * e] + lbp[2 * e];
        const float c = (bf_hi(w[e]) - mu) * rs * lg[2 * e + 1] + lbp[2 * e + 1];
        *(bf16_t*)(sV + (cc + 2 * e) * RS + q * 2) = f2bf(a);
        *(bf16_t*)(sV + (cc + 2 * e + 1) * RS + q * 2) = f2bf(c);
      }
    }
    u32x4 rbu[4], rsg[4];
#pragma unroll
    for (int i = 0; i < 4; ++i) {
      const int id = tid + 512 * i, row = id >> 4, ck = id & 15;
      rbu[i] = *(const u32x4*)(BU + (tok0 + row) * 1024 + g * 128 + ck * 8);
      rsg[i] = *(const u32x4*)(SG + (tok0 + row) * 2048 + 1024 + g * 128 + ck * 8);
    }
    __syncthreads();
    f32x16 acc0, acc1;
#pragma unroll
    for (int r = 0; r < 16; ++r) { acc0[r] = 0.f; acc1[r] = 0.f; }
#pragma unroll
    for (int kk = 0; kk < 8; ++kk) {
      const bf16x8 af = *(const bf16x8*)(sW + (wp * 32 + r32) * RS + kk * 32 + hi * 16);
      const bf16x8 b0 = *(const bf16x8*)(sV + (wc * 64 + r32) * RS + kk * 32 + hi * 16);
      const bf16x8 b1 = *(const bf16x8*)(sV + (wc * 64 + 32 + r32) * RS + kk * 32 + hi * 16);
      acc0 = __builtin_amdgcn_mfma_f32_32x32x16_bf16(b0, af, acc0, 0, 0, 0);
      acc1 = __builtin_amdgcn_mfma_f32_32x32x16_bf16(b1, af, acc1, 0, 0, 0);
    }
    __syncthreads();
#pragma unroll
    for (int i = 0; i < 4; ++i) {
      const int id = tid + 512 * i, row = id >> 4, ck = id & 15;
      *(u32x4*)(sW + row * RS + ck * 16) = rbu[i]; *(u32x4*)(sV + row * RS + ck * 16) = rsg[i];
    }
    __syncthreads();
    const int pr = wp * 32 + r32;
    const float bias = p.e_bs[g * 128 + pr];
#pragma unroll
    for (int nj = 0; nj < 2; ++nj)
#pragma unroll
      for (int q = 0; q < 4; ++q) {
        const int off = pr * RS + (wc * 64 + nj * 32 + q * 8 + hi * 4) * 2;
        const u32x2 bu = *(const u32x2*)(sW + off);
        const u32x2 sg = *(const u32x2*)(sV + off);
        const float m0 = (nj ? acc1[4 * q + 0] : acc0[4 * q + 0]) + bias, m1 = (nj ? acc1[4 * q + 1] : acc0[4 * q + 1]) + bias;
        const float m2 = (nj ? acc1[4 * q + 2] : acc0[4 * q + 2]) + bias, m3 = (nj ? acc1[4 * q + 3] : acc0[4 * q + 3]) + bias;
        u32x2 w = {cvtpk(bf_lo(bu[0]) * m0 * bf_lo(sg[0]), bf_hi(bu[0]) * m1 * bf_hi(sg[0])), cvtpk(bf_lo(bu[1]) * m2 * bf_lo(sg[1]), bf_hi(bu[1]) * m3 * bf_hi(sg[1]))};
        *(u32x2*)(sV + off) = w;
      }
    __syncthreads();
#pragma unroll
    for (int i = 0; i < 4; ++i) {
      const int id = tid + 512 * i, row = id >> 4, ck = id & 15;
      *(u32x4*)(SG + (tok0 + row) * 2048 + 1024 + g * 128 + ck * 8) = *(const u32x4*)(sV + row * RS + ck * 16);
    }
    __syncthreads();
  }
}

__device__ __forceinline__ void post_ln_rows(const float* resid, const bf16_t* yg, float* dst, const float* pg, const float* pb, bf16_t* m1, const float* mod17) {
  const int tid = tid_fresh(), wid = tid >> 6, lane = tid & 63;
  const int gw = blockIdx.x * 8 + wid, nw = gridDim.x * 8;
  float4 nx[4]; u32x2 ny[4];
  { const float4* ps = (const float4*)(resid + (size_t)gw * 1024); const u32x2* py = (const u32x2*)(yg + (size_t)gw * 1024);
#pragma unroll
    for (int j = 0; j < 4; ++j) { nx[j] = ps[lane + 64 * j]; ny[j] = py[lane + 64 * j]; } }
  for (int row = gw; row < NTOK; row += nw) {
    float4 v[4];
#pragma unroll
    for (int j = 0; j < 4; ++j) {
      v[j].x = ALPHA * nx[j].x + bf_lo(ny[j][0]); v[j].y = ALPHA * nx[j].y + bf_hi(ny[j][0]);
      v[j].z = ALPHA * nx[j].z + bf_lo(ny[j][1]); v[j].w = ALPHA * nx[j].w + bf_hi(ny[j][1]);
    }
    { const int nr = (row + nw < NTOK) ? row + nw : row;
      const float4* ps = (const float4*)(resid + (size_t)nr * 1024); const u32x2* py = (const u32x2*)(yg + (size_t)nr * 1024);
#pragma unroll
      for (int j = 0; j < 4; ++j) { nx[j] = ps[lane + 64 * j]; ny[j] = py[lane + 64 * j]; } }
    float s = 0.f;
#pragma unroll
    for (int j = 0; j < 4; ++j) s += v[j].x + v[j].y + v[j].z + v[j].w;
    float mu = wave_sum(s) * (1.f / 1024.f);
    float q = 0.f;
#pragma unroll
    for (int j = 0; j < 4; ++j) { v[j].x -= mu; v[j].y -= mu; v[j].z -= mu; v[j].w -= mu; q += v[j].x * v[j].x + v[j].y * v[j].y + v[j].z * v[j].z + v[j].w * v[j].w; }
    float rstd = rsqrtf(wave_sum(q) * (1.f / 1024.f) + EPS);
    float4* pd = (float4*)(dst + (size_t)row * 1024);
    s = 0.f;
#pragma unroll
    for (int j = 0; j < 4; ++j) {
      const int col = (lane + 64 * j) * 4;
      const float4 g4 = *(const float4*)(pg + col), b4 = *(const float4*)(pb + col);
      v[j].x = v[j].x * rstd * g4.x + b4.x; v[j].y = v[j].y * rstd * g4.y + b4.y; v[j].z = v[j].z * rstd * g4.z + b4.z; v[j].w = v[j].w * rstd * g4.w + b4.w;
      pd[lane + 64 * j] = v[j];
      s += v[j].x + v[j].y + v[j].z + v[j].w;
    }
    if (m1) {
      mu = wave_sum(s) * (1.f / 1024.f);
      q = 0.f;
#pragma unroll
      for (int j = 0; j < 4; ++j) { v[j].x -= mu; v[j].y -= mu; v[j].z -= mu; v[j].w -= mu; q += v[j].x * v[j].x + v[j].y * v[j].y + v[j].z * v[j].z + v[j].w * v[j].w; }
      rstd = rsqrtf(wave_sum(q) * (1.f / 1024.f) + EPS);
      const float* md = mod17 + (size_t)(row >> 11) * 3072;
      bf16_t* pm = m1 + (size_t)row * 1024;
#pragma unroll
      for (int j = 0; j < 4; ++j) {
        const int col = (lane + 64 * j) * 4;
        const float4 sh = *(const float4*)(md + col), sc = *(const float4*)(md + 1024 + col);
        st_bf4(pm + col, v[j].x * rstd * (1.f + sc.x) + sh.x, v[j].y * rstd * (1.f + sc.y) + sh.y, v[j].z * rstd * (1.f + sc.z) + sh.z, v[j].w * rstd * (1.f + sc.w) + sh.w);
      }
    }
  }
}

__device__ __forceinline__ void out_proj(const bf16_t* A, const bf16_t* WT, const float* gate17, bf16_t* dst, char* smem) {
  const int lb = logical_block();
  for (int u = lb; u < 512; u += gridDim.x) {
    const int mt = u >> 2, nt = u & 3;
    f32x16 acc[2][4];
    gemm2(mkPlain(A + (size_t)mt * 256 * 2048, 2048), mkPlain(WT + (size_t)nt * 256 * 2048, 2048), 32, smem, acc);
    const float* gt = gate17 + (size_t)(mt >> 3) * 3072 + 2048 + nt * 256;
    epi2_store_lds(acc, smem, [&](int, int col, float& a, float& b, float& c, float& d) {
      const float4 g4 = *(const float4*)(gt + col);
      a *= g4.x; b *= g4.y; c *= g4.z; d *= g4.w;
    }, dst + (size_t)mt * 256 * 1024 + nt * 256, 1024);
  }
}

#define XB_TMO      128
#define XB_XCNT(j)  (256  + 64 * (j))
#define XB_XSUB(j)  (1280 + 64 * (j))
#define XB_XGEN(j)  (2304 + 64 * (j))
#define XB_TOP      3328
#define XB_TOPGEN   3392
#define XCD_BAR_WORDS 3456
#define XB_SPIN_CAP (1u << 18)
#define LAS __attribute__((address_space(3)))

__device__ __forceinline__ unsigned xb_ld(unsigned* p)              { return __hip_atomic_load(p, __ATOMIC_RELAXED, __HIP_MEMORY_SCOPE_AGENT); }
__device__ __forceinline__ unsigned xb_add(unsigned* p, unsigned v) { return __hip_atomic_fetch_add(p, v, __ATOMIC_RELAXED, __HIP_MEMORY_SCOPE_AGENT); }
__device__ __forceinline__ unsigned xb_xcc_id() { return (unsigned)__builtin_amdgcn_s_getreg((3 << 11) | 20) & 0xFu; }
#define XB_SPIN(cond, bar) do { unsigned _sp = 0; while (cond) { __builtin_amdgcn_s_sleep(1); \
    if ((++_sp & 255u) == 0u) { if (xb_ld(&(bar)[XB_TMO])) break; if (_sp > XB_SPIN_CAP) { atomicAdd(&(bar)[XB_TMO], 1u); break; } } } } while (0)

struct XcdBarrier {
    unsigned* bar; unsigned x;
    volatile LAS unsigned* st;
};

__device__ __forceinline__ XcdBarrier xcd_barrier_post(unsigned* bar, volatile LAS unsigned* st) {
    XcdBarrier b; b.bar = bar; b.x = xb_xcc_id(); b.st = st;
    if (threadIdx.x == 0) (void)xb_add(&bar[XB_XCNT(b.x)], 1u);
    return b;
}
__device__ __forceinline__ void xcd_barrier_complete(unsigned* bar, unsigned x, unsigned& nloc, unsigned& nx) {
    const unsigned G = gridDim.x * gridDim.y * gridDim.z;
    unsigned sum, cnt, mine, sp = 0u;
    for (;;) {
        sum = 0u; cnt = 0u; mine = 0u;
#pragma unroll
        for (unsigned j = 0; j < 16; ++j) { const unsigned c = xb_ld(&bar[XB_XCNT(j)]); sum += c; cnt += (c > 0u) ? 1u : 0u; mine = (j == x) ? c : mine; }
        if (sum == G) break;
        __builtin_amdgcn_s_sleep(1);
        if ((++sp & 255u) == 0u) { if (xb_ld(&bar[XB_TMO])) break; if (sp > XB_SPIN_CAP) { atomicAdd(&bar[XB_TMO], 1u); break; } }
    }
    nloc = mine > 0u ? mine : 1u; nx = cnt > 0u ? cnt : 1u;
}

__device__ __forceinline__ void xcd_barrier(const XcdBarrier& b) {
    asm volatile("s_waitcnt vmcnt(0)" ::: "memory");
    __syncthreads();
    if (threadIdx.x == 0) {
        unsigned* bar = b.bar;
        __builtin_amdgcn_s_waitcnt(0);
        unsigned nloc = b.st[0], nx = b.st[1];
        if (nloc == 0u) { xcd_barrier_complete(bar, b.x, nloc, nx); b.st[0] = nloc; b.st[1] = nx; }
        const unsigned old = xb_add(&bar[XB_XSUB(b.x)], 1u);
        const unsigned gen = old / nloc;
        if (old + 1u == (gen + 1u) * nloc) {
            __builtin_amdgcn_fence(__ATOMIC_RELEASE, "agent");
            asm volatile("s_waitcnt vmcnt(0)" ::: "memory");
            const unsigned og = xb_add(&bar[XB_TOP], 1u);
            const unsigned tg = og / nx;
            if (og + 1u == (tg + 1u) * nx) xb_add(&bar[XB_TOPGEN], 1u);
            else XB_SPIN(xb_ld(&bar[XB_TOPGEN]) == tg, bar);
            __builtin_amdgcn_fence(__ATOMIC_ACQUIRE, "agent");
            xb_add(&bar[XB_XGEN(b.x)], 1u);
            asm volatile("s_waitcnt vmcnt(0)" ::: "memory");
        } else {
            XB_SPIN(xb_ld(&bar[XB_XGEN(b.x)]) == gen, bar);
            __builtin_amdgcn_fence(__ATOMIC_ACQUIRE, "agent");
            asm volatile("s_waitcnt vmcnt(0)" ::: "memory");
        }
    }
    __syncthreads();
}


constexpr size_t OFF_XBAR = OFF_SMALL + 1536 * 1024;
constexpr size_t OFF_PX = OFF_SMALL + 1152 * 1024;
#define GSYNC_CG() do { __threadfence(); grid.sync(); __threadfence(); } while (0)
#define GSYNC() xcd_barrier(xbar)
#ifndef LAUNCH_SPLITS
#define LAUNCH_SPLITS {{0,0},{1,1},{2,2},{3,3},{4,4},{5,5},{6,6},{7,7},{8,8},{9,9},{10,10}}
#endif
template <int PLO, int PHI>
__global__ void __launch_bounds__(512) mega(Params p) {
  cg::grid_group grid = cg::this_grid();
  __shared__ __attribute__((aligned(16))) char smem[SMEM_BYTES];
  char* ws = p.ws;
  float* MOD = (float*)(ws + OFF_MOD);
  const int lb = logical_block();
  volatile LAS unsigned* xst = (volatile LAS unsigned*)(smem + LDS_RED + 2048);
  if (tid_fresh() < 4) xst[tid_fresh()] = 0u;
  __syncthreads();
  XcdBarrier xbar = xcd_barrier_post((unsigned*)(ws + OFF_XBAR), xst);
  if (PLO < PHI) grid.sync();

  if (PLO <= 0 && 0 <= PHI) {
  phase0(p, smem);
  }
  if (PLO <= 0 && 0 < PHI) { GSYNC(); }
  if (PLO <= 1 && 1 <= PHI) {

  ln_rows_modulate(p.x, (bf16_t*)(ws + OFF_M0), NTOK, SEQ, MOD, -1);
  ln_rows_modulate(p.ctx, (bf16_t*)(ws + OFF_MC), NCTX, CTXL, MOD, 16);
  }
  if (PLO <= 1 && 1 < PHI) { GSYNC(); }
  if (PLO <= 2 && 2 <= PHI) {

  phase2(p, smem);
  }
  if (PLO <= 2 && 2 < PHI) { GSYNC(); }
  if (PLO <= 3 && 3 <= PHI) {

  for (int u = lb; u < 1024; u += gridDim.x) {
      const int grp = u >> 5, j = u & 31, b = grp >> 1, kvh = grp & 1, hq = kvh * 4 + (j >> 3), qb = j & 7;
      const bf16_t* Qb = (const bf16_t*)(ws + OFF_Q) + ((size_t)(b * SEQ + qb * 256) * 8 + hq) * 128;
      const bf16_t* Kh = (const bf16_t*)(ws + OFF_KALL) + ((size_t)b * SKV * 2 + kvh) * 128;
      const bf16_t* Vh = (const bf16_t*)(ws + OFF_VALL) + ((size_t)b * SKV * 2 + kvh) * 128;
      bf16_t* GO = (bf16_t*)(ws + OFF_SG) + (size_t)(b * SEQ + qb * 256) * 2048 + hq * 128;
      att::attn_body(Qb, Kh, Vh, GO, SKV, smem);
  }
  for (int v = lb; v < 256; v += gridDim.x) chunk_gate_unit(p, v >> 4, v & 15, smem);
  }
  if (PLO <= 3 && 3 < PHI) { GSYNC(); }
  if (PLO <= 4 && 4 <= PHI) {

  out_proj((const bf16_t*)(ws + OFF_SG), (const bf16_t*)(ws + OFF_WT_EOUT), MOD, (bf16_t*)(ws + OFF_YG), smem);
  }
  if (PLO <= 4 && 4 < PHI) { GSYNC(); }
  if (PLO <= 5 && 5 <= PHI) {

  post_ln_rows(p.x, (const bf16_t*)(ws + OFF_YG), (float*)(ws + OFF_Q), p.post_g, p.post_b, (bf16_t*)(ws + OFF_M0), MOD + 17 * 3072);
  }
  if (PLO <= 5 && 5 < PHI) { GSYNC(); }
  if (PLO <= 6 && 6 <= PHI) {

  {
    const bf16_t* M1 = (const bf16_t*)(ws + OFF_M0); const bf16_t* WT = (const bf16_t*)(ws + OFF_WT_OIN);
    bf16_t* F = (bf16_t*)(ws + OFF_F); bf16_t* RV = (bf16_t*)(ws + OFF_RV); bf16_t* XM = (bf16_t*)(ws + OFF_XM);
    bf16_t* SG1 = (bf16_t*)(ws + OFF_SG);
    for (int u = lb; u < 2048; u += gridDim.x) {
      f32x16 acc[2][4];
      if (u < 1024) {
        const int tt = u >> 3, ct = u & 7, b = tt >> 3, t0 = (tt & 7) * 256;
        gemm2(mkPlain(WT + (size_t)ct * 256 * 1024, 1024), mkPlain(M1 + (size_t)tt * 256 * 1024, 1024), 16, smem, acc);
        const size_t rbase = ((size_t)b * 2048 + ct * 256) * 1024;
        if (t0 < 1024) {
          epi2_store_lds(acc, smem, [&](int, int, float&, float&, float&, float&) {}, F + rbase + t0, 1024);
          if (t0 == 0 && tid_fresh() < 256) RV[rbase + (size_t)tid_fresh() * 1024] = 0;
        } else {
          const int P0 = 1792 - t0;
          epi2_foreach(acc, [&](int row, int col, float a, float bq, float c, float d) {
            char* lr = smem + row * ET_S;
            if (col == 0) {
              const bf16_t v0 = f2bf(a);
              if (t0 == 1024) XM[(size_t)b * 2048 + ct * 256 + row] = v0; else RV[rbase + (size_t)row * 1024 + P0 + 256] = v0;
            } else *(bf16_t*)(lr + (256 - col) * 2) = f2bf(a);
            *(bf16_t*)(lr + (255 - col) * 2) = f2bf(bq); *(bf16_t*)(lr + (254 - col) * 2) = f2bf(c); *(bf16_t*)(lr + (253 - col) * 2) = f2bf(d);
          });
          __syncthreads();
          {
            const int tid = tid_fresh();
#pragma unroll
            for (int i = 0; i < 16; ++i) {
              const int id = tid + 512 * i, row = id >> 5, ck = id & 31;
              bf16_t* gp = RV + rbase + (size_t)row * 1024 + P0 + ck * 8;
              const char* lp = smem + row * ET_S + ck * 16;
              if (ck) *(u32x4*)gp = *(const u32x4*)lp;
              else {
#pragma unroll
                for (int e = 1; e < 8; ++e) gp[e] = *(const bf16_t*)(lp + e * 2);
              }
            }
          }
          __syncthreads();
        }
      } else {
        const int v = u - 1024, mt = v >> 3, nt = v & 7;
        gemm2(mkPlain(M1 + (size_t)mt * 256 * 1024, 1024), mkPlain(WT + (size_t)(2048 + nt * 256) * 1024, 1024), 16, smem, acc);
        epi2_store_lds(acc, smem, [&](int, int, float& a, float& bq, float& c, float& d) { a = silu_f(a); bq = silu_f(bq); c = silu_f(c); d = silu_f(d); },
                       SG1 + (size_t)mt * 256 * 2048 + nt * 256, 2048);
      }
    }
  }
  }
  if (PLO <= 6 && 6 < PHI) { GSYNC(); }
  if (PLO <= 7 && 7 <= PHI) {

  {
    bf16_t* EE = (bf16_t*)p.out + (size_t)32 * MiB;
    bf16_t* EO = EE + (size_t)16 * MiB;
    bf16_t* OE = (bf16_t*)(ws + OFF_M0); bf16_t* OO = OE + (size_t)16 * MiB;
    float* PX = (float*)(ws + OFF_PX); float* E512 = PX + 32768; float* O512 = PX + 65536;
    {
      const int tid = tid_fresh(), wid = tid >> 6, lane = tid & 63;
      const int gw = blockIdx.x * 8 + wid, nw = gridDim.x * 8;
      const bf16_t* XMr = (const bf16_t*)(ws + OFF_XM);
      u32x4 na0, na1, nb0, nb1;
      { const size_t ro = (size_t)gw * 128; const u32x4* Fr = (const u32x4*)(ws + OFF_F) + ro; const u32x4* Rr = (const u32x4*)(ws + OFF_RV) + ro;
        na0 = Fr[lane]; na1 = Fr[lane + 64]; nb0 = Rr[lane]; nb1 = Rr[lane + 64]; }
      const int src1 = 63 - lane, src0 = (64 - lane) & 63;
      for (int row = gw; row < 16 * 2048; row += nw) {
        const u32x4 a0 = na0, a1 = na1, b0 = nb0, b1 = nb1;
        { const int nr = (row + nw < 16 * 2048) ? row + nw : row; const size_t ro = (size_t)nr * 128;
          const u32x4* Fr = (const u32x4*)(ws + OFF_F) + ro; const u32x4* Rr = (const u32x4*)(ws + OFF_RV) + ro;
          na0 = Fr[lane]; na1 = Fr[lane + 64]; nb0 = Rr[lane]; nb1 = Rr[lane + 64]; }
        float e1[8], o1[8], e2[8], o2[8];
#pragma unroll
        for (int k = 0; k < 4; ++k) {
          { const float al = bf_lo(a0[k]), ah = bf_hi(a0[k]), bl = bf_lo(b0[k]), bh = bf_hi(b0[k]);
            e1[2 * k] = al + bl; e1[2 * k + 1] = ah + bh; o1[2 * k] = al - bl; o1[2 * k + 1] = ah - bh; }
          { const float al = bf_lo(a1[k]), ah = bf_hi(a1[k]), bl = bf_lo(b1[k]), bh = bf_hi(b1[k]);
            e2[2 * k] = al + bl; e2[2 * k + 1] = ah + bh; o2[2 * k] = al - bl; o2[2 * k + 1] = ah - bh; }
        }
        float alt = 0.f;
#pragma unroll
        for (int j = 0; j < 8; j += 2) alt += (e1[j] - e1[j + 1]) + (e2[j] - e2[j + 1]);
        float me[8], mo[8];
        me[0] = __shfl(e2[0], src0); mo[0] = __shfl(o2[0], src0);
        if (lane == 0) { me[0] = 0.f; mo[0] = 0.f; }
#pragma unroll
        for (int j = 1; j < 8; ++j) { me[j] = __shfl(e2[8 - j], src1); mo[j] = __shfl(o2[8 - j], src1); }
        u32x4 wee, weo, woe, woo;
#pragma unroll
        for (int k = 0; k < 4; ++k) {
          wee[k] = cvtpk(e1[2 * k] + me[2 * k], e1[2 * k + 1] + me[2 * k + 1]);
          weo[k] = cvtpk(e1[2 * k] - me[2 * k], e1[2 * k + 1] - me[2 * k + 1]);
          woe[k] = cvtpk(o1[2 * k] - mo[2 * k], o1[2 * k + 1] - mo[2 * k + 1]);
          woo[k] = cvtpk(o1[2 * k] + mo[2 * k], o1[2 * k + 1] + mo[2 * k + 1]);
        }
        const size_t wo = (size_t)row * 64 + lane;
        ((u32x4*)EE)[wo] = wee; ((u32x4*)EO)[wo] = weo; ((u32x4*)OE)[wo] = woe; ((u32x4*)OO)[wo] = woo;
        alt = wave_sum(alt);
        if (lane == 0) { PX[row] = alt + bf2f(XMr[row]); E512[row] = e2[0]; O512[row] = o2[0]; }
      }
    }
    if (PLO < PHI) { GSYNC(); }
    const bf16_t* XM = (const bf16_t*)(ws + OFF_XM);
    const bf16_t* TAB = (const bf16_t*)(ws + OFF_TAB_C);
    bf16_t* PC = (bf16_t*)p.out; bf16_t* PS = (bf16_t*)(ws + OFF_F);
    for (int u = lb; u < 1024; u += gridDim.x) {
      f32x16 acc[2][4];
      const int ty = u >> 8, v = u & 255, b = v >> 4, mt = (v >> 3) & 1, nt = v & 7;
      const bf16_t* Bsrc = (ty == 0) ? EE : (ty == 1) ? EO : (ty == 2) ? OE : OO;
      gemm2(mkPlain(TAB + (size_t)ty * 512 * 512 + (size_t)mt * 256 * 512, 512), mkPlain(Bsrc + ((size_t)b * 2048 + nt * 256) * 512, 512), 8, smem, acc);
      bf16_t* dstP = (ty < 2) ? PC : PS;
      const int par = ty & 1;
      epi2_store_lds(acc, smem, [&](int row, int col, float& a, float& bq, float& c, float& d) {
        const int sidx = mt * 256 + row, ch = nt * 256 + col;
        const size_t vi = (size_t)b * 2048 + ch;
        const float sg = (sidx & 1) ? -1.f : 1.f;
        if (ty == 0) {
          const u32x2 xm = *(const u32x2*)(XM + vi); const float4 em = *(const float4*)(E512 + vi);
          a += sg * em.x + bf_lo(xm[0]); bq += sg * em.y + bf_hi(xm[0]); c += sg * em.z + bf_lo(xm[1]); d += sg * em.w + bf_hi(xm[1]);
        } else if (ty == 1) {
          const u32x2 xm = *(const u32x2*)(XM + vi);
          a -= bf_lo(xm[0]); bq -= bf_hi(xm[0]); c -= bf_lo(xm[1]); d -= bf_hi(xm[1]);
        } else if (ty == 3) {
          const float4 om = *(const float4*)(O512 + vi);
          a += sg * om.x; bq += sg * om.y; c += sg * om.z; d += sg * om.w;
        }
      }, dstP + ((size_t)b * 1024 + 2 * (mt * 256) + par) * 2048 + nt * 256, 4096);
    }
  }
  }
  if (PLO <= 7 && 7 < PHI) { GSYNC(); }
  if (PLO <= 8 && 8 <= PHI) {

  {
    const bf16_t* PC = (const bf16_t*)p.out; const bf16_t* PS = (const bf16_t*)(ws + OFF_F);
    const bf16_t* CDP = (const bf16_t*)(ws + OFF_CDP);
    bf16_t* SG1 = (bf16_t*)(ws + OFF_SG);
    const int tid = tid_fresh(), wid = tid >> 6, lane = tid & 63, r32 = lane & 31, hi = lane >> 5, wm = wid >> 1, wn = wid & 1;
    constexpr int TBS = 528;
    constexpr int TB_BYTES = 128 * TBS;
    char* sT = smem; char* sA = smem + TB_BYTES;
#pragma unroll
    for (int i = 0; i < 8; ++i) {
      const int id = tid + 512 * i, row = id >> 5, ck = id & 31;
      *(u32x4*)(sT + row * TBS + ck * 16) = *(const u32x4*)(CDP + row * 256 + ck * 8);
    }
    const int st_off = (tid >> 3) * LDS_ROWB + (tid & 7) * 16;
    const int a_rd = (wm * 64 + r32) * LDS_ROWB + hi * 16;
    const int b_rd = (wn * 32 + r32) * TBS + hi * 16;
    const size_t rowoff = (size_t)(tid >> 3) * 2048 + (tid & 7) * 8;
    u32x4 r00, r01, r02, r03, r10, r11, r12, r13, r20, r21, r22, r23, r30, r31, r32_, r33;
    auto a_base = [&](int u_, int s_) -> const bf16_t* {
      const int b_ = u_ >> 6, j_ = (u_ >> 4) & 3, G_ = u_ & 15;
      return ((s_ < 2) ? PC : PS) + ((size_t)b_ * 1024 + j_ * 256) * 2048 + G_ * 128 + (s_ & 1) * 64 + rowoff;
    };
#define P8_LOAD(S, U, A, B, C, D) do { const bf16_t* q_ = a_base((U), (S)); A = *(const u32x4*)(q_); B = *(const u32x4*)(q_ + (size_t)64 * 2048); \
      C = *(const u32x4*)(q_ + (size_t)128 * 2048); D = *(const u32x4*)(q_ + (size_t)192 * 2048); } while (0)
#define P8_WRITE(ST, A, B, C, D) do { char* s_ = sA + (ST) * L2_A + st_off; *(u32x4*)(s_) = A; *(u32x4*)(s_ + 64 * LDS_ROWB) = B; \
      *(u32x4*)(s_ + 128 * LDS_ROWB) = C; *(u32x4*)(s_ + 192 * LDS_ROWB) = D; } while (0)
#define P8_COMPUTE(ST, S, ACC) do { const char* sb_ = sA + (ST) * L2_A;                                              \
      _Pragma("unroll") for (int kk = 0; kk < 4; ++kk) {                                                               \
        const bf16x8 fa0 = *(const bf16x8*)(sb_ + a_rd + kk * 32);                                                      \
        const bf16x8 fa1 = *(const bf16x8*)(sb_ + a_rd + 32 * LDS_ROWB + kk * 32);                                      \
        const bf16x8 fb0 = *(const bf16x8*)(sT + b_rd + ((S) * 64 + kk * 16) * 2);                                      \
        const bf16x8 fb1 = *(const bf16x8*)(sT + b_rd + 64 * TBS + ((S) * 64 + kk * 16) * 2);                           \
        ACC[0][0] = __builtin_amdgcn_mfma_f32_32x32x16_bf16(fb0, fa0, ACC[0][0], 0, 0, 0);                              \
        ACC[0][1] = __builtin_amdgcn_mfma_f32_32x32x16_bf16(fb1, fa0, ACC[0][1], 0, 0, 0);                              \
        ACC[1][0] = __builtin_amdgcn_mfma_f32_32x32x16_bf16(fb0, fa1, ACC[1][0], 0, 0, 0);                              \
        ACC[1][1] = __builtin_amdgcn_mfma_f32_32x32x16_bf16(fb1, fa1, ACC[1][1], 0, 0, 0);                              \
      } } while (0)
    P8_LOAD(0, lb, r00, r01, r02, r03); P8_LOAD(1, lb, r10, r11, r12, r13); P8_LOAD(2, lb, r20, r21, r22, r23); P8_LOAD(3, lb, r30, r31, r32_, r33);
    for (int u = lb; u < 1024; u += gridDim.x) {
      const int un = (u + (int)gridDim.x < 1024) ? u + (int)gridDim.x : u;
      f32x16 acc1[2][2], acc2[2][2];
#pragma unroll
      for (int mi = 0; mi < 2; ++mi)
#pragma unroll
        for (int nj = 0; nj < 2; ++nj)
#pragma unroll
          for (int r = 0; r < 16; ++r) { acc1[mi][nj][r] = 0.f; acc2[mi][nj][r] = 0.f; }
      P8_WRITE(0, r00, r01, r02, r03); __syncthreads(); P8_LOAD(0, un, r00, r01, r02, r03); P8_COMPUTE(0, 0, acc1);
      P8_WRITE(1, r10, r11, r12, r13); __syncthreads(); P8_LOAD(1, un, r10, r11, r12, r13); P8_COMPUTE(1, 1, acc1);
      P8_WRITE(0, r20, r21, r22, r23); __syncthreads(); P8_LOAD(2, un, r20, r21, r22, r23); P8_COMPUTE(0, 2, acc2);
      P8_WRITE(1, r30, r31, r32_, r33); __syncthreads(); P8_LOAD(3, un, r30, r31, r32_, r33); P8_COMPUTE(1, 3, acc2);
      const int b = u >> 6, j = (u >> 4) & 3, G = u & 15;
      const float sc = 1.f / 512.f;
      char* sE = sA;
      constexpr int ES = 272;
      __syncthreads();
#pragma unroll 1
      for (int pass = 0; pass < 2; ++pass) {
#pragma unroll
        for (int i = 0; i < 8; ++i) {
          const int id = tid + 512 * i, row = id >> 4, ck = id & 15, tp = j * 256 + row;
          const int tok = pass ? ((tp >= 1) ? 2048 - tp : 0) : tp;
          *(u32x4*)(sE + row * ES + ck * 16) = *(const u32x4*)(SG1 + ((size_t)b * 2048 + tok) * 2048 + G * 128 + ck * 8);
        }
        __syncthreads();
        const float sgn = pass ? 1.f : -1.f;
#pragma unroll
        for (int mi = 0; mi < 2; ++mi)
#pragma unroll
          for (int nj = 0; nj < 2; ++nj)
#pragma unroll
            for (int q = 0; q < 4; ++q) {
              char* ad = sE + (wm * 64 + mi * 32 + r32) * ES + (nj * 64 + wn * 32 + q * 8 + hi * 4) * 2;
              const u32x2 sg = *(const u32x2*)ad;
              const float y0 = (acc1[mi][nj][4 * q + 0] + sgn * acc2[mi][nj][4 * q + 0]) * sc, y1 = (acc1[mi][nj][4 * q + 1] + sgn * acc2[mi][nj][4 * q + 1]) * sc;
              const float y2 = (acc1[mi][nj][4 * q + 2] + sgn * acc2[mi][nj][4 * q + 2]) * sc, y3 = (acc1[mi][nj][4 * q + 3] + sgn * acc2[mi][nj][4 * q + 3]) * sc;
              u32x2 w = {cvtpk(y0 * bf_lo(sg[0]), y1 * bf_hi(sg[0])), cvtpk(y2 * bf_lo(sg[1]), y3 * bf_hi(sg[1]))};
              *(u32x2*)ad = w;
            }
        __syncthreads();
#pragma unroll
        for (int i = 0; i < 8; ++i) {
          const int id = tid + 512 * i, row = id >> 4, ck = id & 15, tp = j * 256 + row;
          if (!pass || tp >= 1) {
            const int tok = pass ? 2048 - tp : tp;
            *(u32x4*)(SG1 + ((size_t)b * 2048 + tok) * 2048 + G * 128 + ck * 8) = *(const u32x4*)(sE + row * ES + ck * 16);
          }
        }
        __syncthreads();
      }
    }
#undef P8_LOAD
#undef P8_WRITE
#undef P8_COMPUTE
    {
      const float* PX = (const float*)(ws + OFF_PX);
      for (int i = blockIdx.x; i < 256; i += gridDim.x) {
        if (tid < 128) {
          const int b = i >> 4, G = i & 15;
          const float* px = PX + (size_t)b * 2048 + G * 128;
          float y = 0.f;
          for (int c = 0; c < 128; ++c) y += px[c] * bf2f(*(const bf16_t*)(sT + tid * TBS + c * 2));
          bf16_t* gp = SG1 + ((size_t)b * 2048 + 1024) * 2048 + G * 128 + tid;
          *gp = f2bf(y * (1.f / 512.f) * bf2f(*gp));
        }
      }
    }
  }
  }
  if (PLO <= 8 && 8 < PHI) { GSYNC(); }
  if (PLO <= 9 && 9 <= PHI) {

  out_proj((const bf16_t*)(ws + OFF_SG), (const bf16_t*)(ws + OFF_WT_OOUT), MOD + 17 * 3072, (bf16_t*)(ws + OFF_YG), smem);
  }
  if (PLO <= 9 && 9 < PHI) { GSYNC(); }
  if (PLO <= 10 && 10 <= PHI) {

  post_ln_rows((const float*)(ws + OFF_Q), (const bf16_t*)(ws + OFF_YG), p.out, p.post_g + 1024, p.post_b + 1024, nullptr, nullptr);
  }
}

extern "C" void kernel_launch(void* const* d_in, const int* in_sizes, int n_in, void* d_out, int out_size, void* d_ws, size_t ws_size,
                              hipStream_t stream) {
  static int grid_blocks = 0;
  if (!grid_blocks) {
    int dev = 0, cus = 0, per_cu = 0;
    hipGetDevice(&dev);
    hipDeviceGetAttribute(&cus, hipDeviceAttributeMultiprocessorCount, dev);
    hipOccupancyMaxActiveBlocksPerMultiprocessor(&per_cu, mega<0, 10>, 512, 0);
    if (per_cu > 1) per_cu = 1;
    grid_blocks = cus * per_cu;
    if (n_in != 18 || ws_size < WS_NEED) fprintf(stderr, "kernel_launch: unexpected n_in %d or ws_size %zu (need %zu)\n", n_in, ws_size, (size_t)WS_NEED);
  }
  Params p{};
  p.x = (const float*)d_in[0]; p.c = (const float*)d_in[1]; p.ctx = (const float*)d_in[2]; p.c_ctx = (const float*)d_in[3];
  p.w_mod = (const float*)d_in[4]; p.b_mod = (const float*)d_in[5]; p.post_g = (const float*)d_in[6]; p.post_b = (const float*)d_in[7];
  p.e_w_in = (const float*)d_in[8]; p.e_qn = (const float*)d_in[9]; p.e_kn = (const float*)d_in[10]; p.e_vg = (const float*)d_in[11];
  p.e_vb = (const float*)d_in[12]; p.e_ws = (const float*)d_in[13]; p.e_bs = (const float*)d_in[14]; p.e_w_out = (const float*)d_in[15];
  p.o_w_in = (const float*)d_in[16]; p.o_w_out = (const float*)d_in[17];
  p.out = (float*)d_out; p.ws = (char*)d_ws;
#define ONE_LAUNCH 1
#ifdef ONE_LAUNCH
  hipMemsetAsync((char*)d_ws + OFF_XBAR, 0, XCD_BAR_WORDS * 4, stream);
  { void* args[] = {&p};
    hipError_t e = hipLaunchCooperativeKernel((void*)mega<0, 10>, dim3(grid_blocks), dim3(512), args, 0, stream);
    if (e != hipSuccess) fprintf(stderr, "cooperative launch failed: %s (grid %d)\n", hipGetErrorString(e), grid_blocks); }
#else
  hipLaunchKernelGGL((mega<0, 0>), dim3(grid_blocks), dim3(512), 0, stream, p);
  hipLaunchKernelGGL((mega<1, 1>), dim3(grid_blocks), dim3(512), 0, stream, p);
  hipLaunchKernelGGL((mega<2, 2>), dim3(grid_blocks), dim3(512), 0, stream, p);
  hipLaunchKernelGGL((mega<3, 3>), dim3(grid_blocks), dim3(512), 0, stream, p);
  hipLaunchKernelGGL((mega<4, 4>), dim3(grid_blocks), dim3(512), 0, stream, p);
  hipLaunchKernelGGL((mega<5, 5>), dim3(grid_blocks), dim3(512), 0, stream, p);
  hipLaunchKernelGGL((mega<6, 6>), dim3(grid_blocks), dim3(512), 0, stream, p);
  hipLaunchKernelGGL((mega<7, 7>), dim3(grid_blocks), dim3(512), 0, stream, p);
  hipLaunchKernelGGL((mega<8, 8>), dim3(grid_blocks), dim3(512), 0, stream, p);
  hipLaunchKernelGGL((mega<9, 9>), dim3(grid_blocks), dim3(512), 0, stream, p);
  hipLaunchKernelGGL((mega<10, 10>), dim3(grid_blocks), dim3(512), 0, stream, p);
#endif
}
```
